# Optimizing an MI355X kernel written in HIP

```python
import jax, jax.numpy as jnp
from jax import lax
import numpy as np

D_MODEL = 1024
BATCH = 4
SEQ = 4096
DEPTH = 4

ML_WIDTH = D_MODEL // 2
ML_HEADS = 4
ML_HEAD_DIM = ML_WIDTH // ML_HEADS
ML_CHUNK = 128
G_WIDTH = D_MODEL // 4
G_HEADS = 4
G_HEAD_DIM = G_WIDTH // G_HEADS
G_CHUNK = 128
C_WIDTH = D_MODEL // 4
C_GROUPS = 4
CONV_WIDTH = 31
MIX_WIDTH = ML_WIDTH + G_WIDTH + C_WIDTH
P_IN = 4 * ML_WIDTH + 2 * ML_HEADS + 2 * G_WIDTH + 2 * C_WIDTH
N_EXPERTS = 16
N_GROUPS = 4
EXPERTS_PER_GROUP = N_EXPERTS // N_GROUPS
TOP_K = 2
D_EXPERT = D_MODEL // 2
DEEPNORM_ALPHA = (2.0 * DEPTH) ** 0.25
DEEPNORM_BETA = (8.0 * DEPTH) ** -0.25
LN_EPS = 1e-5

kernel_name = "hybrid_mlstm_gmlp_conv_groupmoe_deepnorm"


def layer_norm(x, w, b, eps=LN_EPS):
    xf = x.astype(jnp.float32)
    mu = xf.mean(-1, keepdims=True)
    var = jnp.square(xf - mu).mean(-1, keepdims=True)
    return ((xf - mu) * lax.rsqrt(var + eps) * w.astype(jnp.float32) + b.astype(jnp.float32)).astype(x.dtype)


def mlstm_chunkwise(q, k, v, i_pre, f_pre):
    B_, S_, H_, Dh = q.shape
    L = ML_CHUNK
    NC = S_ // L
    f32 = jnp.float32

    def chunks(t):
        return t.astype(f32).reshape(B_, NC, L, H_, -1).transpose(0, 3, 1, 2, 4)

    q_c = chunks(q)
    k_c = chunks(k) * (Dh ** -0.5)
    v_c = chunks(v)
    logi = i_pre.astype(f32).reshape(B_, NC, L, H_).transpose(0, 3, 1, 2)
    logf = jax.nn.log_sigmoid(f_pre.astype(f32)).reshape(B_, NC, L, H_).transpose(0, 3, 1, 2)
    b = jnp.cumsum(logf, axis=-1)
    g = b[..., -1]
    a = g[..., None] - b + logi

    def step(carry, xs):
        C, n, m = carry
        k_j, v_j, a_j, g_j = xs
        m_new = jnp.maximum(g_j + m, a_j.max(-1))
        w = jnp.exp(a_j - m_new[..., None])
        decay = jnp.exp(g_j + m - m_new)
        C_new = decay[..., None, None] * C + jnp.einsum('bhl,bhld,bhle->bhde', w, k_j, v_j)
        n_new = decay[..., None] * n + jnp.einsum('bhl,bhld->bhd', w, k_j)
        return (C_new, n_new, m_new), (C, n, m)

    init = (jnp.zeros((B_, H_, Dh, Dh), f32), jnp.zeros((B_, H_, Dh), f32), jnp.zeros((B_, H_), f32))
    xs = (jnp.moveaxis(k_c, 2, 0), jnp.moveaxis(v_c, 2, 0), jnp.moveaxis(a, 2, 0), jnp.moveaxis(g, 2, 0))
    _, (C_prev, n_prev, m_prev) = lax.scan(step, init, xs)
    C_prev = jnp.moveaxis(C_prev, 0, 2)
    n_prev = jnp.moveaxis(n_prev, 0, 2)
    m_prev = jnp.moveaxis(m_prev, 0, 2)

    causal = jnp.tril(jnp.ones((L, L), bool))
    log_d = jnp.where(causal, b[..., :, None] - b[..., None, :] + logi[..., None, :], -jnp.inf)
    log_inter = b + m_prev[..., None]
    m_row = jnp.maximum(log_inter, log_d.max(-1))
    p = jnp.einsum('bhcld,bhcsd->bhcls', q_c, k_c) * jnp.exp(log_d - m_row[..., None])
    w_inter = jnp.exp(log_inter - m_row)
    num = jnp.einsum('bhcls,bhcsd->bhcld', p, v_c) + w_inter[..., None] * jnp.einsum('bhcld,bhcde->bhcle', q_c, C_prev)
    den = p.sum(-1) + w_inter * jnp.einsum('bhcld,bhcd->bhcl', q_c, n_prev)
    h = num / jnp.maximum(jnp.abs(den), jnp.exp(-m_row))[..., None]
    return h.transpose(0, 2, 3, 1, 4).reshape(B_, S_, H_ * Dh)


def mixer(x, w_in, b_in, mlstm_norm_w, gmlp_norm_w, gmlp_norm_b, gmlp_ws, gmlp_bs,
          conv_w, conv_b, conv_norm_w, conv_norm_b, w_out):
    B_, S_, _ = x.shape
    proj = x @ w_in + b_in
    sizes = (ML_WIDTH,) * 4 + (ML_HEADS,) * 2 + (G_WIDTH,) * 2 + (C_WIDTH,) * 2
    q, k, v, o, i_pre, f_pre, gu, gv, ca, cb = jnp.split(proj, np.cumsum(sizes)[:-1].tolist(), axis=-1)

    heads = lambda t: t.reshape(B_, S_, ML_HEADS, ML_HEAD_DIM)
    h = mlstm_chunkwise(heads(q), heads(k), heads(v), i_pre, f_pre)
    hh = h.reshape(B_, S_, ML_HEADS, ML_HEAD_DIM)
    mu = hh.mean(-1, keepdims=True)
    var = jnp.square(hh - mu).mean(-1, keepdims=True)
    hh = ((hh - mu) * lax.rsqrt(var + 1e-6)).reshape(B_, S_, ML_WIDTH) * mlstm_norm_w.astype(jnp.float32)
    h_a = (jax.nn.sigmoid(o.astype(jnp.float32)) * hh).astype(x.dtype)

    u = jax.nn.gelu(gu)
    z = layer_norm(jax.nn.gelu(gv), gmlp_norm_w, gmlp_norm_b)
    z = z.reshape(B_, S_ // G_CHUNK, G_CHUNK, G_HEADS, G_HEAD_DIM)
    ws = gmlp_ws * jnp.tril(jnp.ones((G_CHUNK, G_CHUNK), gmlp_ws.dtype))
    z = jnp.einsum('hts,bcshd->bcthd', ws, z) + gmlp_bs.T[:, :, None]
    h_b = u * z.reshape(B_, S_, G_WIDTH)

    c = ca * jax.nn.sigmoid(cb)
    c = lax.conv_general_dilated(c, conv_w[:, None, :], window_strides=(1,),
                                 padding=[(CONV_WIDTH - 1, 0)],
                                 dimension_numbers=('NWC', 'WIO', 'NWC'),
                                 feature_group_count=C_WIDTH) + conv_b
    h_c = jax.nn.silu(layer_norm(c, conv_norm_w, conv_norm_b))

    return jnp.concatenate([h_a, h_b, h_c], axis=-1) @ w_out


def moe(x, router_w, router_b, w_gate, w_up, w_down):
    B_, S_, D_ = x.shape
    xt = x.reshape(B_ * S_, D_)
    s = jax.nn.sigmoid(xt.astype(jnp.float32) @ router_w.astype(jnp.float32))
    sel = s + router_b.astype(jnp.float32)
    gscore = lax.top_k(sel.reshape(-1, N_GROUPS, EXPERTS_PER_GROUP), 2)[0].sum(-1)
    gidx = jnp.argmax(gscore, axis=-1)
    in_group = (jnp.arange(N_EXPERTS) // EXPERTS_PER_GROUP)[None, :] == gidx[:, None]
    _, eidx = lax.top_k(jnp.where(in_group, sel, -jnp.inf), TOP_K)
    gate = jnp.take_along_axis(s, eidx, axis=1)
    gate = gate / gate.sum(-1, keepdims=True)
    combine = (jax.nn.one_hot(eidx, N_EXPERTS, dtype=jnp.float32) * gate[..., None]).sum(1).astype(x.dtype)
    out = jnp.zeros_like(xt)
    for e in range(N_EXPERTS):
        hid = jax.nn.silu(xt @ w_gate[e]) * (xt @ w_up[e])
        out = out + combine[:, e:e + 1] * (hid @ w_down[e])
    return out.reshape(B_, S_, D_)


def setup_inputs(seed: int = 0) -> dict:
    key = jax.random.key(seed)
    ks = jax.random.split(key, 24)
    f32 = jnp.float32
    nrm = lambda k, shape, scale: jax.random.normal(k, shape, f32) * scale
    L = DEPTH
    x = nrm(ks[0], (BATCH, SEQ, D_MODEL), 1.0)
    v_lo = 2 * ML_WIDTH
    w_in = nrm(ks[1], (L, D_MODEL, P_IN), D_MODEL ** -0.5)
    w_in = w_in.at[:, :, v_lo:v_lo + ML_WIDTH].multiply(DEEPNORM_BETA)
    f_lo = 4 * ML_WIDTH + ML_HEADS
    b_in = nrm(ks[2], (L, P_IN), 0.02).at[:, f_lo:f_lo + ML_HEADS].add(jnp.linspace(3.0, 6.0, ML_HEADS))
    mlstm_norm_w = 1.0 + nrm(ks[3], (L, ML_WIDTH), 0.02)
    gmlp_norm_w = 1.0 + nrm(ks[4], (L, G_WIDTH), 0.02)
    gmlp_norm_b = nrm(ks[5], (L, G_WIDTH), 0.02)
    gmlp_ws = nrm(ks[6], (L, G_HEADS, G_CHUNK, G_CHUNK), G_CHUNK ** -0.5)
    gmlp_bs = 1.0 + nrm(ks[7], (L, G_HEADS, G_CHUNK), 0.02)
    conv_w = nrm(ks[8], (L, CONV_WIDTH, C_WIDTH), CONV_WIDTH ** -0.5)
    conv_b = nrm(ks[9], (L, C_WIDTH), 0.02)
    conv_norm_w = 1.0 + nrm(ks[10], (L, C_WIDTH), 0.02)
    conv_norm_b = nrm(ks[11], (L, C_WIDTH), 0.02)
    w_out = nrm(ks[12], (L, MIX_WIDTH, D_MODEL), MIX_WIDTH ** -0.5 * DEEPNORM_BETA)
    ln1_w = 1.0 + nrm(ks[13], (L, D_MODEL), 0.02)
    ln1_b = nrm(ks[14], (L, D_MODEL), 0.02)
    router_w = nrm(ks[15], (D_MODEL, N_EXPERTS), D_MODEL ** -0.5)
    router_b = nrm(ks[16], (N_EXPERTS,), 0.01)
    w_gate = nrm(ks[17], (L, N_EXPERTS, D_MODEL, D_EXPERT), D_MODEL ** -0.5)
    w_up = nrm(ks[18], (L, N_EXPERTS, D_MODEL, D_EXPERT), D_MODEL ** -0.5)
    w_down = nrm(ks[19], (L, N_EXPERTS, D_EXPERT, D_MODEL), D_EXPERT ** -0.5 * DEEPNORM_BETA)
    ln2_w = 1.0 + nrm(ks[20], (L, D_MODEL), 0.02)
    ln2_b = nrm(ks[21], (L, D_MODEL), 0.02)
    return {"x": x, "w_in": w_in, "b_in": b_in, "mlstm_norm_w": mlstm_norm_w,
            "gmlp_norm_w": gmlp_norm_w, "gmlp_norm_b": gmlp_norm_b, "gmlp_ws": gmlp_ws, "gmlp_bs": gmlp_bs,
            "conv_w": conv_w, "conv_b": conv_b, "conv_norm_w": conv_norm_w, "conv_norm_b": conv_norm_b,
            "w_out": w_out, "ln1_w": ln1_w, "ln1_b": ln1_b, "router_w": router_w, "router_b": router_b,
            "w_gate": w_gate, "w_up": w_up, "w_down": w_down, "ln2_w": ln2_w, "ln2_b": ln2_b}


def reference(x, w_in, b_in, mlstm_norm_w, gmlp_norm_w, gmlp_norm_b, gmlp_ws, gmlp_bs,
              conv_w, conv_b, conv_norm_w, conv_norm_b, w_out, ln1_w, ln1_b, router_w, router_b,
              w_gate, w_up, w_down, ln2_w, ln2_b):
    for l in range(DEPTH):
        y = mixer(x, w_in[l], b_in[l], mlstm_norm_w[l], gmlp_norm_w[l], gmlp_norm_b[l], gmlp_ws[l], gmlp_bs[l],
                  conv_w[l], conv_b[l], conv_norm_w[l], conv_norm_b[l], w_out[l])
        x = layer_norm(DEEPNORM_ALPHA * x + y, ln1_w[l], ln1_b[l])
        y = moe(x, router_w, router_b, w_gate[l], w_up[l], w_down[l])
        x = layer_norm(DEEPNORM_ALPHA * x + y, ln2_w[l], ln2_b[l])
    return x
```

```cpp
#include <hip/hip_runtime.h>
#include <cstdio>
#include <cstdint>
namespace pg8 {
#define PG8_LAS __attribute__((address_space(3)))
typedef unsigned short bf16_t;
typedef short bf16x8 __attribute__((ext_vector_type(8)));
typedef float f32x4 __attribute__((ext_vector_type(4)));
typedef unsigned u32x4 __attribute__((ext_vector_type(4)));
constexpr int BM = 256, BK = 64, HALF = 128, HTB = HALF * BK * 2  , STAGE_BYTES = 8 * HTB, NXCD = 8, WGM = 8;

__host__ __device__ __forceinline__ int lds_byte(int r, int c) { const int st = (r >> 4) * 2 + (c >> 5), rr = r & 15, cc = c & 31, ob = rr * 64 + cc * 2; return st * 1024 + (ob ^ (((ob >> 9) & 1) << 5)); }
__host__ __device__ __forceinline__ void stage_rc(int b, int& R, int& C) { const int st = b / 1024, sb = b % 1024, swz = sb ^ (((sb >> 9) & 1) << 5); R = (st >> 1) * 16 + swz / 64; C = (st & 1) * 32 + (swz % 64) / 2; }
__host__ __device__ __forceinline__ int perm32(int rho) { const int n = rho >> 4, i = rho & 15; return 8 * (i >> 2) + 4 * n + (i & 3); }

struct Unit { int pm, pn; };
struct Gemm { const bf16_t* A; const bf16_t* Bt; int M, N, K; };

struct StaticOrder {
    int nM, nN, nwg, G, c;
    __host__ __device__ void init(int M, int N, int G_, int c_) { nM = M / BM; nN = N / BM; nwg = nM * nN; G = G_; c = c_; }
    __host__ __device__ bool next(int i, Unit& u) const {
        const long L = (long)i * G + c; if (L >= nwg) return false;
        int wgid = (int)L; { const int q = nwg / NXCD, r = nwg % NXCD, xcd = wgid % NXCD, off = wgid / NXCD; wgid = (xcd < r ? xcd * (q + 1) : r * (q + 1) + (xcd - r) * q) + off; }
        const int nig = WGM * nN, gid = wgid / nig, fm = gid * WGM, gsz = (nM - fm) < WGM ? (nM - fm) : WGM;
        u.pm = fm + ((wgid % nig) % gsz); u.pn = (wgid % nig) / gsz; return true;
    }
    __device__ __forceinline__ void a_ready(const Unit&) const {}
    __device__ __forceinline__ void done(const Unit&) const {}
};
struct ListOrder {
    const int* meta; int nunits, G, c;
    __device__ __forceinline__ bool next(int i, Unit& u) const {
        const int L = i * G + c; if (L >= nunits) return false;
        const int rt = L >> 2; u.pm = rt; u.pn = __builtin_amdgcn_readfirstlane(meta[16 + rt]) * 4 + (L & 3); return true;
    }
    __device__ __forceinline__ void a_ready(const Unit&) const {}
    __device__ __forceinline__ void done(const Unit&) const {}
};

__device__ __forceinline__ unsigned cvt_pk_bf16(float lo, float hi) { unsigned r; asm volatile("v_cvt_pk_bf16_f32 %0, %1, %2" : "=v"(r) : "v"(lo), "v"(hi)); return r; }

struct EpiStoreBf16 {
    static constexpr bool PERM = true, AFTER_DRAIN = false;
    bf16_t* O; int ldc; const float* bias; int pn_mask;
    __device__ __forceinline__ void operator()(const f32x4 (&acc)[2][2][4][2], const Unit& u, int wr, int wc, int fr, int fq) const {
        const int row0 = u.pm * BM + wr * 64 + fr; const int col0 = (u.pn & pn_mask) * BM + wc * 32 + 8 * fq;
        f32x4 bv[2][2];
#pragma unroll
        for (int bj = 0; bj < 2; ++bj)
#pragma unroll
            for (int n = 0; n < 2; ++n) bv[bj][n] = bias ? *(const f32x4*)(bias + col0 + bj * HALF + 4 * n) : (f32x4){0.f, 0.f, 0.f, 0.f};
#pragma unroll
        for (int ai = 0; ai < 2; ++ai)
#pragma unroll
            for (int m = 0; m < 4; ++m) { bf16_t* rowp = O + (size_t)(row0 + ai * HALF + m * 16) * ldc + col0;
#pragma unroll
                for (int bj = 0; bj < 2; ++bj) { const f32x4 v0 = acc[ai][bj][m][0] + bv[bj][0], v1 = acc[ai][bj][m][1] + bv[bj][1];
                    u32x4 w; w.x = cvt_pk_bf16(v0[0], v0[1]); w.y = cvt_pk_bf16(v0[2], v0[3]); w.z = cvt_pk_bf16(v1[0], v1[1]); w.w = cvt_pk_bf16(v1[2], v1[3]);
                    *(u32x4*)(rowp + bj * HALF) = w; } }
    }
};
struct EpiSwiGLU {
    static constexpr bool PERM = true, AFTER_DRAIN = false;
    bf16_t* O; int ldc;
    __device__ __forceinline__ void operator()(const f32x4 (&acc)[2][2][4][2], const Unit& u, int wr, int wc, int fr, int fq) const {
        const int row0 = u.pm * BM + wr * 64 + fr; const int col0 = (u.pn & 3) * HALF + wc * 32 + 8 * fq;
#pragma unroll
        for (int ai = 0; ai < 2; ++ai)
#pragma unroll
            for (int m = 0; m < 4; ++m) { bf16_t* rowp = O + (size_t)(row0 + ai * HALF + m * 16) * ldc + col0;
                float h[8];
#pragma unroll
                for (int n = 0; n < 2; ++n)
#pragma unroll
                    for (int k = 0; k < 4; ++k) { const float g = acc[ai][0][m][n][k], up = acc[ai][1][m][n][k]; h[4 * n + k] = g * up / (1.0f + __expf(-g)); }
                u32x4 w; w.x = cvt_pk_bf16(h[0], h[1]); w.y = cvt_pk_bf16(h[2], h[3]); w.z = cvt_pk_bf16(h[4], h[5]); w.w = cvt_pk_bf16(h[6], h[7]);
                *(u32x4*)rowp = w; }
    }
};
template <class Epi, class Sched, bool ALIGN_EPI = false, bool SP2 = false>
__device__ __forceinline__ void gemm_phase(PG8_LAS unsigned char* lds, const Gemm g, const Sched& S, const Epi& E) {
    int tid_l = threadIdx.x; asm volatile("" : "+v"(tid_l)); const int tid = tid_l, wid = __builtin_amdgcn_readfirstlane(tid >> 6), lane = tid & 63, wr = wid >> 2, wc = wid & 3, fr = lane & 15, fq = lane >> 4;
    const int K = g.K, nt = K / BK;
    unsigned voffA[2], voffB[2];
#pragma unroll
    for (int i = 0; i < 2; ++i) { int R, C; stage_rc(tid * 16 + i * 8192, R, C); const int Rb = Epi::PERM ? ((R & ~31) + perm32(R & 31)) : R;
        voffA[i] = (unsigned)(R * K + C) * 2u; voffB[i] = (unsigned)(Rb * K + C) * 2u; }
    const size_t kstep = (size_t)(BK * 2);
    const size_t hstep = (size_t)HALF * K * 2;
    const size_t tstep = 2 * hstep;
    const unsigned ldsw = (unsigned)wid * 1024u;
    const int aoff = lds_byte(wr * 64 + fr, fq * 8), boff = lds_byte(wc * 32 + fr, fq * 8);
#define PG8_SA(b, h) (((b) * 2 + (h)) * HTB)
#define PG8_SB(b, h) ((4 + (b) * 2 + (h)) * HTB)
#define PG8_STAGE(bufoff, gbase, voff) do { _Pragma("unroll") for (int _i = 0; _i < 2; ++_i) \
        __builtin_amdgcn_global_load_lds((const unsigned*)((const char*)(gbase) + (voff)[_i]), (PG8_LAS unsigned*)(lds + (bufoff) + ldsw + _i * 8192), 16, 0, 0); } while (0)
#define PG8_LDA(dst, b, h) do { _Pragma("unroll") for (int m = 0; m < 4; ++m) _Pragma("unroll") for (int k = 0; k < 2; ++k) dst[m][k] = *(const PG8_LAS bf16x8*)(lds + PG8_SA(b, h) + aoff + m * 2048 + k * 1024); } while (0)
#define PG8_LDB(dst, b, h) do { _Pragma("unroll") for (int n = 0; n < 2; ++n) _Pragma("unroll") for (int k = 0; k < 2; ++k) dst[n][k] = *(const PG8_LAS bf16x8*)(lds + PG8_SB(b, h) + boff + n * 2048 + k * 1024); } while (0)
#define PG8_MMA(ai, bj, At, Bt) do { __builtin_amdgcn_s_setprio(1); _Pragma("unroll") for (int m = 0; m < 4; ++m) _Pragma("unroll") for (int n = 0; n < 2; ++n) _Pragma("unroll") for (int k = 0; k < 2; ++k) \
        acc[ai][bj][m][n] = __builtin_amdgcn_mfma_f32_16x16x32_bf16(Bt[n][k], At[m][k], acc[ai][bj][m][n], 0, 0, 0); __builtin_amdgcn_s_setprio(0); } while (0)
#define PG8_WAIT_V(n) asm volatile("s_waitcnt vmcnt(" #n ")" ::: "memory")
#define PG8_WAIT_L(n) asm volatile("s_waitcnt lgkmcnt(" #n ")" ::: "memory")
#define PG8_BAR __builtin_amdgcn_s_barrier()
#define PG8_SCHED __builtin_amdgcn_sched_barrier(0)
    Unit cur, nxt; int ui = 0;
    if (!S.next(0, cur)) return;
    f32x4 acc[2][2][4][2];
#pragma unroll
    for (int a = 0; a < 2; ++a)
#pragma unroll
        for (int b = 0; b < 2; ++b)
#pragma unroll
            for (int m = 0; m < 4; ++m)
#pragma unroll
                for (int n = 0; n < 2; ++n) acc[a][b][m][n] = (f32x4){0.f, 0.f, 0.f, 0.f};
    bf16x8 At[4][2], B0[2][2], B1[2][2];
    const char* cA = (const char*)g.A + (size_t)cur.pm * tstep; const char* cB = (const char*)g.Bt + (size_t)cur.pn * tstep;
    S.a_ready(cur);
    if constexpr (SP2) {
        PG8_STAGE(PG8_SB(0, 0), cB, voffB); PG8_STAGE(PG8_SB(0, 1), cB + hstep, voffB); PG8_STAGE(PG8_SA(0, 0), cA, voffA); PG8_STAGE(PG8_SA(0, 1), cA + hstep, voffA);
        if (wr == 1) PG8_BAR;
        PG8_WAIT_V(2); PG8_BAR;
        PG8_STAGE(PG8_SB(1, 0), cB + kstep, voffB); PG8_STAGE(PG8_SA(1, 0), cA + kstep, voffA); PG8_STAGE(PG8_SB(1, 1), cB + hstep + kstep, voffB);
        PG8_WAIT_V(6); PG8_BAR;
    } else {
        PG8_STAGE(PG8_SB(0, 0), cB, voffB); PG8_STAGE(PG8_SA(0, 0), cA, voffA); PG8_STAGE(PG8_SB(0, 1), cB + hstep, voffB); PG8_STAGE(PG8_SA(0, 1), cA + hstep, voffA);
        if (wr == 1) PG8_BAR;
        PG8_WAIT_V(4); PG8_BAR;
        PG8_STAGE(PG8_SB(1, 0), cB + kstep, voffB); PG8_STAGE(PG8_SA(1, 0), cA + kstep, voffA); PG8_STAGE(PG8_SB(1, 1), cB + hstep + kstep, voffB);
        PG8_WAIT_V(6); PG8_BAR;
    }
    for (;;) {
        const bool has_next = S.next(ui + 1, nxt);
        const char* nA = has_next ? (const char*)g.A + (size_t)nxt.pm * tstep : cA; const char* nB = has_next ? (const char*)g.Bt + (size_t)nxt.pn * tstep : cB;
        for (int t = 0; t < nt; t += 2) {
            const bool last = (t == nt - 2);
            const char* a1 = cA + (size_t)(t + 1) * kstep;
            const char* a2 = last ? nA : cA + (size_t)(t + 2) * kstep; const char* b2 = last ? nB : cB + (size_t)(t + 2) * kstep;
            const char* a3 = a2 + kstep; const char* b3 = b2 + kstep;
            if (last && has_next) S.a_ready(nxt);
            if constexpr (SP2) {
            PG8_LDB(B0, 0, 0); PG8_LDB(B1, 0, 1); PG8_SCHED; PG8_LDA(At, 0, 0); PG8_STAGE(PG8_SA(1, 1), a1 + hstep, voffA);
            PG8_WAIT_V(8); PG8_WAIT_L(0); PG8_BAR; PG8_MMA(0, 0, At, B0); PG8_MMA(0, 1, At, B1); PG8_BAR; PG8_SCHED;
            PG8_LDA(At, 0, 1); PG8_STAGE(PG8_SB(0, 0), b2, voffB); PG8_STAGE(PG8_SB(0, 1), b2 + hstep, voffB); PG8_STAGE(PG8_SA(0, 0), a2, voffA);
            PG8_WAIT_V(8); PG8_WAIT_L(0); PG8_BAR; PG8_MMA(1, 0, At, B0); PG8_MMA(1, 1, At, B1); PG8_BAR; PG8_SCHED;
            PG8_LDB(B0, 1, 0); PG8_LDB(B1, 1, 1); PG8_SCHED; PG8_LDA(At, 1, 0); PG8_STAGE(PG8_SA(0, 1), a2 + hstep, voffA);
            PG8_WAIT_V(8); PG8_WAIT_L(0); PG8_BAR; PG8_MMA(0, 0, At, B0); PG8_MMA(0, 1, At, B1); PG8_BAR; PG8_SCHED;
            PG8_LDA(At, 1, 1); PG8_STAGE(PG8_SB(1, 0), b3, voffB); PG8_STAGE(PG8_SB(1, 1), b3 + hstep, voffB); PG8_STAGE(PG8_SA(1, 0), a3, voffA);
            PG8_WAIT_V(8); PG8_WAIT_L(0); PG8_BAR; PG8_MMA(1, 0, At, B0); PG8_MMA(1, 1, At, B1); PG8_BAR; PG8_SCHED;
            } else {
            PG8_LDB(B0, 0, 0); PG8_SCHED; PG8_LDA(At, 0, 0); PG8_STAGE(PG8_SA(1, 1), a1 + hstep, voffA);
            PG8_WAIT_L(8); PG8_BAR; PG8_WAIT_L(0); PG8_MMA(0, 0, At, B0); PG8_BAR; PG8_SCHED;
            PG8_LDB(B1, 0, 1); PG8_STAGE(PG8_SB(0, 0), b2, voffB);
            PG8_BAR; PG8_WAIT_L(0); PG8_MMA(0, 1, At, B1); PG8_BAR;
            PG8_LDA(At, 0, 1); PG8_STAGE(PG8_SA(0, 0), a2, voffA);
            PG8_BAR; PG8_WAIT_L(0); PG8_MMA(1, 0, At, B0); PG8_BAR; PG8_SCHED;
            PG8_STAGE(PG8_SB(0, 1), b2 + hstep, voffB);
            PG8_WAIT_V(6); PG8_BAR; PG8_MMA(1, 1, At, B1); PG8_BAR;
            PG8_LDB(B0, 1, 0); PG8_SCHED; PG8_LDA(At, 1, 0); PG8_STAGE(PG8_SA(0, 1), a2 + hstep, voffA);
            PG8_WAIT_L(8); PG8_BAR; PG8_WAIT_L(0); PG8_MMA(0, 0, At, B0); PG8_BAR; PG8_SCHED;
            PG8_LDB(B1, 1, 1); PG8_STAGE(PG8_SB(1, 0), b3, voffB);
            PG8_BAR; PG8_WAIT_L(0); PG8_MMA(0, 1, At, B1); PG8_BAR;
            PG8_LDA(At, 1, 1); PG8_STAGE(PG8_SA(1, 0), a3, voffA);
            PG8_BAR; PG8_WAIT_L(0); PG8_MMA(1, 0, At, B0); PG8_BAR; PG8_SCHED;
            PG8_STAGE(PG8_SB(1, 1), b3 + hstep, voffB);
            PG8_WAIT_V(6); PG8_BAR; PG8_MMA(1, 1, At, B1); PG8_BAR;
            }
        }
        if constexpr (ALIGN_EPI) { if (wr == 0) PG8_BAR; }
        if constexpr (!Epi::AFTER_DRAIN) { E(acc, cur, wr, wc, fr, fq); S.done(cur); }
        if (!has_next) break;
#pragma unroll
        for (int a = 0; a < 2; ++a)
#pragma unroll
            for (int b = 0; b < 2; ++b)
#pragma unroll
                for (int m = 0; m < 4; ++m)
#pragma unroll
                    for (int n = 0; n < 2; ++n) acc[a][b][m][n] = (f32x4){0.f, 0.f, 0.f, 0.f};
        cur = nxt; cA = nA; cB = nB; ++ui;
        if constexpr (ALIGN_EPI) { if (wr == 1) PG8_BAR; }
    }
    PG8_WAIT_V(0);
    if constexpr (!ALIGN_EPI) { if (wr == 0) PG8_BAR; }
    PG8_BAR;
    if constexpr (Epi::AFTER_DRAIN) { E.fused(acc, cur, wr, wc, fr, fq, lds, wid, lane); S.done(cur); }
#undef PG8_SA
#undef PG8_SB
#undef PG8_STAGE
#undef PG8_LDA
#undef PG8_LDB
#undef PG8_MMA
#undef PG8_WAIT_V
#undef PG8_WAIT_L
#undef PG8_BAR
#undef PG8_SCHED
}
}
#ifndef DBG_CHECK
#define DBG_CHECK 0
#endif
#define DBG_LAYER 0
#define DBG_BIAS 0
constexpr int NWAVES = 8, NTHREADS = 512, GRID = 256;
constexpr int NLAYER_RUN = DBG_CHECK ? (DBG_LAYER + 1) : 4;
constexpr int T = 16384, D = 1024, SEQ = 4096, NLAYER = 4;
constexpr int PIN = 3080, NPROJ = 3072;
constexpr int CH = 128, NCH = 32, NUNIT = 512;
constexpr int NEXP = 16, DEXP = 512;
constexpr int PADROWS = 36864;
constexpr float ALPHA = 1.6817928305074290f;
constexpr float LN_EPS = 1e-5f;
constexpr int PQ = 0, PK = 512, PV = 1024, PO = 1536, PGU = 2048, PGV = 2304, PCA = 2560, PCB = 2816;
constexpr size_t MiB = 1u << 20;
constexpr size_t WS_CTL = 0, CTL_ZERO_BYTES = 1 * MiB;
constexpr size_t WS_WIN = 2 * MiB, WS_WOUT = 8 * MiB, WS_WGU = 10 * MiB, WS_WD = 42 * MiB;
constexpr size_t WS_SMALL = 58 * MiB;
constexpr size_t SM_BIAS = WS_SMALL;
constexpr size_t SM_GATES = WS_SMALL + 64 * 1024;
constexpr size_t SM_SEL = SM_GATES + 512 * 1024;
constexpr size_t SM_HIST = SM_SEL + 256 * 1024;
constexpr size_t SM_META = SM_HIST + 16 * 1024;
constexpr size_t SM_TOKSLOT = SM_META + 4 * 1024;
constexpr size_t SM_G = SM_TOKSLOT + 128 * 1024;
constexpr size_t SM_MLOC = SM_G + 2048;
constexpr size_t SM_MPREV = SM_MLOC + 2048;
constexpr size_t SM_NLOC = SM_MPREV + 2048;
constexpr size_t SM_NPREV = SM_NLOC + 256 * 1024;
constexpr size_t SM_END = SM_NPREV + 256 * 1024;
constexpr size_t SM_GW = SM_END;
static_assert(SM_GW + 128 * 1024 <= 62 * MiB, "small region");
constexpr size_t WS_XN = 62 * MiB, WS_HCAT = 94 * MiB, WS_X1 = 126 * MiB, WS_CLOCT = 190 * MiB, WS_CPREVT = 222 * MiB, WS_HID = 238 * MiB;
constexpr size_t WS_PROJ = 274 * MiB;
constexpr size_t WS_END = 370 * MiB;
static_assert(WS_HID + (size_t)PADROWS * DEXP * 2 <= WS_PROJ && WS_PROJ + (size_t)PADROWS * D * 2 <= WS_END && WS_PROJ + (size_t)T * NPROJ * 2 <= WS_END, "ws map");
constexpr int CW_TMO = 0, CW_BAR = 4096;
constexpr int RING_BYTES = 131072, LDSCTL_OFF = 131072, MISC_OFF = LDSCTL_OFF + 320, PTR_OFF = LDSCTL_OFF + 512, VEC_OFF = LDSCTL_OFF + 1024, LDS_BYTES = 147456;

#define LAS __attribute__((address_space(3)))
typedef unsigned short bf16;
typedef unsigned v4u __attribute__((ext_vector_type(4)));
typedef unsigned v2u __attribute__((ext_vector_type(2)));
typedef float f32x4 __attribute__((ext_vector_type(4)));
typedef float f32x2 __attribute__((ext_vector_type(2)));
#define DI __device__ __forceinline__
DI unsigned f2bf(float f) { unsigned u = __builtin_bit_cast(unsigned, f); return (u + 0x7fffu + ((u >> 16) & 1u)) >> 16; }
DI unsigned pk2(float lo, float hi) { return f2bf(lo) | (f2bf(hi) << 16); }
DI float bflo(unsigned w) { return __builtin_bit_cast(float, w << 16); }
DI float bfhi(unsigned w) { return __builtin_bit_cast(float, w & 0xffff0000u); }
DI float bf2f(bf16 h) { return __builtin_bit_cast(float, (unsigned)h << 16); }
DI float wave_sum(float v) {
#pragma unroll
    for (int o = 1; o < 64; o <<= 1) v += __shfl_xor(v, o);
    return v;
}
DI float sigmoidf_(float x) { return 1.0f / (1.0f + __expf(-x)); }
DI float gelu_tanh(float x) { const float u = 0.7978845608028654f * (x + 0.044715f * x * x * x); const float e = __expf(2.0f * u); const float th = 1.0f - 2.0f / (e + 1.0f); return 0.5f * x * (1.0f + th); }
DI float logsigmoidf_(float x) { return fminf(x, 0.0f) - log1pf(__expf(-fabsf(x))); }

#define XB_TMO      128
#define XB_XCNT(j)  (256  + 64 * (j))
#define XB_XSUB(j)  (1280 + 64 * (j))
#define XB_XGEN(j)  (2304 + 64 * (j))
#define XB_TOP      3328
#define XB_TOPGEN   3392
#define XCD_BAR_WORDS 3456
#define XB_SPIN_CAP (1u << 18)
__device__ __forceinline__ unsigned xb_ld(unsigned* p)              { return __hip_atomic_load(p, __ATOMIC_RELAXED, __HIP_MEMORY_SCOPE_AGENT); }
__device__ __forceinline__ unsigned xb_add(unsigned* p, unsigned v) { return __hip_atomic_fetch_add(p, v, __ATOMIC_RELAXED, __HIP_MEMORY_SCOPE_AGENT); }
__device__ __forceinline__ unsigned xb_xcc_id() { return (unsigned)__builtin_amdgcn_s_getreg((3 << 11) | 20) & 0xFu; }
#define XB_SPIN(cond, bar) do { unsigned _sp = 0; while (cond) { __builtin_amdgcn_s_sleep(1); \
    if ((++_sp & 255u) == 0u) { if (xb_ld(&(bar)[XB_TMO])) break; if (_sp > XB_SPIN_CAP) { atomicAdd(&(bar)[XB_TMO], 1u); break; } } } } while (0)
struct XcdBarrier { unsigned* bar; unsigned x; volatile LAS unsigned* st; };
__device__ __forceinline__ XcdBarrier xcd_barrier_post(unsigned* bar, volatile LAS unsigned* st) {
    XcdBarrier b; b.bar = bar; b.x = xb_xcc_id(); b.st = st;
    if (threadIdx.x == 0) (void)xb_add(&bar[XB_XCNT(b.x)], 1u);
    return b;
}
__device__ __forceinline__ void xcd_barrier_complete(unsigned* bar, unsigned x, unsigned& nloc, unsigned& nx) {
    const unsigned G = gridDim.x * gridDim.y * gridDim.z;
    unsigned sum, cnt, mine, sp = 0u;
    for (;;) {
        sum = 0u; cnt = 0u; mine = 0u;
#pragma unroll
        for (unsigned j = 0; j < 16; ++j) { const unsigned c = xb_ld(&bar[XB_XCNT(j)]); sum += c; cnt += (c > 0u) ? 1u : 0u; mine = (j == x) ? c : mine; }
        if (sum == G) break;
        __builtin_amdgcn_s_sleep(1);
        if ((++sp & 255u) == 0u) { if (xb_ld(&bar[XB_TMO])) break; if (sp > XB_SPIN_CAP) { atomicAdd(&bar[XB_TMO], 1u); break; } }
    }
    nloc = mine > 0u ? mine : 1u; nx = cnt > 0u ? cnt : 1u;
}
template <bool FIRST> __device__ __forceinline__ void xcd_barrier(const XcdBarrier& b) {
    asm volatile("s_waitcnt vmcnt(0)" ::: "memory");
    __syncthreads();
    if (threadIdx.x == 0) {
        unsigned* bar = b.bar; unsigned bx = b.x; { int z_ = 0; asm volatile("" : "+s"(z_)); bar += z_; bx += (unsigned)z_; }
        __builtin_amdgcn_s_waitcnt(0);
        unsigned nloc = b.st[0], nx = b.st[1];
        if (FIRST) { if (nloc == 0u) { xcd_barrier_complete(bar, bx, nloc, nx); b.st[0] = nloc; b.st[1] = nx; } }
        const unsigned old = xb_add(&bar[XB_XSUB(bx)], 1u);
        const unsigned gen = old / nloc;
        if (old + 1u == (gen + 1u) * nloc) {
            __builtin_amdgcn_fence(__ATOMIC_RELEASE, "agent");
            asm volatile("s_waitcnt vmcnt(0)" ::: "memory");
            const unsigned og = xb_add(&bar[XB_TOP], 1u);
            const unsigned tg = og / nx;
            if (og + 1u == (tg + 1u) * nx) xb_add(&bar[XB_TOPGEN], 1u);
            else XB_SPIN(xb_ld(&bar[XB_TOPGEN]) == tg, bar);
            __builtin_amdgcn_fence(__ATOMIC_ACQUIRE, "agent");
            xb_add(&bar[XB_XGEN(bx)], 1u);
            asm volatile("s_waitcnt vmcnt(0)" ::: "memory");
        } else {
            XB_SPIN(xb_ld(&bar[XB_XGEN(bx)]) == gen, bar);
            __builtin_amdgcn_fence(__ATOMIC_ACQUIRE, "agent");
            asm volatile("s_waitcnt vmcnt(0)" ::: "memory");
        }
    }
    __syncthreads();
}

struct Args { const float* in[22]; float* out; unsigned char* ws; };
struct Ctx { LAS unsigned char* lds; int tid, lane, wave, bid; };
__device__ __forceinline__ Ctx fresh_ctx(const Ctx& C0) { Ctx C = C0; asm volatile("" : "+v"(C.tid)); asm volatile("" : "+s"(C.bid)); asm volatile("" : "+s"(C.lds)); C.lane = C.tid & 63; C.wave = __builtin_amdgcn_readfirstlane(C.tid >> 6); return C; }

DI void transpose_item(const float* src, int ld, int k0, int n0, bf16* dst, int K, int drow0, LAS float* scr, int lane) {
#pragma unroll 8
    for (int i = 0; i < 32; ++i) { const int kk = 2 * i + (lane >> 5); scr[kk * 33 + (lane & 31)] = src[(size_t)(k0 + kk) * ld + n0 + (lane & 31)]; }
    asm volatile("s_waitcnt lgkmcnt(0)" ::: "memory");
    const int c = lane & 7;
#pragma unroll
    for (int j = 0; j < 4; ++j) { const int n = (lane >> 3) + 8 * j; const LAS float* s = scr + (8 * c) * 33 + n;
        v4u o; o.x = pk2(s[0 * 33], s[1 * 33]); o.y = pk2(s[2 * 33], s[3 * 33]); o.z = pk2(s[4 * 33], s[5 * 33]); o.w = pk2(s[6 * 33], s[7 * 33]);
        *(v4u*)(dst + (size_t)(drow0 + n) * K + k0 + 8 * c) = o; }
    asm volatile("s_waitcnt lgkmcnt(0)" ::: "memory");
}
DI void phase_convert(const Args& A, const Ctx& C0, int l) { const Ctx C = fresh_ctx(C0);
    LAS float* scr = (LAS float*)(C.lds + C.wave * 16384);
    const int gw = C.bid * NWAVES + C.wave, NGW = GRID * NWAVES;
    bf16* WIN = (bf16*)(A.ws + WS_WIN); bf16* WOUT = (bf16*)(A.ws + WS_WOUT); bf16* WGU = (bf16*)(A.ws + WS_WGU); bf16* WD = (bf16*)(A.ws + WS_WD);
    constexpr int I_IN = 16 * 96, I_OUT = 16 * 32, I_GU = 16 * 512, I_D = 16 * 256, NITEMS = I_IN + I_OUT + I_GU + I_D;
    for (int it = gw; it < NITEMS; it += NGW) {
        int r = it;
        if (r < I_IN) { const int kb = r / 96, nb = r % 96, n0 = 32 * nb; transpose_item(A.in[1] + (size_t)l * D * PIN, PIN, 64 * kb, n0 + (n0 >= 2048 ? 8 : 0), WIN, D, n0, scr, C.lane); continue; } r -= I_IN;
        if (r < I_OUT) { const int kb = r / 32, nb = r % 32; transpose_item(A.in[12] + (size_t)l * D * D, D, 64 * kb, 32 * nb, WOUT, D, 32 * nb, scr, C.lane); continue; } r -= I_OUT;
        if (r < I_GU) { const int e = r / 512, r1 = r % 512, half = r1 / 256, r2 = r1 % 256, kb = r2 / 16, nb = r2 % 16, j0 = 32 * nb;
            transpose_item((half ? A.in[18] : A.in[17]) + (size_t)(l * NEXP + e) * D * DEXP, DEXP, 64 * kb, j0, WGU, D, e * 1024 + (j0 / 128) * 256 + half * 128 + (j0 % 128), scr, C.lane); continue; } r -= I_GU;
        { const int e = r / 256, r1 = r % 256, kb = r1 / 32, nb = r1 % 32;
            transpose_item(A.in[19] + (size_t)(l * NEXP + e) * DEXP * D, D, 64 * kb, 32 * nb, WD, DEXP, e * 1024 + 32 * nb, scr, C.lane); }
    }
    float* BIAS = (float*)(A.ws + SM_BIAS);
    for (int n = C.bid * NTHREADS + C.tid; n < NPROJ; n += GRID * NTHREADS) BIAS[n] = A.in[2][(size_t)l * PIN + n + (n >= 2048 ? 8 : 0)];
}

DI void stage_gate_weights(const Args& A, const Ctx& C, int lg) {
    LAS float* gwl = (LAS float*)C.lds;
    const float* w = A.in[1] + (size_t)lg * D * PIN + 2048;
    for (int i = C.tid; i < 8 * D; i += NTHREADS) { const int col = i >> 3, g = i & 7; gwl[g * D + col] = w[(size_t)col * PIN + g]; }
}
DI void row_emit(const Args& A, const Ctx& C, int t, const f32x4 (&v)[4], float* xout, bool want_xn, int lg) {
    if (xout) {
#pragma unroll
        for (int j = 0; j < 4; ++j) *(f32x4*)(xout + (size_t)t * D + 256 * j + 4 * C.lane) = v[j];
    }
    if (want_xn) {
        bf16* XN = (bf16*)(A.ws + WS_XN);
#pragma unroll
        for (int j = 0; j < 4; ++j) { v2u w; w.x = pk2(v[j][0], v[j][1]); w.y = pk2(v[j][2], v[j][3]); *(v2u*)(XN + (size_t)t * D + 256 * j + 4 * C.lane) = w; }
    }
    if (lg >= 0) {
        const LAS float* gwl = (const LAS float*)C.lds;
        float* GATES = (float*)(A.ws + SM_GATES);
        float gs[8];
#pragma unroll
        for (int g = 0; g < 8; ++g) { float s = 0.f;
#pragma unroll
            for (int j = 0; j < 4; ++j) { const f32x4 w = *(const LAS f32x4*)(gwl + g * D + 256 * j + 4 * C.lane); s += v[j][0] * w[0] + v[j][1] * w[1] + v[j][2] * w[2] + v[j][3] * w[3]; }
            gs[g] = wave_sum(s); }
        if (C.lane == 0) {
            const float* bg = A.in[2] + (size_t)lg * PIN + 2048;
            f32x4 o0 = {gs[0] + bg[0], gs[1] + bg[1], gs[2] + bg[2], gs[3] + bg[3]}, o1 = {gs[4] + bg[4], gs[5] + bg[5], gs[6] + bg[6], gs[7] + bg[7]};
            *(f32x4*)(GATES + (size_t)t * 8) = o0; *(f32x4*)(GATES + (size_t)t * 8 + 4) = o1;
        }
    }
}
DI void phase_prologue_rows(const Args& A, const Ctx& C0) { const Ctx C = fresh_ctx(C0);
    stage_gate_weights(A, C, 0);
    __syncthreads();
    for (int t = C.bid * NWAVES + C.wave; t < T; t += GRID * NWAVES) {
        f32x4 v[4];
#pragma unroll
        for (int j = 0; j < 4; ++j) v[j] = *(const f32x4*)(A.in[0] + (size_t)t * D + 256 * j + 4 * C.lane);
        row_emit(A, C, t, v, nullptr, true, 0);
    }
    __syncthreads();
}
DI void row_layernorm(f32x4 (&v)[4], const float* w, const float* b, int lane) {
    float s = 0.f;
#pragma unroll
    for (int j = 0; j < 4; ++j) s += (v[j][0] + v[j][1]) + (v[j][2] + v[j][3]);
    const float mean = wave_sum(s) * (1.0f / D); float q = 0.f;
#pragma unroll
    for (int j = 0; j < 4; ++j) { v[j] = v[j] - mean; q += (v[j][0] * v[j][0] + v[j][1] * v[j][1]) + (v[j][2] * v[j][2] + v[j][3] * v[j][3]); }
    const float rstd = 1.0f / sqrtf(wave_sum(q) * (1.0f / D) + LN_EPS);
#pragma unroll
    for (int j = 0; j < 4; ++j) { const f32x4 ww = *(const f32x4*)(w + 256 * j + 4 * lane), bb = *(const f32x4*)(b + 256 * j + 4 * lane); v[j] = v[j] * rstd * ww + bb; }
}
DI void phase_ln1_router(const Args& A, const Ctx& C0, int l) { const Ctx C = fresh_ctx(C0);
    LAS float* rwl = (LAS float*)C.lds;
    LAS int* hist = (LAS int*)(C.lds + VEC_OFF);
    for (int i = C.tid; i < NEXP * D; i += NTHREADS) { const int col = i >> 4, e = i & 15; rwl[e * D + col] = A.in[15][i]; }
    if (C.tid < 16) hist[C.tid] = 0;
    __syncthreads();
    const float* X = (l == 0) ? A.in[0] : A.out;
    const bf16* Y = (const bf16*)(A.ws + WS_PROJ);
    float* X1 = (float*)(A.ws + WS_X1);
    v4u* SEL = (v4u*)(A.ws + SM_SEL);
    float rb[16];
#pragma unroll
    for (int e = 0; e < 16; ++e) rb[e] = A.in[16][e];
    for (int i = 0; i < 8; ++i) {
        const int t = C.bid * 64 + C.wave * 8 + i;
        f32x4 v[4];
#pragma unroll
        for (int j = 0; j < 4; ++j) { const f32x4 x = *(const f32x4*)(X + (size_t)t * D + 256 * j + 4 * C.lane); const v2u y = *(const v2u*)(Y + (size_t)t * D + 256 * j + 4 * C.lane);
            v[j][0] = ALPHA * x[0] + bflo(y.x); v[j][1] = ALPHA * x[1] + bfhi(y.x); v[j][2] = ALPHA * x[2] + bflo(y.y); v[j][3] = ALPHA * x[3] + bfhi(y.y); }
        row_layernorm(v, A.in[13] + (size_t)l * D, A.in[14] + (size_t)l * D, C.lane);
        row_emit(A, C, t, v, X1, true, -1);
        float best = -INFINITY, bs0 = 0.f, bs1 = 0.f; int be0 = 0, be1 = 1;
#pragma unroll
        for (int g = 0; g < 4; ++g) {
            float sel[4], sg[4];
#pragma unroll
            for (int k = 0; k < 4; ++k) { const int e = 4 * g + k; float s = 0.f;
#pragma unroll
                for (int j = 0; j < 4; ++j) { const f32x4 w = *(const LAS f32x4*)(rwl + e * D + 256 * j + 4 * C.lane); s += v[j][0] * w[0] + v[j][1] * w[1] + v[j][2] * w[2] + v[j][3] * w[3]; }
                s = wave_sum(s); sg[k] = 1.0f / (1.0f + expf(-s)); sel[k] = sg[k] + rb[e]; }
            float m1 = sel[0], s1 = sg[0]; int i1 = 0;
#pragma unroll
            for (int k = 1; k < 4; ++k) if (sel[k] > m1) { m1 = sel[k]; s1 = sg[k]; i1 = k; }
            float m2 = -INFINITY, s2 = 0.f; int i2 = 0;
#pragma unroll
            for (int k = 0; k < 4; ++k) if (k != i1 && sel[k] > m2) { m2 = sel[k]; s2 = sg[k]; i2 = k; }
            const float gsc = m1 + m2;
            if (gsc > best) { best = gsc; be0 = 4 * g + i1; be1 = 4 * g + i2; bs0 = s1; bs1 = s2; }
        }
        if (C.lane == 0) {
            const float inv = 1.0f / (bs0 + bs1);
            v4u o; o.x = (unsigned)be0; o.y = (unsigned)be1; o.z = __builtin_bit_cast(unsigned, bs0 * inv); o.w = __builtin_bit_cast(unsigned, bs1 * inv);
            SEL[t] = o;
            ((f32x2*)(A.ws + SM_GW))[t] = (f32x2){bs0 * inv, bs1 * inv};
            __hip_atomic_fetch_add(hist + be0, 1, __ATOMIC_RELAXED, __HIP_MEMORY_SCOPE_WORKGROUP);
            __hip_atomic_fetch_add(hist + be1, 1, __ATOMIC_RELAXED, __HIP_MEMORY_SCOPE_WORKGROUP);
        }
    }
    __syncthreads();
    if (C.tid < 16) ((int*)(A.ws + SM_HIST))[C.bid * 16 + C.tid] = hist[C.tid];
    __syncthreads();
}
DI void phase_scatter(const Args& A, const Ctx& C0) { const Ctx C = fresh_ctx(C0);
    LAS int* sh = (LAS int*)(C.lds + VEC_OFF);
    LAS int* cnt = sh, *off = sh + 16, *base = sh + 32, *se = sh + 64, *pos = sh + 192;
    const int* HIST = (const int*)(A.ws + SM_HIST);
    const v4u* SEL = (const v4u*)(A.ws + SM_SEL);
    int* META = (int*)(A.ws + SM_META);
    int* TOKSLOT = (int*)(A.ws + SM_TOKSLOT);
    if (C.tid < 16) { int c = 0, o = 0; for (int w = 0; w < GRID; ++w) { const int h = HIST[w * 16 + C.tid]; if (w < C.bid) o += h; c += h; } cnt[C.tid] = c; off[C.tid] = o; }
    if (C.tid >= 64 && C.tid < 128) { const int i = C.tid - 64; const v4u s = SEL[C.bid * 64 + i]; se[2 * i] = (int)s.x; se[2 * i + 1] = (int)s.y; }
    __syncthreads();
    if (C.tid == 0) { int run = 0;
        for (int e = 0; e < 16; ++e) { base[e] = run; const int nt = (cnt[e] + 255) >> 8; if (C.bid == 0) for (int k = 0; k < nt; ++k) META[16 + (run >> 8) + k] = e; run += nt * 256; }
        if (C.bid == 0) META[0] = run >> 8; }
    __syncthreads();
    if (C.tid < 16) { int r = 0; for (int q = 0; q < 128; ++q) if (se[q] == C.tid) { pos[q] = base[C.tid] + off[C.tid] + r; ++r; } }
    __syncthreads();
    if (C.tid < 128) TOKSLOT[C.bid * 128 + C.tid] = pos[C.tid];
    const bf16* XN = (const bf16*)(A.ws + WS_XN); bf16* XG = (bf16*)(A.ws + WS_PROJ);
    for (int r = C.wave; r < 128; r += 8) { const int p = pos[r], t = C.bid * 64 + (r >> 1);
        const v4u a = *(const v4u*)(XN + (size_t)t * D + 8 * C.lane), b = *(const v4u*)(XN + (size_t)t * D + 512 + 8 * C.lane);
        *(v4u*)(XG + (size_t)p * D + 8 * C.lane) = a; *(v4u*)(XG + (size_t)p * D + 512 + 8 * C.lane) = b; }
    __syncthreads();
}
DI void make_list(const Args& A, const Ctx& C, pg8::ListOrder& S) {
    const int* META = (const int*)(A.ws + SM_META);
    S.meta = META; S.nunits = __builtin_amdgcn_readfirstlane(META[0]) * 4; S.G = GRID; S.c = C.bid;
}
DI void phase_combine(const Args& A, const Ctx& C0, int l) { const Ctx C = fresh_ctx(C0);
    const bool last = (l == NLAYER - 1);
    if (!last) { stage_gate_weights(A, C, l + 1); }
    __syncthreads();
    const float* X1 = (const float*)(A.ws + WS_X1); const bf16* YP = (const bf16*)(A.ws + WS_PROJ);
    const v4u* SEL = (const v4u*)(A.ws + SM_SEL); const int* TOKSLOT = (const int*)(A.ws + SM_TOKSLOT);
    for (int t = C.bid * NWAVES + C.wave; t < T; t += GRID * NWAVES) {
        const v4u s = SEL[t]; const int p0 = TOKSLOT[2 * t], p1 = TOKSLOT[2 * t + 1]; const f32x2 gw2 = ((const f32x2*)(A.ws + SM_GW))[t]; const float g0 = gw2[0], g1 = gw2[1];
        f32x4 v[4];
#pragma unroll
        for (int j = 0; j < 4; ++j) { const f32x4 x = *(const f32x4*)(X1 + (size_t)t * D + 256 * j + 4 * C.lane);
            const v2u a = *(const v2u*)(YP + (size_t)p0 * D + 256 * j + 4 * C.lane), b = *(const v2u*)(YP + (size_t)p1 * D + 256 * j + 4 * C.lane);
            v[j][0] = ALPHA * x[0] + g0 * bflo(a.x) + g1 * bflo(b.x); v[j][1] = ALPHA * x[1] + g0 * bfhi(a.x) + g1 * bfhi(b.x);
            v[j][2] = ALPHA * x[2] + g0 * bflo(a.y) + g1 * bflo(b.y); v[j][3] = ALPHA * x[3] + g0 * bfhi(a.y) + g1 * bfhi(b.y); }
        row_layernorm(v, A.in[20] + (size_t)l * D, A.in[21] + (size_t)l * D, C.lane);
        row_emit(A, C, t, v, A.out, !last, last ? -1 : l + 1);
    }
    __syncthreads();
}
DI void unpack8(const v4u w, float (&f)[8]) { f[0] = bflo(w.x); f[1] = bfhi(w.x); f[2] = bflo(w.y); f[3] = bfhi(w.y); f[4] = bflo(w.z); f[5] = bfhi(w.z); f[6] = bflo(w.w); f[7] = bfhi(w.w); }
DI void conv_unit(const Args& A, const Ctx& C0, int l, int unit) { const Ctx C = fresh_ctx(C0);
    const bf16* PROJ = (const bf16*)(A.ws + WS_PROJ); bf16* HCAT = (bf16*)(A.ws + WS_HCAT);
    LAS float* cin = (LAS float*)C.lds;
    LAS float* cou = (LAS float*)(C.lds + 65536);
    const int t0 = unit * 32, tseq = t0 & (SEQ - 1);
    for (int it = C.tid; it < 62 * 32; it += NTHREADS) { const int r = it >> 5, c8 = (it & 31) * 8; float o[8];
        if (tseq - 30 + r >= 0) { const size_t rowo = (size_t)(t0 - 30 + r) * NPROJ; float a[8], b[8]; unpack8(*(const v4u*)(PROJ + rowo + PCA + c8), a); unpack8(*(const v4u*)(PROJ + rowo + PCB + c8), b);
#pragma unroll
            for (int i = 0; i < 8; ++i) o[i] = a[i] * sigmoidf_(b[i]); }
        else {
#pragma unroll
            for (int i = 0; i < 8; ++i) o[i] = 0.f; }
        *(LAS f32x4*)(cin + r * 256 + c8) = (f32x4){o[0], o[1], o[2], o[3]}; *(LAS f32x4*)(cin + r * 256 + c8 + 4) = (f32x4){o[4], o[5], o[6], o[7]}; }
    __syncthreads();
    { const int c = C.tid & 255, half = C.tid >> 8;
        float w[31];
#pragma unroll
        for (int j = 0; j < 31; ++j) w[j] = A.in[8][(size_t)(l * 31 + j) * 256 + c];
        const float bias = A.in[9][l * 256 + c];
        float xin[46];
#pragma unroll
        for (int r = 0; r < 46; ++r) xin[r] = cin[(half * 16 + r) * 256 + c];
#pragma unroll
        for (int i = 0; i < 16; ++i) { float acc = bias;
#pragma unroll
            for (int j = 0; j < 31; ++j) acc += xin[i + j] * w[j];
            cou[(half * 16 + i) * 256 + c] = acc; } }
    __syncthreads();
    { const f32x4 nw = *(const f32x4*)(A.in[10] + l * 256 + 4 * C.lane), nb = *(const f32x4*)(A.in[11] + l * 256 + 4 * C.lane);
#pragma unroll
        for (int q = 0; q < 4; ++q) { const int r = 4 * C.wave + q; f32x4 x = *(const LAS f32x4*)(cou + r * 256 + 4 * C.lane);
            const float mean = wave_sum((x[0] + x[1]) + (x[2] + x[3])) * (1.0f / 256.0f); x = x - mean;
            const float var = wave_sum((x[0] * x[0] + x[1] * x[1]) + (x[2] * x[2] + x[3] * x[3])) * (1.0f / 256.0f);
            const float rstd = 1.0f / sqrtf(var + LN_EPS); x = x * rstd * nw + nb;
            float o[4];
#pragma unroll
            for (int k = 0; k < 4; ++k) o[k] = x[k] * sigmoidf_(x[k]);
            v2u pk; pk.x = pk2(o[0], o[1]); pk.y = pk2(o[2], o[3]);
            *(v2u*)(HCAT + (size_t)(t0 + r) * D + 768 + 4 * C.lane) = pk; } }
    __syncthreads();
}
DI void gmlp_unit_simple(const Args& A, const Ctx& C0, int l, int ck) { const Ctx C = fresh_ctx(C0);
    const bf16* PROJ = (const bf16*)(A.ws + WS_PROJ); bf16* HCAT = (bf16*)(A.ws + WS_HCAT);
    LAS float* zs = (LAS float*)C.lds;
    const int t0 = ck * CH;
    { const f32x4 nw = *(const f32x4*)(A.in[4] + l * 256 + 4 * C.lane), nb = *(const f32x4*)(A.in[5] + l * 256 + 4 * C.lane);
        for (int i = 0; i < 16; ++i) { const int r = C.wave * 16 + i; const v2u g = *(const v2u*)(PROJ + (size_t)(t0 + r) * NPROJ + PGV + 4 * C.lane);
            f32x4 x = {gelu_tanh(bflo(g.x)), gelu_tanh(bfhi(g.x)), gelu_tanh(bflo(g.y)), gelu_tanh(bfhi(g.y))};
            const float mean = wave_sum((x[0] + x[1]) + (x[2] + x[3])) * (1.0f / 256.0f); x = x - mean;
            const float var = wave_sum((x[0] * x[0] + x[1] * x[1]) + (x[2] * x[2] + x[3] * x[3])) * (1.0f / 256.0f);
            const float rstd = 1.0f / sqrtf(var + LN_EPS); x = x * rstd * nw + nb;
            *(LAS f32x4*)(zs + r * 256 + 4 * C.lane) = x; } }
    __syncthreads();
    { const int tb = C.tid >> 4, cb = C.tid & 15, c0 = 16 * cb, h = cb >> 2, tr0 = 4 * tb;
        const float* ws = A.in[6] + (size_t)(l * 4 + h) * CH * CH;
        float acc[4][16];
#pragma unroll
        for (int i = 0; i < 4; ++i)
#pragma unroll
            for (int j = 0; j < 16; ++j) acc[i][j] = 0.f;
        for (int s = 0; s <= tr0 + 3; ++s) {
            float zv[16];
#pragma unroll
            for (int q = 0; q < 4; ++q) { const f32x4 z4 = *(const LAS f32x4*)(zs + s * 256 + c0 + 4 * q); zv[4 * q] = z4[0]; zv[4 * q + 1] = z4[1]; zv[4 * q + 2] = z4[2]; zv[4 * q + 3] = z4[3]; }
#pragma unroll
            for (int i = 0; i < 4; ++i) { const float wg = (s <= tr0 + i) ? ws[(size_t)(tr0 + i) * CH + s] : 0.f;
#pragma unroll
                for (int j = 0; j < 16; ++j) acc[i][j] += wg * zv[j]; }
        }
#pragma unroll
        for (int i = 0; i < 4; ++i) { const int tr = tr0 + i; const float bsv = A.in[7][(size_t)(l * 4 + h) * CH + tr]; const size_t rowo = (size_t)(t0 + tr) * NPROJ + PGU + c0;
            float u[16]; { float tmp[8]; unpack8(*(const v4u*)(PROJ + rowo), tmp);
#pragma unroll
                for (int j = 0; j < 8; ++j) u[j] = tmp[j];
                unpack8(*(const v4u*)(PROJ + rowo + 8), tmp);
#pragma unroll
                for (int j = 0; j < 8; ++j) u[8 + j] = tmp[j]; }
            float o[16];
#pragma unroll
            for (int j = 0; j < 16; ++j) o[j] = gelu_tanh(u[j]) * (acc[i][j] + bsv);
            v4u w0, w1; w0.x = pk2(o[0], o[1]); w0.y = pk2(o[2], o[3]); w0.z = pk2(o[4], o[5]); w0.w = pk2(o[6], o[7]); w1.x = pk2(o[8], o[9]); w1.y = pk2(o[10], o[11]); w1.z = pk2(o[12], o[13]); w1.w = pk2(o[14], o[15]);
            *(v4u*)(HCAT + (size_t)(t0 + tr) * D + 512 + c0) = w0; *(v4u*)(HCAT + (size_t)(t0 + tr) * D + 512 + c0 + 8) = w1; }
    }
    __syncthreads();
}
DI void mlstm_local_simple(const Args& A, const Ctx& C0, int un) { const Ctx C = fresh_ctx(C0);
    const bf16* PROJ = (const bf16*)(A.ws + WS_PROJ); const float* GATES = (const float*)(A.ws + SM_GATES);
    const int bh = un >> 5, c = un & 31, b = bh >> 2, h = bh & 3, t0 = b * SEQ + c * CH;
    LAS float* kw = (LAS float*)C.lds;
    LAS float* vs = (LAS float*)(C.lds + 65536);
    LAS float* vec = (LAS float*)(C.lds + VEC_OFF);
    if (C.tid < CH) { const float fp = GATES[(size_t)(t0 + C.tid) * 8 + 4 + h], ip = GATES[(size_t)(t0 + C.tid) * 8 + h]; vec[C.tid] = logsigmoidf_(fp); vec[128 + C.tid] = ip; }
    __syncthreads();
    if (C.tid == 0) { float run = 0.f; for (int i = 0; i < CH; ++i) { run += vec[i]; vec[i] = run; } const float g = run; float ml = -INFINITY;
        for (int i = 0; i < CH; ++i) { const float a = g - vec[i] + vec[128 + i]; vec[256 + i] = a; ml = fmaxf(ml, a); }
        for (int i = 0; i < CH; ++i) vec[256 + i] = __expf(vec[256 + i] - ml);
        ((float*)(A.ws + SM_G))[un] = g; ((float*)(A.ws + SM_MLOC))[un] = ml; }
    __syncthreads();
    for (int it = C.tid; it < CH * 16; it += NTHREADS) { const int r = it >> 4, c8 = (it & 15) * 8; const size_t rowo = (size_t)(t0 + r) * NPROJ + h * 128 + c8; float k8[8], v8[8];
        unpack8(*(const v4u*)(PROJ + rowo + PK), k8); unpack8(*(const v4u*)(PROJ + rowo + PV), v8); const float sc = vec[256 + r] * 0.08838834764831845f;
#pragma unroll
        for (int i = 0; i < 8; ++i) { kw[r * 128 + c8 + i] = k8[i] * sc; vs[r * 128 + c8 + i] = v8[i]; } }
    __syncthreads();
    { const int db = C.tid >> 4, eb = C.tid & 15, d0 = 4 * db, e0 = 8 * eb; float acc[4][8];
#pragma unroll
        for (int i = 0; i < 4; ++i)
#pragma unroll
            for (int j = 0; j < 8; ++j) acc[i][j] = 0.f;
        for (int r = 0; r < CH; ++r) { const f32x4 kd = *(const LAS f32x4*)(kw + r * 128 + d0); const f32x4 va = *(const LAS f32x4*)(vs + r * 128 + e0), vb = *(const LAS f32x4*)(vs + r * 128 + e0 + 4);
#pragma unroll
            for (int i = 0; i < 4; ++i) { acc[i][0] += kd[i] * va[0]; acc[i][1] += kd[i] * va[1]; acc[i][2] += kd[i] * va[2]; acc[i][3] += kd[i] * va[3]; acc[i][4] += kd[i] * vb[0]; acc[i][5] += kd[i] * vb[1]; acc[i][6] += kd[i] * vb[2]; acc[i][7] += kd[i] * vb[3]; } }
        float* CL = (float*)(A.ws + WS_CLOCT) + (size_t)un * CH * CH;
#pragma unroll
        for (int j = 0; j < 8; ++j) *(f32x4*)(CL + (size_t)(e0 + j) * CH + d0) = (f32x4){acc[0][j], acc[1][j], acc[2][j], acc[3][j]}; }
    if (C.tid < CH) { float s = 0.f; for (int r = 0; r < CH; ++r) s += kw[r * 128 + C.tid]; ((float*)(A.ws + SM_NLOC))[(size_t)un * CH + C.tid] = s; }
    __syncthreads();
}
DI void phase_scan(const Args& A, const Ctx& C0) { const Ctx C = fresh_ctx(C0);
    const int gt = C.bid * NTHREADS + C.tid, bh = gt >> 13, pr = gt & 8191;
    const float* G = (const float*)(A.ws + SM_G); const float* ML = (const float*)(A.ws + SM_MLOC); float* MP = (float*)(A.ws + SM_MPREV);
    const float* CL = (const float*)(A.ws + WS_CLOCT); unsigned* CP = (unsigned*)(A.ws + WS_CPREVT);
    const float* NL = (const float*)(A.ws + SM_NLOC); float* NP = (float*)(A.ws + SM_NPREV);
    float c0 = 0.f, c1 = 0.f, n0 = 0.f, n1 = 0.f, m = 0.f;
    for (int c = 0; c < NCH; ++c) { const int un = bh * NCH + c;
        CP[(size_t)un * (CH * CH / 2) + pr] = pk2(c0, c1);
        if (pr == 0) MP[un] = m;
        if (pr < 64) *(f32x2*)(NP + (size_t)un * CH + 2 * pr) = (f32x2){n0, n1};
        const float g = G[un], ml = ML[un], mn = fmaxf(g + m, ml), dec = __expf(g + m - mn), sc = __expf(ml - mn);
        const f32x2 cl = *(const f32x2*)(CL + (size_t)un * CH * CH + 2 * pr);
        c0 = dec * c0 + sc * cl[0]; c1 = dec * c1 + sc * cl[1];
        if (pr < 64) { const f32x2 nl = *(const f32x2*)(NL + (size_t)un * CH + 2 * pr); n0 = dec * n0 + sc * nl[0]; n1 = dec * n1 + sc * nl[1]; }
        m = mn; }
}
DI void mlstm_out_simple(const Args& A, const Ctx& C0, int l, int un) { const Ctx C = fresh_ctx(C0);
    const bf16* PROJ = (const bf16*)(A.ws + WS_PROJ); const float* GATES = (const float*)(A.ws + SM_GATES); bf16* HCAT = (bf16*)(A.ws + WS_HCAT);
    const int bh = un >> 5, c = un & 31, b = bh >> 2, h = bh & 3, t0 = b * SEQ + c * CH;
    LAS bf16* qs = (LAS bf16*)C.lds;
    LAS bf16* ks = (LAS bf16*)(C.lds + 32768);
    LAS float* ps = (LAS float*)(C.lds + 65536);
    LAS float* vec = (LAS float*)(C.lds + VEC_OFF);
    LAS float* bvec = vec, *uvec = vec + 128, *Mvec = vec + 256, *wint = vec + 384, *flo = vec + 512, *den = vec + 640, *npv = vec + 768, *ipv = vec + 896, *lfv = vec + 1024, *qnv = vec + 1152;
    if (C.tid < CH) { const float fp = GATES[(size_t)(t0 + C.tid) * 8 + 4 + h], ip = GATES[(size_t)(t0 + C.tid) * 8 + h]; lfv[C.tid] = logsigmoidf_(fp); ipv[C.tid] = ip; npv[C.tid] = ((const float*)(A.ws + SM_NPREV))[(size_t)un * CH + C.tid]; }
    __syncthreads();
    if (C.tid == 0) { const float mprev = ((const float*)(A.ws + SM_MPREV))[un]; float run = 0.f, pm = -INFINITY;
        for (int i = 0; i < CH; ++i) { run += lfv[i]; bvec[i] = run; const float u = ipv[i] - run; uvec[i] = u; pm = fmaxf(pm, u); const float M = fmaxf(mprev, pm); Mvec[i] = M; wint[i] = __expf(mprev - M); flo[i] = __expf(-(run + M)); } }
    for (int it = C.tid; it < CH * 16; it += NTHREADS) { const int r = it >> 4, c8 = (it & 15) * 8; const size_t rowo = (size_t)(t0 + r) * NPROJ + h * 128 + c8;
        *(LAS v4u*)(qs + r * 128 + c8) = *(const v4u*)(PROJ + rowo + PQ); *(LAS v4u*)(ks + r * 128 + c8) = *(const v4u*)(PROJ + rowo + PK); }
    __syncthreads();
    const int lb = C.tid >> 4, xb = C.tid & 15, l0 = 4 * lb, x0 = 8 * xb;
    {
        float acc[4][8];
#pragma unroll
        for (int i = 0; i < 4; ++i)
#pragma unroll
            for (int j = 0; j < 8; ++j) acc[i][j] = 0.f;
        if (x0 <= l0 + 3) {
            for (int d8 = 0; d8 < 16; ++d8) { float qf[4][8], kf[8];
#pragma unroll
                for (int i = 0; i < 4; ++i) unpack8(*(const LAS v4u*)(qs + (l0 + i) * 128 + d8 * 8), qf[i]);
#pragma unroll
                for (int j = 0; j < 8; ++j) { unpack8(*(const LAS v4u*)(ks + (x0 + j) * 128 + d8 * 8), kf);
#pragma unroll
                    for (int i = 0; i < 4; ++i) { float s = 0.f;
#pragma unroll
                        for (int dd = 0; dd < 8; ++dd) s += qf[i][dd] * kf[dd];
                        acc[i][j] += s; } } } }
#pragma unroll
        for (int i = 0; i < 4; ++i)
#pragma unroll
            for (int j = 0; j < 8; ++j) { const int li = l0 + i, sj = x0 + j; ps[li * 128 + sj] = (sj <= li) ? acc[i][j] * 0.08838834764831845f * __expf(uvec[sj] - Mvec[li]) : 0.f; }
    }
    __syncthreads();
    if (C.tid < CH) { const int li = C.tid; float s = 0.f; for (int k = 0; k < CH; ++k) s += ps[li * 128 + ((k + li) & 127)]; den[li] = s; }
    else if (C.tid < 2 * CH) { const int li = C.tid - CH; float s = 0.f; for (int k = 0; k < CH; ++k) { const int d = (k + li) & 127; s += bf2f(qs[li * 128 + d]) * npv[d]; } qnv[li] = s; }
    for (int it = C.tid; it < CH * 16; it += NTHREADS) { const int r = it >> 4, c8 = (it & 15) * 8; }
    __syncthreads();
    for (int it = C.tid; it < CH * 16; it += NTHREADS) { const int r = it >> 4, c8 = (it & 15) * 8; const size_t rowo = (size_t)(t0 + r) * NPROJ + h * 128 + c8; *(LAS v4u*)(ks + r * 128 + c8) = *(const v4u*)(PROJ + rowo + PV); }
    __syncthreads();
    float hv[4][8];
    {   const int e0 = x0; float acc[4][8], acc2[4][8];
#pragma unroll
        for (int i = 0; i < 4; ++i)
#pragma unroll
            for (int j = 0; j < 8; ++j) { acc[i][j] = 0.f; acc2[i][j] = 0.f; }
        for (int s = 0; s <= l0 + 3; ++s) { float vv[8]; unpack8(*(const LAS v4u*)(ks + s * 128 + e0), vv);
#pragma unroll
            for (int i = 0; i < 4; ++i) { const float p = ps[(l0 + i) * 128 + s];
#pragma unroll
                for (int j = 0; j < 8; ++j) acc[i][j] += p * vv[j]; } }
        const bf16* CPT = (const bf16*)(A.ws + WS_CPREVT) + (size_t)un * CH * CH;
        for (int d8 = 0; d8 < 16; ++d8) { float qf[4][8], cf[8];
#pragma unroll
            for (int i = 0; i < 4; ++i) unpack8(*(const LAS v4u*)(qs + (l0 + i) * 128 + d8 * 8), qf[i]);
#pragma unroll
            for (int j = 0; j < 8; ++j) { unpack8(*(const v4u*)(CPT + (size_t)(e0 + j) * CH + d8 * 8), cf);
#pragma unroll
                for (int i = 0; i < 4; ++i) { float s = 0.f;
#pragma unroll
                    for (int dd = 0; dd < 8; ++dd) s += qf[i][dd] * cf[dd];
                    acc2[i][j] += s; } } }
#pragma unroll
        for (int i = 0; i < 4; ++i) { const int li = l0 + i; const float wi = wint[li]; const float dn = den[li] + wi * qnv[li]; const float inv = 1.0f / fmaxf(fabsf(dn), flo[li]);
#pragma unroll
            for (int j = 0; j < 8; ++j) hv[i][j] = (acc[i][j] + wi * acc2[i][j]) * inv; }
    }
    __syncthreads();
#pragma unroll
    for (int i = 0; i < 4; ++i)
#pragma unroll
        for (int j = 0; j < 8; ++j) ps[(l0 + i) * 128 + x0 + j] = hv[i][j];
    __syncthreads();
    { const f32x2 nw = *(const f32x2*)(A.in[3] + (size_t)l * 512 + h * 128 + 2 * C.lane);
        for (int i = 0; i < 16; ++i) { const int li = C.wave * 16 + i; f32x2 x = *(const LAS f32x2*)(ps + li * 128 + 2 * C.lane);
            const float mean = wave_sum(x[0] + x[1]) * (1.0f / 128.0f); x = x - mean; const float var = wave_sum(x[0] * x[0] + x[1] * x[1]) * (1.0f / 128.0f);
            const float rstd = 1.0f / sqrtf(var + 1e-6f); const unsigned ow = *(const unsigned*)(PROJ + (size_t)(t0 + li) * NPROJ + PO + h * 128 + 2 * C.lane);
            const float o0 = sigmoidf_(bflo(ow)) * (x[0] * rstd * nw[0]), o1 = sigmoidf_(bfhi(ow)) * (x[1] * rstd * nw[1]);
            *(unsigned*)(HCAT + (size_t)(t0 + li) * D + h * 128 + 2 * C.lane) = pk2(o0, o1); } }
    __syncthreads();
}
#if DBG_CHECK
constexpr size_t SM_ERR = WS_CTL + 8192;
DI unsigned hsh(unsigned s, unsigned k) { unsigned h = s * 2654435761u + k * 40503u + 12345u; h ^= h >> 15; h *= 2246822519u; h ^= h >> 13; return h; }
DI void err_put(const Args& A, int chk, float ref, float got, float floor_) {
    float e = fabsf(ref - got) / (fabsf(ref) + floor_); if (!(e == e)) e = 1e9f;
    atomicMax((unsigned*)(A.ws + SM_ERR) + chk, __builtin_bit_cast(unsigned, e));
}
DI void chk_gates(const Args& A, const Ctx& C, int l, const float* X) {
    const int gt = C.bid * NTHREADS + C.tid; if (gt >= 2048) return;
    const int t = hsh(gt, 1) % T, g = hsh(gt, 2) % 8; float s = 0.f;
    for (int k = 0; k < D; ++k) s += X[(size_t)t * D + k] * A.in[1][((size_t)l * D + k) * PIN + 2048 + g];
    s += A.in[2][(size_t)l * PIN + 2048 + g];
    err_put(A, 1, s, ((const float*)(A.ws + SM_GATES))[(size_t)t * 8 + g], 0.1f);
}
DI void chk_proj(const Args& A, const Ctx& C, int l) {
    const int gt = C.bid * NTHREADS + C.tid; if (gt >= 8192) return;
    const int t = (gt < 64) ? (gt * 4099) % T : hsh(gt, 3) % T, n = hsh(gt, 4) % NPROJ, ns = n + (n >= 2048 ? 8 : 0);
    const bf16* XN = (const bf16*)(A.ws + WS_XN); float s = 0.f;
    for (int k = 0; k < D; ++k) s += bf2f(XN[(size_t)t * D + k]) * A.in[1][((size_t)l * D + k) * PIN + ns];
    s += A.in[2][(size_t)l * PIN + ns];
    err_put(A, 2, s, bf2f(((const bf16*)(A.ws + WS_PROJ))[(size_t)t * NPROJ + n]), 0.5f);
}
DI void chk_conv(const Args& A, const Ctx& C, int l) {
    const int gw = C.bid * NWAVES + C.wave; if (gw >= 1024) return;
    const int t = (gw < 128) ? (gw * 129) % T : hsh(gw, 5) % T; const bf16* PROJ = (const bf16*)(A.ws + WS_PROJ);
    float cv[4];
#pragma unroll
    for (int q = 0; q < 4; ++q) { const int c = C.lane * 4 + q; float acc = A.in[9][l * 256 + c];
        for (int j = 0; j < 31; ++j) { const int ts = t - 30 + j; if ((ts >> 12) != (t >> 12) || ts < 0) continue;
            const float a = bf2f(PROJ[(size_t)ts * NPROJ + PCA + c]), b = bf2f(PROJ[(size_t)ts * NPROJ + PCB + c]);
            acc += a / (1.0f + expf(-b)) * A.in[8][(size_t)(l * 31 + j) * 256 + c]; }
        cv[q] = acc; }
    const float mean = wave_sum(cv[0] + cv[1] + cv[2] + cv[3]) / 256.0f; float q2 = 0.f;
#pragma unroll
    for (int q = 0; q < 4; ++q) { cv[q] -= mean; q2 += cv[q] * cv[q]; }
    const float rstd = 1.0f / sqrtf(wave_sum(q2) / 256.0f + LN_EPS);
#pragma unroll
    for (int q = 0; q < 4; ++q) { const int c = C.lane * 4 + q; const float y = cv[q] * rstd * A.in[10][l * 256 + c] + A.in[11][l * 256 + c]; const float r = y / (1.0f + expf(-y));
        err_put(A, 3, r, bf2f(((const bf16*)(A.ws + WS_HCAT))[(size_t)t * D + 768 + c]), 0.5f); }
}
DI void chk_gmlp(const Args& A, const Ctx& C, int l) {
    const int gw = C.bid * NWAVES + C.wave; if (gw >= 512) return;
    const int t = (gw < 64) ? (gw * 131 + 127) % T : hsh(gw, 6) % T; const bf16* PROJ = (const bf16*)(A.ws + WS_PROJ);
    const int tc = t & 127, t0 = t - tc, h = C.lane >> 4; float acc[4] = {0.f, 0.f, 0.f, 0.f};
    for (int s = 0; s <= tc; ++s) { float x[4];
#pragma unroll
        for (int q = 0; q < 4; ++q) { const float v = bf2f(PROJ[(size_t)(t0 + s) * NPROJ + PGV + C.lane * 4 + q]); x[q] = 0.5f * v * (1.0f + tanhf(0.7978845608028654f * (v + 0.044715f * v * v * v))); }
        const float mean = wave_sum(x[0] + x[1] + x[2] + x[3]) / 256.0f; float q2 = 0.f;
#pragma unroll
        for (int q = 0; q < 4; ++q) { x[q] -= mean; q2 += x[q] * x[q]; }
        const float rstd = 1.0f / sqrtf(wave_sum(q2) / 256.0f + LN_EPS); const float w = A.in[6][((size_t)(l * 4 + h) * CH + tc) * CH + s];
#pragma unroll
        for (int q = 0; q < 4; ++q) { const int c = C.lane * 4 + q; acc[q] += w * (x[q] * rstd * A.in[4][l * 256 + c] + A.in[5][l * 256 + c]); } }
#pragma unroll
    for (int q = 0; q < 4; ++q) { const int c = C.lane * 4 + q; const float v = bf2f(PROJ[(size_t)t * NPROJ + PGU + c]); const float u = 0.5f * v * (1.0f + tanhf(0.7978845608028654f * (v + 0.044715f * v * v * v)));
        const float r = u * (acc[q] + A.in[7][(size_t)(l * 4 + h) * CH + tc]);
        err_put(A, 4, r, bf2f(((const bf16*)(A.ws + WS_HCAT))[(size_t)t * D + 512 + c]), 0.5f); }
}
DI void chk_mlstm(const Args& A, const Ctx& C, int l) {
    const int gw = C.bid * NWAVES + C.wave; if (gw >= 1024) return;
    const int t = (gw < 64) ? (gw * 521 + (gw & 1) * 127) % T : hsh(gw, 7) % T, h = hsh(gw, 8) & 3; const bf16* PROJ = (const bf16*)(A.ws + WS_PROJ); const float* GATES = (const float*)(A.ws + SM_GATES);
    const int tb = t & ~(SEQ - 1); const int d0 = 2 * C.lane;
    const float q0 = bf2f(PROJ[(size_t)t * NPROJ + PQ + h * 128 + d0]), q1 = bf2f(PROJ[(size_t)t * NPROJ + PQ + h * 128 + d0 + 1]);
    float n0 = 0.f, n1 = 0.f, den = 0.f, F = 0.f;
    for (int s = t; s >= tb; --s) {
        const float k0 = bf2f(PROJ[(size_t)s * NPROJ + PK + h * 128 + d0]), k1 = bf2f(PROJ[(size_t)s * NPROJ + PK + h * 128 + d0 + 1]);
        const float qk = wave_sum(q0 * k0 + q1 * k1) * 0.08838834764831845f;
        const float w = expf(F + GATES[(size_t)s * 8 + h]) * qk;
        n0 += w * bf2f(PROJ[(size_t)s * NPROJ + PV + h * 128 + d0]); n1 += w * bf2f(PROJ[(size_t)s * NPROJ + PV + h * 128 + d0 + 1]); den += w;
        const float fp = GATES[(size_t)s * 8 + 4 + h]; F += fminf(fp, 0.f) - log1pf(expf(-fabsf(fp)));
        if (F < -60.f) break; }
    const float inv = 1.0f / fmaxf(fabsf(den), 1.0f); float x0 = n0 * inv, x1 = n1 * inv;
    const float mean = wave_sum(x0 + x1) / 128.0f; x0 -= mean; x1 -= mean; const float rstd = 1.0f / sqrtf(wave_sum(x0 * x0 + x1 * x1) / 128.0f + 1e-6f);
    const float o0 = bf2f(PROJ[(size_t)t * NPROJ + PO + h * 128 + d0]), o1 = bf2f(PROJ[(size_t)t * NPROJ + PO + h * 128 + d0 + 1]);
    const float r0 = x0 * rstd * A.in[3][(size_t)l * 512 + h * 128 + d0] / (1.0f + expf(-o0)), r1 = x1 * rstd * A.in[3][(size_t)l * 512 + h * 128 + d0 + 1] / (1.0f + expf(-o1));
    const bf16* HC = (const bf16*)(A.ws + WS_HCAT);
    err_put(A, 5, r0, bf2f(HC[(size_t)t * D + h * 128 + d0]), 0.5f); err_put(A, 5, r1, bf2f(HC[(size_t)t * D + h * 128 + d0 + 1]), 0.5f);
}
DI void chk_y(const Args& A, const Ctx& C, int l) {
    const int gt = C.bid * NTHREADS + C.tid; if (gt >= 8192) return;
    const int t = hsh(gt, 9) % T, n = hsh(gt, 10) % D; const bf16* HC = (const bf16*)(A.ws + WS_HCAT); float s = 0.f;
    for (int k = 0; k < D; ++k) s += bf2f(HC[(size_t)t * D + k]) * A.in[12][((size_t)l * D + k) * D + n];
    err_put(A, 6, s, bf2f(((const bf16*)(A.ws + WS_PROJ))[(size_t)t * D + n]), 0.2f);
}
DI void chk_ln1(const Args& A, const Ctx& C, int l, const float* X) {
    const int gw = C.bid * NWAVES + C.wave; if (gw >= 2048) return;
    const int t = hsh(gw, 11) % T; const bf16* Y = (const bf16*)(A.ws + WS_PROJ); const float* X1 = (const float*)(A.ws + WS_X1);
    float v[16]; float s = 0.f;
#pragma unroll
    for (int i = 0; i < 16; ++i) { const int c = C.lane + 64 * i; v[i] = ALPHA * X[(size_t)t * D + c] + bf2f(Y[(size_t)t * D + c]); s += v[i]; }
    const float mean = wave_sum(s) / D; float q2 = 0.f;
#pragma unroll
    for (int i = 0; i < 16; ++i) { v[i] -= mean; q2 += v[i] * v[i]; }
    const float rstd = 1.0f / sqrtf(wave_sum(q2) / D + LN_EPS);
#pragma unroll
    for (int i = 0; i < 16; ++i) { const int c = C.lane + 64 * i; v[i] = v[i] * rstd * A.in[13][(size_t)l * D + c] + A.in[14][(size_t)l * D + c]; }
    err_put(A, 7, v[3], X1[(size_t)t * D + C.lane + 192], 0.1f);
    float sel[16], sg[16];
#pragma unroll
    for (int e = 0; e < 16; ++e) { float p = 0.f;
#pragma unroll
        for (int i = 0; i < 16; ++i) p += v[i] * A.in[15][(size_t)(C.lane + 64 * i) * 16 + e];
        p = wave_sum(p); sg[e] = 1.0f / (1.0f + expf(-p)); sel[e] = sg[e] + A.in[16][e]; }
    float bestg = -INFINITY; int bg = 0;
#pragma unroll
    for (int g = 0; g < 4; ++g) { float a = sel[4 * g], b = sel[4 * g + 1], c = sel[4 * g + 2], d = sel[4 * g + 3];
        float m1 = fmaxf(fmaxf(a, b), fmaxf(c, d)); float tot = a + b + c + d; float mn = fminf(fminf(a, b), fminf(c, d));
        float lo1 = fminf(a, b), hi1 = fmaxf(a, b), lo2 = fminf(c, d), hi2 = fmaxf(c, d); float second = fmaxf(fminf(hi1, hi2), fmaxf(lo1, lo2)); (void)tot; (void)mn;
        const float gs = m1 + second; if (gs > bestg) { bestg = gs; bg = g; } }
    int e0 = -1, e1 = -1; float m1 = -INFINITY, m2 = -INFINITY;
#pragma unroll
    for (int e = 0; e < 16; ++e) if ((e >> 2) == bg && sel[e] > m1) { m1 = sel[e]; e0 = e; }
#pragma unroll
    for (int e = 0; e < 16; ++e) if ((e >> 2) == bg && e != e0 && sel[e] > m2) { m2 = sel[e]; e1 = e; }
    const v4u got = ((const v4u*)(A.ws + SM_SEL))[t];
    if (C.lane == 0 && ((int)got.x != e0 || (int)got.y != e1)) atomicAdd((unsigned*)(A.ws + SM_ERR) + 8, 1u);
}
DI void chk_hid(const Args& A, const Ctx& C, int l) {
    const int gt = C.bid * NTHREADS + C.tid; if (gt >= 8192) return;
    const int t = hsh(gt, 12) % T, k = hsh(gt, 13) & 1, j = hsh(gt, 14) % DEXP; const v4u s = ((const v4u*)(A.ws + SM_SEL))[t]; const int e = k ? (int)s.y : (int)s.x; const int p = ((const int*)(A.ws + SM_TOKSLOT))[2 * t + k];
    const bf16* XN = (const bf16*)(A.ws + WS_XN); float g = 0.f, u = 0.f;
    for (int c = 0; c < D; ++c) { const float x = bf2f(XN[(size_t)t * D + c]); g += x * A.in[17][((size_t)(l * NEXP + e) * D + c) * DEXP + j]; u += x * A.in[18][((size_t)(l * NEXP + e) * D + c) * DEXP + j]; }
    err_put(A, 9, g / (1.0f + expf(-g)) * u, bf2f(((const bf16*)(A.ws + WS_HID))[(size_t)p * DEXP + j]), 0.5f);
    if (p < 0 || p >= PADROWS) atomicAdd((unsigned*)(A.ws + SM_ERR) + 11, 1u);
}
DI void chk_yp(const Args& A, const Ctx& C, int l) {
    const int gt = C.bid * NTHREADS + C.tid; if (gt >= 8192) return;
    const int t = hsh(gt, 15) % T, k = hsh(gt, 16) & 1, n = hsh(gt, 17) % D; const v4u s = ((const v4u*)(A.ws + SM_SEL))[t]; const int e = k ? (int)s.y : (int)s.x; const int p = ((const int*)(A.ws + SM_TOKSLOT))[2 * t + k];
    const bf16* HID = (const bf16*)(A.ws + WS_HID); float y = 0.f;
    for (int j = 0; j < DEXP; ++j) y += bf2f(HID[(size_t)p * DEXP + j]) * A.in[19][((size_t)(l * NEXP + e) * DEXP + j) * D + n];
    err_put(A, 10, y, bf2f(((const bf16*)(A.ws + WS_PROJ))[(size_t)p * D + n]), 0.2f);
}
DI void chk_out(const Args& A, const Ctx& C, int l) {
    const int gw = C.bid * NWAVES + C.wave; if (gw >= 2048) return;
    const int t = hsh(gw, 18) % T; const float* X1 = (const float*)(A.ws + WS_X1); const bf16* YP = (const bf16*)(A.ws + WS_PROJ);
    const v4u s = ((const v4u*)(A.ws + SM_SEL))[t]; const int p0 = ((const int*)(A.ws + SM_TOKSLOT))[2 * t], p1 = ((const int*)(A.ws + SM_TOKSLOT))[2 * t + 1];
    const float g0 = __builtin_bit_cast(float, s.z), g1 = __builtin_bit_cast(float, s.w);
    float v[16]; float sm = 0.f;
#pragma unroll
    for (int i = 0; i < 16; ++i) { const int c = C.lane + 64 * i; v[i] = ALPHA * X1[(size_t)t * D + c] + g0 * bf2f(YP[(size_t)p0 * D + c]) + g1 * bf2f(YP[(size_t)p1 * D + c]); sm += v[i]; }
    { float sy = 0.f, sx = 0.f;
#pragma unroll
      for (int i = 0; i < 16; ++i) { const int c = C.lane + 64 * i; const float yy = g0 * bf2f(YP[(size_t)p0 * D + c]) + g1 * bf2f(YP[(size_t)p1 * D + c]); const float xx = ALPHA * X1[(size_t)t * D + c]; sy += yy * yy; sx += xx * xx; }
      sy = wave_sum(sy); sx = wave_sum(sx); const float ratio = sqrtf(sy / sx);
      if (C.lane == 0) atomicMax((unsigned*)(A.ws + SM_ERR) + 20, __builtin_bit_cast(unsigned, ratio));
      float sxn = 0.f, shid = 0.f, syp = 0.f; const bf16* XNb = (const bf16*)(A.ws + WS_XN); const bf16* HIDb = (const bf16*)(A.ws + WS_HID);
#pragma unroll
      for (int i = 0; i < 16; ++i) { const int c = C.lane + 64 * i; const float a = bf2f(YP[(size_t)p0 * D + c]); syp += a * a; }
#pragma unroll
      for (int i = 0; i < 8; ++i) { const int c = C.lane + 64 * i; const float a = bf2f(HIDb[(size_t)p0 * DEXP + c]); shid += a * a; }
      syp = sqrtf(wave_sum(syp) / D); shid = sqrtf(wave_sum(shid) / DEXP);
      if (C.lane == 0) { atomicMax((unsigned*)(A.ws + SM_ERR) + 21, __builtin_bit_cast(unsigned, syp)); atomicMax((unsigned*)(A.ws + SM_ERR) + 22, __builtin_bit_cast(unsigned, shid)); atomicMax((unsigned*)(A.ws + SM_ERR) + 23, __builtin_bit_cast(unsigned, g0 + g1)); atomicMax((unsigned*)(A.ws + SM_ERR) + 24, s.z); atomicMax((unsigned*)(A.ws + SM_ERR) + 25, s.w); atomicMax((unsigned*)(A.ws + SM_ERR) + 26, s.x); } }
    const float mean = wave_sum(sm) / D; float q2 = 0.f;
#pragma unroll
    for (int i = 0; i < 16; ++i) { v[i] -= mean; q2 += v[i] * v[i]; }
    const float rstd = 1.0f / sqrtf(wave_sum(q2) / D + LN_EPS);
    const int c = C.lane + 64 * 5; const float r = v[5] * rstd * A.in[20][(size_t)l * D + c] + A.in[21][(size_t)l * D + c];
    err_put(A, 12, r, A.out[(size_t)t * D + c], 0.1f);
}
DI void probe_gates(const Args& A, const Ctx& C, int slot) {
    const int gt = C.bid * NTHREADS + C.tid; if (gt >= 4096) return;
    const int t = hsh(gt, 30) % T; const v4u s = ((const v4u*)(A.ws + SM_SEL))[t];
    const f32x2 gw2 = ((const f32x2*)(A.ws + SM_GW))[t];
    atomicMax((unsigned*)(A.ws + SM_ERR) + slot, __builtin_bit_cast(unsigned, gw2[0] + gw2[1]));
    { const float sm = gw2[0] + gw2[1]; if (!(fabsf(sm - 1.0f) < 1e-3f)) atomicAdd((unsigned*)(A.ws + SM_ERR) + slot + 8, 1u); }
}
DI void dbg_finish(const Args& A, const Ctx& C) {
    const unsigned* E = (const unsigned*)(A.ws + SM_ERR);
    const float tol[13] = {0, 1e-3f, 0.03f, 0.04f, 0.04f, 0.08f, 0.03f, 1e-3f, 0, 0.04f, 0.04f, 0, 1e-3f};
    int code = 0;
#pragma unroll
    for (int k = 12; k >= 1; --k) { bool bad;
        if (k == 8) bad = E[8] > 20u; else if (k == 11) bad = E[11] > 0u; else bad = __builtin_bit_cast(float, E[k]) > tol[k];
        if (bad) code = k; }
    (void)code; float cv = (float)(E[35] >> 8);
    for (size_t i = (size_t)C.bid * NTHREADS + C.tid; i < (size_t)T * D; i += (size_t)GRID * NTHREADS) A.out[i] = cv;
}
#endif
__global__ void __launch_bounds__(NTHREADS, 2) fwd_kernel(Args A0) {
    extern __shared__ __attribute__((aligned(16))) unsigned char lds_raw[];
    Ctx CK; CK.lds = (LAS unsigned char*)lds_raw; CK.tid = threadIdx.x; CK.lane = CK.tid & 63; CK.wave = __builtin_amdgcn_readfirstlane(CK.tid >> 6); CK.bid = blockIdx.x;
    for (int u = CK.tid; u < (LDS_BYTES - LDSCTL_OFF) / 4; u += NTHREADS) ((LAS unsigned*)(CK.lds + LDSCTL_OFF))[u] = 0u;
    __syncthreads();
    unsigned* ctl = (unsigned*)(A0.ws + WS_CTL);
    XcdBarrier bar = xcd_barrier_post(ctl + CW_BAR, (volatile LAS unsigned*)(CK.lds + MISC_OFF) + 8);
#define GRID_BAR() xcd_barrier<false>(bar)
#define FRESH() Args A; { int z_ = 0; asm volatile("" : "+s"(z_)); _Pragma("unroll") for (int k_ = 0; k_ < 22; ++k_) A.in[k_] = A0.in[k_] + z_; A.out = A0.out + z_; A.ws = A0.ws + z_; } const Ctx C = fresh_ctx(CK)
    { FRESH(); phase_prologue_rows(A, C); }
    xcd_barrier<true>(bar);
#if DBG_CHECK
    if (DBG_LAYER == 0) { FRESH(); chk_gates(A, C, 0, A.in[0]); }
#endif
    for (int l = 0; l < NLAYER_RUN; ++l) {
        { FRESH(); phase_convert(A, C, l); }
        GRID_BAR();
        {
            FRESH(); pg8::Gemm g{(const pg8::bf16_t*)(A.ws + WS_XN), (const pg8::bf16_t*)(A.ws + WS_WIN), T, NPROJ, D}; pg8::StaticOrder S; S.init(T, NPROJ, GRID, C.bid);
            pg8::EpiStoreBf16 E{(pg8::bf16_t*)(A.ws + WS_PROJ), NPROJ, (const float*)(A.ws + SM_BIAS), 0xffff};
            pg8::gemm_phase<pg8::EpiStoreBf16, pg8::StaticOrder, true, true>(C.lds, g, S, E);
        }
        GRID_BAR();
#if DBG_CHECK
        if (l == DBG_LAYER) { FRESH(); chk_proj(A, C, l); }
#endif
        { FRESH(); for (int un = C.bid; un < NUNIT; un += GRID) mlstm_local_simple(A, C, un); }
        { FRESH(); if (C.bid < 128) gmlp_unit_simple(A, C, l, C.bid); }
        { FRESH(); for (int cu = C.bid; cu < T / 32; cu += GRID) conv_unit(A, C, l, cu); }
        GRID_BAR();
        { FRESH(); phase_scan(A, C); }
        GRID_BAR();
        { FRESH(); for (int un = C.bid; un < NUNIT; un += GRID) mlstm_out_simple(A, C, l, un); }
        GRID_BAR();
#if DBG_CHECK
        if (l == DBG_LAYER) { FRESH(); chk_conv(A, C, l); chk_gmlp(A, C, l); chk_mlstm(A, C, l); GRID_BAR(); }
#endif
        {
            FRESH(); pg8::Gemm g{(const pg8::bf16_t*)(A.ws + WS_HCAT), (const pg8::bf16_t*)(A.ws + WS_WOUT), T, D, D}; pg8::StaticOrder S; S.init(T, D, GRID, C.bid);
            pg8::EpiStoreBf16 E{(pg8::bf16_t*)(A.ws + WS_PROJ), D, nullptr, 0xffff};
            pg8::gemm_phase<pg8::EpiStoreBf16, pg8::StaticOrder, true, true>(C.lds, g, S, E);
        }
        GRID_BAR();
#if DBG_CHECK
        if (l == DBG_LAYER) { FRESH(); chk_y(A, C, l); GRID_BAR(); }
#endif
        { FRESH(); phase_ln1_router(A, C, l); }
        GRID_BAR();
#if DBG_CHECK
        if (l == DBG_LAYER) { FRESH(); chk_ln1(A, C, l, l == 0 ? A.in[0] : A.out); probe_gates(A, C, 27); GRID_BAR(); }
#endif
        { FRESH(); phase_scatter(A, C); }
        GRID_BAR();
#if DBG_CHECK
        if (l == DBG_LAYER) { FRESH(); probe_gates(A, C, 28); }
#endif
        {
            FRESH(); pg8::ListOrder S; make_list(A, C, S);
            pg8::Gemm g{(const pg8::bf16_t*)(A.ws + WS_PROJ), (const pg8::bf16_t*)(A.ws + WS_WGU), PADROWS, NEXP * 1024, D};
            pg8::EpiSwiGLU E{(pg8::bf16_t*)(A.ws + WS_HID), DEXP};
            pg8::gemm_phase<pg8::EpiSwiGLU, pg8::ListOrder, true, true>(C.lds, g, S, E);
        }
        GRID_BAR();
#if DBG_CHECK
        if (l == DBG_LAYER) { FRESH(); chk_hid(A, C, l); probe_gates(A, C, 29); }
#endif
        {
            FRESH(); pg8::ListOrder S; make_list(A, C, S);
            pg8::Gemm g{(const pg8::bf16_t*)(A.ws + WS_HID), (const pg8::bf16_t*)(A.ws + WS_WD), PADROWS, NEXP * 1024, DEXP};
            pg8::EpiStoreBf16 E{(pg8::bf16_t*)(A.ws + WS_PROJ), D, nullptr, 3};
            pg8::gemm_phase<pg8::EpiStoreBf16, pg8::ListOrder, true, true>(C.lds, g, S, E);
        }
        GRID_BAR();
#if DBG_CHECK
        if (l == DBG_LAYER) { FRESH(); chk_yp(A, C, l); probe_gates(A, C, 30); }
#endif
        { FRESH(); phase_combine(A, C, l); }
        GRID_BAR();
#if DBG_CHECK
        if (l == DBG_LAYER) { FRESH(); chk_out(A, C, l); if (l + 1 < NLAYER) chk_gates(A, C, l + 1, A.out); GRID_BAR(); }
#endif
    }
#if DBG_CHECK
    { FRESH(); dbg_finish(A, C); }
#endif
}

extern "C" void kernel_launch(void* const* d_in, const int* in_sizes, int n_in, void* d_out, int out_size, void* d_ws, size_t ws_size, hipStream_t stream) {
    static int ready = 0;
    if (ready == 0) {
        if (n_in != 22 || in_sizes[0] != T * D || out_size != T * D || ws_size < WS_END) { fprintf(stderr, "kernel_launch: unexpected shapes (n_in %d, in0 %d, out %d, ws %zu)\n", n_in, n_in > 0 ? in_sizes[0] : -1, out_size, ws_size); ready = -1; return; }
        if (hipFuncSetAttribute((const void*)fwd_kernel, hipFuncAttributeMaxDynamicSharedMemorySize, LDS_BYTES) != hipSuccess) { fprintf(stderr, "kernel_launch: hipFuncSetAttribute failed\n"); ready = -1; return; }
        (void)hipGetLastError();
        ready = 1;
    }
    if (ready < 0) return;
    if (hipMemsetAsync((char*)d_ws + WS_CTL, 0, CTL_ZERO_BYTES, stream) != hipSuccess) return;
    Args a{};
    for (int i = 0; i < 22; ++i) a.in[i] = (const float*)d_in[i];
    a.out = (float*)d_out; a.ws = (unsigned char*)d_ws;
    hipLaunchKernelGGL(fwd_kernel, dim3(GRID), dim3(NTHREADS), LDS_BYTES, stream, a);
}
```

```cpp
#include <hip/hip_runtime.h>
#include <cstdio>
#include <cstdint>
namespace pg8 {
#define PG8_LAS __attribute__((address_space(3)))
typedef unsigned short bf16_t;
typedef short bf16x8 __attribute__((ext_vector_type(8)));
typedef float f32x4 __attribute__((ext_vector_type(4)));
typedef unsigned u32x4 __attribute__((ext_vector_type(4)));
constexpr int BM = 256, BK = 64, HALF = 128, HTB = HALF * BK * 2  , STAGE_BYTES = 8 * HTB, NXCD = 8, WGM = 8;

__host__ __device__ __forceinline__ int lds_byte(int r, int c) { const int st = (r >> 4) * 2 + (c >> 5), rr = r & 15, cc = c & 31, ob = rr * 64 + cc * 2; return st * 1024 + (ob ^ (((ob >> 9) & 1) << 5)); }
__host__ __device__ __forceinline__ void stage_rc(int b, int& R, int& C) { const int st = b / 1024, sb = b % 1024, swz = sb ^ (((sb >> 9) & 1) << 5); R = (st >> 1) * 16 + swz / 64; C = (st & 1) * 32 + (swz % 64) / 2; }
__host__ __device__ __forceinline__ int perm32(int rho) { const int n = rho >> 4, i = rho & 15; return 8 * (i >> 2) + 4 * n + (i & 3); }

struct Unit { int pm, pn; };
struct Gemm { const bf16_t* A; const bf16_t* Bt; int M, N, K; };

struct StaticOrder {
    int nM, nN, nwg, G, c;
    __host__ __device__ void init(int M, int N, int G_, int c_) { nM = M / BM; nN = N / BM; nwg = nM * nN; G = G_; c = c_; }
    __host__ __device__ bool next(int i, Unit& u) const {
        const long L = (long)i * G + c; if (L >= nwg) return false;
        int wgid = (int)L; { const int q = nwg / NXCD, r = nwg % NXCD, xcd = wgid % NXCD, off = wgid / NXCD; wgid = (xcd < r ? xcd * (q + 1) : r * (q + 1) + (xcd - r) * q) + off; }
        const int nig = WGM * nN, gid = wgid / nig, fm = gid * WGM, gsz = (nM - fm) < WGM ? (nM - fm) : WGM;
        u.pm = fm + ((wgid % nig) % gsz); u.pn = (wgid % nig) / gsz; return true;
    }
    __device__ __forceinline__ void a_ready(const Unit&) const {}
    __device__ __forceinline__ void done(const Unit&) const {}
};
struct ListOrder {
    const int* meta; int nunits, G, c;
    __device__ __forceinline__ bool next(int i, Unit& u) const {
        const int L = i * G + c; if (L >= nunits) return false;
        const int rt = L >> 2; u.pm = rt; u.pn = __builtin_amdgcn_readfirstlane(meta[16 + rt]) * 4 + (L & 3); return true;
    }
    __device__ __forceinline__ void a_ready(const Unit&) const {}
    __device__ __forceinline__ void done(const Unit&) const {}
};

__device__ __forceinline__ unsigned cvt_pk_bf16(float lo, float hi) { unsigned r; asm volatile("v_cvt_pk_bf16_f32 %0, %1, %2" : "=v"(r) : "v"(lo), "v"(hi)); return r; }

struct EpiStoreBf16 {
    static constexpr bool PERM = true, AFTER_DRAIN = false;
    bf16_t* O; int ldc; const float* bias; int pn_mask;
    __device__ __forceinline__ void operator()(const f32x4 (&acc)[2][2][4][2], const Unit& u, int wr, int wc, int fr, int fq) const {
        const int row0 = u.pm * BM + wr * 64 + fr; const int col0 = (u.pn & pn_mask) * BM + wc * 32 + 8 * fq;
        f32x4 bv[2][2];
#pragma unroll
        for (int bj = 0; bj < 2; ++bj)
#pragma unroll
            for (int n = 0; n < 2; ++n) bv[bj][n] = bias ? *(const f32x4*)(bias + col0 + bj * HALF + 4 * n) : (f32x4){0.f, 0.f, 0.f, 0.f};
#pragma unroll
        for (int ai = 0; ai < 2; ++ai)
#pragma unroll
            for (int m = 0; m < 4; ++m) { bf16_t* rowp = O + (size_t)(row0 + ai * HALF + m * 16) * ldc + col0;
#pragma unroll
                for (int bj = 0; bj < 2; ++bj) { const f32x4 v0 = acc[ai][bj][m][0] + bv[bj][0], v1 = acc[ai][bj][m][1] + bv[bj][1];
                    u32x4 w; w.x = cvt_pk_bf16(v0[0], v0[1]); w.y = cvt_pk_bf16(v0[2], v0[3]); w.z = cvt_pk_bf16(v1[0], v1[1]); w.w = cvt_pk_bf16(v1[2], v1[3]);
                    *(u32x4*)(rowp + bj * HALF) = w; } }
    }
};
struct EpiSwiGLU {
    static constexpr bool PERM = true, AFTER_DRAIN = false;
    bf16_t* O; int ldc;
    __device__ __forceinline__ void operator()(const f32x4 (&acc)[2][2][4][2], const Unit& u, int wr, int wc, int fr, int fq) const {
        const int row0 = u.pm * BM + wr * 64 + fr; const int col0 = (u.pn & 3) * HALF + wc * 32 + 8 * fq;
#pragma unroll
        for (int ai = 0; ai < 2; ++ai)
#pragma unroll
            for (int m = 0; m < 4; ++m) { bf16_t* rowp = O + (size_t)(row0 + ai * HALF + m * 16) * ldc + col0;
                float h[8];
#pragma unroll
                for (int n = 0; n < 2; ++n)
#pragma unroll
                    for (int k = 0; k < 4; ++k) { const float g = acc[ai][0][m][n][k], up = acc[ai][1][m][n][k]; h[4 * n + k] = g * up / (1.0f + __expf(-g)); }
                u32x4 w; w.x = cvt_pk_bf16(h[0], h[1]); w.y = cvt_pk_bf16(h[2], h[3]); w.z = cvt_pk_bf16(h[4], h[5]); w.w = cvt_pk_bf16(h[6], h[7]);
                *(u32x4*)rowp = w; }
    }
};
template <class Epi, class Sched, bool ALIGN_EPI = false, bool SP2 = false>
__device__ __forceinline__ void gemm_phase(PG8_LAS unsigned char* lds, const Gemm g, const Sched& S, const Epi& E) {
    int tid_l = threadIdx.x; asm volatile("" : "+v"(tid_l)); const int tid = tid_l, wid = __builtin_amdgcn_readfirstlane(tid >> 6), lane = tid & 63, wr = wid >> 2, wc = wid & 3, fr = lane & 15, fq = lane >> 4;
    const int K = g.K, nt = K / BK;
    unsigned voffA[2], voffB[2];
#pragma unroll
    for (int i = 0; i < 2; ++i) { int R, C; stage_rc(tid * 16 + i * 8192, R, C); const int Rb = Epi::PERM ? ((R & ~31) + perm32(R & 31)) : R;
        voffA[i] = (unsigned)(R * K + C) * 2u; voffB[i] = (unsigned)(Rb * K + C) * 2u; }
    const size_t kstep = (size_t)(BK * 2);
    const size_t hstep = (size_t)HALF * K * 2;
    const size_t tstep = 2 * hstep;
    const unsigned ldsw = (unsigned)wid * 1024u;
    const int aoff = lds_byte(wr * 64 + fr, fq * 8), boff = lds_byte(wc * 32 + fr, fq * 8);
#define PG8_SA(b, h) (((b) * 2 + (h)) * HTB)
#define PG8_SB(b, h) ((4 + (b) * 2 + (h)) * HTB)
#define PG8_STAGE(bufoff, gbase, voff) do { _Pragma("unroll") for (int _i = 0; _i < 2; ++_i) \
        __builtin_amdgcn_global_load_lds((const unsigned*)((const char*)(gbase) + (voff)[_i]), (PG8_LAS unsigned*)(lds + (bufoff) + ldsw + _i * 8192), 16, 0, 0); } while (0)
#define PG8_LDA(dst, b, h) do { _Pragma("unroll") for (int m = 0; m < 4; ++m) _Pragma("unroll") for (int k = 0; k < 2; ++k) dst[m][k] = *(const PG8_LAS bf16x8*)(lds + PG8_SA(b, h) + aoff + m * 2048 + k * 1024); } while (0)
#define PG8_LDB(dst, b, h) do { _Pragma("unroll") for (int n = 0; n < 2; ++n) _Pragma("unroll") for (int k = 0; k < 2; ++k) dst[n][k] = *(const PG8_LAS bf16x8*)(lds + PG8_SB(b, h) + boff + n * 2048 + k * 1024); } while (0)
#define PG8_MMA(ai, bj, At, Bt) do { __builtin_amdgcn_s_setprio(1); _Pragma("unroll") for (int m = 0; m < 4; ++m) _Pragma("unroll") for (int n = 0; n < 2; ++n) _Pragma("unroll") for (int k = 0; k < 2; ++k) \
        acc[ai][bj][m][n] = __builtin_amdgcn_mfma_f32_16x16x32_bf16(Bt[n][k], At[m][k], acc[ai][bj][m][n], 0, 0, 0); __builtin_amdgcn_s_setprio(0); } while (0)
#define PG8_WAIT_V(n) asm volatile("s_waitcnt vmcnt(" #n ")" ::: "memory")
#define PG8_WAIT_L(n) asm volatile("s_waitcnt lgkmcnt(" #n ")" ::: "memory")
#define PG8_BAR __builtin_amdgcn_s_barrier()
#define PG8_SCHED __builtin_amdgcn_sched_barrier(0)
    Unit cur, nxt; int ui = 0;
    if (!S.next(0, cur)) return;
    f32x4 acc[2][2][4][2];
#pragma unroll
    for (int a = 0; a < 2; ++a)
#pragma unroll
        for (int b = 0; b < 2; ++b)
#pragma unroll
            for (int m = 0; m < 4; ++m)
#pragma unroll
                for (int n = 0; n < 2; ++n) acc[a][b][m][n] = (f32x4){0.f, 0.f, 0.f, 0.f};
    bf16x8 At[4][2], B0[2][2], B1[2][2];
    const char* cA = (const char*)g.A + (size_t)cur.pm * tstep; const char* cB = (const char*)g.Bt + (size_t)cur.pn * tstep;
    S.a_ready(cur);
    if constexpr (SP2) {
        PG8_STAGE(PG8_SB(0, 0), cB, voffB); PG8_STAGE(PG8_SB(0, 1), cB + hstep, voffB); PG8_STAGE(PG8_SA(0, 0), cA, voffA); PG8_STAGE(PG8_SA(0, 1), cA + hstep, voffA);
        if (wr == 1) PG8_BAR;
        PG8_WAIT_V(2); PG8_BAR;
        PG8_STAGE(PG8_SB(1, 0), cB + kstep, voffB); PG8_STAGE(PG8_SA(1, 0), cA + kstep, voffA); PG8_STAGE(PG8_SB(1, 1), cB + hstep + kstep, voffB);
        PG8_WAIT_V(6); PG8_BAR;
    } else {
        PG8_STAGE(PG8_SB(0, 0), cB, voffB); PG8_STAGE(PG8_SA(0, 0), cA, voffA); PG8_STAGE(PG8_SB(0, 1), cB + hstep, voffB); PG8_STAGE(PG8_SA(0, 1), cA + hstep, voffA);
        if (wr == 1) PG8_BAR;
        PG8_WAIT_V(4); PG8_BAR;
        PG8_STAGE(PG8_SB(1, 0), cB + kstep, voffB); PG8_STAGE(PG8_SA(1, 0), cA + kstep, voffA); PG8_STAGE(PG8_SB(1, 1), cB + hstep + kstep, voffB);
        PG8_WAIT_V(6); PG8_BAR;
    }
    for (;;) {
        const bool has_next = S.next(ui + 1, nxt);
        const char* nA = has_next ? (const char*)g.A + (size_t)nxt.pm * tstep : cA; const char* nB = has_next ? (const char*)g.Bt + (size_t)nxt.pn * tstep : cB;
        for (int t = 0; t < nt; t += 2) {
            const bool last = (t == nt - 2);
            const char* a1 = cA + (size_t)(t + 1) * kstep;
            const char* a2 = last ? nA : cA + (size_t)(t + 2) * kstep; const char* b2 = last ? nB : cB + (size_t)(t + 2) * kstep;
            const char* a3 = a2 + kstep; const char* b3 = b2 + kstep;
            if (last && has_next) S.a_ready(nxt);
            if constexpr (SP2) {
            PG8_LDB(B0, 0, 0); PG8_LDB(B1, 0, 1); PG8_SCHED; PG8_LDA(At, 0, 0); PG8_STAGE(PG8_SA(1, 1), a1 + hstep, voffA);
            PG8_WAIT_V(8); PG8_WAIT_L(0); PG8_BAR; PG8_MMA(0, 0, At, B0); PG8_MMA(0, 1, At, B1); PG8_BAR; PG8_SCHED;
            PG8_LDA(At, 0, 1); PG8_STAGE(PG8_SB(0, 0), b2, voffB); PG8_STAGE(PG8_SB(0, 1), b2 + hstep, voffB); PG8_STAGE(PG8_SA(0, 0), a2, voffA);
            PG8_WAIT_V(8); PG8_WAIT_L(0); PG8_BAR; PG8_MMA(1, 0, At, B0); PG8_MMA(1, 1, At, B1); PG8_BAR; PG8_SCHED;
            PG8_LDB(B0, 1, 0); PG8_LDB(B1, 1, 1); PG8_SCHED; PG8_LDA(At, 1, 0); PG8_STAGE(PG8_SA(0, 1), a2 + hstep, voffA);
            PG8_WAIT_V(8); PG8_WAIT_L(0); PG8_BAR; PG8_MMA(0, 0, At, B0); PG8_MMA(0, 1, At, B1); PG8_BAR; PG8_SCHED;
            PG8_LDA(At, 1, 1); PG8_STAGE(PG8_SB(1, 0), b3, voffB); PG8_STAGE(PG8_SB(1, 1), b3 + hstep, voffB); PG8_STAGE(PG8_SA(1, 0), a3, voffA);
            PG8_WAIT_V(8); PG8_WAIT_L(0); PG8_BAR; PG8_MMA(1, 0, At, B0); PG8_MMA(1, 1, At, B1); PG8_BAR; PG8_SCHED;
            } else {
            PG8_LDB(B0, 0, 0); PG8_SCHED; PG8_LDA(At, 0, 0); PG8_STAGE(PG8_SA(1, 1), a1 + hstep, voffA);
            PG8_WAIT_L(8); PG8_BAR; PG8_WAIT_L(0); PG8_MMA(0, 0, At, B0); PG8_BAR; PG8_SCHED;
            PG8_LDB(B1, 0, 1); PG8_STAGE(PG8_SB(0, 0), b2, voffB);
            PG8_BAR; PG8_WAIT_L(0); PG8_MMA(0, 1, At, B1); PG8_BAR;
            PG8_LDA(At, 0, 1); PG8_STAGE(PG8_SA(0, 0), a2, voffA);
            PG8_BAR; PG8_WAIT_L(0); PG8_MMA(1, 0, At, B0); PG8_BAR; PG8_SCHED;
            PG8_STAGE(PG8_SB(0, 1), b2 + hstep, voffB);
            PG8_WAIT_V(6); PG8_BAR; PG8_MMA(1, 1, At, B1); PG8_BAR;
            PG8_LDB(B0, 1, 0); PG8_SCHED; PG8_LDA(At, 1, 0); PG8_STAGE(PG8_SA(0, 1), a2 + hstep, voffA);
            PG8_WAIT_L(8); PG8_BAR; PG8_WAIT_L(0); PG8_MMA(0, 0, At, B0); PG8_BAR; PG8_SCHED;
            PG8_LDB(B1, 1, 1); PG8_STAGE(PG8_SB(1, 0), b3, voffB);
            PG8_BAR; PG8_WAIT_L(0); PG8_MMA(0, 1, At, B1); PG8_BAR;
            PG8_LDA(At, 1, 1); PG8_STAGE(PG8_SA(1, 0), a3, voffA);
            PG8_BAR; PG8_WAIT_L(0); PG8_MMA(1, 0, At, B0); PG8_BAR; PG8_SCHED;
            PG8_STAGE(PG8_SB(1, 1), b3 + hstep, voffB);
            PG8_WAIT_V(6); PG8_BAR; PG8_MMA(1, 1, At, B1); PG8_BAR;
            }
        }
        if constexpr (ALIGN_EPI) { if (wr == 0) PG8_BAR; }
        if constexpr (!Epi::AFTER_DRAIN) { E(acc, cur, wr, wc, fr, fq); S.done(cur); }
        if (!has_next) break;
#pragma unroll
        for (int a = 0; a < 2; ++a)
#pragma unroll
            for (int b = 0; b < 2; ++b)
#pragma unroll
                for (int m = 0; m < 4; ++m)
#pragma unroll
                    for (int n = 0; n < 2; ++n) acc[a][b][m][n] = (f32x4){0.f, 0.f, 0.f, 0.f};
        cur = nxt; cA = nA; cB = nB; ++ui;
        if constexpr (ALIGN_EPI) { if (wr == 1) PG8_BAR; }
    }
    PG8_WAIT_V(0);
    if constexpr (!ALIGN_EPI) { if (wr == 0) PG8_BAR; }
    PG8_BAR;
    if constexpr (Epi::AFTER_DRAIN) { E.fused(acc, cur, wr, wc, fr, fq, lds, wid, lane); S.done(cur); }
#undef PG8_SA
#undef PG8_SB
#undef PG8_STAGE
#undef PG8_LDA
#undef PG8_LDB
#undef PG8_MMA
#undef PG8_WAIT_V
#undef PG8_WAIT_L
#undef PG8_BAR
#undef PG8_SCHED
}
}
#ifndef DBG_CHECK
#define DBG_CHECK 0
#endif
#define DBG_LAYER 0
#define DBG_BIAS 0
constexpr int NWAVES = 8, NTHREADS = 512, GRID = 256;
constexpr int NLAYER_RUN = DBG_CHECK ? (DBG_LAYER + 1) : 4;
constexpr int T = 16384, D = 1024, SEQ = 4096, NLAYER = 4;
constexpr int PIN = 3080, NPROJ = 3072;
constexpr int CH = 128, NCH = 32, NUNIT = 512;
constexpr int NEXP = 16, DEXP = 512;
constexpr int PADROWS = 36864;
constexpr float ALPHA = 1.6817928305074290f;
constexpr float LN_EPS = 1e-5f;
constexpr int PQ = 0, PK = 512, PV = 1024, PO = 1536, PGU = 2048, PGV = 2304, PCA = 2560, PCB = 2816;
constexpr size_t MiB = 1u << 20;
constexpr size_t WS_CTL = 0, CTL_ZERO_BYTES = 1 * MiB;
constexpr size_t WS_WIN = 2 * MiB, WS_WOUT = 8 * MiB, WS_WGU = 10 * MiB, WS_WD = 42 * MiB;
constexpr size_t WS_SMALL = 58 * MiB;
constexpr size_t SM_BIAS = WS_SMALL;
constexpr size_t SM_GATES = WS_SMALL + 64 * 1024;
constexpr size_t SM_SEL = SM_GATES + 512 * 1024;
constexpr size_t SM_HIST = SM_SEL + 256 * 1024;
constexpr size_t SM_META = SM_HIST + 16 * 1024;
constexpr size_t SM_TOKSLOT = SM_META + 4 * 1024;
constexpr size_t SM_G = SM_TOKSLOT + 128 * 1024;
constexpr size_t SM_MLOC = SM_G + 2048;
constexpr size_t SM_MPREV = SM_MLOC + 2048;
constexpr size_t SM_NLOC = SM_MPREV + 2048;
constexpr size_t SM_NPREV = SM_NLOC + 256 * 1024;
constexpr size_t SM_END = SM_NPREV + 256 * 1024;
constexpr size_t SM_WM = SM_END + 128 * 1024;
constexpr size_t SM_GW = SM_END;
static_assert(SM_WM + 128 * 1024 <= 62 * MiB, "small region");
constexpr size_t WS_XN = 62 * MiB, WS_HCAT = 94 * MiB, WS_X1 = 126 * MiB, WS_CLOCT = 190 * MiB, WS_CPREVT = 222 * MiB, WS_HID = 238 * MiB;
constexpr size_t WS_PROJ = 274 * MiB;
constexpr size_t WS_END = 370 * MiB;
static_assert(WS_HID + (size_t)PADROWS * DEXP * 2 <= WS_PROJ && WS_PROJ + (size_t)PADROWS * D * 2 <= WS_END && WS_PROJ + (size_t)T * NPROJ * 2 <= WS_END, "ws map");
constexpr int CW_TMO = 0, CW_BAR = 4096;
constexpr int RING_BYTES = 131072, LDSCTL_OFF = 139264, MISC_OFF = LDSCTL_OFF + 320, PTR_OFF = LDSCTL_OFF + 512, VEC_OFF = LDSCTL_OFF + 1024, LDS_BYTES = 151552;

#define LAS __attribute__((address_space(3)))
typedef unsigned short bf16;
typedef unsigned v4u __attribute__((ext_vector_type(4)));
typedef unsigned v2u __attribute__((ext_vector_type(2)));
typedef float f32x4 __attribute__((ext_vector_type(4)));
typedef float f32x2 __attribute__((ext_vector_type(2)));
#define DI __device__ __forceinline__
DI unsigned f2bf(float f) { unsigned u = __builtin_bit_cast(unsigned, f); return (u + 0x7fffu + ((u >> 16) & 1u)) >> 16; }
DI unsigned pk2(float lo, float hi) { return f2bf(lo) | (f2bf(hi) << 16); }
DI float bflo(unsigned w) { return __builtin_bit_cast(float, w << 16); }
DI float bfhi(unsigned w) { return __builtin_bit_cast(float, w & 0xffff0000u); }
DI float bf2f(bf16 h) { return __builtin_bit_cast(float, (unsigned)h << 16); }
DI float wave_sum(float v) {
#pragma unroll
    for (int o = 1; o < 64; o <<= 1) v += __shfl_xor(v, o);
    return v;
}
DI float sigmoidf_(float x) { return 1.0f / (1.0f + __expf(-x)); }
DI float gelu_tanh(float x) { const float u = 0.7978845608028654f * (x + 0.044715f * x * x * x); const float e = __expf(2.0f * u); const float th = 1.0f - 2.0f / (e + 1.0f); return 0.5f * x * (1.0f + th); }
DI float logsigmoidf_(float x) { return fminf(x, 0.0f) - log1pf(__expf(-fabsf(x))); }

#define XB_TMO      128
#define XB_XCNT(j)  (256  + 64 * (j))
#define XB_XSUB(j)  (1280 + 64 * (j))
#define XB_XGEN(j)  (2304 + 64 * (j))
#define XB_TOP      3328
#define XB_TOPGEN   3392
#define XCD_BAR_WORDS 3456
#define XB_SPIN_CAP (1u << 18)
__device__ __forceinline__ unsigned xb_ld(unsigned* p)              { return __hip_atomic_load(p, __ATOMIC_RELAXED, __HIP_MEMORY_SCOPE_AGENT); }
__device__ __forceinline__ unsigned xb_add(unsigned* p, unsigned v) { return __hip_atomic_fetch_add(p, v, __ATOMIC_RELAXED, __HIP_MEMORY_SCOPE_AGENT); }
__device__ __forceinline__ unsigned xb_xcc_id() { return (unsigned)__builtin_amdgcn_s_getreg((3 << 11) | 20) & 0xFu; }
#define XB_SPIN(cond, bar) do { unsigned _sp = 0; while (cond) { __builtin_amdgcn_s_sleep(1); \
    if ((++_sp & 255u) == 0u) { if (xb_ld(&(bar)[XB_TMO])) break; if (_sp > XB_SPIN_CAP) { atomicAdd(&(bar)[XB_TMO], 1u); break; } } } } while (0)
struct XcdBarrier { unsigned* bar; unsigned x; volatile LAS unsigned* st; };
__device__ __forceinline__ XcdBarrier xcd_barrier_post(unsigned* bar, volatile LAS unsigned* st) {
    XcdBarrier b; b.bar = bar; b.x = xb_xcc_id(); b.st = st;
    if (threadIdx.x == 0) (void)xb_add(&bar[XB_XCNT(b.x)], 1u);
    return b;
}
__device__ __forceinline__ void xcd_barrier_complete(unsigned* bar, unsigned x, unsigned& nloc, unsigned& nx) {
    const unsigned G = gridDim.x * gridDim.y * gridDim.z;
    unsigned sum, cnt, mine, sp = 0u;
    for (;;) {
        sum = 0u; cnt = 0u; mine = 0u;
#pragma unroll
        for (unsigned j = 0; j < 16; ++j) { const unsigned c = xb_ld(&bar[XB_XCNT(j)]); sum += c; cnt += (c > 0u) ? 1u : 0u; mine = (j == x) ? c : mine; }
        if (sum == G) break;
        __builtin_amdgcn_s_sleep(1);
        if ((++sp & 255u) == 0u) { if (xb_ld(&bar[XB_TMO])) break; if (sp > XB_SPIN_CAP) { atomicAdd(&bar[XB_TMO], 1u); break; } }
    }
    nloc = mine > 0u ? mine : 1u; nx = cnt > 0u ? cnt : 1u;
}
template <bool FIRST> __device__ __forceinline__ void xcd_barrier(const XcdBarrier& b) {
    asm volatile("s_waitcnt vmcnt(0)" ::: "memory");
    __syncthreads();
    if (threadIdx.x == 0) {
        unsigned* bar = b.bar; unsigned bx = b.x; { int z_ = 0; asm volatile("" : "+s"(z_)); bar += z_; bx += (unsigned)z_; }
        __builtin_amdgcn_s_waitcnt(0);
        unsigned nloc = b.st[0], nx = b.st[1];
        if (FIRST) { if (nloc == 0u) { xcd_barrier_complete(bar, bx, nloc, nx); b.st[0] = nloc; b.st[1] = nx; } }
        const unsigned old = xb_add(&bar[XB_XSUB(bx)], 1u);
        const unsigned gen = old / nloc;
        if (old + 1u == (gen + 1u) * nloc) {
            __builtin_amdgcn_fence(__ATOMIC_RELEASE, "agent");
            asm volatile("s_waitcnt vmcnt(0)" ::: "memory");
            const unsigned og = xb_add(&bar[XB_TOP], 1u);
            const unsigned tg = og / nx;
            if (og + 1u == (tg + 1u) * nx) xb_add(&bar[XB_TOPGEN], 1u);
            else XB_SPIN(xb_ld(&bar[XB_TOPGEN]) == tg, bar);
            __builtin_amdgcn_fence(__ATOMIC_ACQUIRE, "agent");
            xb_add(&bar[XB_XGEN(bx)], 1u);
            asm volatile("s_waitcnt vmcnt(0)" ::: "memory");
        } else {
            XB_SPIN(xb_ld(&bar[XB_XGEN(bx)]) == gen, bar);
            __builtin_amdgcn_fence(__ATOMIC_ACQUIRE, "agent");
            asm volatile("s_waitcnt vmcnt(0)" ::: "memory");
        }
    }
    __syncthreads();
}

struct Args { const float* in[22]; float* out; unsigned char* ws; };
struct Ctx { LAS unsigned char* lds; int tid, lane, wave, bid; };
__device__ __forceinline__ Ctx fresh_ctx(const Ctx& C0) { Ctx C = C0; asm volatile("" : "+v"(C.tid)); asm volatile("" : "+s"(C.bid)); asm volatile("" : "+s"(C.lds)); C.lane = C.tid & 63; C.wave = __builtin_amdgcn_readfirstlane(C.tid >> 6); return C; }

DI void transpose_item(const float* src, int ld, int k0, int n0, bf16* dst, int K, int drow0, LAS float* scr, int lane) {
#pragma unroll 8
    for (int i = 0; i < 32; ++i) { const int kk = 2 * i + (lane >> 5); scr[kk * 33 + (lane & 31)] = src[(size_t)(k0 + kk) * ld + n0 + (lane & 31)]; }
    asm volatile("s_waitcnt lgkmcnt(0)" ::: "memory");
    const int c = lane & 7;
#pragma unroll
    for (int j = 0; j < 4; ++j) { const int n = (lane >> 3) + 8 * j; const LAS float* s = scr + (8 * c) * 33 + n;
        v4u o; o.x = pk2(s[0 * 33], s[1 * 33]); o.y = pk2(s[2 * 33], s[3 * 33]); o.z = pk2(s[4 * 33], s[5 * 33]); o.w = pk2(s[6 * 33], s[7 * 33]);
        *(v4u*)(dst + (size_t)(drow0 + n) * K + k0 + 8 * c) = o; }
    asm volatile("s_waitcnt lgkmcnt(0)" ::: "memory");
}
DI void phase_convert(const Args& A, const Ctx& C0, int l) { const Ctx C = fresh_ctx(C0);
    LAS float* scr = (LAS float*)(C.lds + C.wave * 16384);
    const int gw = C.bid * NWAVES + C.wave, NGW = GRID * NWAVES;
    bf16* WIN = (bf16*)(A.ws + WS_WIN); bf16* WOUT = (bf16*)(A.ws + WS_WOUT); bf16* WGU = (bf16*)(A.ws + WS_WGU); bf16* WD = (bf16*)(A.ws + WS_WD);
    constexpr int I_IN = 16 * 96, I_OUT = 16 * 32, I_GU = 16 * 512, I_D = 16 * 256, NITEMS = I_IN + I_OUT + I_GU + I_D;
    for (int it = gw; it < NITEMS; it += NGW) {
        int r = it;
        if (r < I_IN) { const int kb = r / 96, nb = r % 96, n0 = 32 * nb; transpose_item(A.in[1] + (size_t)l * D * PIN, PIN, 64 * kb, n0 + (n0 >= 2048 ? 8 : 0), WIN, D, n0, scr, C.lane); continue; } r -= I_IN;
        if (r < I_OUT) { const int kb = r / 32, nb = r % 32; transpose_item(A.in[12] + (size_t)l * D * D, D, 64 * kb, 32 * nb, WOUT, D, 32 * nb, scr, C.lane); continue; } r -= I_OUT;
        if (r < I_GU) { const int e = r / 512, r1 = r % 512, half = r1 / 256, r2 = r1 % 256, kb = r2 / 16, nb = r2 % 16, j0 = 32 * nb;
            transpose_item((half ? A.in[18] : A.in[17]) + (size_t)(l * NEXP + e) * D * DEXP, DEXP, 64 * kb, j0, WGU, D, e * 1024 + (j0 / 128) * 256 + half * 128 + (j0 % 128), scr, C.lane); continue; } r -= I_GU;
        { const int e = r / 256, r1 = r % 256, kb = r1 / 32, nb = r1 % 32;
            transpose_item(A.in[19] + (size_t)(l * NEXP + e) * DEXP * D, D, 64 * kb, 32 * nb, WD, DEXP, e * 1024 + 32 * nb, scr, C.lane); }
    }
    { bf16* WM = (bf16*)(A.ws + SM_WM); const float* wsrc = A.in[6] + (size_t)l * 4 * CH * CH;
        for (int i = C.bid * NTHREADS + C.tid; i < 4 * CH * CH; i += GRID * NTHREADS) { const int s = i & 127, t = (i >> 7) & 127; WM[i] = (bf16)f2bf(s <= t ? wsrc[i] : 0.f); } }
    float* BIAS = (float*)(A.ws + SM_BIAS);
    for (int n = C.bid * NTHREADS + C.tid; n < NPROJ; n += GRID * NTHREADS) BIAS[n] = A.in[2][(size_t)l * PIN + n + (n >= 2048 ? 8 : 0)];
}

DI void stage_gate_weights(const Args& A, const Ctx& C, int lg) {
    LAS float* gwl = (LAS float*)C.lds;
    const float* w = A.in[1] + (size_t)lg * D * PIN + 2048;
    for (int i = C.tid; i < 8 * D; i += NTHREADS) { const int col = i >> 3, g = i & 7; gwl[g * D + col] = w[(size_t)col * PIN + g]; }
}
DI void row_emit(const Args& A, const Ctx& C, int t, const f32x4 (&v)[4], float* xout, bool want_xn, int lg) {
    if (xout) {
#pragma unroll
        for (int j = 0; j < 4; ++j) *(f32x4*)(xout + (size_t)t * D + 256 * j + 4 * C.lane) = v[j];
    }
    if (want_xn) {
        bf16* XN = (bf16*)(A.ws + WS_XN);
#pragma unroll
        for (int j = 0; j < 4; ++j) { v2u w; w.x = pk2(v[j][0], v[j][1]); w.y = pk2(v[j][2], v[j][3]); *(v2u*)(XN + (size_t)t * D + 256 * j + 4 * C.lane) = w; }
    }
    if (lg >= 0) {
        const LAS float* gwl = (const LAS float*)C.lds;
        float* GATES = (float*)(A.ws + SM_GATES);
        float gs[8];
#pragma unroll
        for (int g = 0; g < 8; ++g) { float s = 0.f;
#pragma unroll
            for (int j = 0; j < 4; ++j) { const f32x4 w = *(const LAS f32x4*)(gwl + g * D + 256 * j + 4 * C.lane); s += v[j][0] * w[0] + v[j][1] * w[1] + v[j][2] * w[2] + v[j][3] * w[3]; }
            gs[g] = wave_sum(s); }
        if (C.lane == 0) {
            const float* bg = A.in[2] + (size_t)lg * PIN + 2048;
            f32x4 o0 = {gs[0] + bg[0], gs[1] + bg[1], gs[2] + bg[2], gs[3] + bg[3]}, o1 = {gs[4] + bg[4], gs[5] + bg[5], gs[6] + bg[6], gs[7] + bg[7]};
            *(f32x4*)(GATES + (size_t)t * 8) = o0; *(f32x4*)(GATES + (size_t)t * 8 + 4) = o1;
        }
    }
}
DI void phase_prologue_rows(const Args& A, const Ctx& C0) { const Ctx C = fresh_ctx(C0);
    stage_gate_weights(A, C, 0);
    __syncthreads();
    for (int t = C.bid * NWAVES + C.wave; t < T; t += GRID * NWAVES) {
        f32x4 v[4];
#pragma unroll
        for (int j = 0; j < 4; ++j) v[j] = *(const f32x4*)(A.in[0] + (size_t)t * D + 256 * j + 4 * C.lane);
        row_emit(A, C, t, v, nullptr, true, 0);
    }
    __syncthreads();
}
DI void row_layernorm(f32x4 (&v)[4], const float* w, const float* b, int lane) {
    float s = 0.f;
#pragma unroll
    for (int j = 0; j < 4; ++j) s += (v[j][0] + v[j][1]) + (v[j][2] + v[j][3]);
    const float mean = wave_sum(s) * (1.0f / D); float q = 0.f;
#pragma unroll
    for (int j = 0; j < 4; ++j) { v[j] = v[j] - mean; q += (v[j][0] * v[j][0] + v[j][1] * v[j][1]) + (v[j][2] * v[j][2] + v[j][3] * v[j][3]); }
    const float rstd = 1.0f / sqrtf(wave_sum(q) * (1.0f / D) + LN_EPS);
#pragma unroll
    for (int j = 0; j < 4; ++j) { const f32x4 ww = *(const f32x4*)(w + 256 * j + 4 * lane), bb = *(const f32x4*)(b + 256 * j + 4 * lane); v[j] = v[j] * rstd * ww + bb; }
}
DI void phase_ln1_router(const Args& A, const Ctx& C0, int l) { const Ctx C = fresh_ctx(C0);
    LAS float* rwl = (LAS float*)C.lds;
    LAS int* hist = (LAS int*)(C.lds + VEC_OFF);
    for (int i = C.tid; i < NEXP * D; i += NTHREADS) { const int col = i >> 4, e = i & 15; rwl[e * D + col] = A.in[15][i]; }
    if (C.tid < 16) hist[C.tid] = 0;
    __syncthreads();
    const float* X = (l == 0) ? A.in[0] : A.out;
    const bf16* Y = (const bf16*)(A.ws + WS_PROJ);
    float* X1 = (float*)(A.ws + WS_X1);
    v4u* SEL = (v4u*)(A.ws + SM_SEL);
    float rb[16];
#pragma unroll
    for (int e = 0; e < 16; ++e) rb[e] = A.in[16][e];
    for (int i = 0; i < 8; ++i) {
        const int t = C.bid * 64 + C.wave * 8 + i;
        f32x4 v[4];
#pragma unroll
        for (int j = 0; j < 4; ++j) { const f32x4 x = *(const f32x4*)(X + (size_t)t * D + 256 * j + 4 * C.lane); const v2u y = *(const v2u*)(Y + (size_t)t * D + 256 * j + 4 * C.lane);
            v[j][0] = ALPHA * x[0] + bflo(y.x); v[j][1] = ALPHA * x[1] + bfhi(y.x); v[j][2] = ALPHA * x[2] + bflo(y.y); v[j][3] = ALPHA * x[3] + bfhi(y.y); }
        row_layernorm(v, A.in[13] + (size_t)l * D, A.in[14] + (size_t)l * D, C.lane);
        row_emit(A, C, t, v, X1, true, -1);
        float best = -INFINITY, bs0 = 0.f, bs1 = 0.f; int be0 = 0, be1 = 1;
#pragma unroll
        for (int g = 0; g < 4; ++g) {
            float sel[4], sg[4];
#pragma unroll
            for (int k = 0; k < 4; ++k) { const int e = 4 * g + k; float s = 0.f;
#pragma unroll
                for (int j = 0; j < 4; ++j) { const f32x4 w = *(const LAS f32x4*)(rwl + e * D + 256 * j + 4 * C.lane); s += v[j][0] * w[0] + v[j][1] * w[1] + v[j][2] * w[2] + v[j][3] * w[3]; }
                s = wave_sum(s); sg[k] = 1.0f / (1.0f + expf(-s)); sel[k] = sg[k] + rb[e]; }
            float m1 = sel[0], s1 = sg[0]; int i1 = 0;
#pragma unroll
            for (int k = 1; k < 4; ++k) if (sel[k] > m1) { m1 = sel[k]; s1 = sg[k]; i1 = k; }
            float m2 = -INFINITY, s2 = 0.f; int i2 = 0;
#pragma unroll
            for (int k = 0; k < 4; ++k) if (k != i1 && sel[k] > m2) { m2 = sel[k]; s2 = sg[k]; i2 = k; }
            const float gsc = m1 + m2;
            if (gsc > best) { best = gsc; be0 = 4 * g + i1; be1 = 4 * g + i2; bs0 = s1; bs1 = s2; }
        }
        if (C.lane == 0) {
            const float inv = 1.0f / (bs0 + bs1);
            v4u o; o.x = (unsigned)be0; o.y = (unsigned)be1; o.z = __builtin_bit_cast(unsigned, bs0 * inv); o.w = __builtin_bit_cast(unsigned, bs1 * inv);
            SEL[t] = o;
            ((f32x2*)(A.ws + SM_GW))[t] = (f32x2){bs0 * inv, bs1 * inv};
            __hip_atomic_fetch_add(hist + be0, 1, __ATOMIC_RELAXED, __HIP_MEMORY_SCOPE_WORKGROUP);
            __hip_atomic_fetch_add(hist + be1, 1, __ATOMIC_RELAXED, __HIP_MEMORY_SCOPE_WORKGROUP);
        }
    }
    __syncthreads();
    if (C.tid < 16) ((int*)(A.ws + SM_HIST))[C.bid * 16 + C.tid] = hist[C.tid];
    __syncthreads();
}
DI void phase_scatter(const Args& A, const Ctx& C0) { const Ctx C = fresh_ctx(C0);
    LAS int* sh = (LAS int*)(C.lds + VEC_OFF);
    LAS int* cnt = sh, *off = sh + 16, *base = sh + 32, *se = sh + 64, *pos = sh + 192;
    const int* HIST = (const int*)(A.ws + SM_HIST);
    const v4u* SEL = (const v4u*)(A.ws + SM_SEL);
    int* META = (int*)(A.ws + SM_META);
    int* TOKSLOT = (int*)(A.ws + SM_TOKSLOT);
    if (C.tid < 16) { int c = 0, o = 0; for (int w = 0; w < GRID; ++w) { const int h = HIST[w * 16 + C.tid]; if (w < C.bid) o += h; c += h; } cnt[C.tid] = c; off[C.tid] = o; }
    if (C.tid >= 64 && C.tid < 128) { const int i = C.tid - 64; const v4u s = SEL[C.bid * 64 + i]; se[2 * i] = (int)s.x; se[2 * i + 1] = (int)s.y; }
    __syncthreads();
    if (C.tid == 0) { int run = 0;
        for (int e = 0; e < 16; ++e) { base[e] = run; const int nt = (cnt[e] + 255) >> 8; if (C.bid == 0) for (int k = 0; k < nt; ++k) META[16 + (run >> 8) + k] = e; run += nt * 256; }
        if (C.bid == 0) META[0] = run >> 8; }
    __syncthreads();
    if (C.tid < 16) { int r = 0; for (int q = 0; q < 128; ++q) if (se[q] == C.tid) { pos[q] = base[C.tid] + off[C.tid] + r; ++r; } }
    __syncthreads();
    if (C.tid < 128) TOKSLOT[C.bid * 128 + C.tid] = pos[C.tid];
    const bf16* XN = (const bf16*)(A.ws + WS_XN); bf16* XG = (bf16*)(A.ws + WS_PROJ);
    for (int r = C.wave; r < 128; r += 8) { const int p = pos[r], t = C.bid * 64 + (r >> 1);
        const v4u a = *(const v4u*)(XN + (size_t)t * D + 8 * C.lane), b = *(const v4u*)(XN + (size_t)t * D + 512 + 8 * C.lane);
        *(v4u*)(XG + (size_t)p * D + 8 * C.lane) = a; *(v4u*)(XG + (size_t)p * D + 512 + 8 * C.lane) = b; }
    __syncthreads();
}
DI void make_list(const Args& A, const Ctx& C, pg8::ListOrder& S) {
    const int* META = (const int*)(A.ws + SM_META);
    S.meta = META; S.nunits = __builtin_amdgcn_readfirstlane(META[0]) * 4; S.G = GRID; S.c = C.bid;
}
DI void phase_combine(const Args& A, const Ctx& C0, int l) { const Ctx C = fresh_ctx(C0);
    const bool last = (l == NLAYER - 1);
    if (!last) { stage_gate_weights(A, C, l + 1); }
    __syncthreads();
    const float* X1 = (const float*)(A.ws + WS_X1); const bf16* YP = (const bf16*)(A.ws + WS_PROJ);
    const v4u* SEL = (const v4u*)(A.ws + SM_SEL); const int* TOKSLOT = (const int*)(A.ws + SM_TOKSLOT);
    for (int t = C.bid * NWAVES + C.wave; t < T; t += GRID * NWAVES) {
        const v4u s = SEL[t]; const int p0 = TOKSLOT[2 * t], p1 = TOKSLOT[2 * t + 1]; const f32x2 gw2 = ((const f32x2*)(A.ws + SM_GW))[t]; const float g0 = gw2[0], g1 = gw2[1];
        f32x4 v[4];
#pragma unroll
        for (int j = 0; j < 4; ++j) { const f32x4 x = *(const f32x4*)(X1 + (size_t)t * D + 256 * j + 4 * C.lane);
            const v2u a = *(const v2u*)(YP + (size_t)p0 * D + 256 * j + 4 * C.lane), b = *(const v2u*)(YP + (size_t)p1 * D + 256 * j + 4 * C.lane);
            v[j][0] = ALPHA * x[0] + g0 * bflo(a.x) + g1 * bflo(b.x); v[j][1] = ALPHA * x[1] + g0 * bfhi(a.x) + g1 * bfhi(b.x);
            v[j][2] = ALPHA * x[2] + g0 * bflo(a.y) + g1 * bflo(b.y); v[j][3] = ALPHA * x[3] + g0 * bfhi(a.y) + g1 * bfhi(b.y); }
        row_layernorm(v, A.in[20] + (size_t)l * D, A.in[21] + (size_t)l * D, C.lane);
        row_emit(A, C, t, v, A.out, !last, last ? -1 : l + 1);
    }
    __syncthreads();
}
DI void unpack8(const v4u w, float (&f)[8]) { f[0] = bflo(w.x); f[1] = bfhi(w.x); f[2] = bflo(w.y); f[3] = bfhi(w.y); f[4] = bflo(w.z); f[5] = bfhi(w.z); f[6] = bflo(w.w); f[7] = bfhi(w.w); }
DI void conv_unit(const Args& A, const Ctx& C0, int l, int unit) { const Ctx C = fresh_ctx(C0);
    const bf16* PROJ = (const bf16*)(A.ws + WS_PROJ); bf16* HCAT = (bf16*)(A.ws + WS_HCAT);
    LAS float* cin = (LAS float*)C.lds;
    LAS float* cou = (LAS float*)(C.lds + 65536);
    const int t0 = unit * 32, tseq = t0 & (SEQ - 1);
    for (int it = C.tid; it < 62 * 32; it += NTHREADS) { const int r = it >> 5, c8 = (it & 31) * 8; float o[8];
        if (tseq - 30 + r >= 0) { const size_t rowo = (size_t)(t0 - 30 + r) * NPROJ; float a[8], b[8]; unpack8(*(const v4u*)(PROJ + rowo + PCA + c8), a); unpack8(*(const v4u*)(PROJ + rowo + PCB + c8), b);
#pragma unroll
            for (int i = 0; i < 8; ++i) o[i] = a[i] * sigmoidf_(b[i]); }
        else {
#pragma unroll
            for (int i = 0; i < 8; ++i) o[i] = 0.f; }
        *(LAS f32x4*)(cin + r * 256 + c8) = (f32x4){o[0], o[1], o[2], o[3]}; *(LAS f32x4*)(cin + r * 256 + c8 + 4) = (f32x4){o[4], o[5], o[6], o[7]}; }
    __syncthreads();
    { const int c = C.tid & 255, half = C.tid >> 8;
        float w[31];
#pragma unroll
        for (int j = 0; j < 31; ++j) w[j] = A.in[8][(size_t)(l * 31 + j) * 256 + c];
        const float bias = A.in[9][l * 256 + c];
        float xin[46];
#pragma unroll
        for (int r = 0; r < 46; ++r) xin[r] = cin[(half * 16 + r) * 256 + c];
#pragma unroll
        for (int i = 0; i < 16; ++i) { float acc = bias;
#pragma unroll
            for (int j = 0; j < 31; ++j) acc += xin[i + j] * w[j];
            cou[(half * 16 + i) * 256 + c] = acc; } }
    __syncthreads();
    { const f32x4 nw = *(const f32x4*)(A.in[10] + l * 256 + 4 * C.lane), nb = *(const f32x4*)(A.in[11] + l * 256 + 4 * C.lane);
#pragma unroll
        for (int q = 0; q < 4; ++q) { const int r = 4 * C.wave + q; f32x4 x = *(const LAS f32x4*)(cou + r * 256 + 4 * C.lane);
            const float mean = wave_sum((x[0] + x[1]) + (x[2] + x[3])) * (1.0f / 256.0f); x = x - mean;
            const float var = wave_sum((x[0] * x[0] + x[1] * x[1]) + (x[2] * x[2] + x[3] * x[3])) * (1.0f / 256.0f);
            const float rstd = 1.0f / sqrtf(var + LN_EPS); x = x * rstd * nw + nb;
            float o[4];
#pragma unroll
            for (int k = 0; k < 4; ++k) o[k] = x[k] * sigmoidf_(x[k]);
            v2u pk; pk.x = pk2(o[0], o[1]); pk.y = pk2(o[2], o[3]);
            *(v2u*)(HCAT + (size_t)(t0 + r) * D + 768 + 4 * C.lane) = pk; } }
    __syncthreads();
}
DI void gmlp_unit_simple(const Args& A, const Ctx& C0, int l, int ck) { const Ctx C = fresh_ctx(C0);
    const bf16* PROJ = (const bf16*)(A.ws + WS_PROJ); bf16* HCAT = (bf16*)(A.ws + WS_HCAT);
    LAS float* zs = (LAS float*)C.lds;
    const int t0 = ck * CH;
    { const f32x4 nw = *(const f32x4*)(A.in[4] + l * 256 + 4 * C.lane), nb = *(const f32x4*)(A.in[5] + l * 256 + 4 * C.lane);
        for (int i = 0; i < 16; ++i) { const int r = C.wave * 16 + i; const v2u g = *(const v2u*)(PROJ + (size_t)(t0 + r) * NPROJ + PGV + 4 * C.lane);
            f32x4 x = {gelu_tanh(bflo(g.x)), gelu_tanh(bfhi(g.x)), gelu_tanh(bflo(g.y)), gelu_tanh(bfhi(g.y))};
            const float mean = wave_sum((x[0] + x[1]) + (x[2] + x[3])) * (1.0f / 256.0f); x = x - mean;
            const float var = wave_sum((x[0] * x[0] + x[1] * x[1]) + (x[2] * x[2] + x[3] * x[3])) * (1.0f / 256.0f);
            const float rstd = 1.0f / sqrtf(var + LN_EPS); x = x * rstd * nw + nb;
            *(LAS f32x4*)(zs + r * 256 + 4 * C.lane) = x; } }
    __syncthreads();
    { const int tb = C.tid >> 4, cb = C.tid & 15, c0 = 16 * cb, h = cb >> 2, tr0 = 4 * tb;
        const float* ws = A.in[6] + (size_t)(l * 4 + h) * CH * CH;
        float acc[4][16];
#pragma unroll
        for (int i = 0; i < 4; ++i)
#pragma unroll
            for (int j = 0; j < 16; ++j) acc[i][j] = 0.f;
        for (int s = 0; s <= tr0 + 3; ++s) {
            float zv[16];
#pragma unroll
            for (int q = 0; q < 4; ++q) { const f32x4 z4 = *(const LAS f32x4*)(zs + s * 256 + c0 + 4 * q); zv[4 * q] = z4[0]; zv[4 * q + 1] = z4[1]; zv[4 * q + 2] = z4[2]; zv[4 * q + 3] = z4[3]; }
#pragma unroll
            for (int i = 0; i < 4; ++i) { const float wg = (s <= tr0 + i) ? ws[(size_t)(tr0 + i) * CH + s] : 0.f;
#pragma unroll
                for (int j = 0; j < 16; ++j) acc[i][j] += wg * zv[j]; }
        }
#pragma unroll
        for (int i = 0; i < 4; ++i) { const int tr = tr0 + i; const float bsv = A.in[7][(size_t)(l * 4 + h) * CH + tr]; const size_t rowo = (size_t)(t0 + tr) * NPROJ + PGU + c0;
            float u[16]; { float tmp[8]; unpack8(*(const v4u*)(PROJ + rowo), tmp);
#pragma unroll
                for (int j = 0; j < 8; ++j) u[j] = tmp[j];
                unpack8(*(const v4u*)(PROJ + rowo + 8), tmp);
#pragma unroll
                for (int j = 0; j < 8; ++j) u[8 + j] = tmp[j]; }
            float o[16];
#pragma unroll
            for (int j = 0; j < 16; ++j) o[j] = gelu_tanh(u[j]) * (acc[i][j] + bsv);
            v4u w0, w1; w0.x = pk2(o[0], o[1]); w0.y = pk2(o[2], o[3]); w0.z = pk2(o[4], o[5]); w0.w = pk2(o[6], o[7]); w1.x = pk2(o[8], o[9]); w1.y = pk2(o[10], o[11]); w1.z = pk2(o[12], o[13]); w1.w = pk2(o[14], o[15]);
            *(v4u*)(HCAT + (size_t)(t0 + tr) * D + 512 + c0) = w0; *(v4u*)(HCAT + (size_t)(t0 + tr) * D + 512 + c0 + 8) = w1; }
    }
    __syncthreads();
}
DI void mlstm_local_simple(const Args& A, const Ctx& C0, int un) { const Ctx C = fresh_ctx(C0);
    const bf16* PROJ = (const bf16*)(A.ws + WS_PROJ); const float* GATES = (const float*)(A.ws + SM_GATES);
    const int bh = un >> 5, c = un & 31, b = bh >> 2, h = bh & 3, t0 = b * SEQ + c * CH;
    LAS float* kw = (LAS float*)C.lds;
    LAS float* vs = (LAS float*)(C.lds + 65536);
    LAS float* vec = (LAS float*)(C.lds + VEC_OFF);
    if (C.tid < CH) { const float fp = GATES[(size_t)(t0 + C.tid) * 8 + 4 + h], ip = GATES[(size_t)(t0 + C.tid) * 8 + h]; vec[C.tid] = logsigmoidf_(fp); vec[128 + C.tid] = ip; }
    __syncthreads();
    if (C.tid == 0) { float run = 0.f; for (int i = 0; i < CH; ++i) { run += vec[i]; vec[i] = run; } const float g = run; float ml = -INFINITY;
        for (int i = 0; i < CH; ++i) { const float a = g - vec[i] + vec[128 + i]; vec[256 + i] = a; ml = fmaxf(ml, a); }
        for (int i = 0; i < CH; ++i) vec[256 + i] = __expf(vec[256 + i] - ml);
        ((float*)(A.ws + SM_G))[un] = g; ((float*)(A.ws + SM_MLOC))[un] = ml; }
    __syncthreads();
    for (int it = C.tid; it < CH * 16; it += NTHREADS) { const int r = it >> 4, c8 = (it & 15) * 8; const size_t rowo = (size_t)(t0 + r) * NPROJ + h * 128 + c8; float k8[8], v8[8];
        unpack8(*(const v4u*)(PROJ + rowo + PK), k8); unpack8(*(const v4u*)(PROJ + rowo + PV), v8); const float sc = vec[256 + r] * 0.08838834764831845f;
#pragma unroll
        for (int i = 0; i < 8; ++i) { kw[r * 128 + c8 + i] = k8[i] * sc; vs[r * 128 + c8 + i] = v8[i]; } }
    __syncthreads();
    { const int db = C.tid >> 4, eb = C.tid & 15, d0 = 4 * db, e0 = 8 * eb; float acc[4][8];
#pragma unroll
        for (int i = 0; i < 4; ++i)
#pragma unroll
            for (int j = 0; j < 8; ++j) acc[i][j] = 0.f;
        for (int r = 0; r < CH; ++r) { const f32x4 kd = *(const LAS f32x4*)(kw + r * 128 + d0); const f32x4 va = *(const LAS f32x4*)(vs + r * 128 + e0), vb = *(const LAS f32x4*)(vs + r * 128 + e0 + 4);
#pragma unroll
            for (int i = 0; i < 4; ++i) { acc[i][0] += kd[i] * va[0]; acc[i][1] += kd[i] * va[1]; acc[i][2] += kd[i] * va[2]; acc[i][3] += kd[i] * va[3]; acc[i][4] += kd[i] * vb[0]; acc[i][5] += kd[i] * vb[1]; acc[i][6] += kd[i] * vb[2]; acc[i][7] += kd[i] * vb[3]; } }
        float* CL = (float*)(A.ws + WS_CLOCT) + (size_t)un * CH * CH;
#pragma unroll
        for (int j = 0; j < 8; ++j) *(f32x4*)(CL + (size_t)(e0 + j) * CH + d0) = (f32x4){acc[0][j], acc[1][j], acc[2][j], acc[3][j]}; }
    if (C.tid < CH) { float s = 0.f; for (int r = 0; r < CH; ++r) s += kw[r * 128 + C.tid]; ((float*)(A.ws + SM_NLOC))[(size_t)un * CH + C.tid] = s; }
    __syncthreads();
}
DI void phase_scan(const Args& A, const Ctx& C0) { const Ctx C = fresh_ctx(C0);
    const int gt = C.bid * NTHREADS + C.tid, bh = gt >> 13, pr = gt & 8191;
    const float* G = (const float*)(A.ws + SM_G); const float* ML = (const float*)(A.ws + SM_MLOC); float* MP = (float*)(A.ws + SM_MPREV);
    const float* CL = (const float*)(A.ws + WS_CLOCT); unsigned* CP = (unsigned*)(A.ws + WS_CPREVT);
    const float* NL = (const float*)(A.ws + SM_NLOC); float* NP = (float*)(A.ws + SM_NPREV);
    float c0 = 0.f, c1 = 0.f, n0 = 0.f, n1 = 0.f, m = 0.f;
    for (int c = 0; c < NCH; ++c) { const int un = bh * NCH + c;
        CP[(size_t)un * (CH * CH / 2) + pr] = pk2(c0, c1);
        if (pr == 0) MP[un] = m;
        if (pr < 64) *(f32x2*)(NP + (size_t)un * CH + 2 * pr) = (f32x2){n0, n1};
        const float g = G[un], ml = ML[un], mn = fmaxf(g + m, ml), dec = __expf(g + m - mn), sc = __expf(ml - mn);
        const f32x2 cl = *(const f32x2*)(CL + (size_t)un * CH * CH + 2 * pr);
        c0 = dec * c0 + sc * cl[0]; c1 = dec * c1 + sc * cl[1];
        if (pr < 64) { const f32x2 nl = *(const f32x2*)(NL + (size_t)un * CH + 2 * pr); n0 = dec * n0 + sc * nl[0]; n1 = dec * n1 + sc * nl[1]; }
        m = mn; }
}
DI void mlstm_out_simple(const Args& A, const Ctx& C0, int l, int un) { const Ctx C = fresh_ctx(C0);
    const bf16* PROJ = (const bf16*)(A.ws + WS_PROJ); const float* GATES = (const float*)(A.ws + SM_GATES); bf16* HCAT = (bf16*)(A.ws + WS_HCAT);
    const int bh = un >> 5, c = un & 31, b = bh >> 2, h = bh & 3, t0 = b * SEQ + c * CH;
    LAS bf16* qs = (LAS bf16*)C.lds;
    LAS bf16* ks = (LAS bf16*)(C.lds + 32768);
    LAS float* ps = (LAS float*)(C.lds + 65536);
    LAS float* vec = (LAS float*)(C.lds + VEC_OFF);
    LAS float* bvec = vec, *uvec = vec + 128, *Mvec = vec + 256, *wint = vec + 384, *flo = vec + 512, *den = vec + 640, *npv = vec + 768, *ipv = vec + 896, *lfv = vec + 1024, *qnv = vec + 1152;
    if (C.tid < CH) { const float fp = GATES[(size_t)(t0 + C.tid) * 8 + 4 + h], ip = GATES[(size_t)(t0 + C.tid) * 8 + h]; lfv[C.tid] = logsigmoidf_(fp); ipv[C.tid] = ip; npv[C.tid] = ((const float*)(A.ws + SM_NPREV))[(size_t)un * CH + C.tid]; }
    __syncthreads();
    if (C.tid == 0) { const float mprev = ((const float*)(A.ws + SM_MPREV))[un]; float run = 0.f, pm = -INFINITY;
        for (int i = 0; i < CH; ++i) { run += lfv[i]; bvec[i] = run; const float u = ipv[i] - run; uvec[i] = u; pm = fmaxf(pm, u); const float M = fmaxf(mprev, pm); Mvec[i] = M; wint[i] = __expf(mprev - M); flo[i] = __expf(-(run + M)); } }
    for (int it = C.tid; it < CH * 16; it += NTHREADS) { const int r = it >> 4, c8 = (it & 15) * 8; const size_t rowo = (size_t)(t0 + r) * NPROJ + h * 128 + c8;
        *(LAS v4u*)(qs + r * 128 + c8) = *(const v4u*)(PROJ + rowo + PQ); *(LAS v4u*)(ks + r * 128 + c8) = *(const v4u*)(PROJ + rowo + PK); }
    __syncthreads();
    const int lb = C.tid >> 4, xb = C.tid & 15, l0 = 4 * lb, x0 = 8 * xb;
    {
        float acc[4][8];
#pragma unroll
        for (int i = 0; i < 4; ++i)
#pragma unroll
            for (int j = 0; j < 8; ++j) acc[i][j] = 0.f;
        if (x0 <= l0 + 3) {
            for (int d8 = 0; d8 < 16; ++d8) { float qf[4][8], kf[8];
#pragma unroll
                for (int i = 0; i < 4; ++i) unpack8(*(const LAS v4u*)(qs + (l0 + i) * 128 + d8 * 8), qf[i]);
#pragma unroll
                for (int j = 0; j < 8; ++j) { unpack8(*(const LAS v4u*)(ks + (x0 + j) * 128 + d8 * 8), kf);
#pragma unroll
                    for (int i = 0; i < 4; ++i) { float s = 0.f;
#pragma unroll
                        for (int dd = 0; dd < 8; ++dd) s += qf[i][dd] * kf[dd];
                        acc[i][j] += s; } } } }
#pragma unroll
        for (int i = 0; i < 4; ++i)
#pragma unroll
            for (int j = 0; j < 8; ++j) { const int li = l0 + i, sj = x0 + j; ps[li * 128 + sj] = (sj <= li) ? acc[i][j] * 0.08838834764831845f * __expf(uvec[sj] - Mvec[li]) : 0.f; }
    }
    __syncthreads();
    if (C.tid < CH) { const int li = C.tid; float s = 0.f; for (int k = 0; k < CH; ++k) s += ps[li * 128 + ((k + li) & 127)]; den[li] = s; }
    else if (C.tid < 2 * CH) { const int li = C.tid - CH; float s = 0.f; for (int k = 0; k < CH; ++k) { const int d = (k + li) & 127; s += bf2f(qs[li * 128 + d]) * npv[d]; } qnv[li] = s; }
    for (int it = C.tid; it < CH * 16; it += NTHREADS) { const int r = it >> 4, c8 = (it & 15) * 8; }
    __syncthreads();
    for (int it = C.tid; it < CH * 16; it += NTHREADS) { const int r = it >> 4, c8 = (it & 15) * 8; const size_t rowo = (size_t)(t0 + r) * NPROJ + h * 128 + c8; *(LAS v4u*)(ks + r * 128 + c8) = *(const v4u*)(PROJ + rowo + PV); }
    __syncthreads();
    float hv[4][8];
    {   const int e0 = x0; float acc[4][8], acc2[4][8];
#pragma unroll
        for (int i = 0; i < 4; ++i)
#pragma unroll
            for (int j = 0; j < 8; ++j) { acc[i][j] = 0.f; acc2[i][j] = 0.f; }
        for (int s = 0; s <= l0 + 3; ++s) { float vv[8]; unpack8(*(const LAS v4u*)(ks + s * 128 + e0), vv);
#pragma unroll
            for (int i = 0; i < 4; ++i) { const float p = ps[(l0 + i) * 128 + s];
#pragma unroll
                for (int j = 0; j < 8; ++j) acc[i][j] += p * vv[j]; } }
        const bf16* CPT = (const bf16*)(A.ws + WS_CPREVT) + (size_t)un * CH * CH;
        for (int d8 = 0; d8 < 16; ++d8) { float qf[4][8], cf[8];
#pragma unroll
            for (int i = 0; i < 4; ++i) unpack8(*(const LAS v4u*)(qs + (l0 + i) * 128 + d8 * 8), qf[i]);
#pragma unroll
            for (int j = 0; j < 8; ++j) { unpack8(*(const v4u*)(CPT + (size_t)(e0 + j) * CH + d8 * 8), cf);
#pragma unroll
                for (int i = 0; i < 4; ++i) { float s = 0.f;
#pragma unroll
                    for (int dd = 0; dd < 8; ++dd) s += qf[i][dd] * cf[dd];
                    acc2[i][j] += s; } } }
#pragma unroll
        for (int i = 0; i < 4; ++i) { const int li = l0 + i; const float wi = wint[li]; const float dn = den[li] + wi * qnv[li]; const float inv = 1.0f / fmaxf(fabsf(dn), flo[li]);
#pragma unroll
            for (int j = 0; j < 8; ++j) hv[i][j] = (acc[i][j] + wi * acc2[i][j]) * inv; }
    }
    __syncthreads();
#pragma unroll
    for (int i = 0; i < 4; ++i)
#pragma unroll
        for (int j = 0; j < 8; ++j) ps[(l0 + i) * 128 + x0 + j] = hv[i][j];
    __syncthreads();
    { const f32x2 nw = *(const f32x2*)(A.in[3] + (size_t)l * 512 + h * 128 + 2 * C.lane);
        for (int i = 0; i < 16; ++i) { const int li = C.wave * 16 + i; f32x2 x = *(const LAS f32x2*)(ps + li * 128 + 2 * C.lane);
            const float mean = wave_sum(x[0] + x[1]) * (1.0f / 128.0f); x = x - mean; const float var = wave_sum(x[0] * x[0] + x[1] * x[1]) * (1.0f / 128.0f);
            const float rstd = 1.0f / sqrtf(var + 1e-6f); const unsigned ow = *(const unsigned*)(PROJ + (size_t)(t0 + li) * NPROJ + PO + h * 128 + 2 * C.lane);
            const float o0 = sigmoidf_(bflo(ow)) * (x[0] * rstd * nw[0]), o1 = sigmoidf_(bfhi(ow)) * (x[1] * rstd * nw[1]);
            *(unsigned*)(HCAT + (size_t)(t0 + li) * D + h * 128 + 2 * C.lane) = pk2(o0, o1); } }
    __syncthreads();
}
typedef short bf16x8 __attribute__((ext_vector_type(8)));
DI f32x4 mfma16(bf16x8 a, bf16x8 b, f32x4 c) { return __builtin_amdgcn_mfma_f32_16x16x32_bf16(a, b, c, 0, 0, 0); }
constexpr int LDT = 136;
constexpr int TILE_B = 128 * LDT * 2;
DI float wave_scan_add(float v, int lane) {
#pragma unroll
    for (int o = 1; o < 64; o <<= 1) { const float t = __shfl_up(v, o); if (lane >= o) v += t; }
    return v;
}
DI float wave_scan_max(float v, int lane) {
#pragma unroll
    for (int o = 1; o < 64; o <<= 1) { const float t = __shfl_up(v, o); if (lane >= o) v = fmaxf(v, t); }
    return v;
}
DI float wave_max(float v) {
#pragma unroll
    for (int o = 1; o < 64; o <<= 1) v = fmaxf(v, __shfl_xor(v, o));
    return v;
}
DI float red16(float v) { v += __shfl_xor(v, 1); v += __shfl_xor(v, 2); v += __shfl_xor(v, 4); v += __shfl_xor(v, 8); return v; }

DI void mlstm_local_mfma(const Args& A, const Ctx& C0, int un) { const Ctx C = fresh_ctx(C0);
    const bf16* PROJ = (const bf16*)(A.ws + WS_PROJ); const float* GATES = (const float*)(A.ws + SM_GATES);
    const int bh = un >> 5, c = un & 31, b = bh >> 2, h = bh & 3, t0 = b * SEQ + c * CH;
    LAS bf16* VT = (LAS bf16*)C.lds;
    LAS bf16* KWT = (LAS bf16*)(C.lds + TILE_B);
    LAS float* wv = (LAS float*)(C.lds + VEC_OFF);
    if (C.wave == 0) {
        const int l0 = 2 * C.lane; const f32x4 ga = *(const f32x4*)(GATES + (size_t)(t0 + l0) * 8), gb = *(const f32x4*)(GATES + (size_t)(t0 + l0) * 8 + 4), gc = *(const f32x4*)(GATES + (size_t)(t0 + l0 + 1) * 8), gd = *(const f32x4*)(GATES + (size_t)(t0 + l0 + 1) * 8 + 4);
        const float ip0 = h == 0 ? ga[0] : (h == 1 ? ga[1] : (h == 2 ? ga[2] : ga[3])), fp0 = h == 0 ? gb[0] : (h == 1 ? gb[1] : (h == 2 ? gb[2] : gb[3]));
        const float ip1 = h == 0 ? gc[0] : (h == 1 ? gc[1] : (h == 2 ? gc[2] : gc[3])), fp1 = h == 0 ? gd[0] : (h == 1 ? gd[1] : (h == 2 ? gd[2] : gd[3]));
        const float lf0 = logsigmoidf_(fp0), lf1 = logsigmoidf_(fp1);
        const float incl = wave_scan_add(lf0 + lf1, C.lane), b1 = incl, b0 = incl - lf1;
        const float g = __shfl(incl, 63);
        const float a0 = g - b0 + ip0, a1 = g - b1 + ip1, ml = wave_max(fmaxf(a0, a1));
        wv[l0] = __expf(a0 - ml); wv[l0 + 1] = __expf(a1 - ml);
        if (C.lane == 0) { ((float*)(A.ws + SM_G))[un] = g; ((float*)(A.ws + SM_MLOC))[un] = ml; }
    }
    __syncthreads();
    for (int it = C.tid; it < CH * 16; it += NTHREADS) { const int r = it >> 4, c8 = (it & 15) * 8; const size_t rowo = (size_t)(t0 + r) * NPROJ + h * 128 + c8; float k8[8];
        unpack8(*(const v4u*)(PROJ + rowo + PK), k8); const v4u vv = *(const v4u*)(PROJ + rowo + PV); const float sc = wv[r] * 0.08838834764831845f;
        const unsigned vw[4] = {vv.x, vv.y, vv.z, vv.w};
#pragma unroll
        for (int i = 0; i < 8; ++i) { KWT[(c8 + i) * LDT + r] = (bf16)f2bf(k8[i] * sc); VT[(c8 + i) * LDT + r] = (bf16)((i & 1) ? (vw[i >> 1] >> 16) : (vw[i >> 1] & 0xffffu)); } }
    __syncthreads();
    { const int fr = C.lane & 15, fg = C.lane >> 4, w = C.wave;
        bf16x8 a[4];
#pragma unroll
        for (int ks = 0; ks < 4; ++ks) a[ks] = *(const LAS bf16x8*)(VT + (16 * w + fr) * LDT + 32 * ks + 8 * fg);
        float* CL = (float*)(A.ws + WS_CLOCT) + (size_t)un * CH * CH;
#pragma unroll
        for (int dt = 0; dt < 8; ++dt) { f32x4 acc = {0.f, 0.f, 0.f, 0.f};
#pragma unroll
            for (int ks = 0; ks < 4; ++ks) { const bf16x8 bb = *(const LAS bf16x8*)(KWT + (16 * dt + fr) * LDT + 32 * ks + 8 * fg); acc = mfma16(a[ks], bb, acc); }
#pragma unroll
            for (int rg = 0; rg < 4; ++rg) CL[(size_t)(16 * w + 4 * fg + rg) * CH + 16 * dt + fr] = acc[rg]; } }
    if (C.tid < CH) { float s = 0.f;
#pragma unroll
        for (int q = 0; q < 16; ++q) { float f[8]; unpack8(*(const LAS v4u*)(KWT + C.tid * LDT + 8 * q), f); s += ((f[0] + f[1]) + (f[2] + f[3])) + ((f[4] + f[5]) + (f[6] + f[7])); }
        ((float*)(A.ws + SM_NLOC))[(size_t)un * CH + C.tid] = s; }
    __syncthreads();
}
DI void mlstm_out_mfma(const Args& A, const Ctx& C0, int l, int un) { const Ctx C = fresh_ctx(C0);
    const bf16* PROJ = (const bf16*)(A.ws + WS_PROJ); const float* GATES = (const float*)(A.ws + SM_GATES); bf16* HCAT = (bf16*)(A.ws + WS_HCAT);
    const int bh = un >> 5, c = un & 31, b = bh >> 2, h = bh & 3, t0 = b * SEQ + c * CH;
    LAS bf16* QS = (LAS bf16*)C.lds;
    LAS bf16* KS = (LAS bf16*)(C.lds + TILE_B);
    LAS bf16* PS = (LAS bf16*)(C.lds + 2 * TILE_B);
    LAS bf16* CT = (LAS bf16*)(C.lds + 3 * TILE_B);
    LAS float* vec = (LAS float*)(C.lds + VEC_OFF);
    LAS float* uvec = vec, *Mvec = vec + 128, *wint = vec + 256, *flo = vec + 384; LAS bf16* npb = (LAS bf16*)(vec + 512);
    if (C.wave == 0) {
        const int l0 = 2 * C.lane; const f32x4 ga = *(const f32x4*)(GATES + (size_t)(t0 + l0) * 8), gb = *(const f32x4*)(GATES + (size_t)(t0 + l0) * 8 + 4), gc = *(const f32x4*)(GATES + (size_t)(t0 + l0 + 1) * 8), gd = *(const f32x4*)(GATES + (size_t)(t0 + l0 + 1) * 8 + 4);
        const float ip0 = h == 0 ? ga[0] : (h == 1 ? ga[1] : (h == 2 ? ga[2] : ga[3])), fp0 = h == 0 ? gb[0] : (h == 1 ? gb[1] : (h == 2 ? gb[2] : gb[3]));
        const float ip1 = h == 0 ? gc[0] : (h == 1 ? gc[1] : (h == 2 ? gc[2] : gc[3])), fp1 = h == 0 ? gd[0] : (h == 1 ? gd[1] : (h == 2 ? gd[2] : gd[3]));
        const float lf0 = logsigmoidf_(fp0), lf1 = logsigmoidf_(fp1);
        const float incl = wave_scan_add(lf0 + lf1, C.lane), b1 = incl, b0 = incl - lf1;
        const float u0 = ip0 - b0, u1 = ip1 - b1;
        const float pm_incl = wave_scan_max(fmaxf(u0, u1), C.lane); const float pm_prev = __shfl_up(pm_incl, 1);
        const float pm0 = C.lane == 0 ? u0 : fmaxf(pm_prev, u0), pm1 = pm_incl;
        const float mprev = ((const float*)(A.ws + SM_MPREV))[un];
        const float M0 = fmaxf(mprev, pm0), M1 = fmaxf(mprev, pm1);
        uvec[l0] = u0; uvec[l0 + 1] = u1; Mvec[l0] = M0; Mvec[l0 + 1] = M1; wint[l0] = __expf(mprev - M0); wint[l0 + 1] = __expf(mprev - M1); flo[l0] = __expf(-(b0 + M0)); flo[l0 + 1] = __expf(-(b1 + M1));
        const f32x2 np2 = *(const f32x2*)((const float*)(A.ws + SM_NPREV) + (size_t)un * CH + l0); *(LAS unsigned*)(npb + l0) = pk2(np2[0], np2[1]);
    }
    { const bf16* CPT = (const bf16*)(A.ws + WS_CPREVT) + (size_t)un * CH * CH;
        for (int it = C.tid; it < CH * 16; it += NTHREADS) { const int r = it >> 4, c8 = (it & 15) * 8; const size_t rowo = (size_t)(t0 + r) * NPROJ + h * 128 + c8;
            *(LAS v4u*)(QS + r * LDT + c8) = *(const v4u*)(PROJ + rowo + PQ); *(LAS v4u*)(KS + r * LDT + c8) = *(const v4u*)(PROJ + rowo + PK); *(LAS v4u*)(CT + r * LDT + c8) = *(const v4u*)(CPT + (size_t)r * CH + c8); } }
    __syncthreads();
    const int fr = C.lane & 15, fg = C.lane >> 4, w = C.wave;
    bf16x8 aq[4];
#pragma unroll
    for (int ks = 0; ks < 4; ++ks) aq[ks] = *(const LAS bf16x8*)(QS + (16 * w + fr) * LDT + 32 * ks + 8 * fg);
    float Ml[4], wl[4], inv[4];
#pragma unroll
    for (int rg = 0; rg < 4; ++rg) { Ml[rg] = Mvec[16 * w + 4 * fg + rg]; wl[rg] = wint[16 * w + 4 * fg + rg]; }
    {   float rs[4] = {0.f, 0.f, 0.f, 0.f};
#pragma unroll
        for (int st = 0; st < 8; ++st) {
            if (st <= w) { f32x4 acc = {0.f, 0.f, 0.f, 0.f};
#pragma unroll
                for (int ks = 0; ks < 4; ++ks) { const bf16x8 bb = *(const LAS bf16x8*)(KS + (16 * st + fr) * LDT + 32 * ks + 8 * fg); acc = mfma16(aq[ks], bb, acc); }
                const int s = 16 * st + fr; const float us = uvec[s];
#pragma unroll
                for (int rg = 0; rg < 4; ++rg) { const int li = 16 * w + 4 * fg + rg; const float p = (s <= li) ? acc[rg] * 0.08838834764831845f * __expf(us - Ml[rg]) : 0.f; rs[rg] += p; PS[li * LDT + s] = (bf16)f2bf(p); } }
            else if (st == w + 1 && (w & 1) == 0) {
#pragma unroll
                for (int rg = 0; rg < 4; ++rg) PS[(16 * w + 4 * fg + rg) * LDT + 16 * st + fr] = (bf16)0; }
        }
        f32x4 an = {0.f, 0.f, 0.f, 0.f};
#pragma unroll
        for (int ks = 0; ks < 4; ++ks) { bf16x8 bn = *(const LAS bf16x8*)(npb + 32 * ks + 8 * fg); if (fr != 0) bn = (bf16x8){0, 0, 0, 0, 0, 0, 0, 0}; an = mfma16(aq[ks], bn, an); }
#pragma unroll
        for (int rg = 0; rg < 4; ++rg) { const float qn = __shfl(an[rg], 16 * fg); const float dn = red16(rs[rg]) + wl[rg] * qn; inv[rg] = 1.0f / fmaxf(fabsf(dn), flo[16 * w + 4 * fg + rg]); }
    }
    __syncthreads();
    for (int it = C.tid; it < CH * 16; it += NTHREADS) { const int r = it >> 4, c8 = (it & 15) * 8; const v4u vv = *(const v4u*)(PROJ + (size_t)(t0 + r) * NPROJ + h * 128 + c8 + PV); const unsigned vw[4] = {vv.x, vv.y, vv.z, vv.w};
#pragma unroll
        for (int i = 0; i < 8; ++i) KS[(c8 + i) * LDT + r] = (bf16)((i & 1) ? (vw[i >> 1] >> 16) : (vw[i >> 1] & 0xffffu)); }
    __syncthreads();
    {   const int nk2 = (w >> 1) + 1;
        bf16x8 ap[4];
#pragma unroll
        for (int k2 = 0; k2 < 4; ++k2) ap[k2] = (k2 < nk2) ? *(const LAS bf16x8*)(PS + (16 * w + fr) * LDT + 32 * k2 + 8 * fg) : (bf16x8){0, 0, 0, 0, 0, 0, 0, 0};
        float hv[8][4]; float sm[4] = {0.f, 0.f, 0.f, 0.f};
#pragma unroll
        for (int et = 0; et < 8; ++et) { f32x4 a1 = {0.f, 0.f, 0.f, 0.f}, a2 = {0.f, 0.f, 0.f, 0.f};
#pragma unroll
            for (int k2 = 0; k2 < 4; ++k2) if (k2 < nk2) { const bf16x8 bb = *(const LAS bf16x8*)(KS + (16 * et + fr) * LDT + 32 * k2 + 8 * fg); a1 = mfma16(ap[k2], bb, a1); }
#pragma unroll
            for (int ks = 0; ks < 4; ++ks) { const bf16x8 bb = *(const LAS bf16x8*)(CT + (16 * et + fr) * LDT + 32 * ks + 8 * fg); a2 = mfma16(aq[ks], bb, a2); }
#pragma unroll
            for (int rg = 0; rg < 4; ++rg) { hv[et][rg] = (a1[rg] + wl[rg] * a2[rg]) * inv[rg]; sm[rg] += hv[et][rg]; } }
        float mean[4], rstd[4];
#pragma unroll
        for (int rg = 0; rg < 4; ++rg) { mean[rg] = red16(sm[rg]) * (1.0f / 128.0f); float q = 0.f;
#pragma unroll
            for (int et = 0; et < 8; ++et) { const float dlt = hv[et][rg] - mean[rg]; q += dlt * dlt; }
            rstd[rg] = 1.0f / sqrtf(red16(q) * (1.0f / 128.0f) + 1e-6f); }
#pragma unroll
        for (int et = 0; et < 8; ++et) { const int e = 16 * et + fr; const float nw = A.in[3][(size_t)l * 512 + h * 128 + e];
#pragma unroll
            for (int rg = 0; rg < 4; ++rg) { const int li = 16 * w + 4 * fg + rg; const float o = bf2f(PROJ[(size_t)(t0 + li) * NPROJ + PO + h * 128 + e]);
                HCAT[(size_t)(t0 + li) * D + h * 128 + e] = (bf16)f2bf(sigmoidf_(o) * ((hv[et][rg] - mean[rg]) * rstd[rg] * nw)); } }
    }
    __syncthreads();
}
DI void gmlp_unit_mfma(const Args& A, const Ctx& C0, int l, int unit) { const Ctx C = fresh_ctx(C0);
    const bf16* PROJ = (const bf16*)(A.ws + WS_PROJ); bf16* HCAT = (bf16*)(A.ws + WS_HCAT); const bf16* WM = (const bf16*)(A.ws + SM_WM);
    const int ck = unit >> 2, hh = unit & 3, t0 = ck * CH;
    LAS bf16* ZT = (LAS bf16*)C.lds;
    { const f32x4 nw = *(const f32x4*)(A.in[4] + l * 256 + 4 * C.lane), nb = *(const f32x4*)(A.in[5] + l * 256 + 4 * C.lane);
        for (int i = 0; i < 16; ++i) { const int r = C.wave * 16 + i; const v2u g = *(const v2u*)(PROJ + (size_t)(t0 + r) * NPROJ + PGV + 4 * C.lane);
            f32x4 x = {gelu_tanh(bflo(g.x)), gelu_tanh(bfhi(g.x)), gelu_tanh(bflo(g.y)), gelu_tanh(bfhi(g.y))};
            const float mean = wave_sum((x[0] + x[1]) + (x[2] + x[3])) * (1.0f / 256.0f); x = x - mean;
            const float var = wave_sum((x[0] * x[0] + x[1] * x[1]) + (x[2] * x[2] + x[3] * x[3])) * (1.0f / 256.0f);
            const float rstd = 1.0f / sqrtf(var + LN_EPS); x = x * rstd * nw + nb;
            if ((C.lane >> 4) == hh) { const int d0 = 4 * (C.lane & 15);
#pragma unroll
                for (int q = 0; q < 4; ++q) ZT[(d0 + q) * LDT + r] = (bf16)f2bf(x[q]); } } }
    __syncthreads();
    { const int fr = C.lane & 15, fg = C.lane >> 4, w = C.wave, nk = (w >> 1) + 1;
        bf16x8 a[4];
#pragma unroll
        for (int ks = 0; ks < 4; ++ks) a[ks] = (ks < nk) ? *(const bf16x8*)(WM + ((size_t)(hh * CH + 16 * w + fr) * CH + 32 * ks + 8 * fg)) : (bf16x8){0, 0, 0, 0, 0, 0, 0, 0};
#pragma unroll
        for (int dt = 0; dt < 4; ++dt) { f32x4 acc = {0.f, 0.f, 0.f, 0.f};
#pragma unroll
            for (int ks = 0; ks < 4; ++ks) if (ks < nk) { const bf16x8 bb = *(const LAS bf16x8*)(ZT + (16 * dt + fr) * LDT + 32 * ks + 8 * fg); acc = mfma16(a[ks], bb, acc); }
            const int d = 64 * hh + 16 * dt + fr;
#pragma unroll
            for (int rg = 0; rg < 4; ++rg) { const int tr = 16 * w + 4 * fg + rg; const float bsv = A.in[7][(size_t)(l * 4 + hh) * CH + tr]; const float u = bf2f(PROJ[(size_t)(t0 + tr) * NPROJ + PGU + d]);
                HCAT[(size_t)(t0 + tr) * D + 512 + d] = (bf16)f2bf(gelu_tanh(u) * (acc[rg] + bsv)); } } }
    __syncthreads();
}
#if DBG_CHECK
constexpr size_t SM_ERR = WS_CTL + 8192;
DI unsigned hsh(unsigned s, unsigned k) { unsigned h = s * 2654435761u + k * 40503u + 12345u; h ^= h >> 15; h *= 2246822519u; h ^= h >> 13; return h; }
DI void err_put(const Args& A, int chk, float ref, float got, float floor_) {
    float e = fabsf(ref - got) / (fabsf(ref) + floor_); if (!(e == e)) e = 1e9f;
    atomicMax((unsigned*)(A.ws + SM_ERR) + chk, __builtin_bit_cast(unsigned, e));
}
DI void chk_gates(const Args& A, const Ctx& C, int l, const float* X) {
    const int gt = C.bid * NTHREADS + C.tid; if (gt >= 2048) return;
    const int t = hsh(gt, 1) % T, g = hsh(gt, 2) % 8; float s = 0.f;
    for (int k = 0; k < D; ++k) s += X[(size_t)t * D + k] * A.in[1][((size_t)l * D + k) * PIN + 2048 + g];
    s += A.in[2][(size_t)l * PIN + 2048 + g];
    err_put(A, 1, s, ((const float*)(A.ws + SM_GATES))[(size_t)t * 8 + g], 0.1f);
}
DI void chk_proj(const Args& A, const Ctx& C, int l) {
    const int gt = C.bid * NTHREADS + C.tid; if (gt >= 8192) return;
    const int t = (gt < 64) ? (gt * 4099) % T : hsh(gt, 3) % T, n = hsh(gt, 4) % NPROJ, ns = n + (n >= 2048 ? 8 : 0);
    const bf16* XN = (const bf16*)(A.ws + WS_XN); float s = 0.f;
    for (int k = 0; k < D; ++k) s += bf2f(XN[(size_t)t * D + k]) * A.in[1][((size_t)l * D + k) * PIN + ns];
    s += A.in[2][(size_t)l * PIN + ns];
    err_put(A, 2, s, bf2f(((const bf16*)(A.ws + WS_PROJ))[(size_t)t * NPROJ + n]), 0.5f);
}
DI void chk_conv(const Args& A, const Ctx& C, int l) {
    const int gw = C.bid * NWAVES + C.wave; if (gw >= 1024) return;
    const int t = (gw < 128) ? (gw * 129) % T : hsh(gw, 5) % T; const bf16* PROJ = (const bf16*)(A.ws + WS_PROJ);
    float cv[4];
#pragma unroll
    for (int q = 0; q < 4; ++q) { const int c = C.lane * 4 + q; float acc = A.in[9][l * 256 + c];
        for (int j = 0; j < 31; ++j) { const int ts = t - 30 + j; if ((ts >> 12) != (t >> 12) || ts < 0) continue;
            const float a = bf2f(PROJ[(size_t)ts * NPROJ + PCA + c]), b = bf2f(PROJ[(size_t)ts * NPROJ + PCB + c]);
            acc += a / (1.0f + expf(-b)) * A.in[8][(size_t)(l * 31 + j) * 256 + c]; }
        cv[q] = acc; }
    const float mean = wave_sum(cv[0] + cv[1] + cv[2] + cv[3]) / 256.0f; float q2 = 0.f;
#pragma unroll
    for (int q = 0; q < 4; ++q) { cv[q] -= mean; q2 += cv[q] * cv[q]; }
    const float rstd = 1.0f / sqrtf(wave_sum(q2) / 256.0f + LN_EPS);
#pragma unroll
    for (int q = 0; q < 4; ++q) { const int c = C.lane * 4 + q; const float y = cv[q] * rstd * A.in[10][l * 256 + c] + A.in[11][l * 256 + c]; const float r = y / (1.0f + expf(-y));
        err_put(A, 3, r, bf2f(((const bf16*)(A.ws + WS_HCAT))[(size_t)t * D + 768 + c]), 0.5f); }
}
DI void chk_gmlp(const Args& A, const Ctx& C, int l) {
    const int gw = C.bid * NWAVES + C.wave; if (gw >= 512) return;
    const int t = (gw < 64) ? (gw * 131 + 127) % T : hsh(gw, 6) % T; const bf16* PROJ = (const bf16*)(A.ws + WS_PROJ);
    const int tc = t & 127, t0 = t - tc, h = C.lane >> 4; float acc[4] = {0.f, 0.f, 0.f, 0.f};
    for (int s = 0; s <= tc; ++s) { float x[4];
#pragma unroll
        for (int q = 0; q < 4; ++q) { const float v = bf2f(PROJ[(size_t)(t0 + s) * NPROJ + PGV + C.lane * 4 + q]); x[q] = 0.5f * v * (1.0f + tanhf(0.7978845608028654f * (v + 0.044715f * v * v * v))); }
        const float mean = wave_sum(x[0] + x[1] + x[2] + x[3]) / 256.0f; float q2 = 0.f;
#pragma unroll
        for (int q = 0; q < 4; ++q) { x[q] -= mean; q2 += x[q] * x[q]; }
        const float rstd = 1.0f / sqrtf(wave_sum(q2) / 256.0f + LN_EPS); const float w = A.in[6][((size_t)(l * 4 + h) * CH + tc) * CH + s];
#pragma unroll
        for (int q = 0; q < 4; ++q) { const int c = C.lane * 4 + q; acc[q] += w * (x[q] * rstd * A.in[4][l * 256 + c] + A.in[5][l * 256 + c]); } }
#pragma unroll
    for (int q = 0; q < 4; ++q) { const int c = C.lane * 4 + q; const float v = bf2f(PROJ[(size_t)t * NPROJ + PGU + c]); const float u = 0.5f * v * (1.0f + tanhf(0.7978845608028654f * (v + 0.044715f * v * v * v)));
        const float r = u * (acc[q] + A.in[7][(size_t)(l * 4 + h) * CH + tc]);
        err_put(A, 4, r, bf2f(((const bf16*)(A.ws + WS_HCAT))[(size_t)t * D + 512 + c]), 0.5f); }
}
DI void chk_mlstm(const Args& A, const Ctx& C, int l) {
    const int gw = C.bid * NWAVES + C.wave; if (gw >= 1024) return;
    const int t = (gw < 64) ? (gw * 521 + (gw & 1) * 127) % T : hsh(gw, 7) % T, h = hsh(gw, 8) & 3; const bf16* PROJ = (const bf16*)(A.ws + WS_PROJ); const float* GATES = (const float*)(A.ws + SM_GATES);
    const int tb = t & ~(SEQ - 1); const int d0 = 2 * C.lane;
    const float q0 = bf2f(PROJ[(size_t)t * NPROJ + PQ + h * 128 + d0]), q1 = bf2f(PROJ[(size_t)t * NPROJ + PQ + h * 128 + d0 + 1]);
    float n0 = 0.f, n1 = 0.f, den = 0.f, F = 0.f;
    for (int s = t; s >= tb; --s) {
        const float k0 = bf2f(PROJ[(size_t)s * NPROJ + PK + h * 128 + d0]), k1 = bf2f(PROJ[(size_t)s * NPROJ + PK + h * 128 + d0 + 1]);
        const float qk = wave_sum(q0 * k0 + q1 * k1) * 0.08838834764831845f;
        const float w = expf(F + GATES[(size_t)s * 8 + h]) * qk;
        n0 += w * bf2f(PROJ[(size_t)s * NPROJ + PV + h * 128 + d0]); n1 += w * bf2f(PROJ[(size_t)s * NPROJ + PV + h * 128 + d0 + 1]); den += w;
        const float fp = GATES[(size_t)s * 8 + 4 + h]; F += fminf(fp, 0.f) - log1pf(expf(-fabsf(fp)));
        if (F < -60.f) break; }
    const float inv = 1.0f / fmaxf(fabsf(den), 1.0f); float x0 = n0 * inv, x1 = n1 * inv;
    const float mean = wave_sum(x0 + x1) / 128.0f; x0 -= mean; x1 -= mean; const float rstd = 1.0f / sqrtf(wave_sum(x0 * x0 + x1 * x1) / 128.0f + 1e-6f);
    const float o0 = bf2f(PROJ[(size_t)t * NPROJ + PO + h * 128 + d0]), o1 = bf2f(PROJ[(size_t)t * NPROJ + PO + h * 128 + d0 + 1]);
    const float r0 = x0 * rstd * A.in[3][(size_t)l * 512 + h * 128 + d0] / (1.0f + expf(-o0)), r1 = x1 * rstd * A.in[3][(size_t)l * 512 + h * 128 + d0 + 1] / (1.0f + expf(-o1));
    const bf16* HC = (const bf16*)(A.ws + WS_HCAT);
    err_put(A, 5, r0, bf2f(HC[(size_t)t * D + h * 128 + d0]), 0.5f); err_put(A, 5, r1, bf2f(HC[(size_t)t * D + h * 128 + d0 + 1]), 0.5f);
}
DI void chk_y(const Args& A, const Ctx& C, int l) {
    const int gt = C.bid * NTHREADS + C.tid; if (gt >= 8192) return;
    const int t = hsh(gt, 9) % T, n = hsh(gt, 10) % D; const bf16* HC = (const bf16*)(A.ws + WS_HCAT); float s = 0.f;
    for (int k = 0; k < D; ++k) s += bf2f(HC[(size_t)t * D + k]) * A.in[12][((size_t)l * D + k) * D + n];
    err_put(A, 6, s, bf2f(((const bf16*)(A.ws + WS_PROJ))[(size_t)t * D + n]), 0.2f);
}
DI void chk_ln1(const Args& A, const Ctx& C, int l, const float* X) {
    const int gw = C.bid * NWAVES + C.wave; if (gw >= 2048) return;
    const int t = hsh(gw, 11) % T; const bf16* Y = (const bf16*)(A.ws + WS_PROJ); const float* X1 = (const float*)(A.ws + WS_X1);
    float v[16]; float s = 0.f;
#pragma unroll
    for (int i = 0; i < 16; ++i) { const int c = C.lane + 64 * i; v[i] = ALPHA * X[(size_t)t * D + c] + bf2f(Y[(size_t)t * D + c]); s += v[i]; }
    const float mean = wave_sum(s) / D; float q2 = 0.f;
#pragma unroll
    for (int i = 0; i < 16; ++i) { v[i] -= mean; q2 += v[i] * v[i]; }
    const float rstd = 1.0f / sqrtf(wave_sum(q2) / D + LN_EPS);
#pragma unroll
    for (int i = 0; i < 16; ++i) { const int c = C.lane + 64 * i; v[i] = v[i] * rstd * A.in[13][(size_t)l * D + c] + A.in[14][(size_t)l * D + c]; }
    err_put(A, 7, v[3], X1[(size_t)t * D + C.lane + 192], 0.1f);
    float sel[16], sg[16];
#pragma unroll
    for (int e = 0; e < 16; ++e) { float p = 0.f;
#pragma unroll
        for (int i = 0; i < 16; ++i) p += v[i] * A.in[15][(size_t)(C.lane + 64 * i) * 16 + e];
        p = wave_sum(p); sg[e] = 1.0f / (1.0f + expf(-p)); sel[e] = sg[e] + A.in[16][e]; }
    float bestg = -INFINITY; int bg = 0;
#pragma unroll
    for (int g = 0; g < 4; ++g) { float a = sel[4 * g], b = sel[4 * g + 1], c = sel[4 * g + 2], d = sel[4 * g + 3];
        float m1 = fmaxf(fmaxf(a, b), fmaxf(c, d)); float tot = a + b + c + d; float mn = fminf(fminf(a, b), fminf(c, d));
        float lo1 = fminf(a, b), hi1 = fmaxf(a, b), lo2 = fminf(c, d), hi2 = fmaxf(c, d); float second = fmaxf(fminf(hi1, hi2), fmaxf(lo1, lo2)); (void)tot; (void)mn;
        const float gs = m1 + second; if (gs > bestg) { bestg = gs; bg = g; } }
    int e0 = -1, e1 = -1; float m1 = -INFINITY, m2 = -INFINITY;
#pragma unroll
    for (int e = 0; e < 16; ++e) if ((e >> 2) == bg && sel[e] > m1) { m1 = sel[e]; e0 = e; }
#pragma unroll
    for (int e = 0; e < 16; ++e) if ((e >> 2) == bg && e != e0 && sel[e] > m2) { m2 = sel[e]; e1 = e; }
    const v4u got = ((const v4u*)(A.ws + SM_SEL))[t];
    if (C.lane == 0 && ((int)got.x != e0 || (int)got.y != e1)) atomicAdd((unsigned*)(A.ws + SM_ERR) + 8, 1u);
}
DI void chk_hid(const Args& A, const Ctx& C, int l) {
    const int gt = C.bid * NTHREADS + C.tid; if (gt >= 8192) return;
    const int t = hsh(gt, 12) % T, k = hsh(gt, 13) & 1, j = hsh(gt, 14) % DEXP; const v4u s = ((const v4u*)(A.ws + SM_SEL))[t]; const int e = k ? (int)s.y : (int)s.x; const int p = ((const int*)(A.ws + SM_TOKSLOT))[2 * t + k];
    const bf16* XN = (const bf16*)(A.ws + WS_XN); float g = 0.f, u = 0.f;
    for (int c = 0; c < D; ++c) { const float x = bf2f(XN[(size_t)t * D + c]); g += x * A.in[17][((size_t)(l * NEXP + e) * D + c) * DEXP + j]; u += x * A.in[18][((size_t)(l * NEXP + e) * D + c) * DEXP + j]; }
    err_put(A, 9, g / (1.0f + expf(-g)) * u, bf2f(((const bf16*)(A.ws + WS_HID))[(size_t)p * DEXP + j]), 0.5f);
    if (p < 0 || p >= PADROWS) atomicAdd((unsigned*)(A.ws + SM_ERR) + 11, 1u);
}
DI void chk_yp(const Args& A, const Ctx& C, int l) {
    const int gt = C.bid * NTHREADS + C.tid; if (gt >= 8192) return;
    const int t = hsh(gt, 15) % T, k = hsh(gt, 16) & 1, n = hsh(gt, 17) % D; const v4u s = ((const v4u*)(A.ws + SM_SEL))[t]; const int e = k ? (int)s.y : (int)s.x; const int p = ((const int*)(A.ws + SM_TOKSLOT))[2 * t + k];
    const bf16* HID = (const bf16*)(A.ws + WS_HID); float y = 0.f;
    for (int j = 0; j < DEXP; ++j) y += bf2f(HID[(size_t)p * DEXP + j]) * A.in[19][((size_t)(l * NEXP + e) * DEXP + j) * D + n];
    err_put(A, 10, y, bf2f(((const bf16*)(A.ws + WS_PROJ))[(size_t)p * D + n]), 0.2f);
}
DI void chk_out(const Args& A, const Ctx& C, int l) {
    const int gw = C.bid * NWAVES + C.wave; if (gw >= 2048) return;
    const int t = hsh(gw, 18) % T; const float* X1 = (const float*)(A.ws + WS_X1); const bf16* YP = (const bf16*)(A.ws + WS_PROJ);
    const v4u s = ((const v4u*)(A.ws + SM_SEL))[t]; const int p0 = ((const int*)(A.ws + SM_TOKSLOT))[2 * t], p1 = ((const int*)(A.ws + SM_TOKSLOT))[2 * t + 1];
    const f32x2 gw2 = ((const f32x2*)(A.ws + SM_GW))[t]; const float g0 = gw2[0], g1 = gw2[1];
    float v[16]; float sm = 0.f;
#pragma unroll
    for (int i = 0; i < 16; ++i) { const int c = C.lane + 64 * i; v[i] = ALPHA * X1[(size_t)t * D + c] + g0 * bf2f(YP[(size_t)p0 * D + c]) + g1 * bf2f(YP[(size_t)p1 * D + c]); sm += v[i]; }
    { float sy = 0.f, sx = 0.f;
#pragma unroll
      for (int i = 0; i < 16; ++i) { const int c = C.lane + 64 * i; const float yy = g0 * bf2f(YP[(size_t)p0 * D + c]) + g1 * bf2f(YP[(size_t)p1 * D + c]); const float xx = ALPHA * X1[(size_t)t * D + c]; sy += yy * yy; sx += xx * xx; }
      sy = wave_sum(sy); sx = wave_sum(sx); const float ratio = sqrtf(sy / sx);
      if (C.lane == 0) atomicMax((unsigned*)(A.ws + SM_ERR) + 20, __builtin_bit_cast(unsigned, ratio));
      float sxn = 0.f, shid = 0.f, syp = 0.f; const bf16* XNb = (const bf16*)(A.ws + WS_XN); const bf16* HIDb = (const bf16*)(A.ws + WS_HID);
#pragma unroll
      for (int i = 0; i < 16; ++i) { const int c = C.lane + 64 * i; const float a = bf2f(YP[(size_t)p0 * D + c]); syp += a * a; }
#pragma unroll
      for (int i = 0; i < 8; ++i) { const int c = C.lane + 64 * i; const float a = bf2f(HIDb[(size_t)p0 * DEXP + c]); shid += a * a; }
      syp = sqrtf(wave_sum(syp) / D); shid = sqrtf(wave_sum(shid) / DEXP);
      if (C.lane == 0) { atomicMax((unsigned*)(A.ws + SM_ERR) + 21, __builtin_bit_cast(unsigned, syp)); atomicMax((unsigned*)(A.ws + SM_ERR) + 22, __builtin_bit_cast(unsigned, shid)); atomicMax((unsigned*)(A.ws + SM_ERR) + 23, __builtin_bit_cast(unsigned, g0 + g1)); atomicMax((unsigned*)(A.ws + SM_ERR) + 24, s.z); atomicMax((unsigned*)(A.ws + SM_ERR) + 25, s.w); atomicMax((unsigned*)(A.ws + SM_ERR) + 26, s.x); } }
    const float mean = wave_sum(sm) / D; float q2 = 0.f;
#pragma unroll
    for (int i = 0; i < 16; ++i) { v[i] -= mean; q2 += v[i] * v[i]; }
    const float rstd = 1.0f / sqrtf(wave_sum(q2) / D + LN_EPS);
    const int c = C.lane + 64 * 5; const float r = v[5] * rstd * A.in[20][(size_t)l * D + c] + A.in[21][(size_t)l * D + c];
    err_put(A, 12, r, A.out[(size_t)t * D + c], 0.1f);
}
DI void probe_gates(const Args& A, const Ctx& C, int slot) {
    const int gt = C.bid * NTHREADS + C.tid; if (gt >= 4096) return;
    const int t = hsh(gt, 30) % T; const v4u s = ((const v4u*)(A.ws + SM_SEL))[t];
    const f32x2 gw2 = ((const f32x2*)(A.ws + SM_GW))[t];
    atomicMax((unsigned*)(A.ws + SM_ERR) + slot, __builtin_bit_cast(unsigned, gw2[0] + gw2[1]));
    { const float sm = gw2[0] + gw2[1]; if (!(fabsf(sm - 1.0f) < 1e-3f)) atomicAdd((unsigned*)(A.ws + SM_ERR) + slot + 8, 1u); }
}
DI void dbg_finish(const Args& A, const Ctx& C) {
    const unsigned* E = (const unsigned*)(A.ws + SM_ERR);
    const float tol[13] = {0, 1e-3f, 0.03f, 0.04f, 0.04f, 0.08f, 0.03f, 1e-3f, 0, 0.04f, 0.04f, 0, 1e-3f};
    int code = 0;
#pragma unroll
    for (int k = 12; k >= 1; --k) { bool bad;
        if (k == 8) bad = E[8] > 20u; else if (k == 11) bad = E[11] > 0u; else bad = __builtin_bit_cast(float, E[k]) > tol[k];
        if (bad) code = k; }
    const float cv = (float)(code + DBG_BIAS);
    for (size_t i = (size_t)C.bid * NTHREADS + C.tid; i < (size_t)T * D; i += (size_t)GRID * NTHREADS) A.out[i] = cv;
}
#endif
__global__ void __launch_bounds__(NTHREADS, 2) fwd_kernel(Args A0) {
    extern __shared__ __attribute__((aligned(16))) unsigned char lds_raw[];
    Ctx CK; CK.lds = (LAS unsigned char*)lds_raw; CK.tid = threadIdx.x; CK.lane = CK.tid & 63; CK.wave = __builtin_amdgcn_readfirstlane(CK.tid >> 6); CK.bid = blockIdx.x;
    for (int u = CK.tid; u < (LDS_BYTES - LDSCTL_OFF) / 4; u += NTHREADS) ((LAS unsigned*)(CK.lds + LDSCTL_OFF))[u] = 0u;
    __syncthreads();
    unsigned* ctl = (unsigned*)(A0.ws + WS_CTL);
    XcdBarrier bar = xcd_barrier_post(ctl + CW_BAR, (volatile LAS unsigned*)(CK.lds + MISC_OFF) + 8);
#define GRID_BAR() xcd_barrier<false>(bar)
#define FRESH() Args A; { int z_ = 0; asm volatile("" : "+s"(z_)); _Pragma("unroll") for (int k_ = 0; k_ < 22; ++k_) A.in[k_] = A0.in[k_] + z_; A.out = A0.out + z_; A.ws = A0.ws + z_; } const Ctx C = fresh_ctx(CK)
    { FRESH(); phase_prologue_rows(A, C); }
    xcd_barrier<true>(bar);
#if DBG_CHECK
    if (DBG_LAYER == 0) { FRESH(); chk_gates(A, C, 0, A.in[0]); }
#endif
    for (int l = 0; l < NLAYER_RUN; ++l) {
        { FRESH(); phase_convert(A, C, l); }
        GRID_BAR();
        {
            FRESH(); pg8::Gemm g{(const pg8::bf16_t*)(A.ws + WS_XN), (const pg8::bf16_t*)(A.ws + WS_WIN), T, NPROJ, D}; pg8::StaticOrder S; S.init(T, NPROJ, GRID, C.bid);
            pg8::EpiStoreBf16 E{(pg8::bf16_t*)(A.ws + WS_PROJ), NPROJ, (const float*)(A.ws + SM_BIAS), 0xffff};
            pg8::gemm_phase<pg8::EpiStoreBf16, pg8::StaticOrder, true, true>(C.lds, g, S, E);
        }
        GRID_BAR();
#if DBG_CHECK
        if (l == DBG_LAYER) { FRESH(); chk_proj(A, C, l); }
#endif
        { FRESH(); for (int un = C.bid; un < NUNIT; un += GRID) mlstm_local_mfma(A, C, un); }
        { FRESH(); for (int gu = C.bid; gu < 512; gu += GRID) gmlp_unit_mfma(A, C, l, gu); }
        { FRESH(); for (int cu = C.bid; cu < T / 32; cu += GRID) conv_unit(A, C, l, cu); }
        GRID_BAR();
        { FRESH(); phase_scan(A, C); }
        GRID_BAR();
        { FRESH(); for (int un = C.bid; un < NUNIT; un += GRID) mlstm_out_mfma(A, C, l, un); }
        GRID_BAR();
#if DBG_CHECK
        if (l == DBG_LAYER) { FRESH(); chk_conv(A, C, l); chk_gmlp(A, C, l); chk_mlstm(A, C, l); GRID_BAR(); }
#endif
        {
            FRESH(); pg8::Gemm g{(const pg8::bf16_t*)(A.ws + WS_HCAT), (const pg8::bf16_t*)(A.ws + WS_WOUT), T, D, D}; pg8::StaticOrder S; S.init(T, D, GRID, C.bid);
            pg8::EpiStoreBf16 E{(pg8::bf16_t*)(A.ws + WS_PROJ), D, nullptr, 0xffff};
            pg8::gemm_phase<pg8::EpiStoreBf16, pg8::StaticOrder, true, true>(C.lds, g, S, E);
        }
        GRID_BAR();
#if DBG_CHECK
        if (l == DBG_LAYER) { FRESH(); chk_y(A, C, l); GRID_BAR(); }
#endif
        { FRESH(); phase_ln1_router(A, C, l); }
        GRID_BAR();
#if DBG_CHECK
        if (l == DBG_LAYER) { FRESH(); chk_ln1(A, C, l, l == 0 ? A.in[0] : A.out); probe_gates(A, C, 27); GRID_BAR(); }
#endif
        { FRESH(); phase_scatter(A, C); }
        GRID_BAR();
#if DBG_CHECK
        if (l == DBG_LAYER) { FRESH(); probe_gates(A, C, 28); }
#endif
        {
            FRESH(); pg8::ListOrder S; make_list(A, C, S);
            pg8::Gemm g{(const pg8::bf16_t*)(A.ws + WS_PROJ), (const pg8::bf16_t*)(A.ws + WS_WGU), PADROWS, NEXP * 1024, D};
            pg8::EpiSwiGLU E{(pg8::bf16_t*)(A.ws + WS_HID), DEXP};
            pg8::gemm_phase<pg8::EpiSwiGLU, pg8::ListOrder, true, true>(C.lds, g, S, E);
        }
        GRID_BAR();
#if DBG_CHECK
        if (l == DBG_LAYER) { FRESH(); chk_hid(A, C, l); probe_gates(A, C, 29); }
#endif
        {
            FRESH(); pg8::ListOrder S; make_list(A, C, S);
            pg8::Gemm g{(const pg8::bf16_t*)(A.ws + WS_HID), (const pg8::bf16_t*)(A.ws + WS_WD), PADROWS, NEXP * 1024, DEXP};
            pg8::EpiStoreBf16 E{(pg8::bf16_t*)(A.ws + WS_PROJ), D, nullptr, 3};
            pg8::gemm_phase<pg8::EpiStoreBf16, pg8::ListOrder, true, true>(C.lds, g, S, E);
        }
        GRID_BAR();
#if DBG_CHECK
        if (l == DBG_LAYER) { FRESH(); chk_yp(A, C, l); probe_gates(A, C, 30); }
#endif
        { FRESH(); phase_combine(A, C, l); }
        GRID_BAR();
#if DBG_CHECK
        if (l == DBG_LAYER) { FRESH(); chk_out(A, C, l); if (l + 1 < NLAYER) chk_gates(A, C, l + 1, A.out); GRID_BAR(); }
#endif
    }
#if DBG_CHECK
    { FRESH(); dbg_finish(A, C); }
#endif
}

extern "C" void kernel_launch(void* const* d_in, const int* in_sizes, int n_in, void* d_out, int out_size, void* d_ws, size_t ws_size, hipStream_t stream) {
    static int ready = 0;
    if (ready == 0) {
        if (n_in != 22 || in_sizes[0] != T * D || out_size != T * D || ws_size < WS_END) { fprintf(stderr, "kernel_launch: unexpected shapes (n_in %d, in0 %d, out %d, ws %zu)\n", n_in, n_in > 0 ? in_sizes[0] : -1, out_size, ws_size); ready = -1; return; }
        if (hipFuncSetAttribute((const void*)fwd_kernel, hipFuncAttributeMaxDynamicSharedMemorySize, LDS_BYTES) != hipSuccess) { fprintf(stderr, "kernel_launch: hipFuncSetAttribute failed\n"); ready = -1; return; }
        (void)hipGetLastError();
        ready = 1;
    }
    if (ready < 0) return;
    if (hipMemsetAsync((char*)d_ws + WS_CTL, 0, CTL_ZERO_BYTES, stream) != hipSuccess) return;
    Args a{};
    for (int i = 0; i < 22; ++i) a.in[i] = (const float*)d_in[i];
    a.out = (float*)d_out; a.ws = (unsigned char*)d_ws;
    hipLaunchKernelGGL(fwd_kernel, dim3(GRID), dim3(NTHREADS), LDS_BYTES, stream, a);
}
```

```cpp
#include <hip/hip_runtime.h>
#include <cstdio>
#include <cstdint>
namespace pg8 {
#define PG8_LAS __attribute__((address_space(3)))
typedef unsigned short bf16_t;
typedef short bf16x8 __attribute__((ext_vector_type(8)));
typedef float f32x4 __attribute__((ext_vector_type(4)));
typedef unsigned u32x4 __attribute__((ext_vector_type(4)));
constexpr int BM = 256, BK = 64, HALF = 128, HTB = HALF * BK * 2  , STAGE_BYTES = 8 * HTB, NXCD = 8, WGM = 8;

__host__ __device__ __forceinline__ int lds_byte(int r, int c) { const int st = (r >> 4) * 2 + (c >> 5), rr = r & 15, cc = c & 31, ob = rr * 64 + cc * 2; return st * 1024 + (ob ^ (((ob >> 9) & 1) << 5)); }
__host__ __device__ __forceinline__ void stage_rc(int b, int& R, int& C) { const int st = b / 1024, sb = b % 1024, swz = sb ^ (((sb >> 9) & 1) << 5); R = (st >> 1) * 16 + swz / 64; C = (st & 1) * 32 + (swz % 64) / 2; }
__host__ __device__ __forceinline__ int perm32(int rho) { const int n = rho >> 4, i = rho & 15; return 8 * (i >> 2) + 4 * n + (i & 3); }

struct Unit { int pm, pn; };
struct Gemm { const bf16_t* A; const bf16_t* Bt; int M, N, K; };

struct StaticOrder {
    int nM, nN, nwg, G, c;
    __host__ __device__ void init(int M, int N, int G_, int c_) { nM = M / BM; nN = N / BM; nwg = nM * nN; G = G_; c = c_; }
    __host__ __device__ bool next(int i, Unit& u) const {
        const long L = (long)i * G + c; if (L >= nwg) return false;
        int wgid = (int)L; { const int q = nwg / NXCD, r = nwg % NXCD, xcd = wgid % NXCD, off = wgid / NXCD; wgid = (xcd < r ? xcd * (q + 1) : r * (q + 1) + (xcd - r) * q) + off; }
        const int nig = WGM * nN, gid = wgid / nig, fm = gid * WGM, gsz = (nM - fm) < WGM ? (nM - fm) : WGM;
        u.pm = fm + ((wgid % nig) % gsz); u.pn = (wgid % nig) / gsz; return true;
    }
    __device__ __forceinline__ void a_ready(const Unit&) const {}
    __device__ __forceinline__ void done(const Unit&) const {}
};
struct ListOrder {
    const int* meta; int nunits, G, c;
    __device__ __forceinline__ bool next(int i, Unit& u) const {
        const int L = i * G + c; if (L >= nunits) return false;
        const int rt = L >> 2; u.pm = rt; u.pn = __builtin_amdgcn_readfirstlane(meta[16 + rt]) * 4 + (L & 3); return true;
    }
    __device__ __forceinline__ void a_ready(const Unit&) const {}
    __device__ __forceinline__ void done(const Unit&) const {}
};

__device__ __forceinline__ unsigned cvt_pk_bf16(float lo, float hi) { unsigned r; asm volatile("v_cvt_pk_bf16_f32 %0, %1, %2" : "=v"(r) : "v"(lo), "v"(hi)); return r; }

struct EpiStoreBf16 {
    static constexpr bool PERM = true, AFTER_DRAIN = false;
    bf16_t* O; int ldc; const float* bias; int pn_mask;
    __device__ __forceinline__ void operator()(const f32x4 (&acc)[2][2][4][2], const Unit& u, int wr, int wc, int fr, int fq) const {
        const int row0 = u.pm * BM + wr * 64 + fr; const int col0 = (u.pn & pn_mask) * BM + wc * 32 + 8 * fq;
        f32x4 bv[2][2];
#pragma unroll
        for (int bj = 0; bj < 2; ++bj)
#pragma unroll
            for (int n = 0; n < 2; ++n) bv[bj][n] = bias ? *(const f32x4*)(bias + col0 + bj * HALF + 4 * n) : (f32x4){0.f, 0.f, 0.f, 0.f};
#pragma unroll
        for (int ai = 0; ai < 2; ++ai)
#pragma unroll
            for (int m = 0; m < 4; ++m) { bf16_t* rowp = O + (size_t)(row0 + ai * HALF + m * 16) * ldc + col0;
#pragma unroll
                for (int bj = 0; bj < 2; ++bj) { const f32x4 v0 = acc[ai][bj][m][0] + bv[bj][0], v1 = acc[ai][bj][m][1] + bv[bj][1];
                    u32x4 w; w.x = cvt_pk_bf16(v0[0], v0[1]); w.y = cvt_pk_bf16(v0[2], v0[3]); w.z = cvt_pk_bf16(v1[0], v1[1]); w.w = cvt_pk_bf16(v1[2], v1[3]);
                    *(u32x4*)(rowp + bj * HALF) = w; } }
    }
};
struct EpiSwiGLU {
    static constexpr bool PERM = true, AFTER_DRAIN = false;
    bf16_t* O; int ldc;
    __device__ __forceinline__ void operator()(const f32x4 (&acc)[2][2][4][2], const Unit& u, int wr, int wc, int fr, int fq) const {
        const int row0 = u.pm * BM + wr * 64 + fr; const int col0 = (u.pn & 3) * HALF + wc * 32 + 8 * fq;
#pragma unroll
        for (int ai = 0; ai < 2; ++ai)
#pragma unroll
            for (int m = 0; m < 4; ++m) { bf16_t* rowp = O + (size_t)(row0 + ai * HALF + m * 16) * ldc + col0;
                float h[8];
#pragma unroll
                for (int n = 0; n < 2; ++n)
#pragma unroll
                    for (int k = 0; k < 4; ++k) { const float g = acc[ai][0][m][n][k], up = acc[ai][1][m][n][k]; h[4 * n + k] = g * up / (1.0f + __expf(-g)); }
                u32x4 w; w.x = cvt_pk_bf16(h[0], h[1]); w.y = cvt_pk_bf16(h[2], h[3]); w.z = cvt_pk_bf16(h[4], h[5]); w.w = cvt_pk_bf16(h[6], h[7]);
                *(u32x4*)rowp = w; }
    }
};
template <class Epi, class Sched, bool ALIGN_EPI = false, bool SP2 = false>
__device__ __forceinline__ void gemm_phase(PG8_LAS unsigned char* lds, const Gemm g, const Sched& S, const Epi& E) {
    int tid_l = threadIdx.x; asm volatile("" : "+v"(tid_l)); const int tid = tid_l, wid = __builtin_amdgcn_readfirstlane(tid >> 6), lane = tid & 63, wr = wid >> 2, wc = wid & 3, fr = lane & 15, fq = lane >> 4;
    const int K = g.K, nt = K / BK;
    unsigned voffA[2], voffB[2];
#pragma unroll
    for (int i = 0; i < 2; ++i) { int R, C; stage_rc(tid * 16 + i * 8192, R, C); const int Rb = Epi::PERM ? ((R & ~31) + perm32(R & 31)) : R;
        voffA[i] = (unsigned)(R * K + C) * 2u; voffB[i] = (unsigned)(Rb * K + C) * 2u; }
    const size_t kstep = (size_t)(BK * 2);
    const size_t hstep = (size_t)HALF * K * 2;
    const size_t tstep = 2 * hstep;
    const unsigned ldsw = (unsigned)wid * 1024u;
    const int aoff = lds_byte(wr * 64 + fr, fq * 8), boff = lds_byte(wc * 32 + fr, fq * 8);
#define PG8_SA(b, h) (((b) * 2 + (h)) * HTB)
#define PG8_SB(b, h) ((4 + (b) * 2 + (h)) * HTB)
#define PG8_STAGE(bufoff, gbase, voff) do { _Pragma("unroll") for (int _i = 0; _i < 2; ++_i) \
        __builtin_amdgcn_global_load_lds((const unsigned*)((const char*)(gbase) + (voff)[_i]), (PG8_LAS unsigned*)(lds + (bufoff) + ldsw + _i * 8192), 16, 0, 0); } while (0)
#define PG8_LDA(dst, b, h) do { _Pragma("unroll") for (int m = 0; m < 4; ++m) _Pragma("unroll") for (int k = 0; k < 2; ++k) dst[m][k] = *(const PG8_LAS bf16x8*)(lds + PG8_SA(b, h) + aoff + m * 2048 + k * 1024); } while (0)
#define PG8_LDB(dst, b, h) do { _Pragma("unroll") for (int n = 0; n < 2; ++n) _Pragma("unroll") for (int k = 0; k < 2; ++k) dst[n][k] = *(const PG8_LAS bf16x8*)(lds + PG8_SB(b, h) + boff + n * 2048 + k * 1024); } while (0)
#define PG8_MMA(ai, bj, At, Bt) do { __builtin_amdgcn_s_setprio(1); _Pragma("unroll") for (int m = 0; m < 4; ++m) _Pragma("unroll") for (int n = 0; n < 2; ++n) _Pragma("unroll") for (int k = 0; k < 2; ++k) \
        acc[ai][bj][m][n] = __builtin_amdgcn_mfma_f32_16x16x32_bf16(Bt[n][k], At[m][k], acc[ai][bj][m][n], 0, 0, 0); __builtin_amdgcn_s_setprio(0); } while (0)
#define PG8_WAIT_V(n) asm volatile("s_waitcnt vmcnt(" #n ")" ::: "memory")
#define PG8_WAIT_L(n) asm volatile("s_waitcnt lgkmcnt(" #n ")" ::: "memory")
#define PG8_BAR __builtin_amdgcn_s_barrier()
#define PG8_SCHED __builtin_amdgcn_sched_barrier(0)
    Unit cur, nxt; int ui = 0;
    if (!S.next(0, cur)) return;
    f32x4 acc[2][2][4][2];
#pragma unroll
    for (int a = 0; a < 2; ++a)
#pragma unroll
        for (int b = 0; b < 2; ++b)
#pragma unroll
            for (int m = 0; m < 4; ++m)
#pragma unroll
                for (int n = 0; n < 2; ++n) acc[a][b][m][n] = (f32x4){0.f, 0.f, 0.f, 0.f};
    bf16x8 At[4][2], B0[2][2], B1[2][2];
    const char* cA = (const char*)g.A + (size_t)cur.pm * tstep; const char* cB = (const char*)g.Bt + (size_t)cur.pn * tstep;
    S.a_ready(cur);
    if constexpr (SP2) {
        PG8_STAGE(PG8_SB(0, 0), cB, voffB); PG8_STAGE(PG8_SB(0, 1), cB + hstep, voffB); PG8_STAGE(PG8_SA(0, 0), cA, voffA); PG8_STAGE(PG8_SA(0, 1), cA + hstep, voffA);
        if (wr == 1) PG8_BAR;
        PG8_WAIT_V(2); PG8_BAR;
        PG8_STAGE(PG8_SB(1, 0), cB + kstep, voffB); PG8_STAGE(PG8_SA(1, 0), cA + kstep, voffA); PG8_STAGE(PG8_SB(1, 1), cB + hstep + kstep, voffB);
        PG8_WAIT_V(6); PG8_BAR;
    } else {
        PG8_STAGE(PG8_SB(0, 0), cB, voffB); PG8_STAGE(PG8_SA(0, 0), cA, voffA); PG8_STAGE(PG8_SB(0, 1), cB + hstep, voffB); PG8_STAGE(PG8_SA(0, 1), cA + hstep, voffA);
        if (wr == 1) PG8_BAR;
        PG8_WAIT_V(4); PG8_BAR;
        PG8_STAGE(PG8_SB(1, 0), cB + kstep, voffB); PG8_STAGE(PG8_SA(1, 0), cA + kstep, voffA); PG8_STAGE(PG8_SB(1, 1), cB + hstep + kstep, voffB);
        PG8_WAIT_V(6); PG8_BAR;
    }
    for (;;) {
        const bool has_next = S.next(ui + 1, nxt);
        const char* nA = has_next ? (const char*)g.A + (size_t)nxt.pm * tstep : cA; const char* nB = has_next ? (const char*)g.Bt + (size_t)nxt.pn * tstep : cB;
        for (int t = 0; t < nt; t += 2) {
            const bool last = (t == nt - 2);
            const char* a1 = cA + (size_t)(t + 1) * kstep;
            const char* a2 = last ? nA : cA + (size_t)(t + 2) * kstep; const char* b2 = last ? nB : cB + (size_t)(t + 2) * kstep;
            const char* a3 = a2 + kstep; const char* b3 = b2 + kstep;
            if (last && has_next) S.a_ready(nxt);
            if constexpr (SP2) {
            PG8_LDB(B0, 0, 0); PG8_LDB(B1, 0, 1); PG8_SCHED; PG8_LDA(At, 0, 0); PG8_STAGE(PG8_SA(1, 1), a1 + hstep, voffA);
            PG8_WAIT_V(8); PG8_WAIT_L(0); PG8_BAR; PG8_MMA(0, 0, At, B0); PG8_MMA(0, 1, At, B1); PG8_BAR; PG8_SCHED;
            PG8_LDA(At, 0, 1); PG8_STAGE(PG8_SB(0, 0), b2, voffB); PG8_STAGE(PG8_SB(0, 1), b2 + hstep, voffB); PG8_STAGE(PG8_SA(0, 0), a2, voffA);
            PG8_WAIT_V(8); PG8_WAIT_L(0); PG8_BAR; PG8_MMA(1, 0, At, B0); PG8_MMA(1, 1, At, B1); PG8_BAR; PG8_SCHED;
            PG8_LDB(B0, 1, 0); PG8_LDB(B1, 1, 1); PG8_SCHED; PG8_LDA(At, 1, 0); PG8_STAGE(PG8_SA(0, 1), a2 + hstep, voffA);
            PG8_WAIT_V(8); PG8_WAIT_L(0); PG8_BAR; PG8_MMA(0, 0, At, B0); PG8_MMA(0, 1, At, B1); PG8_BAR; PG8_SCHED;
            PG8_LDA(At, 1, 1); PG8_STAGE(PG8_SB(1, 0), b3, voffB); PG8_STAGE(PG8_SB(1, 1), b3 + hstep, voffB); PG8_STAGE(PG8_SA(1, 0), a3, voffA);
            PG8_WAIT_V(8); PG8_WAIT_L(0); PG8_BAR; PG8_MMA(1, 0, At, B0); PG8_MMA(1, 1, At, B1); PG8_BAR; PG8_SCHED;
            } else {
            PG8_LDB(B0, 0, 0); PG8_SCHED; PG8_LDA(At, 0, 0); PG8_STAGE(PG8_SA(1, 1), a1 + hstep, voffA);
            PG8_WAIT_L(8); PG8_BAR; PG8_WAIT_L(0); PG8_MMA(0, 0, At, B0); PG8_BAR; PG8_SCHED;
            PG8_LDB(B1, 0, 1); PG8_STAGE(PG8_SB(0, 0), b2, voffB);
            PG8_BAR; PG8_WAIT_L(0); PG8_MMA(0, 1, At, B1); PG8_BAR;
            PG8_LDA(At, 0, 1); PG8_STAGE(PG8_SA(0, 0), a2, voffA);
            PG8_BAR; PG8_WAIT_L(0); PG8_MMA(1, 0, At, B0); PG8_BAR; PG8_SCHED;
            PG8_STAGE(PG8_SB(0, 1), b2 + hstep, voffB);
            PG8_WAIT_V(6); PG8_BAR; PG8_MMA(1, 1, At, B1); PG8_BAR;
            PG8_LDB(B0, 1, 0); PG8_SCHED; PG8_LDA(At, 1, 0); PG8_STAGE(PG8_SA(0, 1), a2 + hstep, voffA);
            PG8_WAIT_L(8); PG8_BAR; PG8_WAIT_L(0); PG8_MMA(0, 0, At, B0); PG8_BAR; PG8_SCHED;
            PG8_LDB(B1, 1, 1); PG8_STAGE(PG8_SB(1, 0), b3, voffB);
            PG8_BAR; PG8_WAIT_L(0); PG8_MMA(0, 1, At, B1); PG8_BAR;
            PG8_LDA(At, 1, 1); PG8_STAGE(PG8_SA(1, 0), a3, voffA);
            PG8_BAR; PG8_WAIT_L(0); PG8_MMA(1, 0, At, B0); PG8_BAR; PG8_SCHED;
            PG8_STAGE(PG8_SB(1, 1), b3 + hstep, voffB);
            PG8_WAIT_V(6); PG8_BAR; PG8_MMA(1, 1, At, B1); PG8_BAR;
            }
        }
        if constexpr (ALIGN_EPI) { if (wr == 0) PG8_BAR; }
        if constexpr (!Epi::AFTER_DRAIN) { E(acc, cur, wr, wc, fr, fq); S.done(cur); }
        if (!has_next) break;
#pragma unroll
        for (int a = 0; a < 2; ++a)
#pragma unroll
            for (int b = 0; b < 2; ++b)
#pragma unroll
                for (int m = 0; m < 4; ++m)
#pragma unroll
                    for (int n = 0; n < 2; ++n) acc[a][b][m][n] = (f32x4){0.f, 0.f, 0.f, 0.f};
        cur = nxt; cA = nA; cB = nB; ++ui;
        if constexpr (ALIGN_EPI) { if (wr == 1) PG8_BAR; }
    }
    PG8_WAIT_V(0);
    if constexpr (!ALIGN_EPI) { if (wr == 0) PG8_BAR; }
    PG8_BAR;
    if constexpr (Epi::AFTER_DRAIN) { E.fused(acc, cur, wr, wc, fr, fq, lds, wid, lane); S.done(cur); }
#undef PG8_SA
#undef PG8_SB
#undef PG8_STAGE
#undef PG8_LDA
#undef PG8_LDB
#undef PG8_MMA
#undef PG8_WAIT_V
#undef PG8_WAIT_L
#undef PG8_BAR
#undef PG8_SCHED
}
}
#ifndef DBG_CHECK
#define DBG_CHECK 0
#endif
#define DBG_LAYER 0
#ifndef DBG_TIME
#define DBG_TIME 0
#endif
#define TIME_LAYER 1
#define DUP_THIN 0
#define DUP_MIX 0
#define TIME_A 3
#define TIME_B 4
#define DBG_BIAS 0
constexpr int NWAVES = 8, NTHREADS = 512, GRID = 256;
constexpr int NLAYER_RUN = DBG_CHECK ? (DBG_LAYER + 1) : 4;
constexpr int T = 16384, D = 1024, SEQ = 4096, NLAYER = 4;
constexpr int PIN = 3080, NPROJ = 3072;
constexpr int CH = 128, NCH = 32, NUNIT = 512;
constexpr int NEXP = 16, DEXP = 512;
constexpr int PADROWS = 36864;
constexpr float ALPHA = 1.6817928305074290f;
constexpr float LN_EPS = 1e-5f;
constexpr int PQ = 0, PK = 512, PV = 1024, PO = 1536, PGU = 2048, PGV = 2304, PCA = 2560, PCB = 2816;
constexpr size_t MiB = 1u << 20;
constexpr size_t WS_CTL = 0, CTL_ZERO_BYTES = 1 * MiB;
constexpr size_t WS_WIN = 2 * MiB, WS_WOUT = 8 * MiB, WS_WGU = 10 * MiB, WS_WD = 42 * MiB;
constexpr size_t WS_SMALL = 58 * MiB;
constexpr size_t SM_BIAS = WS_SMALL;
constexpr size_t SM_GATES = WS_SMALL + 64 * 1024;
constexpr size_t SM_SEL = SM_GATES + 512 * 1024;
constexpr size_t SM_HIST = SM_SEL + 256 * 1024;
constexpr size_t SM_META = SM_HIST + 16 * 1024;
constexpr size_t SM_TOKSLOT = SM_META + 4 * 1024;
constexpr size_t SM_G = SM_TOKSLOT + 128 * 1024;
constexpr size_t SM_MLOC = SM_G + 2048;
constexpr size_t SM_MPREV = SM_MLOC + 2048;
constexpr size_t SM_NLOC = SM_MPREV + 2048;
constexpr size_t SM_NPREV = SM_NLOC + 256 * 1024;
constexpr size_t SM_END = SM_NPREV + 256 * 1024;
constexpr size_t SM_WM = SM_END + 128 * 1024;
constexpr size_t SM_GW = SM_END;
static_assert(SM_WM + 128 * 1024 <= 62 * MiB, "small region");
constexpr size_t WS_XN = 62 * MiB, WS_HCAT = 94 * MiB, WS_XNB = 126 * MiB, WS_CLOCT = 190 * MiB, WS_CPREVT = 222 * MiB, WS_HID = 238 * MiB;
constexpr size_t WS_PROJ = 274 * MiB;
constexpr size_t WS_END = 370 * MiB;
static_assert(WS_HID + (size_t)PADROWS * DEXP * 2 <= WS_PROJ && WS_PROJ + (size_t)PADROWS * D * 2 <= WS_END && WS_PROJ + (size_t)T * NPROJ * 2 <= WS_END, "ws map");
constexpr int CW_TMO = 0, CW_BAR = 4096;
constexpr int RING_BYTES = 131072, LDSCTL_OFF = 139264, MISC_OFF = LDSCTL_OFF + 320, PTR_OFF = LDSCTL_OFF + 512, VEC_OFF = LDSCTL_OFF + 1024, LDS_BYTES = 151552;

#define LAS __attribute__((address_space(3)))
typedef unsigned short bf16;
typedef unsigned v4u __attribute__((ext_vector_type(4)));
typedef unsigned v2u __attribute__((ext_vector_type(2)));
typedef float f32x4 __attribute__((ext_vector_type(4)));
typedef float f32x2 __attribute__((ext_vector_type(2)));
#define DI __device__ __forceinline__
DI unsigned f2bf(float f) { unsigned u = __builtin_bit_cast(unsigned, f); return (u + 0x7fffu + ((u >> 16) & 1u)) >> 16; }
DI unsigned pk2(float lo, float hi) { return f2bf(lo) | (f2bf(hi) << 16); }
DI float bflo(unsigned w) { return __builtin_bit_cast(float, w << 16); }
DI float bfhi(unsigned w) { return __builtin_bit_cast(float, w & 0xffff0000u); }
DI float bf2f(bf16 h) { return __builtin_bit_cast(float, (unsigned)h << 16); }
DI float wave_sum(float v) {
#pragma unroll
    for (int o = 1; o < 64; o <<= 1) v += __shfl_xor(v, o);
    return v;
}
DI float sigmoidf_(float x) { return 1.0f / (1.0f + __expf(-x)); }
DI float gelu_tanh(float x) { const float u = 0.7978845608028654f * (x + 0.044715f * x * x * x); const float e = __expf(2.0f * u); const float th = 1.0f - 2.0f / (e + 1.0f); return 0.5f * x * (1.0f + th); }
DI float logsigmoidf_(float x) { return fminf(x, 0.0f) - log1pf(__expf(-fabsf(x))); }

#define XB_TMO      128
#define XB_XCNT(j)  (256  + 64 * (j))
#define XB_XSUB(j)  (1280 + 64 * (j))
#define XB_XGEN(j)  (2304 + 64 * (j))
#define XB_TOP      3328
#define XB_TOPGEN   3392
#define XCD_BAR_WORDS 3456
#define XB_SPIN_CAP (1u << 18)
__device__ __forceinline__ unsigned xb_ld(unsigned* p)              { return __hip_atomic_load(p, __ATOMIC_RELAXED, __HIP_MEMORY_SCOPE_AGENT); }
__device__ __forceinline__ unsigned xb_add(unsigned* p, unsigned v) { return __hip_atomic_fetch_add(p, v, __ATOMIC_RELAXED, __HIP_MEMORY_SCOPE_AGENT); }
__device__ __forceinline__ unsigned xb_xcc_id() { return (unsigned)__builtin_amdgcn_s_getreg((3 << 11) | 20) & 0xFu; }
#define XB_SPIN(cond, bar) do { unsigned _sp = 0; while (cond) { __builtin_amdgcn_s_sleep(1); \
    if ((++_sp & 255u) == 0u) { if (xb_ld(&(bar)[XB_TMO])) break; if (_sp > XB_SPIN_CAP) { atomicAdd(&(bar)[XB_TMO], 1u); break; } } } } while (0)
struct XcdBarrier { unsigned* bar; unsigned x; volatile LAS unsigned* st; };
__device__ __forceinline__ XcdBarrier xcd_barrier_post(unsigned* bar, volatile LAS unsigned* st) {
    XcdBarrier b; b.bar = bar; b.x = xb_xcc_id(); b.st = st;
    if (threadIdx.x == 0) (void)xb_add(&bar[XB_XCNT(b.x)], 1u);
    return b;
}
__device__ __forceinline__ void xcd_barrier_complete(unsigned* bar, unsigned x, unsigned& nloc, unsigned& nx) {
    const unsigned G = gridDim.x * gridDim.y * gridDim.z;
    unsigned sum, cnt, mine, sp = 0u;
    for (;;) {
        sum = 0u; cnt = 0u; mine = 0u;
#pragma unroll
        for (unsigned j = 0; j < 16; ++j) { const unsigned c = xb_ld(&bar[XB_XCNT(j)]); sum += c; cnt += (c > 0u) ? 1u : 0u; mine = (j == x) ? c : mine; }
        if (sum == G) break;
        __builtin_amdgcn_s_sleep(1);
        if ((++sp & 255u) == 0u) { if (xb_ld(&bar[XB_TMO])) break; if (sp > XB_SPIN_CAP) { atomicAdd(&bar[XB_TMO], 1u); break; } }
    }
    nloc = mine > 0u ? mine : 1u; nx = cnt > 0u ? cnt : 1u;
}
template <bool FIRST> __device__ __forceinline__ void xcd_barrier(const XcdBarrier& b) {
    asm volatile("s_waitcnt vmcnt(0)" ::: "memory");
    __syncthreads();
    if (threadIdx.x == 0) {
        unsigned* bar = b.bar; unsigned bx = b.x; { int z_ = 0; asm volatile("" : "+s"(z_)); bar += z_; bx += (unsigned)z_; }
        __builtin_amdgcn_s_waitcnt(0);
        unsigned nloc = b.st[0], nx = b.st[1];
        if (FIRST) { if (nloc == 0u) { xcd_barrier_complete(bar, bx, nloc, nx); b.st[0] = nloc; b.st[1] = nx; } }
        const unsigned old = xb_add(&bar[XB_XSUB(bx)], 1u);
        const unsigned gen = old / nloc;
        if (old + 1u == (gen + 1u) * nloc) {
            __builtin_amdgcn_fence(__ATOMIC_RELEASE, "agent");
            asm volatile("s_waitcnt vmcnt(0)" ::: "memory");
            const unsigned og = xb_add(&bar[XB_TOP], 1u);
            const unsigned tg = og / nx;
            if (og + 1u == (tg + 1u) * nx) xb_add(&bar[XB_TOPGEN], 1u);
            else XB_SPIN(xb_ld(&bar[XB_TOPGEN]) == tg, bar);
            __builtin_amdgcn_fence(__ATOMIC_ACQUIRE, "agent");
            xb_add(&bar[XB_XGEN(bx)], 1u);
            asm volatile("s_waitcnt vmcnt(0)" ::: "memory");
        } else {
            XB_SPIN(xb_ld(&bar[XB_XGEN(bx)]) == gen, bar);
            __builtin_amdgcn_fence(__ATOMIC_ACQUIRE, "agent");
            asm volatile("s_waitcnt vmcnt(0)" ::: "memory");
        }
    }
    __syncthreads();
}

struct Args { const float* in[22]; float* out; unsigned char* ws; };
struct Ctx { LAS unsigned char* lds; int tid, lane, wave, bid; };
__device__ __forceinline__ Ctx fresh_ctx(const Ctx& C0) { Ctx C = C0; asm volatile("" : "+v"(C.tid)); asm volatile("" : "+s"(C.bid)); asm volatile("" : "+s"(C.lds)); C.lane = C.tid & 63; C.wave = __builtin_amdgcn_readfirstlane(C.tid >> 6); return C; }

DI void transpose_item(const float* src, int ld, int k0, int n0, bf16* dst, int K, int drow0, LAS float* scr, int lane) {
    float tv[32];
#pragma unroll
    for (int i = 0; i < 32; ++i) tv[i] = src[(size_t)(k0 + 2 * i + (lane >> 5)) * ld + n0 + (lane & 31)];
#pragma unroll
    for (int i = 0; i < 32; ++i) scr[(2 * i + (lane >> 5)) * 33 + (lane & 31)] = tv[i];
    asm volatile("s_waitcnt lgkmcnt(0)" ::: "memory");
    const int c = lane & 7;
#pragma unroll
    for (int j = 0; j < 4; ++j) { const int n = (lane >> 3) + 8 * j; const LAS float* s = scr + (8 * c) * 33 + n;
        v4u o; o.x = pk2(s[0 * 33], s[1 * 33]); o.y = pk2(s[2 * 33], s[3 * 33]); o.z = pk2(s[4 * 33], s[5 * 33]); o.w = pk2(s[6 * 33], s[7 * 33]);
        *(v4u*)(dst + (size_t)(drow0 + n) * K + k0 + 8 * c) = o; }
    asm volatile("s_waitcnt lgkmcnt(0)" ::: "memory");
}
DI void phase_convert(const Args& A, const Ctx& C0, int l) { const Ctx C = fresh_ctx(C0);
    LAS float* scr = (LAS float*)(C.lds + C.wave * 16384);
    const int gw = C.bid * NWAVES + C.wave, NGW = GRID * NWAVES;
    bf16* WIN = (bf16*)(A.ws + WS_WIN); bf16* WOUT = (bf16*)(A.ws + WS_WOUT); bf16* WGU = (bf16*)(A.ws + WS_WGU); bf16* WD = (bf16*)(A.ws + WS_WD);
    constexpr int I_IN = 16 * 96, I_OUT = 16 * 32, I_GU = 16 * 512, I_D = 16 * 256, NITEMS = I_IN + I_OUT + I_GU + I_D;
    for (int it = gw; it < NITEMS; it += NGW) {
        int r = it;
        if (r < I_IN) { const int kb = r / 96, nb = r % 96, n0 = 32 * nb; transpose_item(A.in[1] + (size_t)l * D * PIN, PIN, 64 * kb, n0 + (n0 >= 2048 ? 8 : 0), WIN, D, n0, scr, C.lane); continue; } r -= I_IN;
        if (r < I_OUT) { const int kb = r / 32, nb = r % 32; transpose_item(A.in[12] + (size_t)l * D * D, D, 64 * kb, 32 * nb, WOUT, D, 32 * nb, scr, C.lane); continue; } r -= I_OUT;
        if (r < I_GU) { const int e = r / 512, r1 = r % 512, half = r1 / 256, r2 = r1 % 256, kb = r2 / 16, nb = r2 % 16, j0 = 32 * nb;
            transpose_item((half ? A.in[18] : A.in[17]) + (size_t)(l * NEXP + e) * D * DEXP, DEXP, 64 * kb, j0, WGU, D, e * 1024 + (j0 / 128) * 256 + half * 128 + (j0 % 128), scr, C.lane); continue; } r -= I_GU;
        { const int e = r / 256, r1 = r % 256, kb = r1 / 32, nb = r1 % 32;
            transpose_item(A.in[19] + (size_t)(l * NEXP + e) * DEXP * D, D, 64 * kb, 32 * nb, WD, DEXP, e * 1024 + 32 * nb, scr, C.lane); }
    }
    { bf16* WM = (bf16*)(A.ws + SM_WM); const float* wsrc = A.in[6] + (size_t)l * 4 * CH * CH;
        for (int i = C.bid * NTHREADS + C.tid; i < 4 * CH * CH; i += GRID * NTHREADS) { const int s = i & 127, t = (i >> 7) & 127; WM[i] = (bf16)f2bf(s <= t ? wsrc[i] : 0.f); } }
    float* BIAS = (float*)(A.ws + SM_BIAS);
    for (int n = C.bid * NTHREADS + C.tid; n < NPROJ; n += GRID * NTHREADS) BIAS[n] = A.in[2][(size_t)l * PIN + n + (n >= 2048 ? 8 : 0)];
}

DI void stage_gate_weights(const Args& A, const Ctx& C, int lg) {
    LAS float* gwl = (LAS float*)C.lds;
    const float* w = A.in[1] + (size_t)lg * D * PIN + 2048;
    for (int i = C.tid; i < 8 * D; i += NTHREADS) { const int col = i >> 3, g = i & 7; gwl[g * D + col] = w[(size_t)col * PIN + g]; }
}
DI void row_emit(const Args& A, const Ctx& C, int t, const f32x4 (&v)[4], float* xout, bf16* XN, int lg) {
    if (xout) {
#pragma unroll
        for (int j = 0; j < 4; ++j) *(f32x4*)(xout + (size_t)t * D + 256 * j + 4 * C.lane) = v[j];
    }
    if (XN) {
#pragma unroll
        for (int j = 0; j < 4; ++j) { v2u w; w.x = pk2(v[j][0], v[j][1]); w.y = pk2(v[j][2], v[j][3]); *(v2u*)(XN + (size_t)t * D + 256 * j + 4 * C.lane) = w; }
    }
    if (lg >= 0) {
        const LAS float* gwl = (const LAS float*)C.lds;
        float* GATES = (float*)(A.ws + SM_GATES);
        float gs[8];
#pragma unroll
        for (int g = 0; g < 8; ++g) { float s = 0.f;
#pragma unroll
            for (int j = 0; j < 4; ++j) { const f32x4 w = *(const LAS f32x4*)(gwl + g * D + 256 * j + 4 * C.lane); s += v[j][0] * w[0] + v[j][1] * w[1] + v[j][2] * w[2] + v[j][3] * w[3]; }
            gs[g] = wave_sum(s); }
        if (C.lane == 0) {
            const float* bg = A.in[2] + (size_t)lg * PIN + 2048;
            f32x4 o0 = {gs[0] + bg[0], gs[1] + bg[1], gs[2] + bg[2], gs[3] + bg[3]}, o1 = {gs[4] + bg[4], gs[5] + bg[5], gs[6] + bg[6], gs[7] + bg[7]};
            *(f32x4*)(GATES + (size_t)t * 8) = o0; *(f32x4*)(GATES + (size_t)t * 8 + 4) = o1;
        }
    }
}
DI void phase_prologue_rows(const Args& A, const Ctx& C0) { const Ctx C = fresh_ctx(C0);
    stage_gate_weights(A, C, 0);
    __syncthreads();
    for (int t = C.bid * NWAVES + C.wave; t < T; t += GRID * NWAVES) {
        f32x4 v[4];
#pragma unroll
        for (int j = 0; j < 4; ++j) v[j] = *(const f32x4*)(A.in[0] + (size_t)t * D + 256 * j + 4 * C.lane);
        row_emit(A, C, t, v, nullptr, (bf16*)(A.ws + WS_XN), 0);
    }
    __syncthreads();
}
DI void row_layernorm(f32x4 (&v)[4], const float* w, const float* b, int lane) {
    float s = 0.f;
#pragma unroll
    for (int j = 0; j < 4; ++j) s += (v[j][0] + v[j][1]) + (v[j][2] + v[j][3]);
    const float mean = wave_sum(s) * (1.0f / D); float q = 0.f;
#pragma unroll
    for (int j = 0; j < 4; ++j) { v[j] = v[j] - mean; q += (v[j][0] * v[j][0] + v[j][1] * v[j][1]) + (v[j][2] * v[j][2] + v[j][3] * v[j][3]); }
    const float rstd = 1.0f / sqrtf(wave_sum(q) * (1.0f / D) + LN_EPS);
#pragma unroll
    for (int j = 0; j < 4; ++j) { const f32x4 ww = *(const f32x4*)(w + 256 * j + 4 * lane), bb = *(const f32x4*)(b + 256 * j + 4 * lane); v[j] = v[j] * rstd * ww + bb; }
}
DI void phase_ln1_router(const Args& A, const Ctx& C0, int l) { const Ctx C = fresh_ctx(C0);
    LAS float* rwl = (LAS float*)C.lds;
    LAS int* hist = (LAS int*)(C.lds + VEC_OFF);
    for (int i = C.tid; i < NEXP * D; i += NTHREADS) { const int col = i >> 4, e = i & 15; rwl[e * D + col] = A.in[15][i]; }
    if (C.tid < 16) hist[C.tid] = 0;
    __syncthreads();
    const bf16* X = (const bf16*)(A.ws + WS_XN);
    const bf16* Y = (const bf16*)(A.ws + WS_PROJ);
    bf16* XNB = (bf16*)(A.ws + WS_XNB);
    v4u* SEL = (v4u*)(A.ws + SM_SEL);
    float rb[16];
#pragma unroll
    for (int e = 0; e < 16; ++e) rb[e] = A.in[16][e];
    for (int i = 0; i < 8; ++i) {
        const int t = C.bid * 64 + C.wave * 8 + i;
        f32x4 v[4];
#pragma unroll
        for (int j = 0; j < 4; ++j) { const v2u x = *(const v2u*)(X + (size_t)t * D + 256 * j + 4 * C.lane); const v2u y = *(const v2u*)(Y + (size_t)t * D + 256 * j + 4 * C.lane);
            v[j][0] = ALPHA * bflo(x.x) + bflo(y.x); v[j][1] = ALPHA * bfhi(x.x) + bfhi(y.x); v[j][2] = ALPHA * bflo(x.y) + bflo(y.y); v[j][3] = ALPHA * bfhi(x.y) + bfhi(y.y); }
        row_layernorm(v, A.in[13] + (size_t)l * D, A.in[14] + (size_t)l * D, C.lane);
        row_emit(A, C, t, v, nullptr, XNB, -1);
        float best = -INFINITY, bs0 = 0.f, bs1 = 0.f; int be0 = 0, be1 = 1;
#pragma unroll
        for (int g = 0; g < 4; ++g) {
            float sel[4], sg[4];
#pragma unroll
            for (int k = 0; k < 4; ++k) { const int e = 4 * g + k; float s = 0.f;
#pragma unroll
                for (int j = 0; j < 4; ++j) { const f32x4 w = *(const LAS f32x4*)(rwl + e * D + 256 * j + 4 * C.lane); s += v[j][0] * w[0] + v[j][1] * w[1] + v[j][2] * w[2] + v[j][3] * w[3]; }
                s = wave_sum(s); sg[k] = 1.0f / (1.0f + expf(-s)); sel[k] = sg[k] + rb[e]; }
            float m1 = sel[0], s1 = sg[0]; int i1 = 0;
#pragma unroll
            for (int k = 1; k < 4; ++k) if (sel[k] > m1) { m1 = sel[k]; s1 = sg[k]; i1 = k; }
            float m2 = -INFINITY, s2 = 0.f; int i2 = 0;
#pragma unroll
            for (int k = 0; k < 4; ++k) if (k != i1 && sel[k] > m2) { m2 = sel[k]; s2 = sg[k]; i2 = k; }
            const float gsc = m1 + m2;
            if (gsc > best) { best = gsc; be0 = 4 * g + i1; be1 = 4 * g + i2; bs0 = s1; bs1 = s2; }
        }
        if (C.lane == 0) {
            const float inv = 1.0f / (bs0 + bs1);
            v4u o; o.x = (unsigned)be0; o.y = (unsigned)be1; o.z = __builtin_bit_cast(unsigned, bs0 * inv); o.w = __builtin_bit_cast(unsigned, bs1 * inv);
            SEL[t] = o;
            ((f32x2*)(A.ws + SM_GW))[t] = (f32x2){bs0 * inv, bs1 * inv};
            __hip_atomic_fetch_add(hist + be0, 1, __ATOMIC_RELAXED, __HIP_MEMORY_SCOPE_WORKGROUP);
            __hip_atomic_fetch_add(hist + be1, 1, __ATOMIC_RELAXED, __HIP_MEMORY_SCOPE_WORKGROUP);
        }
    }
    __syncthreads();
    if (C.tid < 16) ((int*)(A.ws + SM_HIST))[C.bid * 16 + C.tid] = hist[C.tid];
    __syncthreads();
}
DI void phase_scatter(const Args& A, const Ctx& C0) { const Ctx C = fresh_ctx(C0);
    LAS int* sh = (LAS int*)(C.lds + VEC_OFF);
    LAS int* cnt = sh, *off = sh + 16, *base = sh + 32, *se = sh + 64, *pos = sh + 192;
    const int* HIST = (const int*)(A.ws + SM_HIST);
    const v4u* SEL = (const v4u*)(A.ws + SM_SEL);
    int* META = (int*)(A.ws + SM_META);
    int* TOKSLOT = (int*)(A.ws + SM_TOKSLOT);
    if (C.tid < 16) { int c = 0, o = 0; for (int w = 0; w < GRID; ++w) { const int h = HIST[w * 16 + C.tid]; if (w < C.bid) o += h; c += h; } cnt[C.tid] = c; off[C.tid] = o; }
    if (C.tid >= 64 && C.tid < 128) { const int i = C.tid - 64; const v4u s = SEL[C.bid * 64 + i]; se[2 * i] = (int)s.x; se[2 * i + 1] = (int)s.y; }
    __syncthreads();
    if (C.tid == 0) { int run = 0;
        for (int e = 0; e < 16; ++e) { base[e] = run; const int nt = (cnt[e] + 255) >> 8; if (C.bid == 0) for (int k = 0; k < nt; ++k) META[16 + (run >> 8) + k] = e; run += nt * 256; }
        if (C.bid == 0) META[0] = run >> 8; }
    __syncthreads();
    if (C.tid < 16) { int r = 0; for (int q = 0; q < 128; ++q) if (se[q] == C.tid) { pos[q] = base[C.tid] + off[C.tid] + r; ++r; } }
    __syncthreads();
    if (C.tid < 128) TOKSLOT[C.bid * 128 + C.tid] = pos[C.tid];
    const bf16* XN = (const bf16*)(A.ws + WS_XNB); bf16* XG = (bf16*)(A.ws + WS_PROJ);
    for (int r = C.wave; r < 128; r += 8) { const int p = pos[r], t = C.bid * 64 + (r >> 1);
        const v4u a = *(const v4u*)(XN + (size_t)t * D + 8 * C.lane), b = *(const v4u*)(XN + (size_t)t * D + 512 + 8 * C.lane);
        *(v4u*)(XG + (size_t)p * D + 8 * C.lane) = a; *(v4u*)(XG + (size_t)p * D + 512 + 8 * C.lane) = b; }
    __syncthreads();
}
DI void make_list(const Args& A, const Ctx& C, pg8::ListOrder& S) {
    const int* META = (const int*)(A.ws + SM_META);
    S.meta = META; S.nunits = __builtin_amdgcn_readfirstlane(META[0]) * 4; S.G = GRID; S.c = C.bid;
}
DI void phase_combine(const Args& A, const Ctx& C0, int l) { const Ctx C = fresh_ctx(C0);
    const bool last = (l == NLAYER - 1);
    if (!last) { stage_gate_weights(A, C, l + 1); }
    __syncthreads();
    const bf16* X1 = (const bf16*)(A.ws + WS_XNB); const bf16* YP = (const bf16*)(A.ws + WS_PROJ);
    const v4u* SEL = (const v4u*)(A.ws + SM_SEL); const int* TOKSLOT = (const int*)(A.ws + SM_TOKSLOT);
    for (int t = C.bid * NWAVES + C.wave; t < T; t += GRID * NWAVES) {
        const v4u s = SEL[t]; const int p0 = TOKSLOT[2 * t], p1 = TOKSLOT[2 * t + 1]; const f32x2 gw2 = ((const f32x2*)(A.ws + SM_GW))[t]; const float g0 = gw2[0], g1 = gw2[1];
        f32x4 v[4];
#pragma unroll
        for (int j = 0; j < 4; ++j) { const v2u x = *(const v2u*)(X1 + (size_t)t * D + 256 * j + 4 * C.lane);
            const v2u a = *(const v2u*)(YP + (size_t)p0 * D + 256 * j + 4 * C.lane), b = *(const v2u*)(YP + (size_t)p1 * D + 256 * j + 4 * C.lane);
            v[j][0] = ALPHA * bflo(x.x) + g0 * bflo(a.x) + g1 * bflo(b.x); v[j][1] = ALPHA * bfhi(x.x) + g0 * bfhi(a.x) + g1 * bfhi(b.x);
            v[j][2] = ALPHA * bflo(x.y) + g0 * bflo(a.y) + g1 * bflo(b.y); v[j][3] = ALPHA * bfhi(x.y) + g0 * bfhi(a.y) + g1 * bfhi(b.y); }
        row_layernorm(v, A.in[20] + (size_t)l * D, A.in[21] + (size_t)l * D, C.lane);
        row_emit(A, C, t, v, last ? A.out : nullptr, last ? nullptr : (bf16*)(A.ws + WS_XN), last ? -1 : l + 1);
    }
    __syncthreads();
}
DI void unpack8(const v4u w, float (&f)[8]) { f[0] = bflo(w.x); f[1] = bfhi(w.x); f[2] = bflo(w.y); f[3] = bfhi(w.y); f[4] = bflo(w.z); f[5] = bfhi(w.z); f[6] = bflo(w.w); f[7] = bfhi(w.w); }
DI void conv_unit(const Args& A, const Ctx& C0, int l, int unit) { const Ctx C = fresh_ctx(C0);
    const bf16* PROJ = (const bf16*)(A.ws + WS_PROJ); bf16* HCAT = (bf16*)(A.ws + WS_HCAT);
    LAS float* cin = (LAS float*)C.lds;
    LAS float* cou = (LAS float*)(C.lds + 65536);
    const int t0 = unit * 32, tseq = t0 & (SEQ - 1);
    for (int it = C.tid; it < 62 * 32; it += NTHREADS) { const int r = it >> 5, c8 = (it & 31) * 8; float o[8];
        if (tseq - 30 + r >= 0) { const size_t rowo = (size_t)(t0 - 30 + r) * NPROJ; float a[8], b[8]; unpack8(*(const v4u*)(PROJ + rowo + PCA + c8), a); unpack8(*(const v4u*)(PROJ + rowo + PCB + c8), b);
#pragma unroll
            for (int i = 0; i < 8; ++i) o[i] = a[i] * sigmoidf_(b[i]); }
        else {
#pragma unroll
            for (int i = 0; i < 8; ++i) o[i] = 0.f; }
        *(LAS f32x4*)(cin + r * 256 + c8) = (f32x4){o[0], o[1], o[2], o[3]}; *(LAS f32x4*)(cin + r * 256 + c8 + 4) = (f32x4){o[4], o[5], o[6], o[7]}; }
    __syncthreads();
    { const int c = C.tid & 255, half = C.tid >> 8;
        float w[31];
#pragma unroll
        for (int j = 0; j < 31; ++j) w[j] = A.in[8][(size_t)(l * 31 + j) * 256 + c];
        const float bias = A.in[9][l * 256 + c];
        float xin[46];
#pragma unroll
        for (int r = 0; r < 46; ++r) xin[r] = cin[(half * 16 + r) * 256 + c];
#pragma unroll
        for (int i = 0; i < 16; ++i) { float acc = bias;
#pragma unroll
            for (int j = 0; j < 31; ++j) acc += xin[i + j] * w[j];
            cou[(half * 16 + i) * 256 + c] = acc; } }
    __syncthreads();
    { const f32x4 nw = *(const f32x4*)(A.in[10] + l * 256 + 4 * C.lane), nb = *(const f32x4*)(A.in[11] + l * 256 + 4 * C.lane);
#pragma unroll
        for (int q = 0; q < 4; ++q) { const int r = 4 * C.wave + q; f32x4 x = *(const LAS f32x4*)(cou + r * 256 + 4 * C.lane);
            const float mean = wave_sum((x[0] + x[1]) + (x[2] + x[3])) * (1.0f / 256.0f); x = x - mean;
            const float var = wave_sum((x[0] * x[0] + x[1] * x[1]) + (x[2] * x[2] + x[3] * x[3])) * (1.0f / 256.0f);
            const float rstd = 1.0f / sqrtf(var + LN_EPS); x = x * rstd * nw + nb;
            float o[4];
#pragma unroll
            for (int k = 0; k < 4; ++k) o[k] = x[k] * sigmoidf_(x[k]);
            v2u pk; pk.x = pk2(o[0], o[1]); pk.y = pk2(o[2], o[3]);
            *(v2u*)(HCAT + (size_t)(t0 + r) * D + 768 + 4 * C.lane) = pk; } }
    __syncthreads();
}
DI void gmlp_unit_simple(const Args& A, const Ctx& C0, int l, int ck) { const Ctx C = fresh_ctx(C0);
    const bf16* PROJ = (const bf16*)(A.ws + WS_PROJ); bf16* HCAT = (bf16*)(A.ws + WS_HCAT);
    LAS float* zs = (LAS float*)C.lds;
    const int t0 = ck * CH;
    { const f32x4 nw = *(const f32x4*)(A.in[4] + l * 256 + 4 * C.lane), nb = *(const f32x4*)(A.in[5] + l * 256 + 4 * C.lane);
        for (int i = 0; i < 16; ++i) { const int r = C.wave * 16 + i; const v2u g = *(const v2u*)(PROJ + (size_t)(t0 + r) * NPROJ + PGV + 4 * C.lane);
            f32x4 x = {gelu_tanh(bflo(g.x)), gelu_tanh(bfhi(g.x)), gelu_tanh(bflo(g.y)), gelu_tanh(bfhi(g.y))};
            const float mean = wave_sum((x[0] + x[1]) + (x[2] + x[3])) * (1.0f / 256.0f); x = x - mean;
            const float var = wave_sum((x[0] * x[0] + x[1] * x[1]) + (x[2] * x[2] + x[3] * x[3])) * (1.0f / 256.0f);
            const float rstd = 1.0f / sqrtf(var + LN_EPS); x = x * rstd * nw + nb;
            *(LAS f32x4*)(zs + r * 256 + 4 * C.lane) = x; } }
    __syncthreads();
    { const int tb = C.tid >> 4, cb = C.tid & 15, c0 = 16 * cb, h = cb >> 2, tr0 = 4 * tb;
        const float* ws = A.in[6] + (size_t)(l * 4 + h) * CH * CH;
        float acc[4][16];
#pragma unroll
        for (int i = 0; i < 4; ++i)
#pragma unroll
            for (int j = 0; j < 16; ++j) acc[i][j] = 0.f;
        for (int s = 0; s <= tr0 + 3; ++s) {
            float zv[16];
#pragma unroll
            for (int q = 0; q < 4; ++q) { const f32x4 z4 = *(const LAS f32x4*)(zs + s * 256 + c0 + 4 * q); zv[4 * q] = z4[0]; zv[4 * q + 1] = z4[1]; zv[4 * q + 2] = z4[2]; zv[4 * q + 3] = z4[3]; }
#pragma unroll
            for (int i = 0; i < 4; ++i) { const float wg = (s <= tr0 + i) ? ws[(size_t)(tr0 + i) * CH + s] : 0.f;
#pragma unroll
                for (int j = 0; j < 16; ++j) acc[i][j] += wg * zv[j]; }
        }
#pragma unroll
        for (int i = 0; i < 4; ++i) { const int tr = tr0 + i; const float bsv = A.in[7][(size_t)(l * 4 + h) * CH + tr]; const size_t rowo = (size_t)(t0 + tr) * NPROJ + PGU + c0;
            float u[16]; { float tmp[8]; unpack8(*(const v4u*)(PROJ + rowo), tmp);
#pragma unroll
                for (int j = 0; j < 8; ++j) u[j] = tmp[j];
                unpack8(*(const v4u*)(PROJ + rowo + 8), tmp);
#pragma unroll
                for (int j = 0; j < 8; ++j) u[8 + j] = tmp[j]; }
            float o[16];
#pragma unroll
            for (int j = 0; j < 16; ++j) o[j] = gelu_tanh(u[j]) * (acc[i][j] + bsv);
            v4u w0, w1; w0.x = pk2(o[0], o[1]); w0.y = pk2(o[2], o[3]); w0.z = pk2(o[4], o[5]); w0.w = pk2(o[6], o[7]); w1.x = pk2(o[8], o[9]); w1.y = pk2(o[10], o[11]); w1.z = pk2(o[12], o[13]); w1.w = pk2(o[14], o[15]);
            *(v4u*)(HCAT + (size_t)(t0 + tr) * D + 512 + c0) = w0; *(v4u*)(HCAT + (size_t)(t0 + tr) * D + 512 + c0 + 8) = w1; }
    }
    __syncthreads();
}
DI void mlstm_local_simple(const Args& A, const Ctx& C0, int un) { const Ctx C = fresh_ctx(C0);
    const bf16* PROJ = (const bf16*)(A.ws + WS_PROJ); const float* GATES = (const float*)(A.ws + SM_GATES);
    const int bh = un >> 5, c = un & 31, b = bh >> 2, h = bh & 3, t0 = b * SEQ + c * CH;
    LAS float* kw = (LAS float*)C.lds;
    LAS float* vs = (LAS float*)(C.lds + 65536);
    LAS float* vec = (LAS float*)(C.lds + VEC_OFF);
    if (C.tid < CH) { const float fp = GATES[(size_t)(t0 + C.tid) * 8 + 4 + h], ip = GATES[(size_t)(t0 + C.tid) * 8 + h]; vec[C.tid] = logsigmoidf_(fp); vec[128 + C.tid] = ip; }
    __syncthreads();
    if (C.tid == 0) { float run = 0.f; for (int i = 0; i < CH; ++i) { run += vec[i]; vec[i] = run; } const float g = run; float ml = -INFINITY;
        for (int i = 0; i < CH; ++i) { const float a = g - vec[i] + vec[128 + i]; vec[256 + i] = a; ml = fmaxf(ml, a); }
        for (int i = 0; i < CH; ++i) vec[256 + i] = __expf(vec[256 + i] - ml);
        ((float*)(A.ws + SM_G))[un] = g; ((float*)(A.ws + SM_MLOC))[un] = ml; }
    __syncthreads();
    for (int it = C.tid; it < CH * 16; it += NTHREADS) { const int r = it >> 4, c8 = (it & 15) * 8; const size_t rowo = (size_t)(t0 + r) * NPROJ + h * 128 + c8; float k8[8], v8[8];
        unpack8(*(const v4u*)(PROJ + rowo + PK), k8); unpack8(*(const v4u*)(PROJ + rowo + PV), v8); const float sc = vec[256 + r] * 0.08838834764831845f;
#pragma unroll
        for (int i = 0; i < 8; ++i) { kw[r * 128 + c8 + i] = k8[i] * sc; vs[r * 128 + c8 + i] = v8[i]; } }
    __syncthreads();
    { const int db = C.tid >> 4, eb = C.tid & 15, d0 = 4 * db, e0 = 8 * eb; float acc[4][8];
#pragma unroll
        for (int i = 0; i < 4; ++i)
#pragma unroll
            for (int j = 0; j < 8; ++j) acc[i][j] = 0.f;
        for (int r = 0; r < CH; ++r) { const f32x4 kd = *(const LAS f32x4*)(kw + r * 128 + d0); const f32x4 va = *(const LAS f32x4*)(vs + r * 128 + e0), vb = *(const LAS f32x4*)(vs + r * 128 + e0 + 4);
#pragma unroll
            for (int i = 0; i < 4; ++i) { acc[i][0] += kd[i] * va[0]; acc[i][1] += kd[i] * va[1]; acc[i][2] += kd[i] * va[2]; acc[i][3] += kd[i] * va[3]; acc[i][4] += kd[i] * vb[0]; acc[i][5] += kd[i] * vb[1]; acc[i][6] += kd[i] * vb[2]; acc[i][7] += kd[i] * vb[3]; } }
        float* CL = (float*)(A.ws + WS_CLOCT) + (size_t)un * CH * CH;
#pragma unroll
        for (int j = 0; j < 8; ++j) *(f32x4*)(CL + (size_t)(e0 + j) * CH + d0) = (f32x4){acc[0][j], acc[1][j], acc[2][j], acc[3][j]}; }
    if (C.tid < CH) { float s = 0.f; for (int r = 0; r < CH; ++r) s += kw[r * 128 + C.tid]; ((float*)(A.ws + SM_NLOC))[(size_t)un * CH + C.tid] = s; }
    __syncthreads();
}
DI void phase_scan(const Args& A, const Ctx& C0) { const Ctx C = fresh_ctx(C0);
    const int gt = C.bid * NTHREADS + C.tid, bh = gt >> 13, pr = gt & 8191;
    const float* G = (const float*)(A.ws + SM_G); const float* ML = (const float*)(A.ws + SM_MLOC); float* MP = (float*)(A.ws + SM_MPREV);
    const float* CL = (const float*)(A.ws + WS_CLOCT); unsigned* CP = (unsigned*)(A.ws + WS_CPREVT);
    const float* NL = (const float*)(A.ws + SM_NLOC); float* NP = (float*)(A.ws + SM_NPREV);
    float c0 = 0.f, c1 = 0.f, n0 = 0.f, n1 = 0.f, m = 0.f;
    for (int cb = 0; cb < NCH; cb += 8) {
        f32x2 cl[8], nl[8]; float g[8], ml[8];
#pragma unroll
        for (int i = 0; i < 8; ++i) { const int un = bh * NCH + cb + i; cl[i] = *(const f32x2*)(CL + (size_t)un * CH * CH + 2 * pr); g[i] = G[un]; ml[i] = ML[un]; nl[i] = (pr < 64) ? *(const f32x2*)(NL + (size_t)un * CH + 2 * pr) : (f32x2){0.f, 0.f}; }
#pragma unroll
        for (int i = 0; i < 8; ++i) { const int un = bh * NCH + cb + i;
            CP[(size_t)un * (CH * CH / 2) + pr] = pk2(c0, c1);
            if (pr == 0) MP[un] = m;
            if (pr < 64) *(f32x2*)(NP + (size_t)un * CH + 2 * pr) = (f32x2){n0, n1};
            const float mn = fmaxf(g[i] + m, ml[i]), dec = __expf(g[i] + m - mn), sc = __expf(ml[i] - mn);
            c0 = dec * c0 + sc * cl[i][0]; c1 = dec * c1 + sc * cl[i][1]; n0 = dec * n0 + sc * nl[i][0]; n1 = dec * n1 + sc * nl[i][1]; m = mn; }
    }
}
DI void mlstm_out_simple(const Args& A, const Ctx& C0, int l, int un) { const Ctx C = fresh_ctx(C0);
    const bf16* PROJ = (const bf16*)(A.ws + WS_PROJ); const float* GATES = (const float*)(A.ws + SM_GATES); bf16* HCAT = (bf16*)(A.ws + WS_HCAT);
    const int bh = un >> 5, c = un & 31, b = bh >> 2, h = bh & 3, t0 = b * SEQ + c * CH;
    LAS bf16* qs = (LAS bf16*)C.lds;
    LAS bf16* ks = (LAS bf16*)(C.lds + 32768);
    LAS float* ps = (LAS float*)(C.lds + 65536);
    LAS float* vec = (LAS float*)(C.lds + VEC_OFF);
    LAS float* bvec = vec, *uvec = vec + 128, *Mvec = vec + 256, *wint = vec + 384, *flo = vec + 512, *den = vec + 640, *npv = vec + 768, *ipv = vec + 896, *lfv = vec + 1024, *qnv = vec + 1152;
    if (C.tid < CH) { const float fp = GATES[(size_t)(t0 + C.tid) * 8 + 4 + h], ip = GATES[(size_t)(t0 + C.tid) * 8 + h]; lfv[C.tid] = logsigmoidf_(fp); ipv[C.tid] = ip; npv[C.tid] = ((const float*)(A.ws + SM_NPREV))[(size_t)un * CH + C.tid]; }
    __syncthreads();
    if (C.tid == 0) { const float mprev = ((const float*)(A.ws + SM_MPREV))[un]; float run = 0.f, pm = -INFINITY;
        for (int i = 0; i < CH; ++i) { run += lfv[i]; bvec[i] = run; const float u = ipv[i] - run; uvec[i] = u; pm = fmaxf(pm, u); const float M = fmaxf(mprev, pm); Mvec[i] = M; wint[i] = __expf(mprev - M); flo[i] = __expf(-(run + M)); } }
    for (int it = C.tid; it < CH * 16; it += NTHREADS) { const int r = it >> 4, c8 = (it & 15) * 8; const size_t rowo = (size_t)(t0 + r) * NPROJ + h * 128 + c8;
        *(LAS v4u*)(qs + r * 128 + c8) = *(const v4u*)(PROJ + rowo + PQ); *(LAS v4u*)(ks + r * 128 + c8) = *(const v4u*)(PROJ + rowo + PK); }
    __syncthreads();
    const int lb = C.tid >> 4, xb = C.tid & 15, l0 = 4 * lb, x0 = 8 * xb;
    {
        float acc[4][8];
#pragma unroll
        for (int i = 0; i < 4; ++i)
#pragma unroll
            for (int j = 0; j < 8; ++j) acc[i][j] = 0.f;
        if (x0 <= l0 + 3) {
            for (int d8 = 0; d8 < 16; ++d8) { float qf[4][8], kf[8];
#pragma unroll
                for (int i = 0; i < 4; ++i) unpack8(*(const LAS v4u*)(qs + (l0 + i) * 128 + d8 * 8), qf[i]);
#pragma unroll
                for (int j = 0; j < 8; ++j) { unpack8(*(const LAS v4u*)(ks + (x0 + j) * 128 + d8 * 8), kf);
#pragma unroll
                    for (int i = 0; i < 4; ++i) { float s = 0.f;
#pragma unroll
                        for (int dd = 0; dd < 8; ++dd) s += qf[i][dd] * kf[dd];
                        acc[i][j] += s; } } } }
#pragma unroll
        for (int i = 0; i < 4; ++i)
#pragma unroll
            for (int j = 0; j < 8; ++j) { const int li = l0 + i, sj = x0 + j; ps[li * 128 + sj] = (sj <= li) ? acc[i][j] * 0.08838834764831845f * __expf(uvec[sj] - Mvec[li]) : 0.f; }
    }
    __syncthreads();
    if (C.tid < CH) { const int li = C.tid; float s = 0.f; for (int k = 0; k < CH; ++k) s += ps[li * 128 + ((k + li) & 127)]; den[li] = s; }
    else if (C.tid < 2 * CH) { const int li = C.tid - CH; float s = 0.f; for (int k = 0; k < CH; ++k) { const int d = (k + li) & 127; s += bf2f(qs[li * 128 + d]) * npv[d]; } qnv[li] = s; }
    for (int it = C.tid; it < CH * 16; it += NTHREADS) { const int r = it >> 4, c8 = (it & 15) * 8; }
    __syncthreads();
    for (int it = C.tid; it < CH * 16; it += NTHREADS) { const int r = it >> 4, c8 = (it & 15) * 8; const size_t rowo = (size_t)(t0 + r) * NPROJ + h * 128 + c8; *(LAS v4u*)(ks + r * 128 + c8) = *(const v4u*)(PROJ + rowo + PV); }
    __syncthreads();
    float hv[4][8];
    {   const int e0 = x0; float acc[4][8], acc2[4][8];
#pragma unroll
        for (int i = 0; i < 4; ++i)
#pragma unroll
            for (int j = 0; j < 8; ++j) { acc[i][j] = 0.f; acc2[i][j] = 0.f; }
        for (int s = 0; s <= l0 + 3; ++s) { float vv[8]; unpack8(*(const LAS v4u*)(ks + s * 128 + e0), vv);
#pragma unroll
            for (int i = 0; i < 4; ++i) { const float p = ps[(l0 + i) * 128 + s];
#pragma unroll
                for (int j = 0; j < 8; ++j) acc[i][j] += p * vv[j]; } }
        const bf16* CPT = (const bf16*)(A.ws + WS_CPREVT) + (size_t)un * CH * CH;
        for (int d8 = 0; d8 < 16; ++d8) { float qf[4][8], cf[8];
#pragma unroll
            for (int i = 0; i < 4; ++i) unpack8(*(const LAS v4u*)(qs + (l0 + i) * 128 + d8 * 8), qf[i]);
#pragma unroll
            for (int j = 0; j < 8; ++j) { unpack8(*(const v4u*)(CPT + (size_t)(e0 + j) * CH + d8 * 8), cf);
#pragma unroll
                for (int i = 0; i < 4; ++i) { float s = 0.f;
#pragma unroll
                    for (int dd = 0; dd < 8; ++dd) s += qf[i][dd] * cf[dd];
                    acc2[i][j] += s; } } }
#pragma unroll
        for (int i = 0; i < 4; ++i) { const int li = l0 + i; const float wi = wint[li]; const float dn = den[li] + wi * qnv[li]; const float inv = 1.0f / fmaxf(fabsf(dn), flo[li]);
#pragma unroll
            for (int j = 0; j < 8; ++j) hv[i][j] = (acc[i][j] + wi * acc2[i][j]) * inv; }
    }
    __syncthreads();
#pragma unroll
    for (int i = 0; i < 4; ++i)
#pragma unroll
        for (int j = 0; j < 8; ++j) ps[(l0 + i) * 128 + x0 + j] = hv[i][j];
    __syncthreads();
    { const f32x2 nw = *(const f32x2*)(A.in[3] + (size_t)l * 512 + h * 128 + 2 * C.lane);
        for (int i = 0; i < 16; ++i) { const int li = C.wave * 16 + i; f32x2 x = *(const LAS f32x2*)(ps + li * 128 + 2 * C.lane);
            const float mean = wave_sum(x[0] + x[1]) * (1.0f / 128.0f); x = x - mean; const float var = wave_sum(x[0] * x[0] + x[1] * x[1]) * (1.0f / 128.0f);
            const float rstd = 1.0f / sqrtf(var + 1e-6f); const unsigned ow = *(const unsigned*)(PROJ + (size_t)(t0 + li) * NPROJ + PO + h * 128 + 2 * C.lane);
            const float o0 = sigmoidf_(bflo(ow)) * (x[0] * rstd * nw[0]), o1 = sigmoidf_(bfhi(ow)) * (x[1] * rstd * nw[1]);
            *(unsigned*)(HCAT + (size_t)(t0 + li) * D + h * 128 + 2 * C.lane) = pk2(o0, o1); } }
    __syncthreads();
}
typedef short bf16x8 __attribute__((ext_vector_type(8)));
DI f32x4 mfma16(bf16x8 a, bf16x8 b, f32x4 c) { return __builtin_amdgcn_mfma_f32_16x16x32_bf16(a, b, c, 0, 0, 0); }
constexpr int LDT = 136;
constexpr int TILE_B = 128 * LDT * 2;
DI float wave_scan_add(float v, int lane) {
#pragma unroll
    for (int o = 1; o < 64; o <<= 1) { const float t = __shfl_up(v, o); if (lane >= o) v += t; }
    return v;
}
DI float wave_scan_max(float v, int lane) {
#pragma unroll
    for (int o = 1; o < 64; o <<= 1) { const float t = __shfl_up(v, o); if (lane >= o) v = fmaxf(v, t); }
    return v;
}
DI float wave_max(float v) {
#pragma unroll
    for (int o = 1; o < 64; o <<= 1) v = fmaxf(v, __shfl_xor(v, o));
    return v;
}
DI float red16(float v) { v += __shfl_xor(v, 1); v += __shfl_xor(v, 2); v += __shfl_xor(v, 4); v += __shfl_xor(v, 8); return v; }

DI void mlstm_local_mfma(const Args& A, const Ctx& C0, int un) { const Ctx C = fresh_ctx(C0);
    const bf16* PROJ = (const bf16*)(A.ws + WS_PROJ); const float* GATES = (const float*)(A.ws + SM_GATES);
    const int bh = un >> 5, c = un & 31, b = bh >> 2, h = bh & 3, t0 = b * SEQ + c * CH;
    LAS bf16* VT = (LAS bf16*)C.lds;
    LAS bf16* KWT = (LAS bf16*)(C.lds + TILE_B);
    LAS float* wv = (LAS float*)(C.lds + VEC_OFF);
    if (C.wave == 0) {
        const int l0 = 2 * C.lane; const f32x4 ga = *(const f32x4*)(GATES + (size_t)(t0 + l0) * 8), gb = *(const f32x4*)(GATES + (size_t)(t0 + l0) * 8 + 4), gc = *(const f32x4*)(GATES + (size_t)(t0 + l0 + 1) * 8), gd = *(const f32x4*)(GATES + (size_t)(t0 + l0 + 1) * 8 + 4);
        const float ip0 = h == 0 ? ga[0] : (h == 1 ? ga[1] : (h == 2 ? ga[2] : ga[3])), fp0 = h == 0 ? gb[0] : (h == 1 ? gb[1] : (h == 2 ? gb[2] : gb[3]));
        const float ip1 = h == 0 ? gc[0] : (h == 1 ? gc[1] : (h == 2 ? gc[2] : gc[3])), fp1 = h == 0 ? gd[0] : (h == 1 ? gd[1] : (h == 2 ? gd[2] : gd[3]));
        const float lf0 = logsigmoidf_(fp0), lf1 = logsigmoidf_(fp1);
        const float incl = wave_scan_add(lf0 + lf1, C.lane), b1 = incl, b0 = incl - lf1;
        const float g = __shfl(incl, 63);
        const float a0 = g - b0 + ip0, a1 = g - b1 + ip1, ml = wave_max(fmaxf(a0, a1));
        wv[l0] = __expf(a0 - ml); wv[l0 + 1] = __expf(a1 - ml);
        if (C.lane == 0) { ((float*)(A.ws + SM_G))[un] = g; ((float*)(A.ws + SM_MLOC))[un] = ml; }
    }
    __syncthreads();
    for (int it = C.tid; it < CH * 16; it += NTHREADS) { const int r = it >> 4, c8 = (it & 15) * 8; const size_t rowo = (size_t)(t0 + r) * NPROJ + h * 128 + c8; float k8[8];
        unpack8(*(const v4u*)(PROJ + rowo + PK), k8); const v4u vv = *(const v4u*)(PROJ + rowo + PV); const float sc = wv[r] * 0.08838834764831845f;
        const unsigned vw[4] = {vv.x, vv.y, vv.z, vv.w};
#pragma unroll
        for (int i = 0; i < 8; ++i) { KWT[(c8 + i) * LDT + r] = (bf16)f2bf(k8[i] * sc); VT[(c8 + i) * LDT + r] = (bf16)((i & 1) ? (vw[i >> 1] >> 16) : (vw[i >> 1] & 0xffffu)); } }
    __syncthreads();
    { const int fr = C.lane & 15, fg = C.lane >> 4, w = C.wave;
        bf16x8 a[4];
#pragma unroll
        for (int ks = 0; ks < 4; ++ks) a[ks] = *(const LAS bf16x8*)(VT + (16 * w + fr) * LDT + 32 * ks + 8 * fg);
        float* CL = (float*)(A.ws + WS_CLOCT) + (size_t)un * CH * CH;
#pragma unroll
        for (int dt = 0; dt < 8; ++dt) { f32x4 acc = {0.f, 0.f, 0.f, 0.f};
#pragma unroll
            for (int ks = 0; ks < 4; ++ks) { const bf16x8 bb = *(const LAS bf16x8*)(KWT + (16 * dt + fr) * LDT + 32 * ks + 8 * fg); acc = mfma16(a[ks], bb, acc); }
#pragma unroll
            for (int rg = 0; rg < 4; ++rg) CL[(size_t)(16 * w + 4 * fg + rg) * CH + 16 * dt + fr] = acc[rg]; } }
    if (C.tid < CH) { float s = 0.f;
#pragma unroll
        for (int q = 0; q < 16; ++q) { float f[8]; unpack8(*(const LAS v4u*)(KWT + C.tid * LDT + 8 * q), f); s += ((f[0] + f[1]) + (f[2] + f[3])) + ((f[4] + f[5]) + (f[6] + f[7])); }
        ((float*)(A.ws + SM_NLOC))[(size_t)un * CH + C.tid] = s; }
    __syncthreads();
}
DI void mlstm_out_mfma(const Args& A, const Ctx& C0, int l, int un) { const Ctx C = fresh_ctx(C0);
    const bf16* PROJ = (const bf16*)(A.ws + WS_PROJ); const float* GATES = (const float*)(A.ws + SM_GATES); bf16* HCAT = (bf16*)(A.ws + WS_HCAT);
    const int bh = un >> 5, c = un & 31, b = bh >> 2, h = bh & 3, t0 = b * SEQ + c * CH;
    LAS bf16* QS = (LAS bf16*)C.lds;
    LAS bf16* KS = (LAS bf16*)(C.lds + TILE_B);
    LAS bf16* PS = (LAS bf16*)(C.lds + 2 * TILE_B);
    LAS bf16* CT = (LAS bf16*)(C.lds + 3 * TILE_B);
    LAS float* vec = (LAS float*)(C.lds + VEC_OFF);
    LAS float* uvec = vec, *Mvec = vec + 128, *wint = vec + 256, *flo = vec + 384; LAS bf16* npb = (LAS bf16*)(vec + 512);
    if (C.wave == 0) {
        const int l0 = 2 * C.lane; const f32x4 ga = *(const f32x4*)(GATES + (size_t)(t0 + l0) * 8), gb = *(const f32x4*)(GATES + (size_t)(t0 + l0) * 8 + 4), gc = *(const f32x4*)(GATES + (size_t)(t0 + l0 + 1) * 8), gd = *(const f32x4*)(GATES + (size_t)(t0 + l0 + 1) * 8 + 4);
        const float ip0 = h == 0 ? ga[0] : (h == 1 ? ga[1] : (h == 2 ? ga[2] : ga[3])), fp0 = h == 0 ? gb[0] : (h == 1 ? gb[1] : (h == 2 ? gb[2] : gb[3]));
        const float ip1 = h == 0 ? gc[0] : (h == 1 ? gc[1] : (h == 2 ? gc[2] : gc[3])), fp1 = h == 0 ? gd[0] : (h == 1 ? gd[1] : (h == 2 ? gd[2] : gd[3]));
        const float lf0 = logsigmoidf_(fp0), lf1 = logsigmoidf_(fp1);
        const float incl = wave_scan_add(lf0 + lf1, C.lane), b1 = incl, b0 = incl - lf1;
        const float u0 = ip0 - b0, u1 = ip1 - b1;
        const float pm_incl = wave_scan_max(fmaxf(u0, u1), C.lane); const float pm_prev = __shfl_up(pm_incl, 1);
        const float pm0 = C.lane == 0 ? u0 : fmaxf(pm_prev, u0), pm1 = pm_incl;
        const float mprev = ((const float*)(A.ws + SM_MPREV))[un];
        const float M0 = fmaxf(mprev, pm0), M1 = fmaxf(mprev, pm1);
        uvec[l0] = u0; uvec[l0 + 1] = u1; Mvec[l0] = M0; Mvec[l0 + 1] = M1; wint[l0] = __expf(mprev - M0); wint[l0 + 1] = __expf(mprev - M1); flo[l0] = __expf(-(b0 + M0)); flo[l0 + 1] = __expf(-(b1 + M1));
        const f32x2 np2 = *(const f32x2*)((const float*)(A.ws + SM_NPREV) + (size_t)un * CH + l0); *(LAS unsigned*)(npb + l0) = pk2(np2[0], np2[1]);
    }
    { const bf16* CPT = (const bf16*)(A.ws + WS_CPREVT) + (size_t)un * CH * CH;
        for (int it = C.tid; it < CH * 16; it += NTHREADS) { const int r = it >> 4, c8 = (it & 15) * 8; const size_t rowo = (size_t)(t0 + r) * NPROJ + h * 128 + c8;
            *(LAS v4u*)(QS + r * LDT + c8) = *(const v4u*)(PROJ + rowo + PQ); *(LAS v4u*)(KS + r * LDT + c8) = *(const v4u*)(PROJ + rowo + PK); *(LAS v4u*)(CT + r * LDT + c8) = *(const v4u*)(CPT + (size_t)r * CH + c8); } }
    __syncthreads();
    const int fr = C.lane & 15, fg = C.lane >> 4, w = C.wave;
    bf16x8 aq[4];
#pragma unroll
    for (int ks = 0; ks < 4; ++ks) aq[ks] = *(const LAS bf16x8*)(QS + (16 * w + fr) * LDT + 32 * ks + 8 * fg);
    float Ml[4], wl[4], inv[4];
#pragma unroll
    for (int rg = 0; rg < 4; ++rg) { Ml[rg] = Mvec[16 * w + 4 * fg + rg]; wl[rg] = wint[16 * w + 4 * fg + rg]; }
    {   float rs[4] = {0.f, 0.f, 0.f, 0.f};
#pragma unroll
        for (int st = 0; st < 8; ++st) {
            if (st <= w) { f32x4 acc = {0.f, 0.f, 0.f, 0.f};
#pragma unroll
                for (int ks = 0; ks < 4; ++ks) { const bf16x8 bb = *(const LAS bf16x8*)(KS + (16 * st + fr) * LDT + 32 * ks + 8 * fg); acc = mfma16(aq[ks], bb, acc); }
                const int s = 16 * st + fr; const float us = uvec[s];
#pragma unroll
                for (int rg = 0; rg < 4; ++rg) { const int li = 16 * w + 4 * fg + rg; const float p = (s <= li) ? acc[rg] * 0.08838834764831845f * __expf(us - Ml[rg]) : 0.f; rs[rg] += p; PS[li * LDT + s] = (bf16)f2bf(p); } }
            else if (st == w + 1 && (w & 1) == 0) {
#pragma unroll
                for (int rg = 0; rg < 4; ++rg) PS[(16 * w + 4 * fg + rg) * LDT + 16 * st + fr] = (bf16)0; }
        }
        f32x4 an = {0.f, 0.f, 0.f, 0.f};
#pragma unroll
        for (int ks = 0; ks < 4; ++ks) { bf16x8 bn = *(const LAS bf16x8*)(npb + 32 * ks + 8 * fg); if (fr != 0) bn = (bf16x8){0, 0, 0, 0, 0, 0, 0, 0}; an = mfma16(aq[ks], bn, an); }
#pragma unroll
        for (int rg = 0; rg < 4; ++rg) { const float qn = __shfl(an[rg], 16 * fg); const float dn = red16(rs[rg]) + wl[rg] * qn; inv[rg] = 1.0f / fmaxf(fabsf(dn), flo[16 * w + 4 * fg + rg]); }
    }
    __syncthreads();
    for (int it = C.tid; it < CH * 16; it += NTHREADS) { const int r = it >> 4, c8 = (it & 15) * 8; const v4u vv = *(const v4u*)(PROJ + (size_t)(t0 + r) * NPROJ + h * 128 + c8 + PV); const unsigned vw[4] = {vv.x, vv.y, vv.z, vv.w};
#pragma unroll
        for (int i = 0; i < 8; ++i) KS[(c8 + i) * LDT + r] = (bf16)((i & 1) ? (vw[i >> 1] >> 16) : (vw[i >> 1] & 0xffffu)); }
    __syncthreads();
    {   const int nk2 = (w >> 1) + 1;
        bf16x8 ap[4];
#pragma unroll
        for (int k2 = 0; k2 < 4; ++k2) ap[k2] = (k2 < nk2) ? *(const LAS bf16x8*)(PS + (16 * w + fr) * LDT + 32 * k2 + 8 * fg) : (bf16x8){0, 0, 0, 0, 0, 0, 0, 0};
        float hv[8][4]; float sm[4] = {0.f, 0.f, 0.f, 0.f};
#pragma unroll
        for (int et = 0; et < 8; ++et) { f32x4 a1 = {0.f, 0.f, 0.f, 0.f}, a2 = {0.f, 0.f, 0.f, 0.f};
#pragma unroll
            for (int k2 = 0; k2 < 4; ++k2) if (k2 < nk2) { const bf16x8 bb = *(const LAS bf16x8*)(KS + (16 * et + fr) * LDT + 32 * k2 + 8 * fg); a1 = mfma16(ap[k2], bb, a1); }
#pragma unroll
            for (int ks = 0; ks < 4; ++ks) { const bf16x8 bb = *(const LAS bf16x8*)(CT + (16 * et + fr) * LDT + 32 * ks + 8 * fg); a2 = mfma16(aq[ks], bb, a2); }
#pragma unroll
            for (int rg = 0; rg < 4; ++rg) { hv[et][rg] = (a1[rg] + wl[rg] * a2[rg]) * inv[rg]; sm[rg] += hv[et][rg]; } }
        float mean[4], rstd[4];
#pragma unroll
        for (int rg = 0; rg < 4; ++rg) { mean[rg] = red16(sm[rg]) * (1.0f / 128.0f); float q = 0.f;
#pragma unroll
            for (int et = 0; et < 8; ++et) { const float dlt = hv[et][rg] - mean[rg]; q += dlt * dlt; }
            rstd[rg] = 1.0f / sqrtf(red16(q) * (1.0f / 128.0f) + 1e-6f); }
#pragma unroll
        for (int et = 0; et < 8; ++et) { const int e = 16 * et + fr; const float nw = A.in[3][(size_t)l * 512 + h * 128 + e];
#pragma unroll
            for (int rg = 0; rg < 4; ++rg) { const int li = 16 * w + 4 * fg + rg; const float o = bf2f(PROJ[(size_t)(t0 + li) * NPROJ + PO + h * 128 + e]);
                HCAT[(size_t)(t0 + li) * D + h * 128 + e] = (bf16)f2bf(sigmoidf_(o) * ((hv[et][rg] - mean[rg]) * rstd[rg] * nw)); } }
    }
    __syncthreads();
}
DI void gmlp_unit_mfma(const Args& A, const Ctx& C0, int l, int unit) { const Ctx C = fresh_ctx(C0);
    const bf16* PROJ = (const bf16*)(A.ws + WS_PROJ); bf16* HCAT = (bf16*)(A.ws + WS_HCAT); const bf16* WM = (const bf16*)(A.ws + SM_WM);
    const int ck = unit >> 2, hh = unit & 3, t0 = ck * CH;
    LAS bf16* ZT = (LAS bf16*)C.lds;
    { const f32x4 nw = *(const f32x4*)(A.in[4] + l * 256 + 4 * C.lane), nb = *(const f32x4*)(A.in[5] + l * 256 + 4 * C.lane);
        for (int i = 0; i < 16; ++i) { const int r = C.wave * 16 + i; const v2u g = *(const v2u*)(PROJ + (size_t)(t0 + r) * NPROJ + PGV + 4 * C.lane);
            f32x4 x = {gelu_tanh(bflo(g.x)), gelu_tanh(bfhi(g.x)), gelu_tanh(bflo(g.y)), gelu_tanh(bfhi(g.y))};
            const float mean = wave_sum((x[0] + x[1]) + (x[2] + x[3])) * (1.0f / 256.0f); x = x - mean;
            const float var = wave_sum((x[0] * x[0] + x[1] * x[1]) + (x[2] * x[2] + x[3] * x[3])) * (1.0f / 256.0f);
            const float rstd = 1.0f / sqrtf(var + LN_EPS); x = x * rstd * nw + nb;
            if ((C.lane >> 4) == hh) { const int d0 = 4 * (C.lane & 15);
#pragma unroll
                for (int q = 0; q < 4; ++q) ZT[(d0 + q) * LDT + r] = (bf16)f2bf(x[q]); } } }
    __syncthreads();
    { const int fr = C.lane & 15, fg = C.lane >> 4, w = C.wave, nk = (w >> 1) + 1;
        bf16x8 a[4];
#pragma unroll
        for (int ks = 0; ks < 4; ++ks) a[ks] = (ks < nk) ? *(const bf16x8*)(WM + ((size_t)(hh * CH + 16 * w + fr) * CH + 32 * ks + 8 * fg)) : (bf16x8){0, 0, 0, 0, 0, 0, 0, 0};
#pragma unroll
        for (int dt = 0; dt < 4; ++dt) { f32x4 acc = {0.f, 0.f, 0.f, 0.f};
#pragma unroll
            for (int ks = 0; ks < 4; ++ks) if (ks < nk) { const bf16x8 bb = *(const LAS bf16x8*)(ZT + (16 * dt + fr) * LDT + 32 * ks + 8 * fg); acc = mfma16(a[ks], bb, acc); }
            const int d = 64 * hh + 16 * dt + fr;
#pragma unroll
            for (int rg = 0; rg < 4; ++rg) { const int tr = 16 * w + 4 * fg + rg; const float bsv = A.in[7][(size_t)(l * 4 + hh) * CH + tr]; const float u = bf2f(PROJ[(size_t)(t0 + tr) * NPROJ + PGU + d]);
                HCAT[(size_t)(t0 + tr) * D + 512 + d] = (bf16)f2bf(gelu_tanh(u) * (acc[rg] + bsv)); } } }
    __syncthreads();
}
#if DBG_CHECK
constexpr size_t SM_ERR = WS_CTL + 8192;
DI unsigned hsh(unsigned s, unsigned k) { unsigned h = s * 2654435761u + k * 40503u + 12345u; h ^= h >> 15; h *= 2246822519u; h ^= h >> 13; return h; }
DI void err_put(const Args& A, int chk, float ref, float got, float floor_) {
    float e = fabsf(ref - got) / (fabsf(ref) + floor_); if (!(e == e)) e = 1e9f;
    atomicMax((unsigned*)(A.ws + SM_ERR) + chk, __builtin_bit_cast(unsigned, e));
}
DI void chk_gates(const Args& A, const Ctx& C, int l, const float* X) {
    const int gt = C.bid * NTHREADS + C.tid; if (gt >= 2048) return;
    const int t = hsh(gt, 1) % T, g = hsh(gt, 2) % 8; float s = 0.f;
    for (int k = 0; k < D; ++k) s += X[(size_t)t * D + k] * A.in[1][((size_t)l * D + k) * PIN + 2048 + g];
    s += A.in[2][(size_t)l * PIN + 2048 + g];
    err_put(A, 1, s, ((const float*)(A.ws + SM_GATES))[(size_t)t * 8 + g], 0.1f);
}
DI void chk_proj(const Args& A, const Ctx& C, int l) {
    const int gt = C.bid * NTHREADS + C.tid; if (gt >= 8192) return;
    const int t = (gt < 64) ? (gt * 4099) % T : hsh(gt, 3) % T, n = hsh(gt, 4) % NPROJ, ns = n + (n >= 2048 ? 8 : 0);
    const bf16* XN = (const bf16*)(A.ws + WS_XN); float s = 0.f;
    for (int k = 0; k < D; ++k) s += bf2f(XN[(size_t)t * D + k]) * A.in[1][((size_t)l * D + k) * PIN + ns];
    s += A.in[2][(size_t)l * PIN + ns];
    err_put(A, 2, s, bf2f(((const bf16*)(A.ws + WS_PROJ))[(size_t)t * NPROJ + n]), 0.5f);
}
DI void chk_conv(const Args& A, const Ctx& C, int l) {
    const int gw = C.bid * NWAVES + C.wave; if (gw >= 1024) return;
    const int t = (gw < 128) ? (gw * 129) % T : hsh(gw, 5) % T; const bf16* PROJ = (const bf16*)(A.ws + WS_PROJ);
    float cv[4];
#pragma unroll
    for (int q = 0; q < 4; ++q) { const int c = C.lane * 4 + q; float acc = A.in[9][l * 256 + c];
        for (int j = 0; j < 31; ++j) { const int ts = t - 30 + j; if ((ts >> 12) != (t >> 12) || ts < 0) continue;
            const float a = bf2f(PROJ[(size_t)ts * NPROJ + PCA + c]), b = bf2f(PROJ[(size_t)ts * NPROJ + PCB + c]);
            acc += a / (1.0f + expf(-b)) * A.in[8][(size_t)(l * 31 + j) * 256 + c]; }
        cv[q] = acc; }
    const float mean = wave_sum(cv[0] + cv[1] + cv[2] + cv[3]) / 256.0f; float q2 = 0.f;
#pragma unroll
    for (int q = 0; q < 4; ++q) { cv[q] -= mean; q2 += cv[q] * cv[q]; }
    const float rstd = 1.0f / sqrtf(wave_sum(q2) / 256.0f + LN_EPS);
#pragma unroll
    for (int q = 0; q < 4; ++q) { const int c = C.lane * 4 + q; const float y = cv[q] * rstd * A.in[10][l * 256 + c] + A.in[11][l * 256 + c]; const float r = y / (1.0f + expf(-y));
        err_put(A, 3, r, bf2f(((const bf16*)(A.ws + WS_HCAT))[(size_t)t * D + 768 + c]), 0.5f); }
}
DI void chk_gmlp(const Args& A, const Ctx& C, int l) {
    const int gw = C.bid * NWAVES + C.wave; if (gw >= 512) return;
    const int t = (gw < 64) ? (gw * 131 + 127) % T : hsh(gw, 6) % T; const bf16* PROJ = (const bf16*)(A.ws + WS_PROJ);
    const int tc = t & 127, t0 = t - tc, h = C.lane >> 4; float acc[4] = {0.f, 0.f, 0.f, 0.f};
    for (int s = 0; s <= tc; ++s) { float x[4];
#pragma unroll
        for (int q = 0; q < 4; ++q) { const float v = bf2f(PROJ[(size_t)(t0 + s) * NPROJ + PGV + C.lane * 4 + q]); x[q] = 0.5f * v * (1.0f + tanhf(0.7978845608028654f * (v + 0.044715f * v * v * v))); }
        const float mean = wave_sum(x[0] + x[1] + x[2] + x[3]) / 256.0f; float q2 = 0.f;
#pragma unroll
        for (int q = 0; q < 4; ++q) { x[q] -= mean; q2 += x[q] * x[q]; }
        const float rstd = 1.0f / sqrtf(wave_sum(q2) / 256.0f + LN_EPS); const float w = A.in[6][((size_t)(l * 4 + h) * CH + tc) * CH + s];
#pragma unroll
        for (int q = 0; q < 4; ++q) { const int c = C.lane * 4 + q; acc[q] += w * (x[q] * rstd * A.in[4][l * 256 + c] + A.in[5][l * 256 + c]); } }
#pragma unroll
    for (int q = 0; q < 4; ++q) { const int c = C.lane * 4 + q; const float v = bf2f(PROJ[(size_t)t * NPROJ + PGU + c]); const float u = 0.5f * v * (1.0f + tanhf(0.7978845608028654f * (v + 0.044715f * v * v * v)));
        const float r = u * (acc[q] + A.in[7][(size_t)(l * 4 + h) * CH + tc]);
        err_put(A, 4, r, bf2f(((const bf16*)(A.ws + WS_HCAT))[(size_t)t * D + 512 + c]), 0.5f); }
}
DI void chk_mlstm(const Args& A, const Ctx& C, int l) {
    const int gw = C.bid * NWAVES + C.wave; if (gw >= 1024) return;
    const int t = (gw < 64) ? (gw * 521 + (gw & 1) * 127) % T : hsh(gw, 7) % T, h = hsh(gw, 8) & 3; const bf16* PROJ = (const bf16*)(A.ws + WS_PROJ); const float* GATES = (const float*)(A.ws + SM_GATES);
    const int tb = t & ~(SEQ - 1); const int d0 = 2 * C.lane;
    const float q0 = bf2f(PROJ[(size_t)t * NPROJ + PQ + h * 128 + d0]), q1 = bf2f(PROJ[(size_t)t * NPROJ + PQ + h * 128 + d0 + 1]);
    float n0 = 0.f, n1 = 0.f, den = 0.f, F = 0.f;
    for (int s = t; s >= tb; --s) {
        const float k0 = bf2f(PROJ[(size_t)s * NPROJ + PK + h * 128 + d0]), k1 = bf2f(PROJ[(size_t)s * NPROJ + PK + h * 128 + d0 + 1]);
        const float qk = wave_sum(q0 * k0 + q1 * k1) * 0.08838834764831845f;
        const float w = expf(F + GATES[(size_t)s * 8 + h]) * qk;
        n0 += w * bf2f(PROJ[(size_t)s * NPROJ + PV + h * 128 + d0]); n1 += w * bf2f(PROJ[(size_t)s * NPROJ + PV + h * 128 + d0 + 1]); den += w;
        const float fp = GATES[(size_t)s * 8 + 4 + h]; F += fminf(fp, 0.f) - log1pf(expf(-fabsf(fp)));
        if (F < -60.f) break; }
    const float inv = 1.0f / fmaxf(fabsf(den), 1.0f); float x0 = n0 * inv, x1 = n1 * inv;
    const float mean = wave_sum(x0 + x1) / 128.0f; x0 -= mean; x1 -= mean; const float rstd = 1.0f / sqrtf(wave_sum(x0 * x0 + x1 * x1) / 128.0f + 1e-6f);
    const float o0 = bf2f(PROJ[(size_t)t * NPROJ + PO + h * 128 + d0]), o1 = bf2f(PROJ[(size_t)t * NPROJ + PO + h * 128 + d0 + 1]);
    const float r0 = x0 * rstd * A.in[3][(size_t)l * 512 + h * 128 + d0] / (1.0f + expf(-o0)), r1 = x1 * rstd * A.in[3][(size_t)l * 512 + h * 128 + d0 + 1] / (1.0f + expf(-o1));
    const bf16* HC = (const bf16*)(A.ws + WS_HCAT);
    err_put(A, 5, r0, bf2f(HC[(size_t)t * D + h * 128 + d0]), 0.5f); err_put(A, 5, r1, bf2f(HC[(size_t)t * D + h * 128 + d0 + 1]), 0.5f);
}
DI void chk_y(const Args& A, const Ctx& C, int l) {
    const int gt = C.bid * NTHREADS + C.tid; if (gt >= 8192) return;
    const int t = hsh(gt, 9) % T, n = hsh(gt, 10) % D; const bf16* HC = (const bf16*)(A.ws + WS_HCAT); float s = 0.f;
    for (int k = 0; k < D; ++k) s += bf2f(HC[(size_t)t * D + k]) * A.in[12][((size_t)l * D + k) * D + n];
    err_put(A, 6, s, bf2f(((const bf16*)(A.ws + WS_PROJ))[(size_t)t * D + n]), 0.2f);
}
DI void chk_ln1(const Args& A, const Ctx& C, int l, const bf16* X) {
    const int gw = C.bid * NWAVES + C.wave; if (gw >= 2048) return;
    const int t = hsh(gw, 11) % T; const bf16* Y = (const bf16*)(A.ws + WS_PROJ); const bf16* X1 = (const bf16*)(A.ws + WS_XNB);
    float v[16]; float s = 0.f;
#pragma unroll
    for (int i = 0; i < 16; ++i) { const int c = C.lane + 64 * i; v[i] = ALPHA * bf2f(X[(size_t)t * D + c]) + bf2f(Y[(size_t)t * D + c]); s += v[i]; }
    const float mean = wave_sum(s) / D; float q2 = 0.f;
#pragma unroll
    for (int i = 0; i < 16; ++i) { v[i] -= mean; q2 += v[i] * v[i]; }
    const float rstd = 1.0f / sqrtf(wave_sum(q2) / D + LN_EPS);
#pragma unroll
    for (int i = 0; i < 16; ++i) { const int c = C.lane + 64 * i; v[i] = v[i] * rstd * A.in[13][(size_t)l * D + c] + A.in[14][(size_t)l * D + c]; }
    err_put(A, 7, v[3], bf2f(X1[(size_t)t * D + C.lane + 192]), 1.0f);
    float sel[16], sg[16];
#pragma unroll
    for (int e = 0; e < 16; ++e) { float p = 0.f;
#pragma unroll
        for (int i = 0; i < 16; ++i) p += v[i] * A.in[15][(size_t)(C.lane + 64 * i) * 16 + e];
        p = wave_sum(p); sg[e] = 1.0f / (1.0f + expf(-p)); sel[e] = sg[e] + A.in[16][e]; }
    float bestg = -INFINITY; int bg = 0;
#pragma unroll
    for (int g = 0; g < 4; ++g) { float a = sel[4 * g], b = sel[4 * g + 1], c = sel[4 * g + 2], d = sel[4 * g + 3];
        float m1 = fmaxf(fmaxf(a, b), fmaxf(c, d)); float tot = a + b + c + d; float mn = fminf(fminf(a, b), fminf(c, d));
        float lo1 = fminf(a, b), hi1 = fmaxf(a, b), lo2 = fminf(c, d), hi2 = fmaxf(c, d); float second = fmaxf(fminf(hi1, hi2), fmaxf(lo1, lo2)); (void)tot; (void)mn;
        const float gs = m1 + second; if (gs > bestg) { bestg = gs; bg = g; } }
    int e0 = -1, e1 = -1; float m1 = -INFINITY, m2 = -INFINITY;
#pragma unroll
    for (int e = 0; e < 16; ++e) if ((e >> 2) == bg && sel[e] > m1) { m1 = sel[e]; e0 = e; }
#pragma unroll
    for (int e = 0; e < 16; ++e) if ((e >> 2) == bg && e != e0 && sel[e] > m2) { m2 = sel[e]; e1 = e; }
    const v4u got = ((const v4u*)(A.ws + SM_SEL))[t];
    if (C.lane == 0 && ((int)got.x != e0 || (int)got.y != e1)) atomicAdd((unsigned*)(A.ws + SM_ERR) + 8, 1u);
}
DI void chk_hid(const Args& A, const Ctx& C, int l) {
    const int gt = C.bid * NTHREADS + C.tid; if (gt >= 8192) return;
    const int t = hsh(gt, 12) % T, k = hsh(gt, 13) & 1, j = hsh(gt, 14) % DEXP; const v4u s = ((const v4u*)(A.ws + SM_SEL))[t]; const int e = k ? (int)s.y : (int)s.x; const int p = ((const int*)(A.ws + SM_TOKSLOT))[2 * t + k];
    const bf16* XN = (const bf16*)(A.ws + WS_XNB); float g = 0.f, u = 0.f;
    for (int c = 0; c < D; ++c) { const float x = bf2f(XN[(size_t)t * D + c]); g += x * A.in[17][((size_t)(l * NEXP + e) * D + c) * DEXP + j]; u += x * A.in[18][((size_t)(l * NEXP + e) * D + c) * DEXP + j]; }
    err_put(A, 9, g / (1.0f + expf(-g)) * u, bf2f(((const bf16*)(A.ws + WS_HID))[(size_t)p * DEXP + j]), 0.5f);
    if (p < 0 || p >= PADROWS) atomicAdd((unsigned*)(A.ws + SM_ERR) + 11, 1u);
}
DI void chk_yp(const Args& A, const Ctx& C, int l) {
    const int gt = C.bid * NTHREADS + C.tid; if (gt >= 8192) return;
    const int t = hsh(gt, 15) % T, k = hsh(gt, 16) & 1, n = hsh(gt, 17) % D; const v4u s = ((const v4u*)(A.ws + SM_SEL))[t]; const int e = k ? (int)s.y : (int)s.x; const int p = ((const int*)(A.ws + SM_TOKSLOT))[2 * t + k];
    const bf16* HID = (const bf16*)(A.ws + WS_HID); float y = 0.f;
    for (int j = 0; j < DEXP; ++j) y += bf2f(HID[(size_t)p * DEXP + j]) * A.in[19][((size_t)(l * NEXP + e) * DEXP + j) * D + n];
    err_put(A, 10, y, bf2f(((const bf16*)(A.ws + WS_PROJ))[(size_t)p * D + n]), 0.2f);
}
DI void chk_out(const Args& A, const Ctx& C, int l) {
    const int gw = C.bid * NWAVES + C.wave; if (gw >= 2048) return;
    const int t = hsh(gw, 18) % T; const bf16* X1 = (const bf16*)(A.ws + WS_XNB); const bf16* YP = (const bf16*)(A.ws + WS_PROJ);
    const v4u s = ((const v4u*)(A.ws + SM_SEL))[t]; const int p0 = ((const int*)(A.ws + SM_TOKSLOT))[2 * t], p1 = ((const int*)(A.ws + SM_TOKSLOT))[2 * t + 1];
    const f32x2 gw2 = ((const f32x2*)(A.ws + SM_GW))[t]; const float g0 = gw2[0], g1 = gw2[1];
    float v[16]; float sm = 0.f;
#pragma unroll
    for (int i = 0; i < 16; ++i) { const int c = C.lane + 64 * i; v[i] = ALPHA * bf2f(X1[(size_t)t * D + c]) + g0 * bf2f(YP[(size_t)p0 * D + c]) + g1 * bf2f(YP[(size_t)p1 * D + c]); sm += v[i]; }
    { float sy = 0.f, sx = 0.f;
#pragma unroll
      for (int i = 0; i < 16; ++i) { const int c = C.lane + 64 * i; const float yy = g0 * bf2f(YP[(size_t)p0 * D + c]) + g1 * bf2f(YP[(size_t)p1 * D + c]); const float xx = ALPHA * bf2f(X1[(size_t)t * D + c]); sy += yy * yy; sx += xx * xx; }
      sy = wave_sum(sy); sx = wave_sum(sx); const float ratio = sqrtf(sy / sx);
      if (C.lane == 0) atomicMax((unsigned*)(A.ws + SM_ERR) + 20, __builtin_bit_cast(unsigned, ratio));
      float sxn = 0.f, shid = 0.f, syp = 0.f; const bf16* XNb = (const bf16*)(A.ws + WS_XN); const bf16* HIDb = (const bf16*)(A.ws + WS_HID);
#pragma unroll
      for (int i = 0; i < 16; ++i) { const int c = C.lane + 64 * i; const float a = bf2f(YP[(size_t)p0 * D + c]); syp += a * a; }
#pragma unroll
      for (int i = 0; i < 8; ++i) { const int c = C.lane + 64 * i; const float a = bf2f(HIDb[(size_t)p0 * DEXP + c]); shid += a * a; }
      syp = sqrtf(wave_sum(syp) / D); shid = sqrtf(wave_sum(shid) / DEXP);
      if (C.lane == 0) { atomicMax((unsigned*)(A.ws + SM_ERR) + 21, __builtin_bit_cast(unsigned, syp)); atomicMax((unsigned*)(A.ws + SM_ERR) + 22, __builtin_bit_cast(unsigned, shid)); atomicMax((unsigned*)(A.ws + SM_ERR) + 23, __builtin_bit_cast(unsigned, g0 + g1)); atomicMax((unsigned*)(A.ws + SM_ERR) + 24, s.z); atomicMax((unsigned*)(A.ws + SM_ERR) + 25, s.w); atomicMax((unsigned*)(A.ws + SM_ERR) + 26, s.x); } }
    const float mean = wave_sum(sm) / D; float q2 = 0.f;
#pragma unroll
    for (int i = 0; i < 16; ++i) { v[i] -= mean; q2 += v[i] * v[i]; }
    const float rstd = 1.0f / sqrtf(wave_sum(q2) / D + LN_EPS);
    const int c = C.lane + 64 * 5; const float r = v[5] * rstd * A.in[20][(size_t)l * D + c] + A.in[21][(size_t)l * D + c];
    err_put(A, 12, r, (l == NLAYER - 1) ? A.out[(size_t)t * D + c] : bf2f(((const bf16*)(A.ws + WS_XN))[(size_t)t * D + c]), 1.0f);
}
DI void probe_gates(const Args& A, const Ctx& C, int slot) {
    const int gt = C.bid * NTHREADS + C.tid; if (gt >= 4096) return;
    const int t = hsh(gt, 30) % T; const v4u s = ((const v4u*)(A.ws + SM_SEL))[t];
    const f32x2 gw2 = ((const f32x2*)(A.ws + SM_GW))[t];
    atomicMax((unsigned*)(A.ws + SM_ERR) + slot, __builtin_bit_cast(unsigned, gw2[0] + gw2[1]));
    { const float sm = gw2[0] + gw2[1]; if (!(fabsf(sm - 1.0f) < 1e-3f)) atomicAdd((unsigned*)(A.ws + SM_ERR) + slot + 8, 1u); }
}
DI void dbg_finish(const Args& A, const Ctx& C) {
    const unsigned* E = (const unsigned*)(A.ws + SM_ERR);
    const float tol[13] = {0, 1e-3f, 0.03f, 0.04f, 0.04f, 0.08f, 0.03f, 0.01f, 0, 0.04f, 0.04f, 0, 0.01f};
    int code = 0;
#pragma unroll
    for (int k = 12; k >= 1; --k) { bool bad;
        if (k == 8) bad = E[8] > 20u; else if (k == 11) bad = E[11] > 0u; else bad = __builtin_bit_cast(float, E[k]) > tol[k];
        if (bad) code = k; }
    const float cv = (float)(code + DBG_BIAS);
    for (size_t i = (size_t)C.bid * NTHREADS + C.tid; i < (size_t)T * D; i += (size_t)GRID * NTHREADS) A.out[i] = cv;
}
#endif
__global__ void __launch_bounds__(NTHREADS, 2) fwd_kernel(Args A0) {
    extern __shared__ __attribute__((aligned(16))) unsigned char lds_raw[];
    Ctx CK; CK.lds = (LAS unsigned char*)lds_raw; CK.tid = threadIdx.x; CK.lane = CK.tid & 63; CK.wave = __builtin_amdgcn_readfirstlane(CK.tid >> 6); CK.bid = blockIdx.x;
    for (int u = CK.tid; u < (LDS_BYTES - LDSCTL_OFF) / 4; u += NTHREADS) ((LAS unsigned*)(CK.lds + LDSCTL_OFF))[u] = 0u;
    __syncthreads();
    unsigned* ctl = (unsigned*)(A0.ws + WS_CTL);
    XcdBarrier bar = xcd_barrier_post(ctl + CW_BAR, (volatile LAS unsigned*)(CK.lds + MISC_OFF) + 8);
#define GRID_BAR() xcd_barrier<false>(bar)
#if DBG_TIME
#define TS(k) do { if (l == TIME_LAYER && CK.bid == 0 && CK.tid == 0) ((unsigned long long*)(A0.ws + WS_CTL + 12288))[k] = __builtin_amdgcn_s_memrealtime(); } while (0)
#else
#define TS(k) do { } while (0)
#endif
#define FRESH() Args A; { int z_ = 0; asm volatile("" : "+s"(z_)); _Pragma("unroll") for (int k_ = 0; k_ < 22; ++k_) A.in[k_] = A0.in[k_] + z_; A.out = A0.out + z_; A.ws = A0.ws + z_; } const Ctx C = fresh_ctx(CK)
    { FRESH(); phase_prologue_rows(A, C); }
    xcd_barrier<true>(bar);
#if DBG_CHECK
    if (DBG_LAYER == 0) { FRESH(); chk_gates(A, C, 0, A.in[0]); }
#endif
    for (int l = 0; l < NLAYER_RUN; ++l) {
        TS(0);
        { FRESH(); phase_convert(A, C, l); }
        GRID_BAR(); TS(1);
#if DUP_THIN
        { FRESH(); phase_convert(A, C, l); }
        GRID_BAR(); TS(1);
#endif

        {
            FRESH(); pg8::Gemm g{(const pg8::bf16_t*)(A.ws + WS_XN), (const pg8::bf16_t*)(A.ws + WS_WIN), T, NPROJ, D}; pg8::StaticOrder S; S.init(T, NPROJ, GRID, C.bid);
            pg8::EpiStoreBf16 E{(pg8::bf16_t*)(A.ws + WS_PROJ), NPROJ, (const float*)(A.ws + SM_BIAS), 0xffff};
            pg8::gemm_phase<pg8::EpiStoreBf16, pg8::StaticOrder, true, true>(C.lds, g, S, E);
        }
        GRID_BAR(); TS(2);
#if DBG_CHECK
        if (l == DBG_LAYER) { FRESH(); chk_proj(A, C, l); }
#endif
        { FRESH(); for (int un = C.bid; un < NUNIT; un += GRID) mlstm_local_mfma(A, C, un); } TS(3);
        { FRESH(); for (int gu = C.bid; gu < 512; gu += GRID) gmlp_unit_mfma(A, C, l, gu); } TS(4);
        { FRESH(); for (int cu = C.bid; cu < T / 32; cu += GRID) conv_unit(A, C, l, cu); }
        GRID_BAR(); TS(5);
#if DUP_MIX
        { FRESH(); for (int un = C.bid; un < NUNIT; un += GRID) mlstm_local_mfma(A, C, un); } TS(3);
        { FRESH(); for (int gu = C.bid; gu < 512; gu += GRID) gmlp_unit_mfma(A, C, l, gu); } TS(4);
        { FRESH(); for (int cu = C.bid; cu < T / 32; cu += GRID) conv_unit(A, C, l, cu); }
        GRID_BAR(); TS(5);
#endif

        { FRESH(); phase_scan(A, C); }
        GRID_BAR(); TS(6);
#if DUP_THIN
        { FRESH(); phase_scan(A, C); }
        GRID_BAR(); TS(6);
#endif

        { FRESH(); for (int un = C.bid; un < NUNIT; un += GRID) mlstm_out_mfma(A, C, l, un); }
        GRID_BAR(); TS(7);
#if DUP_MIX
        { FRESH(); for (int un = C.bid; un < NUNIT; un += GRID) mlstm_out_mfma(A, C, l, un); }
        GRID_BAR(); TS(7);
#endif

#if DBG_CHECK
        if (l == DBG_LAYER) { FRESH(); chk_conv(A, C, l); chk_gmlp(A, C, l); chk_mlstm(A, C, l); GRID_BAR(); }
#endif
        {
            FRESH(); pg8::Gemm g{(const pg8::bf16_t*)(A.ws + WS_HCAT), (const pg8::bf16_t*)(A.ws + WS_WOUT), T, D, D}; pg8::StaticOrder S; S.init(T, D, GRID, C.bid);
            pg8::EpiStoreBf16 E{(pg8::bf16_t*)(A.ws + WS_PROJ), D, nullptr, 0xffff};
            pg8::gemm_phase<pg8::EpiStoreBf16, pg8::StaticOrder, true, true>(C.lds, g, S, E);
        }
        GRID_BAR(); TS(8);
#if DBG_CHECK
        if (l == DBG_LAYER) { FRESH(); chk_y(A, C, l); GRID_BAR(); }
#endif
        { FRESH(); phase_ln1_router(A, C, l); }
        GRID_BAR(); TS(9);
#if DUP_THIN
        { FRESH(); phase_ln1_router(A, C, l); }
        GRID_BAR(); TS(9);
#endif

#if DBG_CHECK
        if (l == DBG_LAYER) { FRESH(); chk_ln1(A, C, l, (const bf16*)(A.ws + WS_XN)); probe_gates(A, C, 27); GRID_BAR(); }
#endif
        { FRESH(); phase_scatter(A, C); }
        GRID_BAR(); TS(10);
#if DUP_THIN
        { FRESH(); phase_scatter(A, C); }
        GRID_BAR(); TS(10);
#endif

#if DBG_CHECK
        if (l == DBG_LAYER) { FRESH(); probe_gates(A, C, 28); }
#endif
        {
            FRESH(); pg8::ListOrder S; make_list(A, C, S);
            pg8::Gemm g{(const pg8::bf16_t*)(A.ws + WS_PROJ), (const pg8::bf16_t*)(A.ws + WS_WGU), PADROWS, NEXP * 1024, D};
            pg8::EpiSwiGLU E{(pg8::bf16_t*)(A.ws + WS_HID), DEXP};
            pg8::gemm_phase<pg8::EpiSwiGLU, pg8::ListOrder, true, true>(C.lds, g, S, E);
        }
        GRID_BAR(); TS(11);
#if DBG_CHECK
        if (l == DBG_LAYER) { FRESH(); chk_hid(A, C, l); probe_gates(A, C, 29); }
#endif
        {
            FRESH(); pg8::ListOrder S; make_list(A, C, S);
            pg8::Gemm g{(const pg8::bf16_t*)(A.ws + WS_HID), (const pg8::bf16_t*)(A.ws + WS_WD), PADROWS, NEXP * 1024, DEXP};
            pg8::EpiStoreBf16 E{(pg8::bf16_t*)(A.ws + WS_PROJ), D, nullptr, 3};
            pg8::gemm_phase<pg8::EpiStoreBf16, pg8::ListOrder, true, true>(C.lds, g, S, E);
        }
        GRID_BAR(); TS(12);
#if DBG_CHECK
        if (l == DBG_LAYER) { FRESH(); chk_yp(A, C, l); probe_gates(A, C, 30); }
#endif
        { FRESH(); phase_combine(A, C, l); }
        GRID_BAR(); TS(13);
#if DUP_THIN
        { FRESH(); phase_combine(A, C, l); }
        GRID_BAR(); TS(13);
#endif

#if DBG_CHECK
        if (l == DBG_LAYER) { FRESH(); chk_out(A, C, l);  GRID_BAR(); }
#endif
    }
#if DBG_CHECK
    { FRESH(); dbg_finish(A, C); }
#endif
#if DBG_TIME
    { FRESH(); const unsigned long long* tsb = (const unsigned long long*)(A.ws + WS_CTL + 12288);
      const float c1 = floorf((float)(tsb[TIME_A] - tsb[TIME_A - 1]) / 200.0f + 0.5f), k2 = floorf((float)(tsb[TIME_B] - tsb[TIME_B - 1]) / 400.0f + 0.5f);
      for (size_t i = (size_t)C.bid * NTHREADS + C.tid; i < (size_t)T * D; i += (size_t)GRID * NTHREADS) A.out[i] = (i == 0) ? (1000.0f + 100.0f * k2) : c1; }
#endif
}

extern "C" void kernel_launch(void* const* d_in, const int* in_sizes, int n_in, void* d_out, int out_size, void* d_ws, size_t ws_size, hipStream_t stream) {
    static int ready = 0;
    if (ready == 0) {
        if (n_in != 22 || in_sizes[0] != T * D || out_size != T * D || ws_size < WS_END) { fprintf(stderr, "kernel_launch: unexpected shapes (n_in %d, in0 %d, out %d, ws %zu)\n", n_in, n_in > 0 ? in_sizes[0] : -1, out_size, ws_size); ready = -1; return; }
        if (hipFuncSetAttribute((const void*)fwd_kernel, hipFuncAttributeMaxDynamicSharedMemorySize, LDS_BYTES) != hipSuccess) { fprintf(stderr, "kernel_launch: hipFuncSetAttribute failed\n"); ready = -1; return; }
        (void)hipGetLastError();
        ready = 1;
    }
    if (ready < 0) return;
    if (hipMemsetAsync((char*)d_ws + WS_CTL, 0, CTL_ZERO_BYTES, stream) != hipSuccess) return;
    Args a{};
    for (int i = 0; i < 22; ++i) a.in[i] = (const float*)d_in[i];
    a.out = (float*)d_out; a.ws = (unsigned char*)d_ws;
    hipLaunchKernelGGL(fwd_kernel, dim3(GRID), dim3(NTHREADS), LDS_BYTES, stream, a);
}
```

```cpp
#include <hip/hip_runtime.h>
#include <cstdio>
#include <cstdint>
namespace pg8 {
#define PG8_LAS __attribute__((address_space(3)))
typedef unsigned short bf16_t;
typedef short bf16x8 __attribute__((ext_vector_type(8)));
typedef float f32x4 __attribute__((ext_vector_type(4)));
typedef unsigned u32x4 __attribute__((ext_vector_type(4)));
constexpr int BM = 256, BK = 64, HALF = 128, HTB = HALF * BK * 2  , STAGE_BYTES = 8 * HTB, NXCD = 8, WGM = 8;

__host__ __device__ __forceinline__ int lds_byte(int r, int c) { const int st = (r >> 4) * 2 + (c >> 5), rr = r & 15, cc = c & 31, ob = rr * 64 + cc * 2; return st * 1024 + (ob ^ (((ob >> 9) & 1) << 5)); }
__host__ __device__ __forceinline__ void stage_rc(int b, int& R, int& C) { const int st = b / 1024, sb = b % 1024, swz = sb ^ (((sb >> 9) & 1) << 5); R = (st >> 1) * 16 + swz / 64; C = (st & 1) * 32 + (swz % 64) / 2; }
__host__ __device__ __forceinline__ int perm32(int rho) { const int n = rho >> 4, i = rho & 15; return 8 * (i >> 2) + 4 * n + (i & 3); }

struct Unit { int pm, pn, e, r0, cnt; };
struct Gemm { const bf16_t* A; const bf16_t* Bt; int M, N, K; };

struct StaticOrder {
    static constexpr bool GATHER = false;
    int nM, nN, nwg, G, c;
    __device__ __forceinline__ unsigned a_off(const Unit&, int) const { return 0u; }
    __host__ __device__ void init(int M, int N, int G_, int c_) { nM = M / BM; nN = N / BM; nwg = nM * nN; G = G_; c = c_; }
    __host__ __device__ bool next(int i, Unit& u) const {
        const long L = (long)i * G + c; if (L >= nwg) return false;
        int wgid = (int)L; { const int q = nwg / NXCD, r = nwg % NXCD, xcd = wgid % NXCD, off = wgid / NXCD; wgid = (xcd < r ? xcd * (q + 1) : r * (q + 1) + (xcd - r) * q) + off; }
        const int nig = WGM * nN, gid = wgid / nig, fm = gid * WGM, gsz = (nM - fm) < WGM ? (nM - fm) : WGM;
        u.pm = fm + ((wgid % nig) % gsz); u.pn = (wgid % nig) / gsz; return true;
    }
    __device__ __forceinline__ void a_ready(const Unit&) const {}
    __device__ __forceinline__ void done(const Unit&) const {}
};
template <bool GATH> struct MoeOrder {
    static constexpr bool GATHER = GATH;
    const unsigned* cnt; const int* list; int G, c, rowbytes;
    __device__ __forceinline__ bool next(int i, Unit& u) const {
        const int L = i * G + c, rt = L >> 2; int acc = 0; bool found = false; u.pm = rt; u.pn = 0; u.e = 0; u.r0 = 0; u.cnt = 0;
#pragma unroll
        for (int e = 0; e < 16; ++e) { const int n = (int)__builtin_amdgcn_readfirstlane(__hip_atomic_load(cnt + 16 * e, __ATOMIC_RELAXED, __HIP_MEMORY_SCOPE_AGENT)); const int nt = (n + 255) >> 8;
            if (!found && rt < acc + nt) { found = true; u.e = e; u.r0 = (rt - acc) * 256; u.cnt = n; u.pn = e * 4 + (L & 3); }
            acc += nt; }
        return found;
    }
    __device__ __forceinline__ unsigned a_off(const Unit& u, int row) const { const int pos = u.r0 + row; const int tok = pos < u.cnt ? list[(size_t)u.e * 16384 + pos] : 0; return (unsigned)tok * (unsigned)rowbytes; }
    __device__ __forceinline__ void a_ready(const Unit&) const {}
    __device__ __forceinline__ void done(const Unit&) const {}
};

__device__ __forceinline__ unsigned cvt_pk_bf16(float lo, float hi) { unsigned r; asm volatile("v_cvt_pk_bf16_f32 %0, %1, %2" : "=v"(r) : "v"(lo), "v"(hi)); return r; }

struct EpiStoreBf16 {
    static constexpr bool PERM = true, AFTER_DRAIN = false;
    bf16_t* O; int ldc; const float* bias; int pn_mask;
    __device__ __forceinline__ void operator()(const f32x4 (&acc)[2][2][4][2], const Unit& u, int wr, int wc, int fr, int fq) const {
        const int row0 = u.pm * BM + wr * 64 + fr; const int col0 = (u.pn & pn_mask) * BM + wc * 32 + 8 * fq;
        f32x4 bv[2][2];
#pragma unroll
        for (int bj = 0; bj < 2; ++bj)
#pragma unroll
            for (int n = 0; n < 2; ++n) bv[bj][n] = bias ? *(const f32x4*)(bias + col0 + bj * HALF + 4 * n) : (f32x4){0.f, 0.f, 0.f, 0.f};
#pragma unroll
        for (int ai = 0; ai < 2; ++ai)
#pragma unroll
            for (int m = 0; m < 4; ++m) { bf16_t* rowp = O + (size_t)(row0 + ai * HALF + m * 16) * ldc + col0;
#pragma unroll
                for (int bj = 0; bj < 2; ++bj) { const f32x4 v0 = acc[ai][bj][m][0] + bv[bj][0], v1 = acc[ai][bj][m][1] + bv[bj][1];
                    u32x4 w; w.x = cvt_pk_bf16(v0[0], v0[1]); w.y = cvt_pk_bf16(v0[2], v0[3]); w.z = cvt_pk_bf16(v1[0], v1[1]); w.w = cvt_pk_bf16(v1[2], v1[3]);
                    *(u32x4*)(rowp + bj * HALF) = w; } }
    }
};
struct EpiSwiGLU {
    static constexpr bool PERM = true, AFTER_DRAIN = false;
    bf16_t* O; int ldc;
    __device__ __forceinline__ void operator()(const f32x4 (&acc)[2][2][4][2], const Unit& u, int wr, int wc, int fr, int fq) const {
        const int row0 = u.pm * BM + wr * 64 + fr; const int col0 = (u.pn & 3) * HALF + wc * 32 + 8 * fq;
#pragma unroll
        for (int ai = 0; ai < 2; ++ai)
#pragma unroll
            for (int m = 0; m < 4; ++m) { bf16_t* rowp = O + (size_t)(row0 + ai * HALF + m * 16) * ldc + col0;
                float h[8];
#pragma unroll
                for (int n = 0; n < 2; ++n)
#pragma unroll
                    for (int k = 0; k < 4; ++k) { const float g = acc[ai][0][m][n][k], up = acc[ai][1][m][n][k]; h[4 * n + k] = g * up / (1.0f + __expf(-g)); }
                u32x4 w; w.x = cvt_pk_bf16(h[0], h[1]); w.y = cvt_pk_bf16(h[2], h[3]); w.z = cvt_pk_bf16(h[4], h[5]); w.w = cvt_pk_bf16(h[6], h[7]);
                *(u32x4*)rowp = w; }
    }
};
template <class Epi, class Sched, bool ALIGN_EPI = false, bool SP2 = false>
__device__ __forceinline__ void gemm_phase(PG8_LAS unsigned char* lds, const Gemm g, const Sched& S, const Epi& E) {
    int tid_l = threadIdx.x; asm volatile("" : "+v"(tid_l)); const int tid = tid_l, wid = __builtin_amdgcn_readfirstlane(tid >> 6), lane = tid & 63, wr = wid >> 2, wc = wid & 3, fr = lane & 15, fq = lane >> 4;
    const int K = g.K, nt = K / BK;
    unsigned voffA[2], voffB[2];
#pragma unroll
    for (int i = 0; i < 2; ++i) { int R, C; stage_rc(tid * 16 + i * 8192, R, C); const int Rb = Epi::PERM ? ((R & ~31) + perm32(R & 31)) : R;
        voffA[i] = (unsigned)(R * K + C) * 2u; voffB[i] = (unsigned)(Rb * K + C) * 2u; }
    unsigned cv0[2] = {voffA[0], voffA[1]}, cv1[2] = {voffA[0], voffA[1]};
#define PG8_GOFF(u, d0, d1) do { _Pragma("unroll") for (int _i = 0; _i < 2; ++_i) { int R_, C_; stage_rc(tid * 16 + _i * 8192, R_, C_); d0[_i] = S.a_off(u, R_) + (unsigned)(C_ * 2); d1[_i] = S.a_off(u, HALF + R_) + (unsigned)(C_ * 2); } } while (0)
    const size_t kstep = (size_t)(BK * 2);
    const size_t hstep = (size_t)HALF * K * 2;
    const size_t tstep = 2 * hstep;
    const unsigned ldsw = (unsigned)wid * 1024u;
    const int aoff = lds_byte(wr * 64 + fr, fq * 8), boff = lds_byte(wc * 32 + fr, fq * 8);
#define PG8_SA(b, h) (((b) * 2 + (h)) * HTB)
#define PG8_SB(b, h) ((4 + (b) * 2 + (h)) * HTB)
#define PG8_STAGE(bufoff, gbase, voff) do { _Pragma("unroll") for (int _i = 0; _i < 2; ++_i) \
        __builtin_amdgcn_global_load_lds((const unsigned*)((const char*)(gbase) + (voff)[_i]), (PG8_LAS unsigned*)(lds + (bufoff) + ldsw + _i * 8192), 16, 0, 0); } while (0)
#define PG8_LDA(dst, b, h) do { _Pragma("unroll") for (int m = 0; m < 4; ++m) _Pragma("unroll") for (int k = 0; k < 2; ++k) dst[m][k] = *(const PG8_LAS bf16x8*)(lds + PG8_SA(b, h) + aoff + m * 2048 + k * 1024); } while (0)
#define PG8_LDB(dst, b, h) do { _Pragma("unroll") for (int n = 0; n < 2; ++n) _Pragma("unroll") for (int k = 0; k < 2; ++k) dst[n][k] = *(const PG8_LAS bf16x8*)(lds + PG8_SB(b, h) + boff + n * 2048 + k * 1024); } while (0)
#define PG8_MMA(ai, bj, At, Bt) do { __builtin_amdgcn_s_setprio(1); _Pragma("unroll") for (int m = 0; m < 4; ++m) _Pragma("unroll") for (int n = 0; n < 2; ++n) _Pragma("unroll") for (int k = 0; k < 2; ++k) \
        acc[ai][bj][m][n] = __builtin_amdgcn_mfma_f32_16x16x32_bf16(Bt[n][k], At[m][k], acc[ai][bj][m][n], 0, 0, 0); __builtin_amdgcn_s_setprio(0); } while (0)
#define PG8_WAIT_V(n) asm volatile("s_waitcnt vmcnt(" #n ")" ::: "memory")
#define PG8_WAIT_L(n) asm volatile("s_waitcnt lgkmcnt(" #n ")" ::: "memory")
#define PG8_BAR __builtin_amdgcn_s_barrier()
#define PG8_SCHED __builtin_amdgcn_sched_barrier(0)
    Unit cur, nxt; int ui = 0;
    if (!S.next(0, cur)) return;
    f32x4 acc[2][2][4][2];
#pragma unroll
    for (int a = 0; a < 2; ++a)
#pragma unroll
        for (int b = 0; b < 2; ++b)
#pragma unroll
            for (int m = 0; m < 4; ++m)
#pragma unroll
                for (int n = 0; n < 2; ++n) acc[a][b][m][n] = (f32x4){0.f, 0.f, 0.f, 0.f};
    bf16x8 At[4][2], B0[2][2], B1[2][2];
    const char* cA = Sched::GATHER ? (const char*)g.A : (const char*)g.A + (size_t)cur.pm * tstep; const char* cB = (const char*)g.Bt + (size_t)cur.pn * tstep;
    const size_t hstepA = Sched::GATHER ? 0 : hstep;
    if constexpr (Sched::GATHER) { static_assert(SP2, "gather is wired into the SP2 loop only"); PG8_GOFF(cur, cv0, cv1); }
    S.a_ready(cur);
    if constexpr (SP2) {
        PG8_STAGE(PG8_SB(0, 0), cB, voffB); PG8_STAGE(PG8_SB(0, 1), cB + hstep, voffB); PG8_STAGE(PG8_SA(0, 0), cA, cv0); PG8_STAGE(PG8_SA(0, 1), cA + hstepA, cv1);
        if (wr == 1) PG8_BAR;
        PG8_WAIT_V(2); PG8_BAR;
        PG8_STAGE(PG8_SB(1, 0), cB + kstep, voffB); PG8_STAGE(PG8_SA(1, 0), cA + kstep, cv0); PG8_STAGE(PG8_SB(1, 1), cB + hstep + kstep, voffB);
        PG8_WAIT_V(6); PG8_BAR;
    } else {
        PG8_STAGE(PG8_SB(0, 0), cB, voffB); PG8_STAGE(PG8_SA(0, 0), cA, voffA); PG8_STAGE(PG8_SB(0, 1), cB + hstep, voffB); PG8_STAGE(PG8_SA(0, 1), cA + hstep, voffA);
        if (wr == 1) PG8_BAR;
        PG8_WAIT_V(4); PG8_BAR;
        PG8_STAGE(PG8_SB(1, 0), cB + kstep, voffB); PG8_STAGE(PG8_SA(1, 0), cA + kstep, voffA); PG8_STAGE(PG8_SB(1, 1), cB + hstep + kstep, voffB);
        PG8_WAIT_V(6); PG8_BAR;
    }
    for (;;) {
        const bool has_next = S.next(ui + 1, nxt);
        const char* nA = Sched::GATHER ? (const char*)g.A : (has_next ? (const char*)g.A + (size_t)nxt.pm * tstep : cA); const char* nB = has_next ? (const char*)g.Bt + (size_t)nxt.pn * tstep : cB;
        for (int t = 0; t < nt; t += 2) {
            const bool last = (t == nt - 2);
            const char* a1 = cA + (size_t)(t + 1) * kstep;
            const char* a2 = last ? nA : cA + (size_t)(t + 2) * kstep; const char* b2 = last ? nB : cB + (size_t)(t + 2) * kstep;
            const char* a3 = a2 + kstep; const char* b3 = b2 + kstep;
            if (last && has_next) S.a_ready(nxt);
            if constexpr (SP2) {
            PG8_LDB(B0, 0, 0); PG8_LDB(B1, 0, 1); PG8_SCHED; PG8_LDA(At, 0, 0); PG8_STAGE(PG8_SA(1, 1), a1 + hstepA, cv1);
            if constexpr (Sched::GATHER) { if (last && has_next) { PG8_GOFF(nxt, cv0, cv1); } }
            PG8_WAIT_V(8); PG8_WAIT_L(0); PG8_BAR; PG8_MMA(0, 0, At, B0); PG8_MMA(0, 1, At, B1); PG8_BAR; PG8_SCHED;
            PG8_LDA(At, 0, 1); PG8_STAGE(PG8_SB(0, 0), b2, voffB); PG8_STAGE(PG8_SB(0, 1), b2 + hstep, voffB); PG8_STAGE(PG8_SA(0, 0), a2, cv0);
            PG8_WAIT_V(8); PG8_WAIT_L(0); PG8_BAR; PG8_MMA(1, 0, At, B0); PG8_MMA(1, 1, At, B1); PG8_BAR; PG8_SCHED;
            PG8_LDB(B0, 1, 0); PG8_LDB(B1, 1, 1); PG8_SCHED; PG8_LDA(At, 1, 0); PG8_STAGE(PG8_SA(0, 1), a2 + hstepA, cv1);
            PG8_WAIT_V(8); PG8_WAIT_L(0); PG8_BAR; PG8_MMA(0, 0, At, B0); PG8_MMA(0, 1, At, B1); PG8_BAR; PG8_SCHED;
            PG8_LDA(At, 1, 1); PG8_STAGE(PG8_SB(1, 0), b3, voffB); PG8_STAGE(PG8_SB(1, 1), b3 + hstep, voffB); PG8_STAGE(PG8_SA(1, 0), a3, cv0);
            PG8_WAIT_V(8); PG8_WAIT_L(0); PG8_BAR; PG8_MMA(1, 0, At, B0); PG8_MMA(1, 1, At, B1); PG8_BAR; PG8_SCHED;
            } else {
            PG8_LDB(B0, 0, 0); PG8_SCHED; PG8_LDA(At, 0, 0); PG8_STAGE(PG8_SA(1, 1), a1 + hstep, voffA);
            PG8_WAIT_L(8); PG8_BAR; PG8_WAIT_L(0); PG8_MMA(0, 0, At, B0); PG8_BAR; PG8_SCHED;
            PG8_LDB(B1, 0, 1); PG8_STAGE(PG8_SB(0, 0), b2, voffB);
            PG8_BAR; PG8_WAIT_L(0); PG8_MMA(0, 1, At, B1); PG8_BAR;
            PG8_LDA(At, 0, 1); PG8_STAGE(PG8_SA(0, 0), a2, voffA);
            PG8_BAR; PG8_WAIT_L(0); PG8_MMA(1, 0, At, B0); PG8_BAR; PG8_SCHED;
            PG8_STAGE(PG8_SB(0, 1), b2 + hstep, voffB);
            PG8_WAIT_V(6); PG8_BAR; PG8_MMA(1, 1, At, B1); PG8_BAR;
            PG8_LDB(B0, 1, 0); PG8_SCHED; PG8_LDA(At, 1, 0); PG8_STAGE(PG8_SA(0, 1), a2 + hstep, voffA);
            PG8_WAIT_L(8); PG8_BAR; PG8_WAIT_L(0); PG8_MMA(0, 0, At, B0); PG8_BAR; PG8_SCHED;
            PG8_LDB(B1, 1, 1); PG8_STAGE(PG8_SB(1, 0), b3, voffB);
            PG8_BAR; PG8_WAIT_L(0); PG8_MMA(0, 1, At, B1); PG8_BAR;
            PG8_LDA(At, 1, 1); PG8_STAGE(PG8_SA(1, 0), a3, voffA);
            PG8_BAR; PG8_WAIT_L(0); PG8_MMA(1, 0, At, B0); PG8_BAR; PG8_SCHED;
            PG8_STAGE(PG8_SB(1, 1), b3 + hstep, voffB);
            PG8_WAIT_V(6); PG8_BAR; PG8_MMA(1, 1, At, B1); PG8_BAR;
            }
        }
        if constexpr (ALIGN_EPI) { if (wr == 0) PG8_BAR; }
        if constexpr (!Epi::AFTER_DRAIN) { E(acc, cur, wr, wc, fr, fq); S.done(cur); }
        if (!has_next) break;
#pragma unroll
        for (int a = 0; a < 2; ++a)
#pragma unroll
            for (int b = 0; b < 2; ++b)
#pragma unroll
                for (int m = 0; m < 4; ++m)
#pragma unroll
                    for (int n = 0; n < 2; ++n) acc[a][b][m][n] = (f32x4){0.f, 0.f, 0.f, 0.f};
        cur = nxt; cA = nA; cB = nB; ++ui;
        if constexpr (ALIGN_EPI) { if (wr == 1) PG8_BAR; }
    }
    PG8_WAIT_V(0);
    if constexpr (!ALIGN_EPI) { if (wr == 0) PG8_BAR; }
    PG8_BAR;
    if constexpr (Epi::AFTER_DRAIN) { E.fused(acc, cur, wr, wc, fr, fq, lds, wid, lane); S.done(cur); }
#undef PG8_SA
#undef PG8_SB
#undef PG8_STAGE
#undef PG8_LDA
#undef PG8_LDB
#undef PG8_MMA
#undef PG8_WAIT_V
#undef PG8_WAIT_L
#undef PG8_BAR
#undef PG8_SCHED
#undef PG8_GOFF
}
}
#ifndef DBG_CHECK
#define DBG_CHECK 0
#endif
#define DBG_LAYER 0
#ifndef DBG_TIME
#define DBG_TIME 0
#endif
#define TIME_LAYER 1
#define DUP_THIN 0
#define DUP_MIX 0
#define TIME_A 3
#define TIME_B 4
#define DBG_BIAS 0
constexpr int NWAVES = 8, NTHREADS = 512, GRID = 256;
constexpr int NLAYER_RUN = DBG_CHECK ? (DBG_LAYER + 1) : 4;
constexpr int T = 16384, D = 1024, SEQ = 4096, NLAYER = 4;
constexpr int PIN = 3080, NPROJ = 3072;
constexpr int CH = 128, NCH = 32, NUNIT = 512;
constexpr int NEXP = 16, DEXP = 512;
constexpr int PADROWS = 36864;
constexpr float ALPHA = 1.6817928305074290f;
constexpr float LN_EPS = 1e-5f;
constexpr int PQ = 0, PK = 512, PV = 1024, PO = 1536, PGU = 2048, PGV = 2304, PCA = 2560, PCB = 2816;
constexpr size_t MiB = 1u << 20;
constexpr size_t WS_CTL = 0, CTL_ZERO_BYTES = 1 * MiB;
constexpr size_t WS_WIN = 2 * MiB, WS_WOUT = 8 * MiB, WS_WGU = 10 * MiB, WS_WD = 42 * MiB;
constexpr size_t WS_SMALL = 58 * MiB;
constexpr size_t SM_BIAS = WS_SMALL;
constexpr size_t SM_GATES = WS_SMALL + 64 * 1024;
constexpr size_t SM_SEL = SM_GATES + 512 * 1024;
constexpr size_t SM_HIST = SM_SEL + 256 * 1024;
constexpr size_t SM_META = SM_HIST + 16 * 1024;
constexpr size_t SM_TOKSLOT = SM_META + 4 * 1024;
constexpr size_t SM_G = SM_TOKSLOT + 128 * 1024;
constexpr size_t SM_MLOC = SM_G + 2048;
constexpr size_t SM_MPREV = SM_MLOC + 2048;
constexpr size_t SM_NLOC = SM_MPREV + 2048;
constexpr size_t SM_NPREV = SM_NLOC + 256 * 1024;
constexpr size_t SM_END = SM_NPREV + 256 * 1024;
constexpr size_t SM_WM = SM_END + 128 * 1024;
constexpr size_t SM_GW = SM_END;
static_assert(SM_WM + 128 * 1024 <= 62 * MiB, "small region");
constexpr size_t WS_XN = 62 * MiB, WS_HCAT = 94 * MiB, WS_XNB = 126 * MiB, WS_CLOCT = 190 * MiB, WS_CPREVT = 222 * MiB, WS_HID = 238 * MiB;
constexpr size_t WS_PROJ = 274 * MiB;
constexpr size_t WS_END = 370 * MiB;
static_assert(WS_HID + (size_t)PADROWS * DEXP * 2 <= WS_PROJ && WS_PROJ + (size_t)PADROWS * D * 2 <= WS_END && WS_PROJ + (size_t)T * NPROJ * 2 <= WS_END, "ws map");
constexpr int CW_TMO = 0, CW_BAR = 4096, CW_CNT = 8192;
constexpr size_t WS_LIST = 158 * MiB;
constexpr int RING_BYTES = 131072, LDSCTL_OFF = 139264, MISC_OFF = LDSCTL_OFF + 320, PTR_OFF = LDSCTL_OFF + 512, VEC_OFF = LDSCTL_OFF + 1024, LDS_BYTES = 151552;

#define LAS __attribute__((address_space(3)))
typedef unsigned short bf16;
typedef unsigned v4u __attribute__((ext_vector_type(4)));
typedef unsigned v2u __attribute__((ext_vector_type(2)));
typedef float f32x4 __attribute__((ext_vector_type(4)));
typedef float f32x2 __attribute__((ext_vector_type(2)));
#define DI __device__ __forceinline__
DI unsigned f2bf(float f) { unsigned u = __builtin_bit_cast(unsigned, f); return (u + 0x7fffu + ((u >> 16) & 1u)) >> 16; }
DI unsigned pk2(float lo, float hi) { return f2bf(lo) | (f2bf(hi) << 16); }
DI float bflo(unsigned w) { return __builtin_bit_cast(float, w << 16); }
DI float bfhi(unsigned w) { return __builtin_bit_cast(float, w & 0xffff0000u); }
DI float bf2f(bf16 h) { return __builtin_bit_cast(float, (unsigned)h << 16); }
DI float wave_sum(float v) {
#pragma unroll
    for (int o = 1; o < 64; o <<= 1) v += __shfl_xor(v, o);
    return v;
}
DI float sigmoidf_(float x) { return 1.0f / (1.0f + __expf(-x)); }
DI float gelu_tanh(float x) { const float u = 0.7978845608028654f * (x + 0.044715f * x * x * x); const float e = __expf(2.0f * u); const float th = 1.0f - 2.0f / (e + 1.0f); return 0.5f * x * (1.0f + th); }
DI float logsigmoidf_(float x) { return fminf(x, 0.0f) - log1pf(__expf(-fabsf(x))); }

#define XB_TMO      128
#define XB_XCNT(j)  (256  + 64 * (j))
#define XB_XSUB(j)  (1280 + 64 * (j))
#define XB_XGEN(j)  (2304 + 64 * (j))
#define XB_TOP      3328
#define XB_TOPGEN   3392
#define XCD_BAR_WORDS 3456
#define XB_SPIN_CAP (1u << 18)
__device__ __forceinline__ unsigned xb_ld(unsigned* p)              { return __hip_atomic_load(p, __ATOMIC_RELAXED, __HIP_MEMORY_SCOPE_AGENT); }
__device__ __forceinline__ unsigned xb_add(unsigned* p, unsigned v) { return __hip_atomic_fetch_add(p, v, __ATOMIC_RELAXED, __HIP_MEMORY_SCOPE_AGENT); }
__device__ __forceinline__ unsigned xb_xcc_id() { return (unsigned)__builtin_amdgcn_s_getreg((3 << 11) | 20) & 0xFu; }
#define XB_SPIN(cond, bar) do { unsigned _sp = 0; while (cond) { __builtin_amdgcn_s_sleep(1); \
    if ((++_sp & 255u) == 0u) { if (xb_ld(&(bar)[XB_TMO])) break; if (_sp > XB_SPIN_CAP) { atomicAdd(&(bar)[XB_TMO], 1u); break; } } } } while (0)
struct XcdBarrier { unsigned* bar; unsigned x; volatile LAS unsigned* st; };
__device__ __forceinline__ XcdBarrier xcd_barrier_post(unsigned* bar, volatile LAS unsigned* st) {
    XcdBarrier b; b.bar = bar; b.x = xb_xcc_id(); b.st = st;
    if (threadIdx.x == 0) (void)xb_add(&bar[XB_XCNT(b.x)], 1u);
    return b;
}
__device__ __forceinline__ void xcd_barrier_complete(unsigned* bar, unsigned x, unsigned& nloc, unsigned& nx) {
    const unsigned G = gridDim.x * gridDim.y * gridDim.z;
    unsigned sum, cnt, mine, sp = 0u;
    for (;;) {
        sum = 0u; cnt = 0u; mine = 0u;
#pragma unroll
        for (unsigned j = 0; j < 16; ++j) { const unsigned c = xb_ld(&bar[XB_XCNT(j)]); sum += c; cnt += (c > 0u) ? 1u : 0u; mine = (j == x) ? c : mine; }
        if (sum == G) break;
        __builtin_amdgcn_s_sleep(1);
        if ((++sp & 255u) == 0u) { if (xb_ld(&bar[XB_TMO])) break; if (sp > XB_SPIN_CAP) { atomicAdd(&bar[XB_TMO], 1u); break; } }
    }
    nloc = mine > 0u ? mine : 1u; nx = cnt > 0u ? cnt : 1u;
}
template <bool FIRST> __device__ __forceinline__ void xcd_barrier(const XcdBarrier& b) {
    asm volatile("s_waitcnt vmcnt(0)" ::: "memory");
    __syncthreads();
    if (threadIdx.x == 0) {
        unsigned* bar = b.bar; unsigned bx = b.x; { int z_ = 0; asm volatile("" : "+s"(z_)); bar += z_; bx += (unsigned)z_; }
        __builtin_amdgcn_s_waitcnt(0);
        unsigned nloc = b.st[0], nx = b.st[1];
        if (FIRST) { if (nloc == 0u) { xcd_barrier_complete(bar, bx, nloc, nx); b.st[0] = nloc; b.st[1] = nx; } }
        const unsigned old = xb_add(&bar[XB_XSUB(bx)], 1u);
        const unsigned gen = old / nloc;
        if (old + 1u == (gen + 1u) * nloc) {
            __builtin_amdgcn_fence(__ATOMIC_RELEASE, "agent");
            asm volatile("s_waitcnt vmcnt(0)" ::: "memory");
            const unsigned og = xb_add(&bar[XB_TOP], 1u);
            const unsigned tg = og / nx;
            if (og + 1u == (tg + 1u) * nx) xb_add(&bar[XB_TOPGEN], 1u);
            else XB_SPIN(xb_ld(&bar[XB_TOPGEN]) == tg, bar);
            __builtin_amdgcn_fence(__ATOMIC_ACQUIRE, "agent");
            xb_add(&bar[XB_XGEN(bx)], 1u);
            asm volatile("s_waitcnt vmcnt(0)" ::: "memory");
        } else {
            XB_SPIN(xb_ld(&bar[XB_XGEN(bx)]) == gen, bar);
            __builtin_amdgcn_fence(__ATOMIC_ACQUIRE, "agent");
            asm volatile("s_waitcnt vmcnt(0)" ::: "memory");
        }
    }
    __syncthreads();
}

struct Args { const float* in[22]; float* out; unsigned char* ws; };
struct Ctx { LAS unsigned char* lds; int tid, lane, wave, bid; };
__device__ __forceinline__ Ctx fresh_ctx(const Ctx& C0) { Ctx C = C0; asm volatile("" : "+v"(C.tid)); asm volatile("" : "+s"(C.bid)); asm volatile("" : "+s"(C.lds)); C.lane = C.tid & 63; C.wave = __builtin_amdgcn_readfirstlane(C.tid >> 6); return C; }

DI void transpose_item(const float* src, int ld, int k0, int n0, bf16* dst, int K, int drow0, LAS float* scr, int lane) {
    float tv[32];
#pragma unroll
    for (int i = 0; i < 32; ++i) tv[i] = src[(size_t)(k0 + 2 * i + (lane >> 5)) * ld + n0 + (lane & 31)];
#pragma unroll
    for (int i = 0; i < 32; ++i) scr[(2 * i + (lane >> 5)) * 33 + (lane & 31)] = tv[i];
    asm volatile("s_waitcnt lgkmcnt(0)" ::: "memory");
    const int c = lane & 7;
#pragma unroll
    for (int j = 0; j < 4; ++j) { const int n = (lane >> 3) + 8 * j; const LAS float* s = scr + (8 * c) * 33 + n;
        v4u o; o.x = pk2(s[0 * 33], s[1 * 33]); o.y = pk2(s[2 * 33], s[3 * 33]); o.z = pk2(s[4 * 33], s[5 * 33]); o.w = pk2(s[6 * 33], s[7 * 33]);
        *(v4u*)(dst + (size_t)(drow0 + n) * K + k0 + 8 * c) = o; }
    asm volatile("s_waitcnt lgkmcnt(0)" ::: "memory");
}
DI void phase_convert(const Args& A, const Ctx& C0, int l) { const Ctx C = fresh_ctx(C0);
    LAS float* scr = (LAS float*)(C.lds + C.wave * 16384);
    const int gw = C.bid * NWAVES + C.wave, NGW = GRID * NWAVES;
    bf16* WIN = (bf16*)(A.ws + WS_WIN); bf16* WOUT = (bf16*)(A.ws + WS_WOUT); bf16* WGU = (bf16*)(A.ws + WS_WGU); bf16* WD = (bf16*)(A.ws + WS_WD);
    constexpr int I_IN = 16 * 96, I_OUT = 16 * 32, I_GU = 16 * 512, I_D = 16 * 256, NITEMS = I_IN + I_OUT + I_GU + I_D;
    for (int it = gw; it < NITEMS; it += NGW) {
        int r = it;
        if (r < I_IN) { const int kb = r / 96, nb = r % 96, n0 = 32 * nb; transpose_item(A.in[1] + (size_t)l * D * PIN, PIN, 64 * kb, n0 + (n0 >= 2048 ? 8 : 0), WIN, D, n0, scr, C.lane); continue; } r -= I_IN;
        if (r < I_OUT) { const int kb = r / 32, nb = r % 32; transpose_item(A.in[12] + (size_t)l * D * D, D, 64 * kb, 32 * nb, WOUT, D, 32 * nb, scr, C.lane); continue; } r -= I_OUT;
        if (r < I_GU) { const int e = r / 512, r1 = r % 512, half = r1 / 256, r2 = r1 % 256, kb = r2 / 16, nb = r2 % 16, j0 = 32 * nb;
            transpose_item((half ? A.in[18] : A.in[17]) + (size_t)(l * NEXP + e) * D * DEXP, DEXP, 64 * kb, j0, WGU, D, e * 1024 + (j0 / 128) * 256 + half * 128 + (j0 % 128), scr, C.lane); continue; } r -= I_GU;
        { const int e = r / 256, r1 = r % 256, kb = r1 / 32, nb = r1 % 32;
            transpose_item(A.in[19] + (size_t)(l * NEXP + e) * DEXP * D, D, 64 * kb, 32 * nb, WD, DEXP, e * 1024 + 32 * nb, scr, C.lane); }
    }
    { bf16* WM = (bf16*)(A.ws + SM_WM); const float* wsrc = A.in[6] + (size_t)l * 4 * CH * CH;
        for (int i = C.bid * NTHREADS + C.tid; i < 4 * CH * CH; i += GRID * NTHREADS) { const int s = i & 127, t = (i >> 7) & 127; WM[i] = (bf16)f2bf(s <= t ? wsrc[i] : 0.f); } }
    float* BIAS = (float*)(A.ws + SM_BIAS);
    for (int n = C.bid * NTHREADS + C.tid; n < NPROJ; n += GRID * NTHREADS) BIAS[n] = A.in[2][(size_t)l * PIN + n + (n >= 2048 ? 8 : 0)];
}

DI void stage_gate_weights(const Args& A, const Ctx& C, int lg) {
    LAS float* gwl = (LAS float*)C.lds;
    const float* w = A.in[1] + (size_t)lg * D * PIN + 2048;
    for (int i = C.tid; i < 8 * D; i += NTHREADS) { const int col = i >> 3, g = i & 7; gwl[g * D + col] = w[(size_t)col * PIN + g]; }
}
DI void row_emit(const Args& A, const Ctx& C, int t, const f32x4 (&v)[4], float* xout, bf16* XN, int lg) {
    if (xout) {
#pragma unroll
        for (int j = 0; j < 4; ++j) *(f32x4*)(xout + (size_t)t * D + 256 * j + 4 * C.lane) = v[j];
    }
    if (XN) {
#pragma unroll
        for (int j = 0; j < 4; ++j) { v2u w; w.x = pk2(v[j][0], v[j][1]); w.y = pk2(v[j][2], v[j][3]); *(v2u*)(XN + (size_t)t * D + 256 * j + 4 * C.lane) = w; }
    }
    if (lg >= 0) {
        const LAS float* gwl = (const LAS float*)C.lds;
        float* GATES = (float*)(A.ws + SM_GATES);
        float gs[8];
#pragma unroll
        for (int g = 0; g < 8; ++g) { float s = 0.f;
#pragma unroll
            for (int j = 0; j < 4; ++j) { const f32x4 w = *(const LAS f32x4*)(gwl + g * D + 256 * j + 4 * C.lane); s += v[j][0] * w[0] + v[j][1] * w[1] + v[j][2] * w[2] + v[j][3] * w[3]; }
            gs[g] = wave_sum(s); }
        if (C.lane == 0) {
            const float* bg = A.in[2] + (size_t)lg * PIN + 2048;
            f32x4 o0 = {gs[0] + bg[0], gs[1] + bg[1], gs[2] + bg[2], gs[3] + bg[3]}, o1 = {gs[4] + bg[4], gs[5] + bg[5], gs[6] + bg[6], gs[7] + bg[7]};
            *(f32x4*)(GATES + (size_t)t * 8) = o0; *(f32x4*)(GATES + (size_t)t * 8 + 4) = o1;
        }
    }
}
DI void phase_prologue_rows(const Args& A, const Ctx& C0) { const Ctx C = fresh_ctx(C0);
    stage_gate_weights(A, C, 0);
    __syncthreads();
    for (int t = C.bid * NWAVES + C.wave; t < T; t += GRID * NWAVES) {
        f32x4 v[4];
#pragma unroll
        for (int j = 0; j < 4; ++j) v[j] = *(const f32x4*)(A.in[0] + (size_t)t * D + 256 * j + 4 * C.lane);
        row_emit(A, C, t, v, nullptr, (bf16*)(A.ws + WS_XN), 0);
    }
    __syncthreads();
}
DI void row_layernorm(f32x4 (&v)[4], const float* w, const float* b, int lane) {
    float s = 0.f;
#pragma unroll
    for (int j = 0; j < 4; ++j) s += (v[j][0] + v[j][1]) + (v[j][2] + v[j][3]);
    const float mean = wave_sum(s) * (1.0f / D); float q = 0.f;
#pragma unroll
    for (int j = 0; j < 4; ++j) { v[j] = v[j] - mean; q += (v[j][0] * v[j][0] + v[j][1] * v[j][1]) + (v[j][2] * v[j][2] + v[j][3] * v[j][3]); }
    const float rstd = 1.0f / sqrtf(wave_sum(q) * (1.0f / D) + LN_EPS);
#pragma unroll
    for (int j = 0; j < 4; ++j) { const f32x4 ww = *(const f32x4*)(w + 256 * j + 4 * lane), bb = *(const f32x4*)(b + 256 * j + 4 * lane); v[j] = v[j] * rstd * ww + bb; }
}
DI void phase_ln1_router(const Args& A, const Ctx& C0, int l) { const Ctx C = fresh_ctx(C0);
    LAS float* rwl = (LAS float*)C.lds;
    LAS int* hist = (LAS int*)(C.lds + VEC_OFF); LAS int* lbase = hist + 16, *le = hist + 32, *lrank = hist + 160;
    for (int i = C.tid; i < NEXP * D; i += NTHREADS) { const int col = i >> 4, e = i & 15; rwl[e * D + col] = A.in[15][i]; }
    if (C.tid < 16) hist[C.tid] = 0;
    __syncthreads();
    const bf16* X = (const bf16*)(A.ws + WS_XN);
    const bf16* Y = (const bf16*)(A.ws + WS_PROJ);
    bf16* XNB = (bf16*)(A.ws + WS_XNB);
    v4u* SEL = (v4u*)(A.ws + SM_SEL);
    float rb[16];
#pragma unroll
    for (int e = 0; e < 16; ++e) rb[e] = A.in[16][e];
    for (int i = 0; i < 8; ++i) {
        const int t = C.bid * 64 + C.wave * 8 + i;
        f32x4 v[4];
#pragma unroll
        for (int j = 0; j < 4; ++j) { const v2u x = *(const v2u*)(X + (size_t)t * D + 256 * j + 4 * C.lane); const v2u y = *(const v2u*)(Y + (size_t)t * D + 256 * j + 4 * C.lane);
            v[j][0] = ALPHA * bflo(x.x) + bflo(y.x); v[j][1] = ALPHA * bfhi(x.x) + bfhi(y.x); v[j][2] = ALPHA * bflo(x.y) + bflo(y.y); v[j][3] = ALPHA * bfhi(x.y) + bfhi(y.y); }
        row_layernorm(v, A.in[13] + (size_t)l * D, A.in[14] + (size_t)l * D, C.lane);
        row_emit(A, C, t, v, nullptr, XNB, -1);
        float best = -INFINITY, bs0 = 0.f, bs1 = 0.f; int be0 = 0, be1 = 1;
#pragma unroll
        for (int g = 0; g < 4; ++g) {
            float sel[4], sg[4];
#pragma unroll
            for (int k = 0; k < 4; ++k) { const int e = 4 * g + k; float s = 0.f;
#pragma unroll
                for (int j = 0; j < 4; ++j) { const f32x4 w = *(const LAS f32x4*)(rwl + e * D + 256 * j + 4 * C.lane); s += v[j][0] * w[0] + v[j][1] * w[1] + v[j][2] * w[2] + v[j][3] * w[3]; }
                s = wave_sum(s); sg[k] = 1.0f / (1.0f + expf(-s)); sel[k] = sg[k] + rb[e]; }
            float m1 = sel[0], s1 = sg[0]; int i1 = 0;
#pragma unroll
            for (int k = 1; k < 4; ++k) if (sel[k] > m1) { m1 = sel[k]; s1 = sg[k]; i1 = k; }
            float m2 = -INFINITY, s2 = 0.f; int i2 = 0;
#pragma unroll
            for (int k = 0; k < 4; ++k) if (k != i1 && sel[k] > m2) { m2 = sel[k]; s2 = sg[k]; i2 = k; }
            const float gsc = m1 + m2;
            if (gsc > best) { best = gsc; be0 = 4 * g + i1; be1 = 4 * g + i2; bs0 = s1; bs1 = s2; }
        }
        if (C.lane == 0) {
            const float inv = 1.0f / (bs0 + bs1);
            v4u o; o.x = (unsigned)be0; o.y = (unsigned)be1; o.z = __builtin_bit_cast(unsigned, bs0 * inv); o.w = __builtin_bit_cast(unsigned, bs1 * inv);
            SEL[t] = o;
            ((f32x2*)(A.ws + SM_GW))[t] = (f32x2){bs0 * inv, bs1 * inv};
            const int q = (C.wave * 8 + i) * 2;
            le[q] = be0; lrank[q] = __hip_atomic_fetch_add(hist + be0, 1, __ATOMIC_RELAXED, __HIP_MEMORY_SCOPE_WORKGROUP);
            le[q + 1] = be1; lrank[q + 1] = __hip_atomic_fetch_add(hist + be1, 1, __ATOMIC_RELAXED, __HIP_MEMORY_SCOPE_WORKGROUP);
        }
    }
    __syncthreads();
    if (C.tid < 16) lbase[C.tid] = (int)__hip_atomic_fetch_add((unsigned*)(A.ws + WS_CTL) + CW_CNT + (l * 16 + C.tid) * 16, (unsigned)hist[C.tid], __ATOMIC_RELAXED, __HIP_MEMORY_SCOPE_AGENT);
    __syncthreads();
    if (C.tid < 128) { const int e = le[C.tid], pos = lbase[e] + lrank[C.tid], t = C.bid * 64 + (C.tid >> 1);
        ((int*)(A.ws + WS_LIST))[(size_t)e * 16384 + pos] = t; ((int*)(A.ws + SM_TOKSLOT))[2 * t + (C.tid & 1)] = pos; }
    __syncthreads();
}
DI void phase_combine(const Args& A, const Ctx& C0, int l) { const Ctx C = fresh_ctx(C0);
    const bool last = (l == NLAYER - 1);
    if (!last) { stage_gate_weights(A, C, l + 1); }
    LAS int* tpl = (LAS int*)(C.lds + VEC_OFF);
    if (C.tid == 0) { int run = 0; for (int e = 0; e < 16; ++e) { tpl[e] = run; const int n = (int)__hip_atomic_load((const unsigned*)(A.ws + WS_CTL) + CW_CNT + (l * 16 + e) * 16, __ATOMIC_RELAXED, __HIP_MEMORY_SCOPE_AGENT); run += ((n + 255) >> 8) * 256; } }
    __syncthreads();
    const bf16* X1 = (const bf16*)(A.ws + WS_XNB); const bf16* YP = (const bf16*)(A.ws + WS_PROJ);
    const v4u* SEL = (const v4u*)(A.ws + SM_SEL); const int* TOKSLOT = (const int*)(A.ws + SM_TOKSLOT);
    for (int t = C.bid * NWAVES + C.wave; t < T; t += GRID * NWAVES) {
        const v4u s = SEL[t]; const int p0 = tpl[s.x & 15u] + TOKSLOT[2 * t], p1 = tpl[s.y & 15u] + TOKSLOT[2 * t + 1]; const f32x2 gw2 = ((const f32x2*)(A.ws + SM_GW))[t]; const float g0 = gw2[0], g1 = gw2[1];
        f32x4 v[4];
#pragma unroll
        for (int j = 0; j < 4; ++j) { const v2u x = *(const v2u*)(X1 + (size_t)t * D + 256 * j + 4 * C.lane);
            const v2u a = *(const v2u*)(YP + (size_t)p0 * D + 256 * j + 4 * C.lane), b = *(const v2u*)(YP + (size_t)p1 * D + 256 * j + 4 * C.lane);
            v[j][0] = ALPHA * bflo(x.x) + g0 * bflo(a.x) + g1 * bflo(b.x); v[j][1] = ALPHA * bfhi(x.x) + g0 * bfhi(a.x) + g1 * bfhi(b.x);
            v[j][2] = ALPHA * bflo(x.y) + g0 * bflo(a.y) + g1 * bflo(b.y); v[j][3] = ALPHA * bfhi(x.y) + g0 * bfhi(a.y) + g1 * bfhi(b.y); }
        row_layernorm(v, A.in[20] + (size_t)l * D, A.in[21] + (size_t)l * D, C.lane);
        row_emit(A, C, t, v, last ? A.out : nullptr, last ? nullptr : (bf16*)(A.ws + WS_XN), last ? -1 : l + 1);
    }
    __syncthreads();
}
DI void unpack8(const v4u w, float (&f)[8]) { f[0] = bflo(w.x); f[1] = bfhi(w.x); f[2] = bflo(w.y); f[3] = bfhi(w.y); f[4] = bflo(w.z); f[5] = bfhi(w.z); f[6] = bflo(w.w); f[7] = bfhi(w.w); }
DI void conv_unit(const Args& A, const Ctx& C0, int l, int unit) { const Ctx C = fresh_ctx(C0);
    const bf16* PROJ = (const bf16*)(A.ws + WS_PROJ); bf16* HCAT = (bf16*)(A.ws + WS_HCAT);
    LAS float* cin = (LAS float*)C.lds;
    LAS float* cou = (LAS float*)(C.lds + 65536);
    const int t0 = unit * 32, tseq = t0 & (SEQ - 1);
    for (int it = C.tid; it < 62 * 32; it += NTHREADS) { const int r = it >> 5, c8 = (it & 31) * 8; float o[8];
        if (tseq - 30 + r >= 0) { const size_t rowo = (size_t)(t0 - 30 + r) * NPROJ; float a[8], b[8]; unpack8(*(const v4u*)(PROJ + rowo + PCA + c8), a); unpack8(*(const v4u*)(PROJ + rowo + PCB + c8), b);
#pragma unroll
            for (int i = 0; i < 8; ++i) o[i] = a[i] * sigmoidf_(b[i]); }
        else {
#pragma unroll
            for (int i = 0; i < 8; ++i) o[i] = 0.f; }
        *(LAS f32x4*)(cin + r * 256 + c8) = (f32x4){o[0], o[1], o[2], o[3]}; *(LAS f32x4*)(cin + r * 256 + c8 + 4) = (f32x4){o[4], o[5], o[6], o[7]}; }
    __syncthreads();
    { const int c = C.tid & 255, half = C.tid >> 8;
        float w[31];
#pragma unroll
        for (int j = 0; j < 31; ++j) w[j] = A.in[8][(size_t)(l * 31 + j) * 256 + c];
        const float bias = A.in[9][l * 256 + c];
        float xin[46];
#pragma unroll
        for (int r = 0; r < 46; ++r) xin[r] = cin[(half * 16 + r) * 256 + c];
#pragma unroll
        for (int i = 0; i < 16; ++i) { float acc = bias;
#pragma unroll
            for (int j = 0; j < 31; ++j) acc += xin[i + j] * w[j];
            cou[(half * 16 + i) * 256 + c] = acc; } }
    __syncthreads();
    { const f32x4 nw = *(const f32x4*)(A.in[10] + l * 256 + 4 * C.lane), nb = *(const f32x4*)(A.in[11] + l * 256 + 4 * C.lane);
#pragma unroll
        for (int q = 0; q < 4; ++q) { const int r = 4 * C.wave + q; f32x4 x = *(const LAS f32x4*)(cou + r * 256 + 4 * C.lane);
            const float mean = wave_sum((x[0] + x[1]) + (x[2] + x[3])) * (1.0f / 256.0f); x = x - mean;
            const float var = wave_sum((x[0] * x[0] + x[1] * x[1]) + (x[2] * x[2] + x[3] * x[3])) * (1.0f / 256.0f);
            const float rstd = 1.0f / sqrtf(var + LN_EPS); x = x * rstd * nw + nb;
            float o[4];
#pragma unroll
            for (int k = 0; k < 4; ++k) o[k] = x[k] * sigmoidf_(x[k]);
            v2u pk; pk.x = pk2(o[0], o[1]); pk.y = pk2(o[2], o[3]);
            *(v2u*)(HCAT + (size_t)(t0 + r) * D + 768 + 4 * C.lane) = pk; } }
    __syncthreads();
}
DI void gmlp_unit_simple(const Args& A, const Ctx& C0, int l, int ck) { const Ctx C = fresh_ctx(C0);
    const bf16* PROJ = (const bf16*)(A.ws + WS_PROJ); bf16* HCAT = (bf16*)(A.ws + WS_HCAT);
    LAS float* zs = (LAS float*)C.lds;
    const int t0 = ck * CH;
    { const f32x4 nw = *(const f32x4*)(A.in[4] + l * 256 + 4 * C.lane), nb = *(const f32x4*)(A.in[5] + l * 256 + 4 * C.lane);
        for (int i = 0; i < 16; ++i) { const int r = C.wave * 16 + i; const v2u g = *(const v2u*)(PROJ + (size_t)(t0 + r) * NPROJ + PGV + 4 * C.lane);
            f32x4 x = {gelu_tanh(bflo(g.x)), gelu_tanh(bfhi(g.x)), gelu_tanh(bflo(g.y)), gelu_tanh(bfhi(g.y))};
            const float mean = wave_sum((x[0] + x[1]) + (x[2] + x[3])) * (1.0f / 256.0f); x = x - mean;
            const float var = wave_sum((x[0] * x[0] + x[1] * x[1]) + (x[2] * x[2] + x[3] * x[3])) * (1.0f / 256.0f);
            const float rstd = 1.0f / sqrtf(var + LN_EPS); x = x * rstd * nw + nb;
            *(LAS f32x4*)(zs + r * 256 + 4 * C.lane) = x; } }
    __syncthreads();
    { const int tb = C.tid >> 4, cb = C.tid & 15, c0 = 16 * cb, h = cb >> 2, tr0 = 4 * tb;
        const float* ws = A.in[6] + (size_t)(l * 4 + h) * CH * CH;
        float acc[4][16];
#pragma unroll
        for (int i = 0; i < 4; ++i)
#pragma unroll
            for (int j = 0; j < 16; ++j) acc[i][j] = 0.f;
        for (int s = 0; s <= tr0 + 3; ++s) {
            float zv[16];
#pragma unroll
            for (int q = 0; q < 4; ++q) { const f32x4 z4 = *(const LAS f32x4*)(zs + s * 256 + c0 + 4 * q); zv[4 * q] = z4[0]; zv[4 * q + 1] = z4[1]; zv[4 * q + 2] = z4[2]; zv[4 * q + 3] = z4[3]; }
#pragma unroll
            for (int i = 0; i < 4; ++i) { const float wg = (s <= tr0 + i) ? ws[(size_t)(tr0 + i) * CH + s] : 0.f;
#pragma unroll
                for (int j = 0; j < 16; ++j) acc[i][j] += wg * zv[j]; }
        }
#pragma unroll
        for (int i = 0; i < 4; ++i) { const int tr = tr0 + i; const float bsv = A.in[7][(size_t)(l * 4 + h) * CH + tr]; const size_t rowo = (size_t)(t0 + tr) * NPROJ + PGU + c0;
            float u[16]; { float tmp[8]; unpack8(*(const v4u*)(PROJ + rowo), tmp);
#pragma unroll
                for (int j = 0; j < 8; ++j) u[j] = tmp[j];
                unpack8(*(const v4u*)(PROJ + rowo + 8), tmp);
#pragma unroll
                for (int j = 0; j < 8; ++j) u[8 + j] = tmp[j]; }
            float o[16];
#pragma unroll
            for (int j = 0; j < 16; ++j) o[j] = gelu_tanh(u[j]) * (acc[i][j] + bsv);
            v4u w0, w1; w0.x = pk2(o[0], o[1]); w0.y = pk2(o[2], o[3]); w0.z = pk2(o[4], o[5]); w0.w = pk2(o[6], o[7]); w1.x = pk2(o[8], o[9]); w1.y = pk2(o[10], o[11]); w1.z = pk2(o[12], o[13]); w1.w = pk2(o[14], o[15]);
            *(v4u*)(HCAT + (size_t)(t0 + tr) * D + 512 + c0) = w0; *(v4u*)(HCAT + (size_t)(t0 + tr) * D + 512 + c0 + 8) = w1; }
    }
    __syncthreads();
}
DI void mlstm_local_simple(const Args& A, const Ctx& C0, int un) { const Ctx C = fresh_ctx(C0);
    const bf16* PROJ = (const bf16*)(A.ws + WS_PROJ); const float* GATES = (const float*)(A.ws + SM_GATES);
    const int bh = un >> 5, c = un & 31, b = bh >> 2, h = bh & 3, t0 = b * SEQ + c * CH;
    LAS float* kw = (LAS float*)C.lds;
    LAS float* vs = (LAS float*)(C.lds + 65536);
    LAS float* vec = (LAS float*)(C.lds + VEC_OFF);
    if (C.tid < CH) { const float fp = GATES[(size_t)(t0 + C.tid) * 8 + 4 + h], ip = GATES[(size_t)(t0 + C.tid) * 8 + h]; vec[C.tid] = logsigmoidf_(fp); vec[128 + C.tid] = ip; }
    __syncthreads();
    if (C.tid == 0) { float run = 0.f; for (int i = 0; i < CH; ++i) { run += vec[i]; vec[i] = run; } const float g = run; float ml = -INFINITY;
        for (int i = 0; i < CH; ++i) { const float a = g - vec[i] + vec[128 + i]; vec[256 + i] = a; ml = fmaxf(ml, a); }
        for (int i = 0; i < CH; ++i) vec[256 + i] = __expf(vec[256 + i] - ml);
        ((float*)(A.ws + SM_G))[un] = g; ((float*)(A.ws + SM_MLOC))[un] = ml; }
    __syncthreads();
    for (int it = C.tid; it < CH * 16; it += NTHREADS) { const int r = it >> 4, c8 = (it & 15) * 8; const size_t rowo = (size_t)(t0 + r) * NPROJ + h * 128 + c8; float k8[8], v8[8];
        unpack8(*(const v4u*)(PROJ + rowo + PK), k8); unpack8(*(const v4u*)(PROJ + rowo + PV), v8); const float sc = vec[256 + r] * 0.08838834764831845f;
#pragma unroll
        for (int i = 0; i < 8; ++i) { kw[r * 128 + c8 + i] = k8[i] * sc; vs[r * 128 + c8 + i] = v8[i]; } }
    __syncthreads();
    { const int db = C.tid >> 4, eb = C.tid & 15, d0 = 4 * db, e0 = 8 * eb; float acc[4][8];
#pragma unroll
        for (int i = 0; i < 4; ++i)
#pragma unroll
            for (int j = 0; j < 8; ++j) acc[i][j] = 0.f;
        for (int r = 0; r < CH; ++r) { const f32x4 kd = *(const LAS f32x4*)(kw + r * 128 + d0); const f32x4 va = *(const LAS f32x4*)(vs + r * 128 + e0), vb = *(const LAS f32x4*)(vs + r * 128 + e0 + 4);
#pragma unroll
            for (int i = 0; i < 4; ++i) { acc[i][0] += kd[i] * va[0]; acc[i][1] += kd[i] * va[1]; acc[i][2] += kd[i] * va[2]; acc[i][3] += kd[i] * va[3]; acc[i][4] += kd[i] * vb[0]; acc[i][5] += kd[i] * vb[1]; acc[i][6] += kd[i] * vb[2]; acc[i][7] += kd[i] * vb[3]; } }
        float* CL = (float*)(A.ws + WS_CLOCT) + (size_t)un * CH * CH;
#pragma unroll
        for (int j = 0; j < 8; ++j) *(f32x4*)(CL + (size_t)(e0 + j) * CH + d0) = (f32x4){acc[0][j], acc[1][j], acc[2][j], acc[3][j]}; }
    if (C.tid < CH) { float s = 0.f; for (int r = 0; r < CH; ++r) s += kw[r * 128 + C.tid]; ((float*)(A.ws + SM_NLOC))[(size_t)un * CH + C.tid] = s; }
    __syncthreads();
}
DI void phase_scan(const Args& A, const Ctx& C0) { const Ctx C = fresh_ctx(C0);
    const int gt = C.bid * NTHREADS + C.tid, bh = gt >> 13, pr = gt & 8191;
    const float* G = (const float*)(A.ws + SM_G); const float* ML = (const float*)(A.ws + SM_MLOC); float* MP = (float*)(A.ws + SM_MPREV);
    const float* CL = (const float*)(A.ws + WS_CLOCT); unsigned* CP = (unsigned*)(A.ws + WS_CPREVT);
    const float* NL = (const float*)(A.ws + SM_NLOC); float* NP = (float*)(A.ws + SM_NPREV);
    float c0 = 0.f, c1 = 0.f, n0 = 0.f, n1 = 0.f, m = 0.f;
    for (int cb = 0; cb < NCH; cb += 8) {
        f32x2 cl[8], nl[8]; float g[8], ml[8];
#pragma unroll
        for (int i = 0; i < 8; ++i) { const int un = bh * NCH + cb + i; cl[i] = *(const f32x2*)(CL + (size_t)un * CH * CH + 2 * pr); g[i] = G[un]; ml[i] = ML[un]; nl[i] = (pr < 64) ? *(const f32x2*)(NL + (size_t)un * CH + 2 * pr) : (f32x2){0.f, 0.f}; }
#pragma unroll
        for (int i = 0; i < 8; ++i) { const int un = bh * NCH + cb + i;
            CP[(size_t)un * (CH * CH / 2) + pr] = pk2(c0, c1);
            if (pr == 0) MP[un] = m;
            if (pr < 64) *(f32x2*)(NP + (size_t)un * CH + 2 * pr) = (f32x2){n0, n1};
            const float mn = fmaxf(g[i] + m, ml[i]), dec = __expf(g[i] + m - mn), sc = __expf(ml[i] - mn);
            c0 = dec * c0 + sc * cl[i][0]; c1 = dec * c1 + sc * cl[i][1]; n0 = dec * n0 + sc * nl[i][0]; n1 = dec * n1 + sc * nl[i][1]; m = mn; }
    }
}
DI void mlstm_out_simple(const Args& A, const Ctx& C0, int l, int un) { const Ctx C = fresh_ctx(C0);
    const bf16* PROJ = (const bf16*)(A.ws + WS_PROJ); const float* GATES = (const float*)(A.ws + SM_GATES); bf16* HCAT = (bf16*)(A.ws + WS_HCAT);
    const int bh = un >> 5, c = un & 31, b = bh >> 2, h = bh & 3, t0 = b * SEQ + c * CH;
    LAS bf16* qs = (LAS bf16*)C.lds;
    LAS bf16* ks = (LAS bf16*)(C.lds + 32768);
    LAS float* ps = (LAS float*)(C.lds + 65536);
    LAS float* vec = (LAS float*)(C.lds + VEC_OFF);
    LAS float* bvec = vec, *uvec = vec + 128, *Mvec = vec + 256, *wint = vec + 384, *flo = vec + 512, *den = vec + 640, *npv = vec + 768, *ipv = vec + 896, *lfv = vec + 1024, *qnv = vec + 1152;
    if (C.tid < CH) { const float fp = GATES[(size_t)(t0 + C.tid) * 8 + 4 + h], ip = GATES[(size_t)(t0 + C.tid) * 8 + h]; lfv[C.tid] = logsigmoidf_(fp); ipv[C.tid] = ip; npv[C.tid] = ((const float*)(A.ws + SM_NPREV))[(size_t)un * CH + C.tid]; }
    __syncthreads();
    if (C.tid == 0) { const float mprev = ((const float*)(A.ws + SM_MPREV))[un]; float run = 0.f, pm = -INFINITY;
        for (int i = 0; i < CH; ++i) { run += lfv[i]; bvec[i] = run; const float u = ipv[i] - run; uvec[i] = u; pm = fmaxf(pm, u); const float M = fmaxf(mprev, pm); Mvec[i] = M; wint[i] = __expf(mprev - M); flo[i] = __expf(-(run + M)); } }
    for (int it = C.tid; it < CH * 16; it += NTHREADS) { const int r = it >> 4, c8 = (it & 15) * 8; const size_t rowo = (size_t)(t0 + r) * NPROJ + h * 128 + c8;
        *(LAS v4u*)(qs + r * 128 + c8) = *(const v4u*)(PROJ + rowo + PQ); *(LAS v4u*)(ks + r * 128 + c8) = *(const v4u*)(PROJ + rowo + PK); }
    __syncthreads();
    const int lb = C.tid >> 4, xb = C.tid & 15, l0 = 4 * lb, x0 = 8 * xb;
    {
        float acc[4][8];
#pragma unroll
        for (int i = 0; i < 4; ++i)
#pragma unroll
            for (int j = 0; j < 8; ++j) acc[i][j] = 0.f;
        if (x0 <= l0 + 3) {
            for (int d8 = 0; d8 < 16; ++d8) { float qf[4][8], kf[8];
#pragma unroll
                for (int i = 0; i < 4; ++i) unpack8(*(const LAS v4u*)(qs + (l0 + i) * 128 + d8 * 8), qf[i]);
#pragma unroll
                for (int j = 0; j < 8; ++j) { unpack8(*(const LAS v4u*)(ks + (x0 + j) * 128 + d8 * 8), kf);
#pragma unroll
                    for (int i = 0; i < 4; ++i) { float s = 0.f;
#pragma unroll
                        for (int dd = 0; dd < 8; ++dd) s += qf[i][dd] * kf[dd];
                        acc[i][j] += s; } } } }
#pragma unroll
        for (int i = 0; i < 4; ++i)
#pragma unroll
            for (int j = 0; j < 8; ++j) { const int li = l0 + i, sj = x0 + j; ps[li * 128 + sj] = (sj <= li) ? acc[i][j] * 0.08838834764831845f * __expf(uvec[sj] - Mvec[li]) : 0.f; }
    }
    __syncthreads();
    if (C.tid < CH) { const int li = C.tid; float s = 0.f; for (int k = 0; k < CH; ++k) s += ps[li * 128 + ((k + li) & 127)]; den[li] = s; }
    else if (C.tid < 2 * CH) { const int li = C.tid - CH; float s = 0.f; for (int k = 0; k < CH; ++k) { const int d = (k + li) & 127; s += bf2f(qs[li * 128 + d]) * npv[d]; } qnv[li] = s; }
    for (int it = C.tid; it < CH * 16; it += NTHREADS) { const int r = it >> 4, c8 = (it & 15) * 8; }
    __syncthreads();
    for (int it = C.tid; it < CH * 16; it += NTHREADS) { const int r = it >> 4, c8 = (it & 15) * 8; const size_t rowo = (size_t)(t0 + r) * NPROJ + h * 128 + c8; *(LAS v4u*)(ks + r * 128 + c8) = *(const v4u*)(PROJ + rowo + PV); }
    __syncthreads();
    float hv[4][8];
    {   const int e0 = x0; float acc[4][8], acc2[4][8];
#pragma unroll
        for (int i = 0; i < 4; ++i)
#pragma unroll
            for (int j = 0; j < 8; ++j) { acc[i][j] = 0.f; acc2[i][j] = 0.f; }
        for (int s = 0; s <= l0 + 3; ++s) { float vv[8]; unpack8(*(const LAS v4u*)(ks + s * 128 + e0), vv);
#pragma unroll
            for (int i = 0; i < 4; ++i) { const float p = ps[(l0 + i) * 128 + s];
#pragma unroll
                for (int j = 0; j < 8; ++j) acc[i][j] += p * vv[j]; } }
        const bf16* CPT = (const bf16*)(A.ws + WS_CPREVT) + (size_t)un * CH * CH;
        for (int d8 = 0; d8 < 16; ++d8) { float qf[4][8], cf[8];
#pragma unroll
            for (int i = 0; i < 4; ++i) unpack8(*(const LAS v4u*)(qs + (l0 + i) * 128 + d8 * 8), qf[i]);
#pragma unroll
            for (int j = 0; j < 8; ++j) { unpack8(*(const v4u*)(CPT + (size_t)(e0 + j) * CH + d8 * 8), cf);
#pragma unroll
                for (int i = 0; i < 4; ++i) { float s = 0.f;
#pragma unroll
                    for (int dd = 0; dd < 8; ++dd) s += qf[i][dd] * cf[dd];
                    acc2[i][j] += s; } } }
#pragma unroll
        for (int i = 0; i < 4; ++i) { const int li = l0 + i; const float wi = wint[li]; const float dn = den[li] + wi * qnv[li]; const float inv = 1.0f / fmaxf(fabsf(dn), flo[li]);
#pragma unroll
            for (int j = 0; j < 8; ++j) hv[i][j] = (acc[i][j] + wi * acc2[i][j]) * inv; }
    }
    __syncthreads();
#pragma unroll
    for (int i = 0; i < 4; ++i)
#pragma unroll
        for (int j = 0; j < 8; ++j) ps[(l0 + i) * 128 + x0 + j] = hv[i][j];
    __syncthreads();
    { const f32x2 nw = *(const f32x2*)(A.in[3] + (size_t)l * 512 + h * 128 + 2 * C.lane);
        for (int i = 0; i < 16; ++i) { const int li = C.wave * 16 + i; f32x2 x = *(const LAS f32x2*)(ps + li * 128 + 2 * C.lane);
            const float mean = wave_sum(x[0] + x[1]) * (1.0f / 128.0f); x = x - mean; const float var = wave_sum(x[0] * x[0] + x[1] * x[1]) * (1.0f / 128.0f);
            const float rstd = 1.0f / sqrtf(var + 1e-6f); const unsigned ow = *(const unsigned*)(PROJ + (size_t)(t0 + li) * NPROJ + PO + h * 128 + 2 * C.lane);
            const float o0 = sigmoidf_(bflo(ow)) * (x[0] * rstd * nw[0]), o1 = sigmoidf_(bfhi(ow)) * (x[1] * rstd * nw[1]);
            *(unsigned*)(HCAT + (size_t)(t0 + li) * D + h * 128 + 2 * C.lane) = pk2(o0, o1); } }
    __syncthreads();
}
typedef short bf16x8 __attribute__((ext_vector_type(8)));
DI f32x4 mfma16(bf16x8 a, bf16x8 b, f32x4 c) { return __builtin_amdgcn_mfma_f32_16x16x32_bf16(a, b, c, 0, 0, 0); }
constexpr int LDT = 136;
constexpr int TILE_B = 128 * LDT * 2;
DI float wave_scan_add(float v, int lane) {
#pragma unroll
    for (int o = 1; o < 64; o <<= 1) { const float t = __shfl_up(v, o); if (lane >= o) v += t; }
    return v;
}
DI float wave_scan_max(float v, int lane) {
#pragma unroll
    for (int o = 1; o < 64; o <<= 1) { const float t = __shfl_up(v, o); if (lane >= o) v = fmaxf(v, t); }
    return v;
}
DI float wave_max(float v) {
#pragma unroll
    for (int o = 1; o < 64; o <<= 1) v = fmaxf(v, __shfl_xor(v, o));
    return v;
}
DI float red16(float v) { v += __shfl_xor(v, 1); v += __shfl_xor(v, 2); v += __shfl_xor(v, 4); v += __shfl_xor(v, 8); return v; }

DI void mlstm_local_mfma(const Args& A, const Ctx& C0, int un) { const Ctx C = fresh_ctx(C0);
    const bf16* PROJ = (const bf16*)(A.ws + WS_PROJ); const float* GATES = (const float*)(A.ws + SM_GATES);
    const int bh = un >> 5, c = un & 31, b = bh >> 2, h = bh & 3, t0 = b * SEQ + c * CH;
    LAS bf16* VT = (LAS bf16*)C.lds;
    LAS bf16* KWT = (LAS bf16*)(C.lds + TILE_B);
    LAS float* wv = (LAS float*)(C.lds + VEC_OFF);
    if (C.wave == 0) {
        const int l0 = 2 * C.lane; const f32x4 ga = *(const f32x4*)(GATES + (size_t)(t0 + l0) * 8), gb = *(const f32x4*)(GATES + (size_t)(t0 + l0) * 8 + 4), gc = *(const f32x4*)(GATES + (size_t)(t0 + l0 + 1) * 8), gd = *(const f32x4*)(GATES + (size_t)(t0 + l0 + 1) * 8 + 4);
        const float ip0 = h == 0 ? ga[0] : (h == 1 ? ga[1] : (h == 2 ? ga[2] : ga[3])), fp0 = h == 0 ? gb[0] : (h == 1 ? gb[1] : (h == 2 ? gb[2] : gb[3]));
        const float ip1 = h == 0 ? gc[0] : (h == 1 ? gc[1] : (h == 2 ? gc[2] : gc[3])), fp1 = h == 0 ? gd[0] : (h == 1 ? gd[1] : (h == 2 ? gd[2] : gd[3]));
        const float lf0 = logsigmoidf_(fp0), lf1 = logsigmoidf_(fp1);
        const float incl = wave_scan_add(lf0 + lf1, C.lane), b1 = incl, b0 = incl - lf1;
        const float g = __shfl(incl, 63);
        const float a0 = g - b0 + ip0, a1 = g - b1 + ip1, ml = wave_max(fmaxf(a0, a1));
        wv[l0] = __expf(a0 - ml); wv[l0 + 1] = __expf(a1 - ml);
        if (C.lane == 0) { ((float*)(A.ws + SM_G))[un] = g; ((float*)(A.ws + SM_MLOC))[un] = ml; }
    }
    __syncthreads();
    for (int it = C.tid; it < CH * 16; it += NTHREADS) { const int r = it >> 4, c8 = (it & 15) * 8; const size_t rowo = (size_t)(t0 + r) * NPROJ + h * 128 + c8; float k8[8];
        unpack8(*(const v4u*)(PROJ + rowo + PK), k8); const v4u vv = *(const v4u*)(PROJ + rowo + PV); const float sc = wv[r] * 0.08838834764831845f;
        const unsigned vw[4] = {vv.x, vv.y, vv.z, vv.w};
#pragma unroll
        for (int i = 0; i < 8; ++i) { KWT[(c8 + i) * LDT + r] = (bf16)f2bf(k8[i] * sc); VT[(c8 + i) * LDT + r] = (bf16)((i & 1) ? (vw[i >> 1] >> 16) : (vw[i >> 1] & 0xffffu)); } }
    __syncthreads();
    { const int fr = C.lane & 15, fg = C.lane >> 4, w = C.wave;
        bf16x8 a[4];
#pragma unroll
        for (int ks = 0; ks < 4; ++ks) a[ks] = *(const LAS bf16x8*)(VT + (16 * w + fr) * LDT + 32 * ks + 8 * fg);
        float* CL = (float*)(A.ws + WS_CLOCT) + (size_t)un * CH * CH;
#pragma unroll
        for (int dt = 0; dt < 8; ++dt) { f32x4 acc = {0.f, 0.f, 0.f, 0.f};
#pragma unroll
            for (int ks = 0; ks < 4; ++ks) { const bf16x8 bb = *(const LAS bf16x8*)(KWT + (16 * dt + fr) * LDT + 32 * ks + 8 * fg); acc = mfma16(a[ks], bb, acc); }
#pragma unroll
            for (int rg = 0; rg < 4; ++rg) CL[(size_t)(16 * w + 4 * fg + rg) * CH + 16 * dt + fr] = acc[rg]; } }
    if (C.tid < CH) { float s = 0.f;
#pragma unroll
        for (int q = 0; q < 16; ++q) { float f[8]; unpack8(*(const LAS v4u*)(KWT + C.tid * LDT + 8 * q), f); s += ((f[0] + f[1]) + (f[2] + f[3])) + ((f[4] + f[5]) + (f[6] + f[7])); }
        ((float*)(A.ws + SM_NLOC))[(size_t)un * CH + C.tid] = s; }
    __syncthreads();
}
DI void mlstm_out_mfma(const Args& A, const Ctx& C0, int l, int un) { const Ctx C = fresh_ctx(C0);
    const bf16* PROJ = (const bf16*)(A.ws + WS_PROJ); const float* GATES = (const float*)(A.ws + SM_GATES); bf16* HCAT = (bf16*)(A.ws + WS_HCAT);
    const int bh = un >> 5, c = un & 31, b = bh >> 2, h = bh & 3, t0 = b * SEQ + c * CH;
    LAS bf16* QS = (LAS bf16*)C.lds;
    LAS bf16* KS = (LAS bf16*)(C.lds + TILE_B);
    LAS bf16* PS = (LAS bf16*)(C.lds + 2 * TILE_B);
    LAS bf16* CT = (LAS bf16*)(C.lds + 3 * TILE_B);
    LAS float* vec = (LAS float*)(C.lds + VEC_OFF);
    LAS float* uvec = vec, *Mvec = vec + 128, *wint = vec + 256, *flo = vec + 384; LAS bf16* npb = (LAS bf16*)(vec + 512);
    if (C.wave == 0) {
        const int l0 = 2 * C.lane; const f32x4 ga = *(const f32x4*)(GATES + (size_t)(t0 + l0) * 8), gb = *(const f32x4*)(GATES + (size_t)(t0 + l0) * 8 + 4), gc = *(const f32x4*)(GATES + (size_t)(t0 + l0 + 1) * 8), gd = *(const f32x4*)(GATES + (size_t)(t0 + l0 + 1) * 8 + 4);
        const float ip0 = h == 0 ? ga[0] : (h == 1 ? ga[1] : (h == 2 ? ga[2] : ga[3])), fp0 = h == 0 ? gb[0] : (h == 1 ? gb[1] : (h == 2 ? gb[2] : gb[3]));
        const float ip1 = h == 0 ? gc[0] : (h == 1 ? gc[1] : (h == 2 ? gc[2] : gc[3])), fp1 = h == 0 ? gd[0] : (h == 1 ? gd[1] : (h == 2 ? gd[2] : gd[3]));
        const float lf0 = logsigmoidf_(fp0), lf1 = logsigmoidf_(fp1);
        const float incl = wave_scan_add(lf0 + lf1, C.lane), b1 = incl, b0 = incl - lf1;
        const float u0 = ip0 - b0, u1 = ip1 - b1;
        const float pm_incl = wave_scan_max(fmaxf(u0, u1), C.lane); const float pm_prev = __shfl_up(pm_incl, 1);
        const float pm0 = C.lane == 0 ? u0 : fmaxf(pm_prev, u0), pm1 = pm_incl;
        const float mprev = ((const float*)(A.ws + SM_MPREV))[un];
        const float M0 = fmaxf(mprev, pm0), M1 = fmaxf(mprev, pm1);
        uvec[l0] = u0; uvec[l0 + 1] = u1; Mvec[l0] = M0; Mvec[l0 + 1] = M1; wint[l0] = __expf(mprev - M0); wint[l0 + 1] = __expf(mprev - M1); flo[l0] = __expf(-(b0 + M0)); flo[l0 + 1] = __expf(-(b1 + M1));
        const f32x2 np2 = *(const f32x2*)((const float*)(A.ws + SM_NPREV) + (size_t)un * CH + l0); *(LAS unsigned*)(npb + l0) = pk2(np2[0], np2[1]);
    }
    { const bf16* CPT = (const bf16*)(A.ws + WS_CPREVT) + (size_t)un * CH * CH;
        for (int it = C.tid; it < CH * 16; it += NTHREADS) { const int r = it >> 4, c8 = (it & 15) * 8; const size_t rowo = (size_t)(t0 + r) * NPROJ + h * 128 + c8;
            *(LAS v4u*)(QS + r * LDT + c8) = *(const v4u*)(PROJ + rowo + PQ); *(LAS v4u*)(KS + r * LDT + c8) = *(const v4u*)(PROJ + rowo + PK); *(LAS v4u*)(CT + r * LDT + c8) = *(const v4u*)(CPT + (size_t)r * CH + c8); } }
    __syncthreads();
    const int fr = C.lane & 15, fg = C.lane >> 4, w = C.wave;
    bf16x8 aq[4];
#pragma unroll
    for (int ks = 0; ks < 4; ++ks) aq[ks] = *(const LAS bf16x8*)(QS + (16 * w + fr) * LDT + 32 * ks + 8 * fg);
    float Ml[4], wl[4], inv[4];
#pragma unroll
    for (int rg = 0; rg < 4; ++rg) { Ml[rg] = Mvec[16 * w + 4 * fg + rg]; wl[rg] = wint[16 * w + 4 * fg + rg]; }
    {   float rs[4] = {0.f, 0.f, 0.f, 0.f};
#pragma unroll
        for (int st = 0; st < 8; ++st) {
            if (st <= w) { f32x4 acc = {0.f, 0.f, 0.f, 0.f};
#pragma unroll
                for (int ks = 0; ks < 4; ++ks) { const bf16x8 bb = *(const LAS bf16x8*)(KS + (16 * st + fr) * LDT + 32 * ks + 8 * fg); acc = mfma16(aq[ks], bb, acc); }
                const int s = 16 * st + fr; const float us = uvec[s];
#pragma unroll
                for (int rg = 0; rg < 4; ++rg) { const int li = 16 * w + 4 * fg + rg; const float p = (s <= li) ? acc[rg] * 0.08838834764831845f * __expf(us - Ml[rg]) : 0.f; rs[rg] += p; PS[li * LDT + s] = (bf16)f2bf(p); } }
            else if (st == w + 1 && (w & 1) == 0) {
#pragma unroll
                for (int rg = 0; rg < 4; ++rg) PS[(16 * w + 4 * fg + rg) * LDT + 16 * st + fr] = (bf16)0; }
        }
        f32x4 an = {0.f, 0.f, 0.f, 0.f};
#pragma unroll
        for (int ks = 0; ks < 4; ++ks) { bf16x8 bn = *(const LAS bf16x8*)(npb + 32 * ks + 8 * fg); if (fr != 0) bn = (bf16x8){0, 0, 0, 0, 0, 0, 0, 0}; an = mfma16(aq[ks], bn, an); }
#pragma unroll
        for (int rg = 0; rg < 4; ++rg) { const float qn = __shfl(an[rg], 16 * fg); const float dn = red16(rs[rg]) + wl[rg] * qn; inv[rg] = 1.0f / fmaxf(fabsf(dn), flo[16 * w + 4 * fg + rg]); }
    }
    __syncthreads();
    for (int it = C.tid; it < CH * 16; it += NTHREADS) { const int r = it >> 4, c8 = (it & 15) * 8; const v4u vv = *(const v4u*)(PROJ + (size_t)(t0 + r) * NPROJ + h * 128 + c8 + PV); const unsigned vw[4] = {vv.x, vv.y, vv.z, vv.w};
#pragma unroll
        for (int i = 0; i < 8; ++i) KS[(c8 + i) * LDT + r] = (bf16)((i & 1) ? (vw[i >> 1] >> 16) : (vw[i >> 1] & 0xffffu)); }
    __syncthreads();
    {   const int nk2 = (w >> 1) + 1;
        bf16x8 ap[4];
#pragma unroll
        for (int k2 = 0; k2 < 4; ++k2) ap[k2] = (k2 < nk2) ? *(const LAS bf16x8*)(PS + (16 * w + fr) * LDT + 32 * k2 + 8 * fg) : (bf16x8){0, 0, 0, 0, 0, 0, 0, 0};
        float hv[8][4]; float sm[4] = {0.f, 0.f, 0.f, 0.f};
#pragma unroll
        for (int et = 0; et < 8; ++et) { f32x4 a1 = {0.f, 0.f, 0.f, 0.f}, a2 = {0.f, 0.f, 0.f, 0.f};
#pragma unroll
            for (int k2 = 0; k2 < 4; ++k2) if (k2 < nk2) { const bf16x8 bb = *(const LAS bf16x8*)(KS + (16 * et + fr) * LDT + 32 * k2 + 8 * fg); a1 = mfma16(ap[k2], bb, a1); }
#pragma unroll
            for (int ks = 0; ks < 4; ++ks) { const bf16x8 bb = *(const LAS bf16x8*)(CT + (16 * et + fr) * LDT + 32 * ks + 8 * fg); a2 = mfma16(aq[ks], bb, a2); }
#pragma unroll
            for (int rg = 0; rg < 4; ++rg) { hv[et][rg] = (a1[rg] + wl[rg] * a2[rg]) * inv[rg]; sm[rg] += hv[et][rg]; } }
        float mean[4], rstd[4];
#pragma unroll
        for (int rg = 0; rg < 4; ++rg) { mean[rg] = red16(sm[rg]) * (1.0f / 128.0f); float q = 0.f;
#pragma unroll
            for (int et = 0; et < 8; ++et) { const float dlt = hv[et][rg] - mean[rg]; q += dlt * dlt; }
            rstd[rg] = 1.0f / sqrtf(red16(q) * (1.0f / 128.0f) + 1e-6f); }
#pragma unroll
        for (int et = 0; et < 8; ++et) { const int e = 16 * et + fr; const float nw = A.in[3][(size_t)l * 512 + h * 128 + e];
#pragma unroll
            for (int rg = 0; rg < 4; ++rg) { const int li = 16 * w + 4 * fg + rg; const float o = bf2f(PROJ[(size_t)(t0 + li) * NPROJ + PO + h * 128 + e]);
                HCAT[(size_t)(t0 + li) * D + h * 128 + e] = (bf16)f2bf(sigmoidf_(o) * ((hv[et][rg] - mean[rg]) * rstd[rg] * nw)); } }
    }
    __syncthreads();
}
DI void gmlp_unit_mfma(const Args& A, const Ctx& C0, int l, int unit) { const Ctx C = fresh_ctx(C0);
    const bf16* PROJ = (const bf16*)(A.ws + WS_PROJ); bf16* HCAT = (bf16*)(A.ws + WS_HCAT); const bf16* WM = (const bf16*)(A.ws + SM_WM);
    const int ck = unit >> 2, hh = unit & 3, t0 = ck * CH;
    LAS bf16* ZT = (LAS bf16*)C.lds;
    { const f32x4 nw = *(const f32x4*)(A.in[4] + l * 256 + 4 * C.lane), nb = *(const f32x4*)(A.in[5] + l * 256 + 4 * C.lane);
        for (int i = 0; i < 16; ++i) { const int r = C.wave * 16 + i; const v2u g = *(const v2u*)(PROJ + (size_t)(t0 + r) * NPROJ + PGV + 4 * C.lane);
            f32x4 x = {gelu_tanh(bflo(g.x)), gelu_tanh(bfhi(g.x)), gelu_tanh(bflo(g.y)), gelu_tanh(bfhi(g.y))};
            const float mean = wave_sum((x[0] + x[1]) + (x[2] + x[3])) * (1.0f / 256.0f); x = x - mean;
            const float var = wave_sum((x[0] * x[0] + x[1] * x[1]) + (x[2] * x[2] + x[3] * x[3])) * (1.0f / 256.0f);
            const float rstd = 1.0f / sqrtf(var + LN_EPS); x = x * rstd * nw + nb;
            if ((C.lane >> 4) == hh) { const int d0 = 4 * (C.lane & 15);
#pragma unroll
                for (int q = 0; q < 4; ++q) ZT[(d0 + q) * LDT + r] = (bf16)f2bf(x[q]); } } }
    __syncthreads();
    { const int fr = C.lane & 15, fg = C.lane >> 4, w = C.wave, nk = (w >> 1) + 1;
        bf16x8 a[4];
#pragma unroll
        for (int ks = 0; ks < 4; ++ks) a[ks] = (ks < nk) ? *(const bf16x8*)(WM + ((size_t)(hh * CH + 16 * w + fr) * CH + 32 * ks + 8 * fg)) : (bf16x8){0, 0, 0, 0, 0, 0, 0, 0};
#pragma unroll
        for (int dt = 0; dt < 4; ++dt) { f32x4 acc = {0.f, 0.f, 0.f, 0.f};
#pragma unroll
            for (int ks = 0; ks < 4; ++ks) if (ks < nk) { const bf16x8 bb = *(const LAS bf16x8*)(ZT + (16 * dt + fr) * LDT + 32 * ks + 8 * fg); acc = mfma16(a[ks], bb, acc); }
            const int d = 64 * hh + 16 * dt + fr;
#pragma unroll
            for (int rg = 0; rg < 4; ++rg) { const int tr = 16 * w + 4 * fg + rg; const float bsv = A.in[7][(size_t)(l * 4 + hh) * CH + tr]; const float u = bf2f(PROJ[(size_t)(t0 + tr) * NPROJ + PGU + d]);
                HCAT[(size_t)(t0 + tr) * D + 512 + d] = (bf16)f2bf(gelu_tanh(u) * (acc[rg] + bsv)); } } }
    __syncthreads();
}
#if DBG_CHECK
constexpr size_t SM_ERR = WS_CTL + 8192;
DI int slot_of(const Args& A, int l, int t, int k) { const v4u s = ((const v4u*)(A.ws + SM_SEL))[t]; const int e = k ? (int)s.y : (int)s.x; int run = 0;
    for (int q = 0; q < e; ++q) run += (((int)((const unsigned*)(A.ws + WS_CTL))[CW_CNT + (l * 16 + q) * 16] + 255) >> 8) * 256;
    return run + ((const int*)(A.ws + SM_TOKSLOT))[2 * t + k]; }
DI unsigned hsh(unsigned s, unsigned k) { unsigned h = s * 2654435761u + k * 40503u + 12345u; h ^= h >> 15; h *= 2246822519u; h ^= h >> 13; return h; }
DI void err_put(const Args& A, int chk, float ref, float got, float floor_) {
    float e = fabsf(ref - got) / (fabsf(ref) + floor_); if (!(e == e)) e = 1e9f;
    atomicMax((unsigned*)(A.ws + SM_ERR) + chk, __builtin_bit_cast(unsigned, e));
}
DI void chk_gates(const Args& A, const Ctx& C, int l, const float* X) {
    const int gt = C.bid * NTHREADS + C.tid; if (gt >= 2048) return;
    const int t = hsh(gt, 1) % T, g = hsh(gt, 2) % 8; float s = 0.f;
    for (int k = 0; k < D; ++k) s += X[(size_t)t * D + k] * A.in[1][((size_t)l * D + k) * PIN + 2048 + g];
    s += A.in[2][(size_t)l * PIN + 2048 + g];
    err_put(A, 1, s, ((const float*)(A.ws + SM_GATES))[(size_t)t * 8 + g], 0.1f);
}
DI void chk_proj(const Args& A, const Ctx& C, int l) {
    const int gt = C.bid * NTHREADS + C.tid; if (gt >= 8192) return;
    const int t = (gt < 64) ? (gt * 4099) % T : hsh(gt, 3) % T, n = hsh(gt, 4) % NPROJ, ns = n + (n >= 2048 ? 8 : 0);
    const bf16* XN = (const bf16*)(A.ws + WS_XN); float s = 0.f;
    for (int k = 0; k < D; ++k) s += bf2f(XN[(size_t)t * D + k]) * A.in[1][((size_t)l * D + k) * PIN + ns];
    s += A.in[2][(size_t)l * PIN + ns];
    err_put(A, 2, s, bf2f(((const bf16*)(A.ws + WS_PROJ))[(size_t)t * NPROJ + n]), 0.5f);
}
DI void chk_conv(const Args& A, const Ctx& C, int l) {
    const int gw = C.bid * NWAVES + C.wave; if (gw >= 1024) return;
    const int t = (gw < 128) ? (gw * 129) % T : hsh(gw, 5) % T; const bf16* PROJ = (const bf16*)(A.ws + WS_PROJ);
    float cv[4];
#pragma unroll
    for (int q = 0; q < 4; ++q) { const int c = C.lane * 4 + q; float acc = A.in[9][l * 256 + c];
        for (int j = 0; j < 31; ++j) { const int ts = t - 30 + j; if ((ts >> 12) != (t >> 12) || ts < 0) continue;
            const float a = bf2f(PROJ[(size_t)ts * NPROJ + PCA + c]), b = bf2f(PROJ[(size_t)ts * NPROJ + PCB + c]);
            acc += a / (1.0f + expf(-b)) * A.in[8][(size_t)(l * 31 + j) * 256 + c]; }
        cv[q] = acc; }
    const float mean = wave_sum(cv[0] + cv[1] + cv[2] + cv[3]) / 256.0f; float q2 = 0.f;
#pragma unroll
    for (int q = 0; q < 4; ++q) { cv[q] -= mean; q2 += cv[q] * cv[q]; }
    const float rstd = 1.0f / sqrtf(wave_sum(q2) / 256.0f + LN_EPS);
#pragma unroll
    for (int q = 0; q < 4; ++q) { const int c = C.lane * 4 + q; const float y = cv[q] * rstd * A.in[10][l * 256 + c] + A.in[11][l * 256 + c]; const float r = y / (1.0f + expf(-y));
        err_put(A, 3, r, bf2f(((const bf16*)(A.ws + WS_HCAT))[(size_t)t * D + 768 + c]), 0.5f); }
}
DI void chk_gmlp(const Args& A, const Ctx& C, int l) {
    const int gw = C.bid * NWAVES + C.wave; if (gw >= 512) return;
    const int t = (gw < 64) ? (gw * 131 + 127) % T : hsh(gw, 6) % T; const bf16* PROJ = (const bf16*)(A.ws + WS_PROJ);
    const int tc = t & 127, t0 = t - tc, h = C.lane >> 4; float acc[4] = {0.f, 0.f, 0.f, 0.f};
    for (int s = 0; s <= tc; ++s) { float x[4];
#pragma unroll
        for (int q = 0; q < 4; ++q) { const float v = bf2f(PROJ[(size_t)(t0 + s) * NPROJ + PGV + C.lane * 4 + q]); x[q] = 0.5f * v * (1.0f + tanhf(0.7978845608028654f * (v + 0.044715f * v * v * v))); }
        const float mean = wave_sum(x[0] + x[1] + x[2] + x[3]) / 256.0f; float q2 = 0.f;
#pragma unroll
        for (int q = 0; q < 4; ++q) { x[q] -= mean; q2 += x[q] * x[q]; }
        const float rstd = 1.0f / sqrtf(wave_sum(q2) / 256.0f + LN_EPS); const float w = A.in[6][((size_t)(l * 4 + h) * CH + tc) * CH + s];
#pragma unroll
        for (int q = 0; q < 4; ++q) { const int c = C.lane * 4 + q; acc[q] += w * (x[q] * rstd * A.in[4][l * 256 + c] + A.in[5][l * 256 + c]); } }
#pragma unroll
    for (int q = 0; q < 4; ++q) { const int c = C.lane * 4 + q; const float v = bf2f(PROJ[(size_t)t * NPROJ + PGU + c]); const float u = 0.5f * v * (1.0f + tanhf(0.7978845608028654f * (v + 0.044715f * v * v * v)));
        const float r = u * (acc[q] + A.in[7][(size_t)(l * 4 + h) * CH + tc]);
        err_put(A, 4, r, bf2f(((const bf16*)(A.ws + WS_HCAT))[(size_t)t * D + 512 + c]), 0.5f); }
}
DI void chk_mlstm(const Args& A, const Ctx& C, int l) {
    const int gw = C.bid * NWAVES + C.wave; if (gw >= 1024) return;
    const int t = (gw < 64) ? (gw * 521 + (gw & 1) * 127) % T : hsh(gw, 7) % T, h = hsh(gw, 8) & 3; const bf16* PROJ = (const bf16*)(A.ws + WS_PROJ); const float* GATES = (const float*)(A.ws + SM_GATES);
    const int tb = t & ~(SEQ - 1); const int d0 = 2 * C.lane;
    const float q0 = bf2f(PROJ[(size_t)t * NPROJ + PQ + h * 128 + d0]), q1 = bf2f(PROJ[(size_t)t * NPROJ + PQ + h * 128 + d0 + 1]);
    float n0 = 0.f, n1 = 0.f, den = 0.f, F = 0.f;
    for (int s = t; s >= tb; --s) {
        const float k0 = bf2f(PROJ[(size_t)s * NPROJ + PK + h * 128 + d0]), k1 = bf2f(PROJ[(size_t)s * NPROJ + PK + h * 128 + d0 + 1]);
        const float qk = wave_sum(q0 * k0 + q1 * k1) * 0.08838834764831845f;
        const float w = expf(F + GATES[(size_t)s * 8 + h]) * qk;
        n0 += w * bf2f(PROJ[(size_t)s * NPROJ + PV + h * 128 + d0]); n1 += w * bf2f(PROJ[(size_t)s * NPROJ + PV + h * 128 + d0 + 1]); den += w;
        const float fp = GATES[(size_t)s * 8 + 4 + h]; F += fminf(fp, 0.f) - log1pf(expf(-fabsf(fp)));
        if (F < -60.f) break; }
    const float inv = 1.0f / fmaxf(fabsf(den), 1.0f); float x0 = n0 * inv, x1 = n1 * inv;
    const float mean = wave_sum(x0 + x1) / 128.0f; x0 -= mean; x1 -= mean; const float rstd = 1.0f / sqrtf(wave_sum(x0 * x0 + x1 * x1) / 128.0f + 1e-6f);
    const float o0 = bf2f(PROJ[(size_t)t * NPROJ + PO + h * 128 + d0]), o1 = bf2f(PROJ[(size_t)t * NPROJ + PO + h * 128 + d0 + 1]);
    const float r0 = x0 * rstd * A.in[3][(size_t)l * 512 + h * 128 + d0] / (1.0f + expf(-o0)), r1 = x1 * rstd * A.in[3][(size_t)l * 512 + h * 128 + d0 + 1] / (1.0f + expf(-o1));
    const bf16* HC = (const bf16*)(A.ws + WS_HCAT);
    err_put(A, 5, r0, bf2f(HC[(size_t)t * D + h * 128 + d0]), 0.5f); err_put(A, 5, r1, bf2f(HC[(size_t)t * D + h * 128 + d0 + 1]), 0.5f);
}
DI void chk_y(const Args& A, const Ctx& C, int l) {
    const int gt = C.bid * NTHREADS + C.tid; if (gt >= 8192) return;
    const int t = hsh(gt, 9) % T, n = hsh(gt, 10) % D; const bf16* HC = (const bf16*)(A.ws + WS_HCAT); float s = 0.f;
    for (int k = 0; k < D; ++k) s += bf2f(HC[(size_t)t * D + k]) * A.in[12][((size_t)l * D + k) * D + n];
    err_put(A, 6, s, bf2f(((const bf16*)(A.ws + WS_PROJ))[(size_t)t * D + n]), 0.2f);
}
DI void chk_ln1(const Args& A, const Ctx& C, int l, const bf16* X) {
    const int gw = C.bid * NWAVES + C.wave; if (gw >= 2048) return;
    const int t = hsh(gw, 11) % T; const bf16* Y = (const bf16*)(A.ws + WS_PROJ); const bf16* X1 = (const bf16*)(A.ws + WS_XNB);
    float v[16]; float s = 0.f;
#pragma unroll
    for (int i = 0; i < 16; ++i) { const int c = C.lane + 64 * i; v[i] = ALPHA * bf2f(X[(size_t)t * D + c]) + bf2f(Y[(size_t)t * D + c]); s += v[i]; }
    const float mean = wave_sum(s) / D; float q2 = 0.f;
#pragma unroll
    for (int i = 0; i < 16; ++i) { v[i] -= mean; q2 += v[i] * v[i]; }
    const float rstd = 1.0f / sqrtf(wave_sum(q2) / D + LN_EPS);
#pragma unroll
    for (int i = 0; i < 16; ++i) { const int c = C.lane + 64 * i; v[i] = v[i] * rstd * A.in[13][(size_t)l * D + c] + A.in[14][(size_t)l * D + c]; }
    err_put(A, 7, v[3], bf2f(X1[(size_t)t * D + C.lane + 192]), 1.0f);
    float sel[16], sg[16];
#pragma unroll
    for (int e = 0; e < 16; ++e) { float p = 0.f;
#pragma unroll
        for (int i = 0; i < 16; ++i) p += v[i] * A.in[15][(size_t)(C.lane + 64 * i) * 16 + e];
        p = wave_sum(p); sg[e] = 1.0f / (1.0f + expf(-p)); sel[e] = sg[e] + A.in[16][e]; }
    float bestg = -INFINITY; int bg = 0;
#pragma unroll
    for (int g = 0; g < 4; ++g) { float a = sel[4 * g], b = sel[4 * g + 1], c = sel[4 * g + 2], d = sel[4 * g + 3];
        float m1 = fmaxf(fmaxf(a, b), fmaxf(c, d)); float tot = a + b + c + d; float mn = fminf(fminf(a, b), fminf(c, d));
        float lo1 = fminf(a, b), hi1 = fmaxf(a, b), lo2 = fminf(c, d), hi2 = fmaxf(c, d); float second = fmaxf(fminf(hi1, hi2), fmaxf(lo1, lo2)); (void)tot; (void)mn;
        const float gs = m1 + second; if (gs > bestg) { bestg = gs; bg = g; } }
    int e0 = -1, e1 = -1; float m1 = -INFINITY, m2 = -INFINITY;
#pragma unroll
    for (int e = 0; e < 16; ++e) if ((e >> 2) == bg && sel[e] > m1) { m1 = sel[e]; e0 = e; }
#pragma unroll
    for (int e = 0; e < 16; ++e) if ((e >> 2) == bg && e != e0 && sel[e] > m2) { m2 = sel[e]; e1 = e; }
    const v4u got = ((const v4u*)(A.ws + SM_SEL))[t];
    if (C.lane == 0 && ((int)got.x != e0 || (int)got.y != e1)) atomicAdd((unsigned*)(A.ws + SM_ERR) + 8, 1u);
}
DI void chk_hid(const Args& A, const Ctx& C, int l) {
    const int gt = C.bid * NTHREADS + C.tid; if (gt >= 8192) return;
    const int t = hsh(gt, 12) % T, k = hsh(gt, 13) & 1, j = hsh(gt, 14) % DEXP; const v4u s = ((const v4u*)(A.ws + SM_SEL))[t]; const int e = k ? (int)s.y : (int)s.x; const int p = slot_of(A, l, t, k);
    const bf16* XN = (const bf16*)(A.ws + WS_XNB); float g = 0.f, u = 0.f;
    for (int c = 0; c < D; ++c) { const float x = bf2f(XN[(size_t)t * D + c]); g += x * A.in[17][((size_t)(l * NEXP + e) * D + c) * DEXP + j]; u += x * A.in[18][((size_t)(l * NEXP + e) * D + c) * DEXP + j]; }
    err_put(A, 9, g / (1.0f + expf(-g)) * u, bf2f(((const bf16*)(A.ws + WS_HID))[(size_t)p * DEXP + j]), 0.5f);
    if (p < 0 || p >= PADROWS) atomicAdd((unsigned*)(A.ws + SM_ERR) + 11, 1u);
}
DI void chk_yp(const Args& A, const Ctx& C, int l) {
    const int gt = C.bid * NTHREADS + C.tid; if (gt >= 8192) return;
    const int t = hsh(gt, 15) % T, k = hsh(gt, 16) & 1, n = hsh(gt, 17) % D; const v4u s = ((const v4u*)(A.ws + SM_SEL))[t]; const int e = k ? (int)s.y : (int)s.x; const int p = slot_of(A, l, t, k);
    const bf16* HID = (const bf16*)(A.ws + WS_HID); float y = 0.f;
    for (int j = 0; j < DEXP; ++j) y += bf2f(HID[(size_t)p * DEXP + j]) * A.in[19][((size_t)(l * NEXP + e) * DEXP + j) * D + n];
    err_put(A, 10, y, bf2f(((const bf16*)(A.ws + WS_PROJ))[(size_t)p * D + n]), 0.2f);
}
DI void chk_out(const Args& A, const Ctx& C, int l) {
    const int gw = C.bid * NWAVES + C.wave; if (gw >= 2048) return;
    const int t = hsh(gw, 18) % T; const bf16* X1 = (const bf16*)(A.ws + WS_XNB); const bf16* YP = (const bf16*)(A.ws + WS_PROJ);
    const v4u s = ((const v4u*)(A.ws + SM_SEL))[t]; const int p0 = slot_of(A, l, t, 0), p1 = slot_of(A, l, t, 1);
    const f32x2 gw2 = ((const f32x2*)(A.ws + SM_GW))[t]; const float g0 = gw2[0], g1 = gw2[1];
    float v[16]; float sm = 0.f;
#pragma unroll
    for (int i = 0; i < 16; ++i) { const int c = C.lane + 64 * i; v[i] = ALPHA * bf2f(X1[(size_t)t * D + c]) + g0 * bf2f(YP[(size_t)p0 * D + c]) + g1 * bf2f(YP[(size_t)p1 * D + c]); sm += v[i]; }
    { float sy = 0.f, sx = 0.f;
#pragma unroll
      for (int i = 0; i < 16; ++i) { const int c = C.lane + 64 * i; const float yy = g0 * bf2f(YP[(size_t)p0 * D + c]) + g1 * bf2f(YP[(size_t)p1 * D + c]); const float xx = ALPHA * bf2f(X1[(size_t)t * D + c]); sy += yy * yy; sx += xx * xx; }
      sy = wave_sum(sy); sx = wave_sum(sx); const float ratio = sqrtf(sy / sx);
      if (C.lane == 0) atomicMax((unsigned*)(A.ws + SM_ERR) + 20, __builtin_bit_cast(unsigned, ratio));
      float sxn = 0.f, shid = 0.f, syp = 0.f; const bf16* XNb = (const bf16*)(A.ws + WS_XN); const bf16* HIDb = (const bf16*)(A.ws + WS_HID);
#pragma unroll
      for (int i = 0; i < 16; ++i) { const int c = C.lane + 64 * i; const float a = bf2f(YP[(size_t)p0 * D + c]); syp += a * a; }
#pragma unroll
      for (int i = 0; i < 8; ++i) { const int c = C.lane + 64 * i; const float a = bf2f(HIDb[(size_t)p0 * DEXP + c]); shid += a * a; }
      syp = sqrtf(wave_sum(syp) / D); shid = sqrtf(wave_sum(shid) / DEXP);
      if (C.lane == 0) { atomicMax((unsigned*)(A.ws + SM_ERR) + 21, __builtin_bit_cast(unsigned, syp)); atomicMax((unsigned*)(A.ws + SM_ERR) + 22, __builtin_bit_cast(unsigned, shid)); atomicMax((unsigned*)(A.ws + SM_ERR) + 23, __builtin_bit_cast(unsigned, g0 + g1)); atomicMax((unsigned*)(A.ws + SM_ERR) + 24, s.z); atomicMax((unsigned*)(A.ws + SM_ERR) + 25, s.w); atomicMax((unsigned*)(A.ws + SM_ERR) + 26, s.x); } }
    const float mean = wave_sum(sm) / D; float q2 = 0.f;
#pragma unroll
    for (int i = 0; i < 16; ++i) { v[i] -= mean; q2 += v[i] * v[i]; }
    const float rstd = 1.0f / sqrtf(wave_sum(q2) / D + LN_EPS);
    const int c = C.lane + 64 * 5; const float r = v[5] * rstd * A.in[20][(size_t)l * D + c] + A.in[21][(size_t)l * D + c];
    err_put(A, 12, r, (l == NLAYER - 1) ? A.out[(size_t)t * D + c] : bf2f(((const bf16*)(A.ws + WS_XN))[(size_t)t * D + c]), 1.0f);
}
DI void probe_gates(const Args& A, const Ctx& C, int slot) {
    const int gt = C.bid * NTHREADS + C.tid; if (gt >= 4096) return;
    const int t = hsh(gt, 30) % T; const v4u s = ((const v4u*)(A.ws + SM_SEL))[t];
    const f32x2 gw2 = ((const f32x2*)(A.ws + SM_GW))[t];
    atomicMax((unsigned*)(A.ws + SM_ERR) + slot, __builtin_bit_cast(unsigned, gw2[0] + gw2[1]));
    { const float sm = gw2[0] + gw2[1]; if (!(fabsf(sm - 1.0f) < 1e-3f)) atomicAdd((unsigned*)(A.ws + SM_ERR) + slot + 8, 1u); }
}
DI void dbg_finish(const Args& A, const Ctx& C) {
    const unsigned* E = (const unsigned*)(A.ws + SM_ERR);
    const float tol[13] = {0, 1e-3f, 0.03f, 0.04f, 0.04f, 0.08f, 0.03f, 0.01f, 0, 0.04f, 0.04f, 0, 0.01f};
    int code = 0;
#pragma unroll
    for (int k = 12; k >= 1; --k) { bool bad;
        if (k == 8) bad = E[8] > 20u; else if (k == 11) bad = E[11] > 0u; else bad = __builtin_bit_cast(float, E[k]) > tol[k];
        if (bad) code = k; }
    const float cv = (float)(code + DBG_BIAS);
    for (size_t i = (size_t)C.bid * NTHREADS + C.tid; i < (size_t)T * D; i += (size_t)GRID * NTHREADS) A.out[i] = cv;
}
#endif
__global__ void __launch_bounds__(NTHREADS, 2) fwd_kernel(Args A0) {
    extern __shared__ __attribute__((aligned(16))) unsigned char lds_raw[];
    Ctx CK; CK.lds = (LAS unsigned char*)lds_raw; CK.tid = threadIdx.x; CK.lane = CK.tid & 63; CK.wave = __builtin_amdgcn_readfirstlane(CK.tid >> 6); CK.bid = blockIdx.x;
    for (int u = CK.tid; u < (LDS_BYTES - LDSCTL_OFF) / 4; u += NTHREADS) ((LAS unsigned*)(CK.lds + LDSCTL_OFF))[u] = 0u;
    __syncthreads();
    unsigned* ctl = (unsigned*)(A0.ws + WS_CTL);
    XcdBarrier bar = xcd_barrier_post(ctl + CW_BAR, (volatile LAS unsigned*)(CK.lds + MISC_OFF) + 8);
#define GRID_BAR() xcd_barrier<false>(bar)
#if DBG_TIME
#define TS(k) do { if (l == TIME_LAYER && CK.bid == 0 && CK.tid == 0) ((unsigned long long*)(A0.ws + WS_CTL + 12288))[k] = __builtin_amdgcn_s_memrealtime(); } while (0)
#else
#define TS(k) do { } while (0)
#endif
#define FRESH() Args A; { int z_ = 0; asm volatile("" : "+s"(z_)); _Pragma("unroll") for (int k_ = 0; k_ < 22; ++k_) A.in[k_] = A0.in[k_] + z_; A.out = A0.out + z_; A.ws = A0.ws + z_; } const Ctx C = fresh_ctx(CK)
    { FRESH(); phase_prologue_rows(A, C); }
    xcd_barrier<true>(bar);
#if DBG_CHECK
    if (DBG_LAYER == 0) { FRESH(); chk_gates(A, C, 0, A.in[0]); }
#endif
    for (int l = 0; l < NLAYER_RUN; ++l) {
        TS(0);
        { FRESH(); phase_convert(A, C, l); }
        GRID_BAR(); TS(1);
#if DUP_THIN
        { FRESH(); phase_convert(A, C, l); }
        GRID_BAR(); TS(1);
#endif

        {
            FRESH(); pg8::Gemm g{(const pg8::bf16_t*)(A.ws + WS_XN), (const pg8::bf16_t*)(A.ws + WS_WIN), T, NPROJ, D}; pg8::StaticOrder S; S.init(T, NPROJ, GRID, C.bid);
            pg8::EpiStoreBf16 E{(pg8::bf16_t*)(A.ws + WS_PROJ), NPROJ, (const float*)(A.ws + SM_BIAS), 0xffff};
            pg8::gemm_phase<pg8::EpiStoreBf16, pg8::StaticOrder, true, true>(C.lds, g, S, E);
        }
        GRID_BAR(); TS(2);
#if DBG_CHECK
        if (l == DBG_LAYER) { FRESH(); chk_proj(A, C, l); }
#endif
        { FRESH(); for (int un = C.bid; un < NUNIT; un += GRID) mlstm_local_mfma(A, C, un); } TS(3);
        { FRESH(); for (int gu = C.bid; gu < 512; gu += GRID) gmlp_unit_mfma(A, C, l, gu); } TS(4);
        { FRESH(); for (int cu = C.bid; cu < T / 32; cu += GRID) conv_unit(A, C, l, cu); }
        GRID_BAR(); TS(5);
#if DUP_MIX
        { FRESH(); for (int un = C.bid; un < NUNIT; un += GRID) mlstm_local_mfma(A, C, un); } TS(3);
        { FRESH(); for (int gu = C.bid; gu < 512; gu += GRID) gmlp_unit_mfma(A, C, l, gu); } TS(4);
        { FRESH(); for (int cu = C.bid; cu < T / 32; cu += GRID) conv_unit(A, C, l, cu); }
        GRID_BAR(); TS(5);
#endif

        { FRESH(); phase_scan(A, C); }
        GRID_BAR(); TS(6);
#if DUP_THIN
        { FRESH(); phase_scan(A, C); }
        GRID_BAR(); TS(6);
#endif

        { FRESH(); for (int un = C.bid; un < NUNIT; un += GRID) mlstm_out_mfma(A, C, l, un); }
        GRID_BAR(); TS(7);
#if DUP_MIX
        { FRESH(); for (int un = C.bid; un < NUNIT; un += GRID) mlstm_out_mfma(A, C, l, un); }
        GRID_BAR(); TS(7);
#endif

#if DBG_CHECK
        if (l == DBG_LAYER) { FRESH(); chk_conv(A, C, l); chk_gmlp(A, C, l); chk_mlstm(A, C, l); GRID_BAR(); }
#endif
        {
            FRESH(); pg8::Gemm g{(const pg8::bf16_t*)(A.ws + WS_HCAT), (const pg8::bf16_t*)(A.ws + WS_WOUT), T, D, D}; pg8::StaticOrder S; S.init(T, D, GRID, C.bid);
            pg8::EpiStoreBf16 E{(pg8::bf16_t*)(A.ws + WS_PROJ), D, nullptr, 0xffff};
            pg8::gemm_phase<pg8::EpiStoreBf16, pg8::StaticOrder, true, true>(C.lds, g, S, E);
        }
        GRID_BAR(); TS(8);
#if DBG_CHECK
        if (l == DBG_LAYER) { FRESH(); chk_y(A, C, l); GRID_BAR(); }
#endif
        { FRESH(); phase_ln1_router(A, C, l); }
        GRID_BAR(); TS(9);
#if DUP_THIN
        { FRESH(); phase_ln1_router(A, C, l); }
        GRID_BAR(); TS(9);
#endif

#if DBG_CHECK
        if (l == DBG_LAYER) { FRESH(); chk_ln1(A, C, l, (const bf16*)(A.ws + WS_XN)); probe_gates(A, C, 27); GRID_BAR(); }
#endif


        {
            FRESH(); pg8::MoeOrder<true> S{(const unsigned*)(A.ws + WS_CTL) + CW_CNT + l * 256, (const int*)(A.ws + WS_LIST), GRID, C.bid, D * 2};
            pg8::Gemm g{(const pg8::bf16_t*)(A.ws + WS_XNB), (const pg8::bf16_t*)(A.ws + WS_WGU), PADROWS, NEXP * 1024, D};
            pg8::EpiSwiGLU E{(pg8::bf16_t*)(A.ws + WS_HID), DEXP};
            pg8::gemm_phase<pg8::EpiSwiGLU, pg8::MoeOrder<true>, true, true>(C.lds, g, S, E);
        }
        GRID_BAR(); TS(11);
#if DBG_CHECK
        if (l == DBG_LAYER) { FRESH(); chk_hid(A, C, l); probe_gates(A, C, 29); }
#endif
        {
            FRESH(); pg8::MoeOrder<false> S{(const unsigned*)(A.ws + WS_CTL) + CW_CNT + l * 256, (const int*)(A.ws + WS_LIST), GRID, C.bid, 0};
            pg8::Gemm g{(const pg8::bf16_t*)(A.ws + WS_HID), (const pg8::bf16_t*)(A.ws + WS_WD), PADROWS, NEXP * 1024, DEXP};
            pg8::EpiStoreBf16 E{(pg8::bf16_t*)(A.ws + WS_PROJ), D, nullptr, 3};
            pg8::gemm_phase<pg8::EpiStoreBf16, pg8::MoeOrder<false>, true, true>(C.lds, g, S, E);
        }
        GRID_BAR(); TS(12);
#if DBG_CHECK
        if (l == DBG_LAYER) { FRESH(); chk_yp(A, C, l); probe_gates(A, C, 30); }
#endif
        { FRESH(); phase_combine(A, C, l); }
        GRID_BAR(); TS(13);
#if DUP_THIN
        { FRESH(); phase_combine(A, C, l); }
        GRID_BAR(); TS(13);
#endif

#if DBG_CHECK
        if (l == DBG_LAYER) { FRESH(); chk_out(A, C, l);  GRID_BAR(); }
#endif
    }
#if DBG_CHECK
    { FRESH(); dbg_finish(A, C); }
#endif
#if DBG_TIME
    { FRESH(); const unsigned long long* tsb = (const unsigned long long*)(A.ws + WS_CTL + 12288);
      const float c1 = floorf((float)(tsb[TIME_A] - tsb[TIME_A - 1]) / 200.0f + 0.5f), k2 = floorf((float)(tsb[TIME_B] - tsb[TIME_B - 1]) / 400.0f + 0.5f);
      for (size_t i = (size_t)C.bid * NTHREADS + C.tid; i < (size_t)T * D; i += (size_t)GRID * NTHREADS) A.out[i] = (i == 0) ? (1000.0f + 100.0f * k2) : c1; }
#endif
}

extern "C" void kernel_launch(void* const* d_in, const int* in_sizes, int n_in, void* d_out, int out_size, void* d_ws, size_t ws_size, hipStream_t stream) {
    static int ready = 0;
    if (ready == 0) {
        if (n_in != 22 || in_sizes[0] != T * D || out_size != T * D || ws_size < WS_END) { fprintf(stderr, "kernel_launch: unexpected shapes (n_in %d, in0 %d, out %d, ws %zu)\n", n_in, n_in > 0 ? in_sizes[0] : -1, out_size, ws_size); ready = -1; return; }
        if (hipFuncSetAttribute((const void*)fwd_kernel, hipFuncAttributeMaxDynamicSharedMemorySize, LDS_BYTES) != hipSuccess) { fprintf(stderr, "kernel_launch: hipFuncSetAttribute failed\n"); ready = -1; return; }
        (void)hipGetLastError();
        ready = 1;
    }
    if (ready < 0) return;
    if (hipMemsetAsync((char*)d_ws + WS_CTL, 0, CTL_ZERO_BYTES, stream) != hipSuccess) return;
    Args a{};
    for (int i = 0; i < 22; ++i) a.in[i] = (const float*)d_in[i];
    a.out = (float*)d_out; a.ws = (unsigned char*)d_ws;
    hipLaunchKernelGGL(fwd_kernel, dim3(GRID), dim3(NTHREADS), LDS_BYTES, stream, a);
}
```

```cpp
#include <hip/hip_runtime.h>
#include <cstdio>
#include <cstdint>
namespace pg8 {
#define PG8_LAS __attribute__((address_space(3)))
typedef unsigned short bf16_t;
typedef short bf16x8 __attribute__((ext_vector_type(8)));
typedef float f32x4 __attribute__((ext_vector_type(4)));
typedef unsigned u32x4 __attribute__((ext_vector_type(4)));
constexpr int BM = 256, BK = 64, HALF = 128, HTB = HALF * BK * 2  , STAGE_BYTES = 8 * HTB, NXCD = 8, WGM = 8;

__host__ __device__ __forceinline__ int lds_byte(int r, int c) { const int st = (r >> 4) * 2 + (c >> 5), rr = r & 15, cc = c & 31, ob = rr * 64 + cc * 2; return st * 1024 + (ob ^ (((ob >> 9) & 1) << 5)); }
__host__ __device__ __forceinline__ void stage_rc(int b, int& R, int& C) { const int st = b / 1024, sb = b % 1024, swz = sb ^ (((sb >> 9) & 1) << 5); R = (st >> 1) * 16 + swz / 64; C = (st & 1) * 32 + (swz % 64) / 2; }
__host__ __device__ __forceinline__ int perm32(int rho) { const int n = rho >> 4, i = rho & 15; return 8 * (i >> 2) + 4 * n + (i & 3); }

struct Unit { int pm, pn, e, r0, cnt; };
struct Gemm { const bf16_t* A; const bf16_t* Bt; int M, N, K; };

struct StaticOrder {
    static constexpr bool GATHER = false;
    int nM, nN, nwg, G, c;
    __device__ __forceinline__ unsigned a_off(const Unit&, int) const { return 0u; }
    __host__ __device__ void init(int M, int N, int G_, int c_) { nM = M / BM; nN = N / BM; nwg = nM * nN; G = G_; c = c_; }
    __host__ __device__ bool next(int i, Unit& u) const {
        const long L = (long)i * G + c; if (L >= nwg) return false;
        int wgid = (int)L; { const int q = nwg / NXCD, r = nwg % NXCD, xcd = wgid % NXCD, off = wgid / NXCD; wgid = (xcd < r ? xcd * (q + 1) : r * (q + 1) + (xcd - r) * q) + off; }
        const int nig = WGM * nN, gid = wgid / nig, fm = gid * WGM, gsz = (nM - fm) < WGM ? (nM - fm) : WGM;
        u.pm = fm + ((wgid % nig) % gsz); u.pn = (wgid % nig) / gsz; return true;
    }
    __device__ __forceinline__ void a_ready(const Unit&) const {}
    __device__ __forceinline__ void done(const Unit&) const {}
};
template <bool GATH> struct MoeOrder {
    static constexpr bool GATHER = GATH;
    const unsigned* cnt; const int* list; int G, c, rowbytes;
    __device__ __forceinline__ bool next(int i, Unit& u) const {
        const int L = i * G + c, rt = L >> 2; int acc = 0; bool found = false; u.pm = rt; u.pn = 0; u.e = 0; u.r0 = 0; u.cnt = 0;
#pragma unroll
        for (int e = 0; e < 16; ++e) { const int n = (int)__builtin_amdgcn_readfirstlane(__hip_atomic_load(cnt + 16 * e, __ATOMIC_RELAXED, __HIP_MEMORY_SCOPE_AGENT)); const int nt = (n + 255) >> 8;
            if (!found && rt < acc + nt) { found = true; u.e = e; u.r0 = (rt - acc) * 256; u.cnt = n; u.pn = e * 4 + (L & 3); }
            acc += nt; }
        return found;
    }
    __device__ __forceinline__ unsigned a_off(const Unit& u, int row) const { const int pos = u.r0 + row; const int tok = pos < u.cnt ? list[(size_t)u.e * 16384 + pos] : 0; return (unsigned)tok * (unsigned)rowbytes; }
    __device__ __forceinline__ void a_ready(const Unit&) const {}
    __device__ __forceinline__ void done(const Unit&) const {}
};

__device__ __forceinline__ unsigned cvt_pk_bf16(float lo, float hi) { unsigned r; asm volatile("v_cvt_pk_bf16_f32 %0, %1, %2" : "=v"(r) : "v"(lo), "v"(hi)); return r; }

struct EpiStoreBf16 {
    static constexpr bool PERM = true, AFTER_DRAIN = false;
    bf16_t* O; int ldc; const float* bias; int pn_mask;
    __device__ __forceinline__ void operator()(const f32x4 (&acc)[2][2][4][2], const Unit& u, int wr, int wc, int fr, int fq) const {
        const int row0 = u.pm * BM + wr * 64 + fr; const int col0 = (u.pn & pn_mask) * BM + wc * 32 + 8 * fq;
        f32x4 bv[2][2];
#pragma unroll
        for (int bj = 0; bj < 2; ++bj)
#pragma unroll
            for (int n = 0; n < 2; ++n) bv[bj][n] = bias ? *(const f32x4*)(bias + col0 + bj * HALF + 4 * n) : (f32x4){0.f, 0.f, 0.f, 0.f};
#pragma unroll
        for (int ai = 0; ai < 2; ++ai)
#pragma unroll
            for (int m = 0; m < 4; ++m) { bf16_t* rowp = O + (size_t)(row0 + ai * HALF + m * 16) * ldc + col0;
#pragma unroll
                for (int bj = 0; bj < 2; ++bj) { const f32x4 v0 = acc[ai][bj][m][0] + bv[bj][0], v1 = acc[ai][bj][m][1] + bv[bj][1];
                    u32x4 w; w.x = cvt_pk_bf16(v0[0], v0[1]); w.y = cvt_pk_bf16(v0[2], v0[3]); w.z = cvt_pk_bf16(v1[0], v1[1]); w.w = cvt_pk_bf16(v1[2], v1[3]);
                    *(u32x4*)(rowp + bj * HALF) = w; } }
    }
};
struct EpiSwiGLU {
    static constexpr bool PERM = true, AFTER_DRAIN = false;
    bf16_t* O; int ldc;
    __device__ __forceinline__ void operator()(const f32x4 (&acc)[2][2][4][2], const Unit& u, int wr, int wc, int fr, int fq) const {
        const int row0 = u.pm * BM + wr * 64 + fr; const int col0 = (u.pn & 3) * HALF + wc * 32 + 8 * fq;
#pragma unroll
        for (int ai = 0; ai < 2; ++ai)
#pragma unroll
            for (int m = 0; m < 4; ++m) { bf16_t* rowp = O + (size_t)(row0 + ai * HALF + m * 16) * ldc + col0;
                float h[8];
#pragma unroll
                for (int n = 0; n < 2; ++n)
#pragma unroll
                    for (int k = 0; k < 4; ++k) { const float g = acc[ai][0][m][n][k], up = acc[ai][1][m][n][k]; h[4 * n + k] = g * up / (1.0f + __expf(-g)); }
                u32x4 w; w.x = cvt_pk_bf16(h[0], h[1]); w.y = cvt_pk_bf16(h[2], h[3]); w.z = cvt_pk_bf16(h[4], h[5]); w.w = cvt_pk_bf16(h[6], h[7]);
                *(u32x4*)rowp = w; }
    }
};
template <class Epi, class Sched, bool ALIGN_EPI = false, bool SP2 = false>
__device__ __forceinline__ void gemm_phase(PG8_LAS unsigned char* lds, const Gemm g, const Sched& S, const Epi& E) {
    int tid_l = threadIdx.x; asm volatile("" : "+v"(tid_l)); const int tid = tid_l, wid = __builtin_amdgcn_readfirstlane(tid >> 6), lane = tid & 63, wr = wid >> 2, wc = wid & 3, fr = lane & 15, fq = lane >> 4;
    const int K = g.K, nt = K / BK;
    unsigned voffA[2], voffB[2];
#pragma unroll
    for (int i = 0; i < 2; ++i) { int R, C; stage_rc(tid * 16 + i * 8192, R, C); const int Rb = Epi::PERM ? ((R & ~31) + perm32(R & 31)) : R;
        voffA[i] = (unsigned)(R * K + C) * 2u; voffB[i] = (unsigned)(Rb * K + C) * 2u; }
    unsigned cv0[2] = {voffA[0], voffA[1]}, cv1[2] = {voffA[0], voffA[1]};
#define PG8_GOFF(u, d0, d1) do { _Pragma("unroll") for (int _i = 0; _i < 2; ++_i) { int R_, C_; stage_rc(tid * 16 + _i * 8192, R_, C_); d0[_i] = S.a_off(u, R_) + (unsigned)(C_ * 2); d1[_i] = S.a_off(u, HALF + R_) + (unsigned)(C_ * 2); } } while (0)
    const size_t kstep = (size_t)(BK * 2);
    const size_t hstep = (size_t)HALF * K * 2;
    const size_t tstep = 2 * hstep;
    const unsigned ldsw = (unsigned)wid * 1024u;
    const int aoff = lds_byte(wr * 64 + fr, fq * 8), boff = lds_byte(wc * 32 + fr, fq * 8);
#define PG8_SA(b, h) (((b) * 2 + (h)) * HTB)
#define PG8_SB(b, h) ((4 + (b) * 2 + (h)) * HTB)
#define PG8_STAGE(bufoff, gbase, voff) do { _Pragma("unroll") for (int _i = 0; _i < 2; ++_i) \
        __builtin_amdgcn_global_load_lds((const unsigned*)((const char*)(gbase) + (voff)[_i]), (PG8_LAS unsigned*)(lds + (bufoff) + ldsw + _i * 8192), 16, 0, 0); } while (0)
#define PG8_LDA(dst, b, h) do { _Pragma("unroll") for (int m = 0; m < 4; ++m) _Pragma("unroll") for (int k = 0; k < 2; ++k) dst[m][k] = *(const PG8_LAS bf16x8*)(lds + PG8_SA(b, h) + aoff + m * 2048 + k * 1024); } while (0)
#define PG8_LDB(dst, b, h) do { _Pragma("unroll") for (int n = 0; n < 2; ++n) _Pragma("unroll") for (int k = 0; k < 2; ++k) dst[n][k] = *(const PG8_LAS bf16x8*)(lds + PG8_SB(b, h) + boff + n * 2048 + k * 1024); } while (0)
#define PG8_MMA(ai, bj, At, Bt) do { __builtin_amdgcn_s_setprio(1); _Pragma("unroll") for (int m = 0; m < 4; ++m) _Pragma("unroll") for (int n = 0; n < 2; ++n) _Pragma("unroll") for (int k = 0; k < 2; ++k) \
        acc[ai][bj][m][n] = __builtin_amdgcn_mfma_f32_16x16x32_bf16(Bt[n][k], At[m][k], acc[ai][bj][m][n], 0, 0, 0); __builtin_amdgcn_s_setprio(0); } while (0)
#define PG8_WAIT_V(n) asm volatile("s_waitcnt vmcnt(" #n ")" ::: "memory")
#define PG8_WAIT_L(n) asm volatile("s_waitcnt lgkmcnt(" #n ")" ::: "memory")
#define PG8_BAR __builtin_amdgcn_s_barrier()
#define PG8_SCHED __builtin_amdgcn_sched_barrier(0)
    Unit cur, nxt; int ui = 0;
    if (!S.next(0, cur)) return;
    f32x4 acc[2][2][4][2];
#pragma unroll
    for (int a = 0; a < 2; ++a)
#pragma unroll
        for (int b = 0; b < 2; ++b)
#pragma unroll
            for (int m = 0; m < 4; ++m)
#pragma unroll
                for (int n = 0; n < 2; ++n) acc[a][b][m][n] = (f32x4){0.f, 0.f, 0.f, 0.f};
    bf16x8 At[4][2], B0[2][2], B1[2][2];
    const char* cA = Sched::GATHER ? (const char*)g.A : (const char*)g.A + (size_t)cur.pm * tstep; const char* cB = (const char*)g.Bt + (size_t)cur.pn * tstep;
    const size_t hstepA = Sched::GATHER ? 0 : hstep;
    if constexpr (Sched::GATHER) { static_assert(SP2, "gather is wired into the SP2 loop only"); PG8_GOFF(cur, cv0, cv1); }
    S.a_ready(cur);
    if constexpr (SP2) {
        PG8_STAGE(PG8_SB(0, 0), cB, voffB); PG8_STAGE(PG8_SB(0, 1), cB + hstep, voffB); PG8_STAGE(PG8_SA(0, 0), cA, cv0); PG8_STAGE(PG8_SA(0, 1), cA + hstepA, cv1);
        if (wr == 1) PG8_BAR;
        PG8_WAIT_V(2); PG8_BAR;
        PG8_STAGE(PG8_SB(1, 0), cB + kstep, voffB); PG8_STAGE(PG8_SA(1, 0), cA + kstep, cv0); PG8_STAGE(PG8_SB(1, 1), cB + hstep + kstep, voffB);
        PG8_WAIT_V(6); PG8_BAR;
    } else {
        PG8_STAGE(PG8_SB(0, 0), cB, voffB); PG8_STAGE(PG8_SA(0, 0), cA, voffA); PG8_STAGE(PG8_SB(0, 1), cB + hstep, voffB); PG8_STAGE(PG8_SA(0, 1), cA + hstep, voffA);
        if (wr == 1) PG8_BAR;
        PG8_WAIT_V(4); PG8_BAR;
        PG8_STAGE(PG8_SB(1, 0), cB + kstep, voffB); PG8_STAGE(PG8_SA(1, 0), cA + kstep, voffA); PG8_STAGE(PG8_SB(1, 1), cB + hstep + kstep, voffB);
        PG8_WAIT_V(6); PG8_BAR;
    }
    for (;;) {
        const bool has_next = S.next(ui + 1, nxt);
        const char* nA = Sched::GATHER ? (const char*)g.A : (has_next ? (const char*)g.A + (size_t)nxt.pm * tstep : cA); const char* nB = has_next ? (const char*)g.Bt + (size_t)nxt.pn * tstep : cB;
        for (int t = 0; t < nt; t += 2) {
            const bool last = (t == nt - 2);
            const char* a1 = cA + (size_t)(t + 1) * kstep;
            const char* a2 = last ? nA : cA + (size_t)(t + 2) * kstep; const char* b2 = last ? nB : cB + (size_t)(t + 2) * kstep;
            const char* a3 = a2 + kstep; const char* b3 = b2 + kstep;
            if (last && has_next) S.a_ready(nxt);
            if constexpr (SP2) {
            PG8_LDB(B0, 0, 0); PG8_LDB(B1, 0, 1); PG8_SCHED; PG8_LDA(At, 0, 0); PG8_STAGE(PG8_SA(1, 1), a1 + hstepA, cv1);
            if constexpr (Sched::GATHER) { if (last && has_next) { PG8_GOFF(nxt, cv0, cv1); } }
            PG8_WAIT_V(8); PG8_WAIT_L(0); PG8_BAR; PG8_MMA(0, 0, At, B0); PG8_MMA(0, 1, At, B1); PG8_BAR; PG8_SCHED;
            PG8_LDA(At, 0, 1); PG8_STAGE(PG8_SB(0, 0), b2, voffB); PG8_STAGE(PG8_SB(0, 1), b2 + hstep, voffB); PG8_STAGE(PG8_SA(0, 0), a2, cv0);
            PG8_WAIT_V(8); PG8_WAIT_L(0); PG8_BAR; PG8_MMA(1, 0, At, B0); PG8_MMA(1, 1, At, B1); PG8_BAR; PG8_SCHED;
            PG8_LDB(B0, 1, 0); PG8_LDB(B1, 1, 1); PG8_SCHED; PG8_LDA(At, 1, 0); PG8_STAGE(PG8_SA(0, 1), a2 + hstepA, cv1);
            PG8_WAIT_V(8); PG8_WAIT_L(0); PG8_BAR; PG8_MMA(0, 0, At, B0); PG8_MMA(0, 1, At, B1); PG8_BAR; PG8_SCHED;
            PG8_LDA(At, 1, 1); PG8_STAGE(PG8_SB(1, 0), b3, voffB); PG8_STAGE(PG8_SB(1, 1), b3 + hstep, voffB); PG8_STAGE(PG8_SA(1, 0), a3, cv0);
            PG8_WAIT_V(8); PG8_WAIT_L(0); PG8_BAR; PG8_MMA(1, 0, At, B0); PG8_MMA(1, 1, At, B1); PG8_BAR; PG8_SCHED;
            } else {
            PG8_LDB(B0, 0, 0); PG8_SCHED; PG8_LDA(At, 0, 0); PG8_STAGE(PG8_SA(1, 1), a1 + hstep, voffA);
            PG8_WAIT_L(8); PG8_BAR; PG8_WAIT_L(0); PG8_MMA(0, 0, At, B0); PG8_BAR; PG8_SCHED;
            PG8_LDB(B1, 0, 1); PG8_STAGE(PG8_SB(0, 0), b2, voffB);
            PG8_BAR; PG8_WAIT_L(0); PG8_MMA(0, 1, At, B1); PG8_BAR;
            PG8_LDA(At, 0, 1); PG8_STAGE(PG8_SA(0, 0), a2, voffA);
            PG8_BAR; PG8_WAIT_L(0); PG8_MMA(1, 0, At, B0); PG8_BAR; PG8_SCHED;
            PG8_STAGE(PG8_SB(0, 1), b2 + hstep, voffB);
            PG8_WAIT_V(6); PG8_BAR; PG8_MMA(1, 1, At, B1); PG8_BAR;
            PG8_LDB(B0, 1, 0); PG8_SCHED; PG8_LDA(At, 1, 0); PG8_STAGE(PG8_SA(0, 1), a2 + hstep, voffA);
            PG8_WAIT_L(8); PG8_BAR; PG8_WAIT_L(0); PG8_MMA(0, 0, At, B0); PG8_BAR; PG8_SCHED;
            PG8_LDB(B1, 1, 1); PG8_STAGE(PG8_SB(1, 0), b3, voffB);
            PG8_BAR; PG8_WAIT_L(0); PG8_MMA(0, 1, At, B1); PG8_BAR;
            PG8_LDA(At, 1, 1); PG8_STAGE(PG8_SA(1, 0), a3, voffA);
            PG8_BAR; PG8_WAIT_L(0); PG8_MMA(1, 0, At, B0); PG8_BAR; PG8_SCHED;
            PG8_STAGE(PG8_SB(1, 1), b3 + hstep, voffB);
            PG8_WAIT_V(6); PG8_BAR; PG8_MMA(1, 1, At, B1); PG8_BAR;
            }
        }
        if constexpr (ALIGN_EPI) { if (wr == 0) PG8_BAR; }
        if constexpr (!Epi::AFTER_DRAIN) { E(acc, cur, wr, wc, fr, fq); S.done(cur); }
        if (!has_next) break;
#pragma unroll
        for (int a = 0; a < 2; ++a)
#pragma unroll
            for (int b = 0; b < 2; ++b)
#pragma unroll
                for (int m = 0; m < 4; ++m)
#pragma unroll
                    for (int n = 0; n < 2; ++n) acc[a][b][m][n] = (f32x4){0.f, 0.f, 0.f, 0.f};
        cur = nxt; cA = nA; cB = nB; ++ui;
        if constexpr (ALIGN_EPI) { if (wr == 1) PG8_BAR; }
    }
    PG8_WAIT_V(0);
    if constexpr (!ALIGN_EPI) { if (wr == 0) PG8_BAR; }
    PG8_BAR;
    if constexpr (Epi::AFTER_DRAIN) { E.fused(acc, cur, wr, wc, fr, fq, lds, wid, lane); S.done(cur); }
#undef PG8_SA
#undef PG8_SB
#undef PG8_STAGE
#undef PG8_LDA
#undef PG8_LDB
#undef PG8_MMA
#undef PG8_WAIT_V
#undef PG8_WAIT_L
#undef PG8_BAR
#undef PG8_SCHED
#undef PG8_GOFF
}
}
#ifndef DBG_CHECK
#define DBG_CHECK 0
#endif
#define DBG_LAYER 0
#ifndef DBG_TIME
#define DBG_TIME 0
#endif
#define TIME_LAYER 1
#define DUP_CONV 0
#define DUP_SCAN 0
#define DUP_P10 0
#define DUP_P6 0
#define DUP_P2 0
#define DUP_P4 0
#define DUP_G1 0
#define DUP_G5 0
#define DUP_G8 0
#define DUP_G9 0
#define TIME_A 9
#define TIME_B 2
#define TIME_OFF 0
#define DBG_BIAS 0
constexpr int NWAVES = 8, NTHREADS = 512, GRID = 256;
constexpr int NLAYER_RUN = DBG_CHECK ? (DBG_LAYER + 1) : 4;
constexpr int T = 16384, D = 1024, SEQ = 4096, NLAYER = 4;
constexpr int PIN = 3080, NPROJ = 3072;
constexpr int CH = 128, NCH = 32, NUNIT = 512;
constexpr int NEXP = 16, DEXP = 512;
constexpr int PADROWS = 36864;
constexpr float ALPHA = 1.6817928305074290f;
constexpr float LN_EPS = 1e-5f;
constexpr int PQ = 0, PK = 512, PV = 1024, PO = 1536, PGU = 2048, PGV = 2304, PCA = 2560, PCB = 2816;
constexpr size_t MiB = 1u << 20;
constexpr size_t WS_CTL = 0, CTL_ZERO_BYTES = 1 * MiB;
constexpr size_t WS_WIN = 2 * MiB, WS_WOUT = 8 * MiB, WS_WGU = 10 * MiB, WS_WD = 42 * MiB;
constexpr size_t WS_SMALL = 58 * MiB;
constexpr size_t SM_BIAS = WS_SMALL;
constexpr size_t SM_GATES = WS_SMALL + 64 * 1024;
constexpr size_t SM_SEL = SM_GATES + 512 * 1024;
constexpr size_t SM_HIST = SM_SEL + 256 * 1024;
constexpr size_t SM_META = SM_HIST + 16 * 1024;
constexpr size_t SM_TOKSLOT = SM_META + 4 * 1024;
constexpr size_t SM_G = SM_TOKSLOT + 128 * 1024;
constexpr size_t SM_MLOC = SM_G + 2048;
constexpr size_t SM_MPREV = SM_MLOC + 2048;
constexpr size_t SM_NLOC = SM_MPREV + 2048;
constexpr size_t SM_NPREV = SM_NLOC + 256 * 1024;
constexpr size_t SM_END = SM_NPREV + 256 * 1024;
constexpr size_t SM_WM = SM_END + 128 * 1024;
constexpr size_t SM_GW = SM_END;
static_assert(SM_WM + 128 * 1024 <= 62 * MiB, "small region");
constexpr size_t WS_XN = 62 * MiB, WS_HCAT = 94 * MiB, WS_XNB = 126 * MiB, WS_CLOCT = 190 * MiB, WS_CPREVT = 222 * MiB, WS_HID = 238 * MiB;
constexpr size_t WS_PROJ = 274 * MiB;
constexpr size_t WS_END = 370 * MiB;
static_assert(WS_HID + (size_t)PADROWS * DEXP * 2 <= WS_PROJ && WS_PROJ + (size_t)PADROWS * D * 2 <= WS_END && WS_PROJ + (size_t)T * NPROJ * 2 <= WS_END, "ws map");
constexpr int CW_TMO = 0, CW_BAR = 4096, CW_CNT = 8192;
constexpr size_t WS_LIST = 158 * MiB;
constexpr int RING_BYTES = 131072, LDSCTL_OFF = 139264, MISC_OFF = LDSCTL_OFF + 320, PTR_OFF = LDSCTL_OFF + 512, VEC_OFF = LDSCTL_OFF + 1024, LDS_BYTES = 151552;

#define LAS __attribute__((address_space(3)))
typedef unsigned short bf16;
typedef unsigned v4u __attribute__((ext_vector_type(4)));
typedef unsigned v2u __attribute__((ext_vector_type(2)));
typedef float f32x4 __attribute__((ext_vector_type(4)));
typedef float f32x2 __attribute__((ext_vector_type(2)));
#define DI __device__ __forceinline__
typedef __bf16 bf16x2_t __attribute__((ext_vector_type(2)));
DI unsigned pk2(float lo, float hi) { const f32x2 v = {lo, hi}; return __builtin_bit_cast(unsigned, __builtin_convertvector(v, bf16x2_t)); }
DI unsigned f2bf(float f) { return pk2(f, 0.f) & 0xffffu; }
DI float bflo(unsigned w) { return __builtin_bit_cast(float, w << 16); }
DI float bfhi(unsigned w) { return __builtin_bit_cast(float, w & 0xffff0000u); }
DI float bf2f(bf16 h) { return __builtin_bit_cast(float, (unsigned)h << 16); }
DI float wave_sum(float v) {
#pragma unroll
    for (int o = 1; o < 64; o <<= 1) v += __shfl_xor(v, o);
    return v;
}
template <int N> DI int red_idx(int lane) { int idx = 0, n = N, o = 32; while (n > 1) { n >>= 1; if (lane & o) idx += n; o >>= 1; } return idx; }
template <int N, int O> struct RedStep { template <int NN> static DI void run(float (&v)[NN], int lane) { const bool up = (lane & O) != 0;
#pragma unroll
        for (int k = 0; k < N / 2; ++k) { const float keep = up ? v[k + N / 2] : v[k], send = up ? v[k] : v[k + N / 2]; v[k] = keep + __shfl_xor(send, O); }
        RedStep<N / 2, O / 2>::run(v, lane); } };
template <int O> struct RedStep<1, O> { template <int NN> static DI void run(float (&v)[NN], int) { v[0] += __shfl_xor(v[0], O); RedStep<1, O / 2>::run(v, 0); } };
template <> struct RedStep<1, 0> { template <int NN> static DI void run(float (&)[NN], int) {} };
template <int N> DI void red_multi(float (&v)[N], int lane) { RedStep<N, 32>::run(v, lane); }
DI float sigmoidf_(float x) { return __builtin_amdgcn_rcpf(1.0f + __builtin_amdgcn_exp2f(-1.4426950408889634f * x)); }
DI float gelu_tanh(float x) { const float t = x * x; const float p = x * __builtin_fmaf(t, -0.10294324f, -2.3022082f); return x * __builtin_amdgcn_rcpf(1.0f + __builtin_amdgcn_exp2f(p)); }
DI float logsigmoidf_(float x) { return fminf(x, 0.0f) - log1pf(__expf(-fabsf(x))); }

#define XB_TMO      128
#define XB_XCNT(j)  (256  + 64 * (j))
#define XB_XSUB(j)  (1280 + 64 * (j))
#define XB_XGEN(j)  (2304 + 64 * (j))
#define XB_TOP      3328
#define XB_TOPGEN   3392
#define XCD_BAR_WORDS 3456
#define XB_SPIN_CAP (1u << 18)
__device__ __forceinline__ unsigned xb_ld(unsigned* p)              { return __hip_atomic_load(p, __ATOMIC_RELAXED, __HIP_MEMORY_SCOPE_AGENT); }
__device__ __forceinline__ unsigned xb_add(unsigned* p, unsigned v) { return __hip_atomic_fetch_add(p, v, __ATOMIC_RELAXED, __HIP_MEMORY_SCOPE_AGENT); }
__device__ __forceinline__ unsigned xb_xcc_id() { return (unsigned)__builtin_amdgcn_s_getreg((3 << 11) | 20) & 0xFu; }
#define XB_SPIN(cond, bar) do { unsigned _sp = 0; while (cond) { __builtin_amdgcn_s_sleep(1); \
    if ((++_sp & 255u) == 0u) { if (xb_ld(&(bar)[XB_TMO])) break; if (_sp > XB_SPIN_CAP) { atomicAdd(&(bar)[XB_TMO], 1u); break; } } } } while (0)
struct XcdBarrier { unsigned* bar; unsigned x; volatile LAS unsigned* st; };
__device__ __forceinline__ XcdBarrier xcd_barrier_post(unsigned* bar, volatile LAS unsigned* st) {
    XcdBarrier b; b.bar = bar; b.x = xb_xcc_id(); b.st = st;
    if (threadIdx.x == 0) (void)xb_add(&bar[XB_XCNT(b.x)], 1u);
    return b;
}
__device__ __forceinline__ void xcd_barrier_complete(unsigned* bar, unsigned x, unsigned& nloc, unsigned& nx) {
    const unsigned G = gridDim.x * gridDim.y * gridDim.z;
    unsigned sum, cnt, mine, sp = 0u;
    for (;;) {
        sum = 0u; cnt = 0u; mine = 0u;
#pragma unroll
        for (unsigned j = 0; j < 16; ++j) { const unsigned c = xb_ld(&bar[XB_XCNT(j)]); sum += c; cnt += (c > 0u) ? 1u : 0u; mine = (j == x) ? c : mine; }
        if (sum == G) break;
        __builtin_amdgcn_s_sleep(1);
        if ((++sp & 255u) == 0u) { if (xb_ld(&bar[XB_TMO])) break; if (sp > XB_SPIN_CAP) { atomicAdd(&bar[XB_TMO], 1u); break; } }
    }
    nloc = mine > 0u ? mine : 1u; nx = cnt > 0u ? cnt : 1u;
}
template <bool FIRST> __device__ __forceinline__ void xcd_barrier(const XcdBarrier& b) {
    asm volatile("s_waitcnt vmcnt(0)" ::: "memory");
    __syncthreads();
    if (threadIdx.x == 0) {
        unsigned* bar = b.bar; unsigned bx = b.x; { int z_ = 0; asm volatile("" : "+s"(z_)); bar += z_; bx += (unsigned)z_; }
        __builtin_amdgcn_s_waitcnt(0);
        unsigned nloc = b.st[0], nx = b.st[1];
        if (FIRST) { if (nloc == 0u) { xcd_barrier_complete(bar, bx, nloc, nx); b.st[0] = nloc; b.st[1] = nx; } }
        const unsigned old = xb_add(&bar[XB_XSUB(bx)], 1u);
        const unsigned gen = old / nloc;
        if (old + 1u == (gen + 1u) * nloc) {
            __builtin_amdgcn_fence(__ATOMIC_RELEASE, "agent");
            asm volatile("s_waitcnt vmcnt(0)" ::: "memory");
            const unsigned og = xb_add(&bar[XB_TOP], 1u);
            const unsigned tg = og / nx;
            if (og + 1u == (tg + 1u) * nx) xb_add(&bar[XB_TOPGEN], 1u);
            else XB_SPIN(xb_ld(&bar[XB_TOPGEN]) == tg, bar);
            __builtin_amdgcn_fence(__ATOMIC_ACQUIRE, "agent");
            xb_add(&bar[XB_XGEN(bx)], 1u);
            asm volatile("s_waitcnt vmcnt(0)" ::: "memory");
        } else {
            XB_SPIN(xb_ld(&bar[XB_XGEN(bx)]) == gen, bar);
            __builtin_amdgcn_fence(__ATOMIC_ACQUIRE, "agent");
            asm volatile("s_waitcnt vmcnt(0)" ::: "memory");
        }
    }
    __syncthreads();
}

struct Args { const float* in[22]; float* out; unsigned char* ws; };
struct Ctx { LAS unsigned char* lds; int tid, lane, wave, bid; };
__device__ __forceinline__ Ctx fresh_ctx(const Ctx& C0) { Ctx C = C0; asm volatile("" : "+v"(C.tid)); asm volatile("" : "+s"(C.bid)); asm volatile("" : "+s"(C.lds)); C.lane = C.tid & 63; C.wave = __builtin_amdgcn_readfirstlane(C.tid >> 6); return C; }

DI void transpose_item(const float* src, int ld, int k0, int n0, bf16* dst, int K, int drow0, LAS float* scr, int lane) {
    float tv[32];
#pragma unroll
    for (int i = 0; i < 32; ++i) tv[i] = src[(size_t)(k0 + 2 * i + (lane >> 5)) * ld + n0 + (lane & 31)];
#pragma unroll
    for (int i = 0; i < 32; ++i) scr[(2 * i + (lane >> 5)) * 33 + (lane & 31)] = tv[i];
    asm volatile("s_waitcnt lgkmcnt(0)" ::: "memory");
    const int c = lane & 7;
#pragma unroll
    for (int j = 0; j < 4; ++j) { const int n = (lane >> 3) + 8 * j; const LAS float* s = scr + (8 * c) * 33 + n;
        v4u o; o.x = pk2(s[0 * 33], s[1 * 33]); o.y = pk2(s[2 * 33], s[3 * 33]); o.z = pk2(s[4 * 33], s[5 * 33]); o.w = pk2(s[6 * 33], s[7 * 33]);
        *(v4u*)(dst + (size_t)(drow0 + n) * K + k0 + 8 * c) = o; }
    asm volatile("s_waitcnt lgkmcnt(0)" ::: "memory");
}
DI void phase_convert(const Args& A, const Ctx& C0, int l) { const Ctx C = fresh_ctx(C0);
    LAS float* scr = (LAS float*)(C.lds + C.wave * 16384);
    const int gw = C.bid * NWAVES + C.wave, NGW = GRID * NWAVES;
    bf16* WIN = (bf16*)(A.ws + WS_WIN); bf16* WOUT = (bf16*)(A.ws + WS_WOUT); bf16* WGU = (bf16*)(A.ws + WS_WGU); bf16* WD = (bf16*)(A.ws + WS_WD);
    constexpr int I_IN = 16 * 96, I_OUT = 16 * 32, I_GU = 16 * 512, I_D = 16 * 256, NITEMS = I_IN + I_OUT + I_GU + I_D;
    for (int it = gw; it < NITEMS; it += NGW) {
        int r = it;
        if (r < I_IN) { const int kb = r / 96, nb = r % 96, n0 = 32 * nb; transpose_item(A.in[1] + (size_t)l * D * PIN, PIN, 64 * kb, n0 + (n0 >= 2048 ? 8 : 0), WIN, D, n0, scr, C.lane); continue; } r -= I_IN;
        if (r < I_OUT) { const int kb = r / 32, nb = r % 32; transpose_item(A.in[12] + (size_t)l * D * D, D, 64 * kb, 32 * nb, WOUT, D, 32 * nb, scr, C.lane); continue; } r -= I_OUT;
        if (r < I_GU) { const int e = r / 512, r1 = r % 512, half = r1 / 256, r2 = r1 % 256, kb = r2 / 16, nb = r2 % 16, j0 = 32 * nb;
            transpose_item((half ? A.in[18] : A.in[17]) + (size_t)(l * NEXP + e) * D * DEXP, DEXP, 64 * kb, j0, WGU, D, e * 1024 + (j0 / 128) * 256 + half * 128 + (j0 % 128), scr, C.lane); continue; } r -= I_GU;
        { const int e = r / 256, r1 = r % 256, kb = r1 / 32, nb = r1 % 32;
            transpose_item(A.in[19] + (size_t)(l * NEXP + e) * DEXP * D, D, 64 * kb, 32 * nb, WD, DEXP, e * 1024 + 32 * nb, scr, C.lane); }
    }
    { bf16* WM = (bf16*)(A.ws + SM_WM); const float* wsrc = A.in[6] + (size_t)l * 4 * CH * CH;
        for (int i = C.bid * NTHREADS + C.tid; i < 4 * CH * CH; i += GRID * NTHREADS) { const int s = i & 127, t = (i >> 7) & 127; WM[i] = (bf16)f2bf(s <= t ? wsrc[i] : 0.f); } }
    float* BIAS = (float*)(A.ws + SM_BIAS);
    for (int n = C.bid * NTHREADS + C.tid; n < NPROJ; n += GRID * NTHREADS) BIAS[n] = A.in[2][(size_t)l * PIN + n + (n >= 2048 ? 8 : 0)];
}

DI void stage_gate_weights(const Args& A, const Ctx& C, int lg) {
    LAS float* gwl = (LAS float*)C.lds;
    const float* w = A.in[1] + (size_t)lg * D * PIN + 2048;
    f32x4 gq[2][2];
#pragma unroll
    for (int k = 0; k < 2; ++k) { const int col = C.tid + k * NTHREADS; gq[k][0] = *(const f32x4*)(w + (size_t)col * PIN); gq[k][1] = *(const f32x4*)(w + (size_t)col * PIN + 4); }
#pragma unroll
    for (int k = 0; k < 2; ++k) { const int col = C.tid + k * NTHREADS;
#pragma unroll
        for (int g = 0; g < 4; ++g) { gwl[g * D + col] = gq[k][0][g]; gwl[(4 + g) * D + col] = gq[k][1][g]; } }
}
DI void row_emit(const Args& A, const Ctx& C, int t, const f32x4 (&v)[4], float* xout, bf16* XN, int lg) {
    if (xout) {
#pragma unroll
        for (int j = 0; j < 4; ++j) *(f32x4*)(xout + (size_t)t * D + 256 * j + 4 * C.lane) = v[j];
    }
    if (XN) {
#pragma unroll
        for (int j = 0; j < 4; ++j) { v2u w; w.x = pk2(v[j][0], v[j][1]); w.y = pk2(v[j][2], v[j][3]); *(v2u*)(XN + (size_t)t * D + 256 * j + 4 * C.lane) = w; }
    }
    if (lg >= 0) {
        const LAS float* gwl = (const LAS float*)C.lds;
        float* GATES = (float*)(A.ws + SM_GATES);
        float gs[8];
#pragma unroll
        for (int g = 0; g < 8; ++g) { float s = 0.f;
#pragma unroll
            for (int j = 0; j < 4; ++j) { const f32x4 w = *(const LAS f32x4*)(gwl + g * D + 256 * j + 4 * C.lane); s += v[j][0] * w[0] + v[j][1] * w[1] + v[j][2] * w[2] + v[j][3] * w[3]; }
            gs[g] = s; }
        red_multi<8>(gs, C.lane);
        if ((C.lane & 7) == 0) { const int g = red_idx<8>(C.lane); GATES[(size_t)t * 8 + g] = gs[0] + A.in[2][(size_t)lg * PIN + 2048 + g]; }
    }
}
DI void phase_prologue_rows(const Args& A, const Ctx& C0) { const Ctx C = fresh_ctx(C0);
    stage_gate_weights(A, C, 0);
    __syncthreads();
    for (int t = C.bid * NWAVES + C.wave; t < T; t += GRID * NWAVES) {
        f32x4 v[4];
#pragma unroll
        for (int j = 0; j < 4; ++j) v[j] = *(const f32x4*)(A.in[0] + (size_t)t * D + 256 * j + 4 * C.lane);
        row_emit(A, C, t, v, nullptr, (bf16*)(A.ws + WS_XN), 0);
    }
    __syncthreads();
}
DI void row_layernorm(f32x4 (&v)[4], const float* w, const float* b, int lane) {
    float s = 0.f;
#pragma unroll
    for (int j = 0; j < 4; ++j) s += (v[j][0] + v[j][1]) + (v[j][2] + v[j][3]);
    const float mean = wave_sum(s) * (1.0f / D); float q = 0.f;
#pragma unroll
    for (int j = 0; j < 4; ++j) { v[j] = v[j] - mean; q += (v[j][0] * v[j][0] + v[j][1] * v[j][1]) + (v[j][2] * v[j][2] + v[j][3] * v[j][3]); }
    const float rstd = __builtin_amdgcn_rsqf(wave_sum(q) * (1.0f / D) + LN_EPS);
#pragma unroll
    for (int j = 0; j < 4; ++j) { const f32x4 ww = *(const f32x4*)(w + 256 * j + 4 * lane), bb = *(const f32x4*)(b + 256 * j + 4 * lane); v[j] = v[j] * rstd * ww + bb; }
}
DI void phase_ln1_router(const Args& A, const Ctx& C0, int l, bool dry = false) { const Ctx C = fresh_ctx(C0);
    LAS float* rwl = (LAS float*)C.lds;
    LAS int* hist = (LAS int*)(C.lds + VEC_OFF); LAS int* lbase = hist + 16, *le = hist + 32, *lrank = hist + 160;
    { f32x4 rq[8];
#pragma unroll
      for (int k = 0; k < 8; ++k) rq[k] = *(const f32x4*)(A.in[15] + (size_t)(C.tid + k * NTHREADS) * 4);
#pragma unroll
      for (int k = 0; k < 8; ++k) { const int i4 = C.tid + k * NTHREADS, col = i4 >> 2, e4 = (i4 & 3) * 4;
#pragma unroll
          for (int q = 0; q < 4; ++q) rwl[(e4 + q) * D + col] = rq[k][q]; } }
    if (C.tid < 16) hist[C.tid] = 0;
    __syncthreads();
    const bf16* X = (const bf16*)(A.ws + WS_XN);
    const bf16* Y = (const bf16*)(A.ws + WS_PROJ);
    bf16* XNB = (bf16*)(A.ws + WS_XNB);
    v4u* SEL = (v4u*)(A.ws + SM_SEL);
    float rb[16];
#pragma unroll
    for (int e = 0; e < 16; ++e) rb[e] = A.in[16][e];
    v2u xr[2][4], yr[2][4];
#pragma unroll
    for (int j = 0; j < 4; ++j) { const size_t o = (size_t)(C.bid * 64 + C.wave * 8) * D + 256 * j + 4 * C.lane; xr[0][j] = *(const v2u*)(X + o); yr[0][j] = *(const v2u*)(Y + o); }
#pragma unroll
    for (int i = 0; i < 8; ++i) {
        const int t = C.bid * 64 + C.wave * 8 + i;
        if (i < 7) {
#pragma unroll
            for (int j = 0; j < 4; ++j) { const size_t o = (size_t)(t + 1) * D + 256 * j + 4 * C.lane; xr[(i + 1) & 1][j] = *(const v2u*)(X + o); yr[(i + 1) & 1][j] = *(const v2u*)(Y + o); } }
        f32x4 v[4];
#pragma unroll
        for (int j = 0; j < 4; ++j) { const v2u x = xr[i & 1][j]; const v2u y = yr[i & 1][j];
            v[j][0] = ALPHA * bflo(x.x) + bflo(y.x); v[j][1] = ALPHA * bfhi(x.x) + bfhi(y.x); v[j][2] = ALPHA * bflo(x.y) + bflo(y.y); v[j][3] = ALPHA * bfhi(x.y) + bfhi(y.y); }
        row_layernorm(v, A.in[13] + (size_t)l * D, A.in[14] + (size_t)l * D, C.lane);
        row_emit(A, C, t, v, nullptr, XNB, -1);
        float lg16[16];
#pragma unroll
        for (int e = 0; e < 16; ++e) { float s = 0.f;
#pragma unroll
            for (int j = 0; j < 4; ++j) { const f32x4 w = *(const LAS f32x4*)(rwl + e * D + 256 * j + 4 * C.lane); s += v[j][0] * w[0] + v[j][1] * w[1] + v[j][2] * w[2] + v[j][3] * w[3]; }
            lg16[e] = s; }
        red_multi<16>(lg16, C.lane);
        float best = -INFINITY, bs0 = 0.f, bs1 = 0.f; int be0 = 0, be1 = 1;
#pragma unroll
        for (int g = 0; g < 4; ++g) {
            float sel[4], sg[4];
#pragma unroll
            for (int k = 0; k < 4; ++k) { const int e = 4 * g + k;
                const int src = 32 * ((e >> 3) & 1) + 16 * ((e >> 2) & 1) + 8 * ((e >> 1) & 1) + 4 * (e & 1);
                const float s = __builtin_bit_cast(float, __builtin_amdgcn_readlane(__builtin_bit_cast(int, lg16[0]), src));
                sg[k] = sigmoidf_(s); sel[k] = sg[k] + rb[e]; }
            float m1 = sel[0], s1 = sg[0]; int i1 = 0;
#pragma unroll
            for (int k = 1; k < 4; ++k) if (sel[k] > m1) { m1 = sel[k]; s1 = sg[k]; i1 = k; }
            float m2 = -INFINITY, s2 = 0.f; int i2 = 0;
#pragma unroll
            for (int k = 0; k < 4; ++k) if (k != i1 && sel[k] > m2) { m2 = sel[k]; s2 = sg[k]; i2 = k; }
            const float gsc = m1 + m2;
            if (gsc > best) { best = gsc; be0 = 4 * g + i1; be1 = 4 * g + i2; bs0 = s1; bs1 = s2; }
        }
        if (C.lane == 0) {
            const float inv = __builtin_amdgcn_rcpf(bs0 + bs1);
            v4u o; o.x = (unsigned)be0; o.y = (unsigned)be1; o.z = __builtin_bit_cast(unsigned, bs0 * inv); o.w = __builtin_bit_cast(unsigned, bs1 * inv);
            SEL[t] = o;
            ((f32x2*)(A.ws + SM_GW))[t] = (f32x2){bs0 * inv, bs1 * inv};
            const int q = (C.wave * 8 + i) * 2;
            le[q] = be0; lrank[q] = __hip_atomic_fetch_add(hist + be0, 1, __ATOMIC_RELAXED, __HIP_MEMORY_SCOPE_WORKGROUP);
            le[q + 1] = be1; lrank[q + 1] = __hip_atomic_fetch_add(hist + be1, 1, __ATOMIC_RELAXED, __HIP_MEMORY_SCOPE_WORKGROUP);
        }
    }
    __syncthreads();
    if (dry) return;
    if (C.tid < 16) lbase[C.tid] = (int)__hip_atomic_fetch_add((unsigned*)(A.ws + WS_CTL) + CW_CNT + (l * 16 + C.tid) * 16, (unsigned)hist[C.tid], __ATOMIC_RELAXED, __HIP_MEMORY_SCOPE_AGENT);
    __syncthreads();
    if (C.tid < 128) { const int e = le[C.tid], pos = lbase[e] + lrank[C.tid], t = C.bid * 64 + (C.tid >> 1);
        ((int*)(A.ws + WS_LIST))[(size_t)e * 16384 + pos] = t; ((int*)(A.ws + SM_TOKSLOT))[2 * t + (C.tid & 1)] = pos; }
    __syncthreads();
}
DI void phase_combine(const Args& A, const Ctx& C0, int l) { const Ctx C = fresh_ctx(C0);
    const bool last = (l == NLAYER - 1);
    if (!last) { stage_gate_weights(A, C, l + 1); }
    LAS int* tpl = (LAS int*)(C.lds + VEC_OFF);
    if (C.tid == 0) { int run = 0; for (int e = 0; e < 16; ++e) { tpl[e] = run; const int n = (int)__hip_atomic_load((const unsigned*)(A.ws + WS_CTL) + CW_CNT + (l * 16 + e) * 16, __ATOMIC_RELAXED, __HIP_MEMORY_SCOPE_AGENT); run += ((n + 255) >> 8) * 256; } }
    __syncthreads();
    const bf16* X1 = (const bf16*)(A.ws + WS_XNB); const bf16* YP = (const bf16*)(A.ws + WS_PROJ);
    const v4u* SEL = (const v4u*)(A.ws + SM_SEL); const int* TOKSLOT = (const int*)(A.ws + SM_TOKSLOT);
    const int tb = C.bid * 64 + C.wave * 8;
    int pp0[8], pp1[8]; float gg0[8], gg1[8];
#pragma unroll
    for (int i = 0; i < 8; ++i) { const int t = tb + i; const v4u s = SEL[t]; const f32x2 gw2 = ((const f32x2*)(A.ws + SM_GW))[t]; pp0[i] = tpl[s.x & 15u] + TOKSLOT[2 * t]; pp1[i] = tpl[s.y & 15u] + TOKSLOT[2 * t + 1]; gg0[i] = gw2[0]; gg1[i] = gw2[1]; }
    v2u xr[2][4], ar[2][4], br[2][4];
#pragma unroll
    for (int j = 0; j < 4; ++j) { xr[0][j] = *(const v2u*)(X1 + (size_t)tb * D + 256 * j + 4 * C.lane); ar[0][j] = *(const v2u*)(YP + (size_t)pp0[0] * D + 256 * j + 4 * C.lane); br[0][j] = *(const v2u*)(YP + (size_t)pp1[0] * D + 256 * j + 4 * C.lane); }
#pragma unroll
    for (int i = 0; i < 8; ++i) { const int t = tb + i;
        if (i < 7) {
#pragma unroll
            for (int j = 0; j < 4; ++j) { xr[(i + 1) & 1][j] = *(const v2u*)(X1 + (size_t)(t + 1) * D + 256 * j + 4 * C.lane); ar[(i + 1) & 1][j] = *(const v2u*)(YP + (size_t)pp0[(i + 1) & 7] * D + 256 * j + 4 * C.lane); br[(i + 1) & 1][j] = *(const v2u*)(YP + (size_t)pp1[(i + 1) & 7] * D + 256 * j + 4 * C.lane); } }
        const float g0 = gg0[i], g1 = gg1[i];
        f32x4 v[4];
#pragma unroll
        for (int j = 0; j < 4; ++j) { const v2u x = xr[i & 1][j], a = ar[i & 1][j], b = br[i & 1][j];
            v[j][0] = ALPHA * bflo(x.x) + g0 * bflo(a.x) + g1 * bflo(b.x); v[j][1] = ALPHA * bfhi(x.x) + g0 * bfhi(a.x) + g1 * bfhi(b.x);
            v[j][2] = ALPHA * bflo(x.y) + g0 * bflo(a.y) + g1 * bflo(b.y); v[j][3] = ALPHA * bfhi(x.y) + g0 * bfhi(a.y) + g1 * bfhi(b.y); }
        row_layernorm(v, A.in[20] + (size_t)l * D, A.in[21] + (size_t)l * D, C.lane);
        row_emit(A, C, t, v, last ? A.out : nullptr, last ? nullptr : (bf16*)(A.ws + WS_XN), last ? -1 : l + 1);
    }
    __syncthreads();
}
DI void unpack8(const v4u w, float (&f)[8]) { f[0] = bflo(w.x); f[1] = bfhi(w.x); f[2] = bflo(w.y); f[3] = bfhi(w.y); f[4] = bflo(w.z); f[5] = bfhi(w.z); f[6] = bflo(w.w); f[7] = bfhi(w.w); }
DI void conv_unit(const Args& A, const Ctx& C0, int l, int unit) { const Ctx C = fresh_ctx(C0);
    const bf16* PROJ = (const bf16*)(A.ws + WS_PROJ); bf16* HCAT = (bf16*)(A.ws + WS_HCAT);
    LAS float* cin = (LAS float*)C.lds;
    LAS float* cou = (LAS float*)(C.lds + 65536);
    const int t0 = unit * 32, tseq = t0 & (SEQ - 1);
    v4u cqa[4], cqb[4];
#pragma unroll
    for (int kq = 0; kq < 4; ++kq) { const int it = C.tid + kq * NTHREADS, r = it >> 5, c8 = (it & 31) * 8; const bool ok = (it < 62 * 32) && (tseq - 30 + r >= 0); const size_t rowo = ok ? (size_t)(t0 - 30 + r) * NPROJ : 0;
        cqa[kq] = ok ? *(const v4u*)(PROJ + rowo + PCA + c8) : (v4u){0u, 0u, 0u, 0u}; cqb[kq] = ok ? *(const v4u*)(PROJ + rowo + PCB + c8) : (v4u){0u, 0u, 0u, 0u}; }
#pragma unroll
    for (int kq = 0; kq < 4; ++kq) { const int it = C.tid + kq * NTHREADS; if (it >= 62 * 32) continue; const int r = it >> 5, c8 = (it & 31) * 8; float o[8];
        if (tseq - 30 + r >= 0) { float a[8], b[8]; unpack8(cqa[kq], a); unpack8(cqb[kq], b);
#pragma unroll
            for (int i = 0; i < 8; ++i) o[i] = a[i] * sigmoidf_(b[i]); }
        else {
#pragma unroll
            for (int i = 0; i < 8; ++i) o[i] = 0.f; }
        *(LAS f32x4*)(cin + r * 256 + c8) = (f32x4){o[0], o[1], o[2], o[3]}; *(LAS f32x4*)(cin + r * 256 + c8 + 4) = (f32x4){o[4], o[5], o[6], o[7]}; }
    __syncthreads();
    { const int c = C.tid & 255, half = C.tid >> 8;
        float w[31];
#pragma unroll
        for (int j = 0; j < 31; ++j) w[j] = A.in[8][(size_t)(l * 31 + j) * 256 + c];
        const float bias = A.in[9][l * 256 + c];
        float xin[46];
#pragma unroll
        for (int r = 0; r < 46; ++r) xin[r] = cin[(half * 16 + r) * 256 + c];
#pragma unroll
        for (int i = 0; i < 16; ++i) { float acc = bias;
#pragma unroll
            for (int j = 0; j < 31; ++j) acc += xin[i + j] * w[j];
            cou[(half * 16 + i) * 256 + c] = acc; } }
    __syncthreads();
    { const f32x4 nw = *(const f32x4*)(A.in[10] + l * 256 + 4 * C.lane), nb = *(const f32x4*)(A.in[11] + l * 256 + 4 * C.lane);
#pragma unroll
        for (int q = 0; q < 4; ++q) { const int r = 4 * C.wave + q; f32x4 x = *(const LAS f32x4*)(cou + r * 256 + 4 * C.lane);
            const float mean = wave_sum((x[0] + x[1]) + (x[2] + x[3])) * (1.0f / 256.0f); x = x - mean;
            const float var = wave_sum((x[0] * x[0] + x[1] * x[1]) + (x[2] * x[2] + x[3] * x[3])) * (1.0f / 256.0f);
            const float rstd = __builtin_amdgcn_rsqf(var + LN_EPS); x = x * rstd * nw + nb;
            float o[4];
#pragma unroll
            for (int k = 0; k < 4; ++k) o[k] = x[k] * sigmoidf_(x[k]);
            v2u pk; pk.x = pk2(o[0], o[1]); pk.y = pk2(o[2], o[3]);
            *(v2u*)(HCAT + (size_t)(t0 + r) * D + 768 + 4 * C.lane) = pk; } }
    __syncthreads();
}
DI void gmlp_unit_simple(const Args& A, const Ctx& C0, int l, int ck) { const Ctx C = fresh_ctx(C0);
    const bf16* PROJ = (const bf16*)(A.ws + WS_PROJ); bf16* HCAT = (bf16*)(A.ws + WS_HCAT);
    LAS float* zs = (LAS float*)C.lds;
    const int t0 = ck * CH;
    { const f32x4 nw = *(const f32x4*)(A.in[4] + l * 256 + 4 * C.lane), nb = *(const f32x4*)(A.in[5] + l * 256 + 4 * C.lane);
        for (int i = 0; i < 16; ++i) { const int r = C.wave * 16 + i; const v2u g = *(const v2u*)(PROJ + (size_t)(t0 + r) * NPROJ + PGV + 4 * C.lane);
            f32x4 x = {gelu_tanh(bflo(g.x)), gelu_tanh(bfhi(g.x)), gelu_tanh(bflo(g.y)), gelu_tanh(bfhi(g.y))};
            const float mean = wave_sum((x[0] + x[1]) + (x[2] + x[3])) * (1.0f / 256.0f); x = x - mean;
            const float var = wave_sum((x[0] * x[0] + x[1] * x[1]) + (x[2] * x[2] + x[3] * x[3])) * (1.0f / 256.0f);
            const float rstd = __builtin_amdgcn_rsqf(var + LN_EPS); x = x * rstd * nw + nb;
            *(LAS f32x4*)(zs + r * 256 + 4 * C.lane) = x; } }
    __syncthreads();
    { const int tb = C.tid >> 4, cb = C.tid & 15, c0 = 16 * cb, h = cb >> 2, tr0 = 4 * tb;
        const float* ws = A.in[6] + (size_t)(l * 4 + h) * CH * CH;
        float acc[4][16];
#pragma unroll
        for (int i = 0; i < 4; ++i)
#pragma unroll
            for (int j = 0; j < 16; ++j) acc[i][j] = 0.f;
        for (int s = 0; s <= tr0 + 3; ++s) {
            float zv[16];
#pragma unroll
            for (int q = 0; q < 4; ++q) { const f32x4 z4 = *(const LAS f32x4*)(zs + s * 256 + c0 + 4 * q); zv[4 * q] = z4[0]; zv[4 * q + 1] = z4[1]; zv[4 * q + 2] = z4[2]; zv[4 * q + 3] = z4[3]; }
#pragma unroll
            for (int i = 0; i < 4; ++i) { const float wg = (s <= tr0 + i) ? ws[(size_t)(tr0 + i) * CH + s] : 0.f;
#pragma unroll
                for (int j = 0; j < 16; ++j) acc[i][j] += wg * zv[j]; }
        }
#pragma unroll
        for (int i = 0; i < 4; ++i) { const int tr = tr0 + i; const float bsv = A.in[7][(size_t)(l * 4 + h) * CH + tr]; const size_t rowo = (size_t)(t0 + tr) * NPROJ + PGU + c0;
            float u[16]; { float tmp[8]; unpack8(*(const v4u*)(PROJ + rowo), tmp);
#pragma unroll
                for (int j = 0; j < 8; ++j) u[j] = tmp[j];
                unpack8(*(const v4u*)(PROJ + rowo + 8), tmp);
#pragma unroll
                for (int j = 0; j < 8; ++j) u[8 + j] = tmp[j]; }
            float o[16];
#pragma unroll
            for (int j = 0; j < 16; ++j) o[j] = gelu_tanh(u[j]) * (acc[i][j] + bsv);
            v4u w0, w1; w0.x = pk2(o[0], o[1]); w0.y = pk2(o[2], o[3]); w0.z = pk2(o[4], o[5]); w0.w = pk2(o[6], o[7]); w1.x = pk2(o[8], o[9]); w1.y = pk2(o[10], o[11]); w1.z = pk2(o[12], o[13]); w1.w = pk2(o[14], o[15]);
            *(v4u*)(HCAT + (size_t)(t0 + tr) * D + 512 + c0) = w0; *(v4u*)(HCAT + (size_t)(t0 + tr) * D + 512 + c0 + 8) = w1; }
    }
    __syncthreads();
}
DI void mlstm_local_simple(const Args& A, const Ctx& C0, int un) { const Ctx C = fresh_ctx(C0);
    const bf16* PROJ = (const bf16*)(A.ws + WS_PROJ); const float* GATES = (const float*)(A.ws + SM_GATES);
    const int bh = un >> 5, c = un & 31, b = bh >> 2, h = bh & 3, t0 = b * SEQ + c * CH;
    LAS float* kw = (LAS float*)C.lds;
    LAS float* vs = (LAS float*)(C.lds + 65536);
    LAS float* vec = (LAS float*)(C.lds + VEC_OFF);
    if (C.tid < CH) { const float fp = GATES[(size_t)(t0 + C.tid) * 8 + 4 + h], ip = GATES[(size_t)(t0 + C.tid) * 8 + h]; vec[C.tid] = logsigmoidf_(fp); vec[128 + C.tid] = ip; }
    __syncthreads();
    if (C.tid == 0) { float run = 0.f; for (int i = 0; i < CH; ++i) { run += vec[i]; vec[i] = run; } const float g = run; float ml = -INFINITY;
        for (int i = 0; i < CH; ++i) { const float a = g - vec[i] + vec[128 + i]; vec[256 + i] = a; ml = fmaxf(ml, a); }
        for (int i = 0; i < CH; ++i) vec[256 + i] = __expf(vec[256 + i] - ml);
        ((float*)(A.ws + SM_G))[un] = g; ((float*)(A.ws + SM_MLOC))[un] = ml; }
    __syncthreads();
    for (int it = C.tid; it < CH * 16; it += NTHREADS) { const int r = it >> 4, c8 = (it & 15) * 8; const size_t rowo = (size_t)(t0 + r) * NPROJ + h * 128 + c8; float k8[8], v8[8];
        unpack8(*(const v4u*)(PROJ + rowo + PK), k8); unpack8(*(const v4u*)(PROJ + rowo + PV), v8); const float sc = vec[256 + r] * 0.08838834764831845f;
#pragma unroll
        for (int i = 0; i < 8; ++i) { kw[r * 128 + c8 + i] = k8[i] * sc; vs[r * 128 + c8 + i] = v8[i]; } }
    __syncthreads();
    { const int db = C.tid >> 4, eb = C.tid & 15, d0 = 4 * db, e0 = 8 * eb; float acc[4][8];
#pragma unroll
        for (int i = 0; i < 4; ++i)
#pragma unroll
            for (int j = 0; j < 8; ++j) acc[i][j] = 0.f;
        for (int r = 0; r < CH; ++r) { const f32x4 kd = *(const LAS f32x4*)(kw + r * 128 + d0); const f32x4 va = *(const LAS f32x4*)(vs + r * 128 + e0), vb = *(const LAS f32x4*)(vs + r * 128 + e0 + 4);
#pragma unroll
            for (int i = 0; i < 4; ++i) { acc[i][0] += kd[i] * va[0]; acc[i][1] += kd[i] * va[1]; acc[i][2] += kd[i] * va[2]; acc[i][3] += kd[i] * va[3]; acc[i][4] += kd[i] * vb[0]; acc[i][5] += kd[i] * vb[1]; acc[i][6] += kd[i] * vb[2]; acc[i][7] += kd[i] * vb[3]; } }
        float* CL = (float*)(A.ws + WS_CLOCT) + (size_t)un * CH * CH;
#pragma unroll
        for (int j = 0; j < 8; ++j) *(f32x4*)(CL + (size_t)(e0 + j) * CH + d0) = (f32x4){acc[0][j], acc[1][j], acc[2][j], acc[3][j]}; }
    if (C.tid < CH) { float s = 0.f; for (int r = 0; r < CH; ++r) s += kw[r * 128 + C.tid]; ((float*)(A.ws + SM_NLOC))[(size_t)un * CH + C.tid] = s; }
    __syncthreads();
}
DI void phase_scan(const Args& A, const Ctx& C0) { const Ctx C = fresh_ctx(C0);
    const int gt = C.bid * NTHREADS + C.tid, bh = gt >> 13, pr = gt & 8191;
    const float* G = (const float*)(A.ws + SM_G); const float* ML = (const float*)(A.ws + SM_MLOC); float* MP = (float*)(A.ws + SM_MPREV);
    const float* CL = (const float*)(A.ws + WS_CLOCT); unsigned* CP = (unsigned*)(A.ws + WS_CPREVT);
    const float* NL = (const float*)(A.ws + SM_NLOC); float* NP = (float*)(A.ws + SM_NPREV);
    float c0 = 0.f, c1 = 0.f, n0 = 0.f, n1 = 0.f, m = 0.f;
    for (int cb = 0; cb < NCH; cb += 8) {
        f32x2 cl[8], nl[8]; float g[8], ml[8];
#pragma unroll
        for (int i = 0; i < 8; ++i) { const int un = bh * NCH + cb + i; cl[i] = *(const f32x2*)(CL + (size_t)un * CH * CH + 2 * pr); g[i] = G[un]; ml[i] = ML[un]; nl[i] = (pr < 64) ? *(const f32x2*)(NL + (size_t)un * CH + 2 * pr) : (f32x2){0.f, 0.f}; }
#pragma unroll
        for (int i = 0; i < 8; ++i) { const int un = bh * NCH + cb + i;
            CP[(size_t)un * (CH * CH / 2) + pr] = pk2(c0, c1);
            if (pr == 0) MP[un] = m;
            if (pr < 64) *(f32x2*)(NP + (size_t)un * CH + 2 * pr) = (f32x2){n0, n1};
            const float mn = fmaxf(g[i] + m, ml[i]), dec = __expf(g[i] + m - mn), sc = __expf(ml[i] - mn);
            c0 = dec * c0 + sc * cl[i][0]; c1 = dec * c1 + sc * cl[i][1]; n0 = dec * n0 + sc * nl[i][0]; n1 = dec * n1 + sc * nl[i][1]; m = mn; }
    }
}
DI void mlstm_out_simple(const Args& A, const Ctx& C0, int l, int un) { const Ctx C = fresh_ctx(C0);
    const bf16* PROJ = (const bf16*)(A.ws + WS_PROJ); const float* GATES = (const float*)(A.ws + SM_GATES); bf16* HCAT = (bf16*)(A.ws + WS_HCAT);
    const int bh = un >> 5, c = un & 31, b = bh >> 2, h = bh & 3, t0 = b * SEQ + c * CH;
    LAS bf16* qs = (LAS bf16*)C.lds;
    LAS bf16* ks = (LAS bf16*)(C.lds + 32768);
    LAS float* ps = (LAS float*)(C.lds + 65536);
    LAS float* vec = (LAS float*)(C.lds + VEC_OFF);
    LAS float* bvec = vec, *uvec = vec + 128, *Mvec = vec + 256, *wint = vec + 384, *flo = vec + 512, *den = vec + 640, *npv = vec + 768, *ipv = vec + 896, *lfv = vec + 1024, *qnv = vec + 1152;
    if (C.tid < CH) { const float fp = GATES[(size_t)(t0 + C.tid) * 8 + 4 + h], ip = GATES[(size_t)(t0 + C.tid) * 8 + h]; lfv[C.tid] = logsigmoidf_(fp); ipv[C.tid] = ip; npv[C.tid] = ((const float*)(A.ws + SM_NPREV))[(size_t)un * CH + C.tid]; }
    __syncthreads();
    if (C.tid == 0) { const float mprev = ((const float*)(A.ws + SM_MPREV))[un]; float run = 0.f, pm = -INFINITY;
        for (int i = 0; i < CH; ++i) { run += lfv[i]; bvec[i] = run; const float u = ipv[i] - run; uvec[i] = u; pm = fmaxf(pm, u); const float M = fmaxf(mprev, pm); Mvec[i] = M; wint[i] = __expf(mprev - M); flo[i] = __expf(-(run + M)); } }
    for (int it = C.tid; it < CH * 16; it += NTHREADS) { const int r = it >> 4, c8 = (it & 15) * 8; const size_t rowo = (size_t)(t0 + r) * NPROJ + h * 128 + c8;
        *(LAS v4u*)(qs + r * 128 + c8) = *(const v4u*)(PROJ + rowo + PQ); *(LAS v4u*)(ks + r * 128 + c8) = *(const v4u*)(PROJ + rowo + PK); }
    __syncthreads();
    const int lb = C.tid >> 4, xb = C.tid & 15, l0 = 4 * lb, x0 = 8 * xb;
    {
        float acc[4][8];
#pragma unroll
        for (int i = 0; i < 4; ++i)
#pragma unroll
            for (int j = 0; j < 8; ++j) acc[i][j] = 0.f;
        if (x0 <= l0 + 3) {
            for (int d8 = 0; d8 < 16; ++d8) { float qf[4][8], kf[8];
#pragma unroll
                for (int i = 0; i < 4; ++i) unpack8(*(const LAS v4u*)(qs + (l0 + i) * 128 + d8 * 8), qf[i]);
#pragma unroll
                for (int j = 0; j < 8; ++j) { unpack8(*(const LAS v4u*)(ks + (x0 + j) * 128 + d8 * 8), kf);
#pragma unroll
                    for (int i = 0; i < 4; ++i) { float s = 0.f;
#pragma unroll
                        for (int dd = 0; dd < 8; ++dd) s += qf[i][dd] * kf[dd];
                        acc[i][j] += s; } } } }
#pragma unroll
        for (int i = 0; i < 4; ++i)
#pragma unroll
            for (int j = 0; j < 8; ++j) { const int li = l0 + i, sj = x0 + j; ps[li * 128 + sj] = (sj <= li) ? acc[i][j] * 0.08838834764831845f * __expf(uvec[sj] - Mvec[li]) : 0.f; }
    }
    __syncthreads();
    if (C.tid < CH) { const int li = C.tid; float s = 0.f; for (int k = 0; k < CH; ++k) s += ps[li * 128 + ((k + li) & 127)]; den[li] = s; }
    else if (C.tid < 2 * CH) { const int li = C.tid - CH; float s = 0.f; for (int k = 0; k < CH; ++k) { const int d = (k + li) & 127; s += bf2f(qs[li * 128 + d]) * npv[d]; } qnv[li] = s; }
    for (int it = C.tid; it < CH * 16; it += NTHREADS) { const int r = it >> 4, c8 = (it & 15) * 8; }
    __syncthreads();
    for (int it = C.tid; it < CH * 16; it += NTHREADS) { const int r = it >> 4, c8 = (it & 15) * 8; const size_t rowo = (size_t)(t0 + r) * NPROJ + h * 128 + c8; *(LAS v4u*)(ks + r * 128 + c8) = *(const v4u*)(PROJ + rowo + PV); }
    __syncthreads();
    float hv[4][8];
    {   const int e0 = x0; float acc[4][8], acc2[4][8];
#pragma unroll
        for (int i = 0; i < 4; ++i)
#pragma unroll
            for (int j = 0; j < 8; ++j) { acc[i][j] = 0.f; acc2[i][j] = 0.f; }
        for (int s = 0; s <= l0 + 3; ++s) { float vv[8]; unpack8(*(const LAS v4u*)(ks + s * 128 + e0), vv);
#pragma unroll
            for (int i = 0; i < 4; ++i) { const float p = ps[(l0 + i) * 128 + s];
#pragma unroll
                for (int j = 0; j < 8; ++j) acc[i][j] += p * vv[j]; } }
        const bf16* CPT = (const bf16*)(A.ws + WS_CPREVT) + (size_t)un * CH * CH;
        for (int d8 = 0; d8 < 16; ++d8) { float qf[4][8], cf[8];
#pragma unroll
            for (int i = 0; i < 4; ++i) unpack8(*(const LAS v4u*)(qs + (l0 + i) * 128 + d8 * 8), qf[i]);
#pragma unroll
            for (int j = 0; j < 8; ++j) { unpack8(*(const v4u*)(CPT + (size_t)(e0 + j) * CH + d8 * 8), cf);
#pragma unroll
                for (int i = 0; i < 4; ++i) { float s = 0.f;
#pragma unroll
                    for (int dd = 0; dd < 8; ++dd) s += qf[i][dd] * cf[dd];
                    acc2[i][j] += s; } } }
#pragma unroll
        for (int i = 0; i < 4; ++i) { const int li = l0 + i; const float wi = wint[li]; const float dn = den[li] + wi * qnv[li]; const float inv = 1.0f / fmaxf(fabsf(dn), flo[li]);
#pragma unroll
            for (int j = 0; j < 8; ++j) hv[i][j] = (acc[i][j] + wi * acc2[i][j]) * inv; }
    }
    __syncthreads();
#pragma unroll
    for (int i = 0; i < 4; ++i)
#pragma unroll
        for (int j = 0; j < 8; ++j) ps[(l0 + i) * 128 + x0 + j] = hv[i][j];
    __syncthreads();
    { const f32x2 nw = *(const f32x2*)(A.in[3] + (size_t)l * 512 + h * 128 + 2 * C.lane);
        for (int i = 0; i < 16; ++i) { const int li = C.wave * 16 + i; f32x2 x = *(const LAS f32x2*)(ps + li * 128 + 2 * C.lane);
            const float mean = wave_sum(x[0] + x[1]) * (1.0f / 128.0f); x = x - mean; const float var = wave_sum(x[0] * x[0] + x[1] * x[1]) * (1.0f / 128.0f);
            const float rstd = 1.0f / sqrtf(var + 1e-6f); const unsigned ow = *(const unsigned*)(PROJ + (size_t)(t0 + li) * NPROJ + PO + h * 128 + 2 * C.lane);
            const float o0 = sigmoidf_(bflo(ow)) * (x[0] * rstd * nw[0]), o1 = sigmoidf_(bfhi(ow)) * (x[1] * rstd * nw[1]);
            *(unsigned*)(HCAT + (size_t)(t0 + li) * D + h * 128 + 2 * C.lane) = pk2(o0, o1); } }
    __syncthreads();
}
typedef short bf16x8 __attribute__((ext_vector_type(8)));
DI f32x4 mfma16(bf16x8 a, bf16x8 b, f32x4 c) { return __builtin_amdgcn_mfma_f32_16x16x32_bf16(a, b, c, 0, 0, 0); }
constexpr int LDT = 136;
constexpr int TILE_B = 128 * LDT * 2;
DI float wave_scan_add(float v, int lane) {
#pragma unroll
    for (int o = 1; o < 64; o <<= 1) { const float t = __shfl_up(v, o); if (lane >= o) v += t; }
    return v;
}
DI float wave_scan_max(float v, int lane) {
#pragma unroll
    for (int o = 1; o < 64; o <<= 1) { const float t = __shfl_up(v, o); if (lane >= o) v = fmaxf(v, t); }
    return v;
}
DI float wave_max(float v) {
#pragma unroll
    for (int o = 1; o < 64; o <<= 1) v = fmaxf(v, __shfl_xor(v, o));
    return v;
}
DI float red16(float v) { v += __shfl_xor(v, 1); v += __shfl_xor(v, 2); v += __shfl_xor(v, 4); v += __shfl_xor(v, 8); return v; }

DI void mlstm_local_mfma(const Args& A, const Ctx& C0, int un) { const Ctx C = fresh_ctx(C0);
    const bf16* PROJ = (const bf16*)(A.ws + WS_PROJ); const float* GATES = (const float*)(A.ws + SM_GATES);
    const int bh = un >> 5, c = un & 31, b = bh >> 2, h = bh & 3, t0 = b * SEQ + c * CH;
    LAS bf16* VT = (LAS bf16*)C.lds;
    LAS bf16* KWT = (LAS bf16*)(C.lds + TILE_B);
    LAS float* wv = (LAS float*)(C.lds + VEC_OFF);
    if (C.wave == 0) {
        const int l0 = 2 * C.lane; const f32x4 ga = *(const f32x4*)(GATES + (size_t)(t0 + l0) * 8), gb = *(const f32x4*)(GATES + (size_t)(t0 + l0) * 8 + 4), gc = *(const f32x4*)(GATES + (size_t)(t0 + l0 + 1) * 8), gd = *(const f32x4*)(GATES + (size_t)(t0 + l0 + 1) * 8 + 4);
        const float ip0 = h == 0 ? ga[0] : (h == 1 ? ga[1] : (h == 2 ? ga[2] : ga[3])), fp0 = h == 0 ? gb[0] : (h == 1 ? gb[1] : (h == 2 ? gb[2] : gb[3]));
        const float ip1 = h == 0 ? gc[0] : (h == 1 ? gc[1] : (h == 2 ? gc[2] : gc[3])), fp1 = h == 0 ? gd[0] : (h == 1 ? gd[1] : (h == 2 ? gd[2] : gd[3]));
        const float lf0 = logsigmoidf_(fp0), lf1 = logsigmoidf_(fp1);
        const float incl = wave_scan_add(lf0 + lf1, C.lane), b1 = incl, b0 = incl - lf1;
        const float g = __shfl(incl, 63);
        const float a0 = g - b0 + ip0, a1 = g - b1 + ip1, ml = wave_max(fmaxf(a0, a1));
        wv[l0] = __expf(a0 - ml); wv[l0 + 1] = __expf(a1 - ml);
        if (C.lane == 0) { ((float*)(A.ws + SM_G))[un] = g; ((float*)(A.ws + SM_MLOC))[un] = ml; }
    }
    __syncthreads();
#pragma unroll
    for (int kq = 0; kq < 4; ++kq) { const int it = C.tid + kq * NTHREADS; const int r = it & 127, c8 = (it >> 7) * 8; const size_t rowo = (size_t)(t0 + r) * NPROJ + h * 128 + c8; float k8[8];
        unpack8(*(const v4u*)(PROJ + rowo + PK), k8); const v4u vv = *(const v4u*)(PROJ + rowo + PV); const float sc = wv[r] * 0.08838834764831845f;
        const unsigned vw[4] = {vv.x, vv.y, vv.z, vv.w};
#pragma unroll
        for (int i = 0; i < 8; ++i) { KWT[(c8 + i) * LDT + r] = (bf16)f2bf(k8[i] * sc); VT[(c8 + i) * LDT + r] = (bf16)((i & 1) ? (vw[i >> 1] >> 16) : (vw[i >> 1] & 0xffffu)); } }
    __syncthreads();
    { const int fr = C.lane & 15, fg = C.lane >> 4, w = C.wave;
        bf16x8 a[4];
#pragma unroll
        for (int ks = 0; ks < 4; ++ks) a[ks] = *(const LAS bf16x8*)(VT + (16 * w + fr) * LDT + 32 * ks + 8 * fg);
        float* CL = (float*)(A.ws + WS_CLOCT) + (size_t)un * CH * CH;
#pragma unroll
        for (int dt = 0; dt < 8; ++dt) { f32x4 acc = {0.f, 0.f, 0.f, 0.f};
#pragma unroll
            for (int ks = 0; ks < 4; ++ks) { const bf16x8 bb = *(const LAS bf16x8*)(KWT + (16 * dt + fr) * LDT + 32 * ks + 8 * fg); acc = mfma16(a[ks], bb, acc); }
#pragma unroll
            for (int rg = 0; rg < 4; ++rg) CL[(size_t)(16 * w + 4 * fg + rg) * CH + 16 * dt + fr] = acc[rg]; } }
    if (C.tid < CH) { float s = 0.f;
#pragma unroll
        for (int q = 0; q < 16; ++q) { float f[8]; unpack8(*(const LAS v4u*)(KWT + C.tid * LDT + 8 * q), f); s += ((f[0] + f[1]) + (f[2] + f[3])) + ((f[4] + f[5]) + (f[6] + f[7])); }
        ((float*)(A.ws + SM_NLOC))[(size_t)un * CH + C.tid] = s; }
    __syncthreads();
}
DI void mlstm_out_mfma(const Args& A, const Ctx& C0, int l, int un) { const Ctx C = fresh_ctx(C0);
    const bf16* PROJ = (const bf16*)(A.ws + WS_PROJ); const float* GATES = (const float*)(A.ws + SM_GATES); bf16* HCAT = (bf16*)(A.ws + WS_HCAT);
    const int bh = un >> 5, c = un & 31, b = bh >> 2, h = bh & 3, t0 = b * SEQ + c * CH;
    LAS bf16* QS = (LAS bf16*)C.lds;
    LAS bf16* KS = (LAS bf16*)(C.lds + TILE_B);
    LAS bf16* PS = (LAS bf16*)(C.lds + 2 * TILE_B);
    LAS bf16* CT = (LAS bf16*)(C.lds + 3 * TILE_B);
    LAS float* vec = (LAS float*)(C.lds + VEC_OFF);
    LAS float* uvec = vec, *Mvec = vec + 128, *wint = vec + 256, *flo = vec + 384; LAS bf16* npb = (LAS bf16*)(vec + 512);
    if (C.wave == 0) {
        const int l0 = 2 * C.lane; const f32x4 ga = *(const f32x4*)(GATES + (size_t)(t0 + l0) * 8), gb = *(const f32x4*)(GATES + (size_t)(t0 + l0) * 8 + 4), gc = *(const f32x4*)(GATES + (size_t)(t0 + l0 + 1) * 8), gd = *(const f32x4*)(GATES + (size_t)(t0 + l0 + 1) * 8 + 4);
        const float ip0 = h == 0 ? ga[0] : (h == 1 ? ga[1] : (h == 2 ? ga[2] : ga[3])), fp0 = h == 0 ? gb[0] : (h == 1 ? gb[1] : (h == 2 ? gb[2] : gb[3]));
        const float ip1 = h == 0 ? gc[0] : (h == 1 ? gc[1] : (h == 2 ? gc[2] : gc[3])), fp1 = h == 0 ? gd[0] : (h == 1 ? gd[1] : (h == 2 ? gd[2] : gd[3]));
        const float lf0 = logsigmoidf_(fp0), lf1 = logsigmoidf_(fp1);
        const float incl = wave_scan_add(lf0 + lf1, C.lane), b1 = incl, b0 = incl - lf1;
        const float u0 = ip0 - b0, u1 = ip1 - b1;
        const float pm_incl = wave_scan_max(fmaxf(u0, u1), C.lane); const float pm_prev = __shfl_up(pm_incl, 1);
        const float pm0 = C.lane == 0 ? u0 : fmaxf(pm_prev, u0), pm1 = pm_incl;
        const float mprev = ((const float*)(A.ws + SM_MPREV))[un];
        const float M0 = fmaxf(mprev, pm0), M1 = fmaxf(mprev, pm1);
        uvec[l0] = u0; uvec[l0 + 1] = u1; Mvec[l0] = M0; Mvec[l0 + 1] = M1; wint[l0] = __expf(mprev - M0); wint[l0 + 1] = __expf(mprev - M1); flo[l0] = __expf(-(b0 + M0)); flo[l0 + 1] = __expf(-(b1 + M1));
        const f32x2 np2 = *(const f32x2*)((const float*)(A.ws + SM_NPREV) + (size_t)un * CH + l0); *(LAS unsigned*)(npb + l0) = pk2(np2[0], np2[1]);
    }
    { const bf16* CPT = (const bf16*)(A.ws + WS_CPREVT) + (size_t)un * CH * CH;
        v4u sq[4], sk[4], sc[4];
#pragma unroll
        for (int kq = 0; kq < 4; ++kq) { const int it = C.tid + kq * NTHREADS, r = it >> 4, c8 = (it & 15) * 8; const size_t rowo = (size_t)(t0 + r) * NPROJ + h * 128 + c8;
            sq[kq] = *(const v4u*)(PROJ + rowo + PQ); sk[kq] = *(const v4u*)(PROJ + rowo + PK); sc[kq] = *(const v4u*)(CPT + (size_t)r * CH + c8); }
#pragma unroll
        for (int kq = 0; kq < 4; ++kq) { const int it = C.tid + kq * NTHREADS, r = it >> 4, c8 = (it & 15) * 8;
            *(LAS v4u*)(QS + r * LDT + c8) = sq[kq]; *(LAS v4u*)(KS + r * LDT + c8) = sk[kq]; *(LAS v4u*)(CT + r * LDT + c8) = sc[kq]; } }
    v4u vpre[4];
#pragma unroll
    for (int kq = 0; kq < 4; ++kq) { const int it = C.tid + kq * NTHREADS; const int r = it & 127, c8 = (it >> 7) * 8; vpre[kq] = *(const v4u*)(PROJ + (size_t)(t0 + r) * NPROJ + h * 128 + c8 + PV); }
    __syncthreads();
    const int fr = C.lane & 15, fg = C.lane >> 4, w = C.wave;
    bf16x8 aq[4];
#pragma unroll
    for (int ks = 0; ks < 4; ++ks) aq[ks] = *(const LAS bf16x8*)(QS + (16 * w + fr) * LDT + 32 * ks + 8 * fg);
    float Ml[4], wl[4], inv[4];
#pragma unroll
    for (int rg = 0; rg < 4; ++rg) { Ml[rg] = Mvec[16 * w + 4 * fg + rg]; wl[rg] = wint[16 * w + 4 * fg + rg]; }
    {   float rs[4] = {0.f, 0.f, 0.f, 0.f};
#pragma unroll
        for (int st = 0; st < 8; ++st) {
            if (st <= w) { f32x4 acc = {0.f, 0.f, 0.f, 0.f};
#pragma unroll
                for (int ks = 0; ks < 4; ++ks) { const bf16x8 bb = *(const LAS bf16x8*)(KS + (16 * st + fr) * LDT + 32 * ks + 8 * fg); acc = mfma16(aq[ks], bb, acc); }
                const int s = 16 * st + fr; const float us = uvec[s];
#pragma unroll
                for (int rg = 0; rg < 4; ++rg) { const int li = 16 * w + 4 * fg + rg; const float p = (s <= li) ? acc[rg] * 0.08838834764831845f * __expf(us - Ml[rg]) : 0.f; rs[rg] += p; PS[li * LDT + s] = (bf16)f2bf(p); } }
            else if (st == w + 1 && (w & 1) == 0) {
#pragma unroll
                for (int rg = 0; rg < 4; ++rg) PS[(16 * w + 4 * fg + rg) * LDT + 16 * st + fr] = (bf16)0; }
        }
        f32x4 an = {0.f, 0.f, 0.f, 0.f};
#pragma unroll
        for (int ks = 0; ks < 4; ++ks) { bf16x8 bn = *(const LAS bf16x8*)(npb + 32 * ks + 8 * fg); if (fr != 0) bn = (bf16x8){0, 0, 0, 0, 0, 0, 0, 0}; an = mfma16(aq[ks], bn, an); }
#pragma unroll
        for (int rg = 0; rg < 4; ++rg) { const float qn = __shfl(an[rg], 16 * fg); const float dn = red16(rs[rg]) + wl[rg] * qn; inv[rg] = __builtin_amdgcn_rcpf(fmaxf(fabsf(dn), flo[16 * w + 4 * fg + rg])); }
    }
    __syncthreads();
#pragma unroll
    for (int kq = 0; kq < 4; ++kq) { const int it = C.tid + kq * NTHREADS; const int r = it & 127, c8 = (it >> 7) * 8; const unsigned vw[4] = {vpre[kq].x, vpre[kq].y, vpre[kq].z, vpre[kq].w};
#pragma unroll
        for (int i = 0; i < 8; ++i) KS[(c8 + i) * LDT + r] = (bf16)((i & 1) ? (vw[i >> 1] >> 16) : (vw[i >> 1] & 0xffffu)); }
    __syncthreads();
    {   const int nk2 = (w >> 1) + 1;
        bf16x8 ap[4];
#pragma unroll
        for (int k2 = 0; k2 < 4; ++k2) ap[k2] = (k2 < nk2) ? *(const LAS bf16x8*)(PS + (16 * w + fr) * LDT + 32 * k2 + 8 * fg) : (bf16x8){0, 0, 0, 0, 0, 0, 0, 0};
        float hv[8][4]; float sm[4] = {0.f, 0.f, 0.f, 0.f};
#pragma unroll
        for (int et = 0; et < 8; ++et) { f32x4 a1 = {0.f, 0.f, 0.f, 0.f}, a2 = {0.f, 0.f, 0.f, 0.f};
#pragma unroll
            for (int k2 = 0; k2 < 4; ++k2) if (k2 < nk2) { const bf16x8 bb = *(const LAS bf16x8*)(KS + (16 * et + fr) * LDT + 32 * k2 + 8 * fg); a1 = mfma16(ap[k2], bb, a1); }
#pragma unroll
            for (int ks = 0; ks < 4; ++ks) { const bf16x8 bb = *(const LAS bf16x8*)(CT + (16 * et + fr) * LDT + 32 * ks + 8 * fg); a2 = mfma16(aq[ks], bb, a2); }
#pragma unroll
            for (int rg = 0; rg < 4; ++rg) { hv[et][rg] = (a1[rg] + wl[rg] * a2[rg]) * inv[rg]; sm[rg] += hv[et][rg]; } }
        float mean[4], rstd[4];
#pragma unroll
        for (int rg = 0; rg < 4; ++rg) { mean[rg] = red16(sm[rg]) * (1.0f / 128.0f); float q = 0.f;
#pragma unroll
            for (int et = 0; et < 8; ++et) { const float dlt = hv[et][rg] - mean[rg]; q += dlt * dlt; }
            rstd[rg] = __builtin_amdgcn_rsqf(red16(q) * (1.0f / 128.0f) + 1e-6f); }
#pragma unroll
        for (int et = 0; et < 8; ++et) { const int e = 16 * et + fr; const float nw = A.in[3][(size_t)l * 512 + h * 128 + e];
#pragma unroll
            for (int rg = 0; rg < 4; ++rg) { const int li = 16 * w + 4 * fg + rg; PS[li * LDT + e] = (bf16)f2bf((hv[et][rg] - mean[rg]) * rstd[rg] * nw); } }
    }
    __syncthreads();
    { const int r = C.tid >> 2, cg = (C.tid & 3) * 32;
#pragma unroll
        for (int q = 0; q < 4; ++q) { float hn[8], ov[8]; unpack8(*(const LAS v4u*)(PS + r * LDT + cg + 8 * q), hn); unpack8(*(const v4u*)(PROJ + (size_t)(t0 + r) * NPROJ + PO + h * 128 + cg + 8 * q), ov);
            v4u o4; o4.x = pk2(sigmoidf_(ov[0]) * hn[0], sigmoidf_(ov[1]) * hn[1]); o4.y = pk2(sigmoidf_(ov[2]) * hn[2], sigmoidf_(ov[3]) * hn[3]); o4.z = pk2(sigmoidf_(ov[4]) * hn[4], sigmoidf_(ov[5]) * hn[5]); o4.w = pk2(sigmoidf_(ov[6]) * hn[6], sigmoidf_(ov[7]) * hn[7]);
            *(v4u*)(HCAT + (size_t)(t0 + r) * D + h * 128 + cg + 8 * q) = o4; } }
    __syncthreads();
}
DI void gmlp_unit_mfma(const Args& A, const Ctx& C0, int l, int unit) { const Ctx C = fresh_ctx(C0);
    const bf16* PROJ = (const bf16*)(A.ws + WS_PROJ); bf16* HCAT = (bf16*)(A.ws + WS_HCAT); const bf16* WM = (const bf16*)(A.ws + SM_WM);
    const int ck = unit >> 2, hh = unit & 3, t0 = ck * CH;
    LAS bf16* ZT = (LAS bf16*)C.lds;
    LAS float* OUTS = (LAS float*)(C.lds + 32768);
    { const f32x4 nw = *(const f32x4*)(A.in[4] + l * 256 + 4 * C.lane), nb = *(const f32x4*)(A.in[5] + l * 256 + 4 * C.lane);
        v2u gvr[16];
#pragma unroll
        for (int i = 0; i < 16; ++i) gvr[i] = *(const v2u*)(PROJ + (size_t)(t0 + C.wave * 16 + i) * NPROJ + PGV + 4 * C.lane);
#pragma unroll
        for (int i = 0; i < 16; ++i) { const int r = C.wave * 16 + i; const v2u g = gvr[i];
            f32x4 x = {gelu_tanh(bflo(g.x)), gelu_tanh(bfhi(g.x)), gelu_tanh(bflo(g.y)), gelu_tanh(bfhi(g.y))};
            const float mean = wave_sum((x[0] + x[1]) + (x[2] + x[3])) * (1.0f / 256.0f); x = x - mean;
            const float var = wave_sum((x[0] * x[0] + x[1] * x[1]) + (x[2] * x[2] + x[3] * x[3])) * (1.0f / 256.0f);
            const float rstd = __builtin_amdgcn_rsqf(var + LN_EPS); x = x * rstd * nw + nb;
            if ((C.lane >> 4) == hh) { const int d0 = 4 * (C.lane & 15);
#pragma unroll
                for (int q = 0; q < 4; ++q) ZT[(d0 + q) * LDT + r] = (bf16)f2bf(x[q]); } } }
    __syncthreads();
    { const int fr = C.lane & 15, fg = C.lane >> 4, w = C.wave, nk = (w >> 1) + 1;
        bf16x8 a[4];
#pragma unroll
        for (int ks = 0; ks < 4; ++ks) a[ks] = (ks < nk) ? *(const bf16x8*)(WM + ((size_t)(hh * CH + 16 * w + fr) * CH + 32 * ks + 8 * fg)) : (bf16x8){0, 0, 0, 0, 0, 0, 0, 0};
#pragma unroll
        for (int dt = 0; dt < 4; ++dt) { f32x4 acc = {0.f, 0.f, 0.f, 0.f};
#pragma unroll
            for (int ks = 0; ks < 4; ++ks) if (ks < nk) { const bf16x8 bb = *(const LAS bf16x8*)(ZT + (16 * dt + fr) * LDT + 32 * ks + 8 * fg); acc = mfma16(a[ks], bb, acc); }
#pragma unroll
            for (int rg = 0; rg < 4; ++rg) OUTS[(16 * w + 4 * fg + rg) * 68 + 16 * dt + fr] = acc[rg]; } }
    __syncthreads();
    { const int r = C.tid >> 2, cg = (C.tid & 3) * 16; const float bsv = A.in[7][(size_t)(l * 4 + hh) * CH + r];
        float u[16]; { float tmp[8]; unpack8(*(const v4u*)(PROJ + (size_t)(t0 + r) * NPROJ + PGU + 64 * hh + cg), tmp);
#pragma unroll
            for (int j = 0; j < 8; ++j) u[j] = tmp[j];
            unpack8(*(const v4u*)(PROJ + (size_t)(t0 + r) * NPROJ + PGU + 64 * hh + cg + 8), tmp);
#pragma unroll
            for (int j = 0; j < 8; ++j) u[8 + j] = tmp[j]; }
        float o[16];
#pragma unroll
        for (int q = 0; q < 4; ++q) { const f32x4 a4 = *(const LAS f32x4*)(OUTS + r * 68 + cg + 4 * q);
#pragma unroll
            for (int j = 0; j < 4; ++j) o[4 * q + j] = gelu_tanh(u[4 * q + j]) * (a4[j] + bsv); }
        v4u w0, w1; w0.x = pk2(o[0], o[1]); w0.y = pk2(o[2], o[3]); w0.z = pk2(o[4], o[5]); w0.w = pk2(o[6], o[7]); w1.x = pk2(o[8], o[9]); w1.y = pk2(o[10], o[11]); w1.z = pk2(o[12], o[13]); w1.w = pk2(o[14], o[15]);
        *(v4u*)(HCAT + (size_t)(t0 + r) * D + 512 + 64 * hh + cg) = w0; *(v4u*)(HCAT + (size_t)(t0 + r) * D + 512 + 64 * hh + cg + 8) = w1; }
    __syncthreads();
}
#if DBG_CHECK
constexpr size_t SM_ERR = WS_CTL + 8192;
DI int slot_of(const Args& A, int l, int t, int k) { const v4u s = ((const v4u*)(A.ws + SM_SEL))[t]; const int e = k ? (int)s.y : (int)s.x; int run = 0;
    for (int q = 0; q < e; ++q) run += (((int)((const unsigned*)(A.ws + WS_CTL))[CW_CNT + (l * 16 + q) * 16] + 255) >> 8) * 256;
    return run + ((const int*)(A.ws + SM_TOKSLOT))[2 * t + k]; }
DI unsigned hsh(unsigned s, unsigned k) { unsigned h = s * 2654435761u + k * 40503u + 12345u; h ^= h >> 15; h *= 2246822519u; h ^= h >> 13; return h; }
DI void err_put(const Args& A, int chk, float ref, float got, float floor_) {
    float e = fabsf(ref - got) / (fabsf(ref) + floor_); if (!(e == e)) e = 1e9f;
    atomicMax((unsigned*)(A.ws + SM_ERR) + chk, __builtin_bit_cast(unsigned, e));
}
DI void chk_gates(const Args& A, const Ctx& C, int l, const float* X) {
    const int gt = C.bid * NTHREADS + C.tid; if (gt >= 2048) return;
    const int t = hsh(gt, 1) % T, g = hsh(gt, 2) % 8; float s = 0.f;
    for (int k = 0; k < D; ++k) s += X[(size_t)t * D + k] * A.in[1][((size_t)l * D + k) * PIN + 2048 + g];
    s += A.in[2][(size_t)l * PIN + 2048 + g];
    err_put(A, 1, s, ((const float*)(A.ws + SM_GATES))[(size_t)t * 8 + g], 0.1f);
}
DI void chk_proj(const Args& A, const Ctx& C, int l) {
    const int gt = C.bid * NTHREADS + C.tid; if (gt >= 8192) return;
    const int t = (gt < 64) ? (gt * 4099) % T : hsh(gt, 3) % T, n = hsh(gt, 4) % NPROJ, ns = n + (n >= 2048 ? 8 : 0);
    const bf16* XN = (const bf16*)(A.ws + WS_XN); float s = 0.f;
    for (int k = 0; k < D; ++k) s += bf2f(XN[(size_t)t * D + k]) * A.in[1][((size_t)l * D + k) * PIN + ns];
    s += A.in[2][(size_t)l * PIN + ns];
    err_put(A, 2, s, bf2f(((const bf16*)(A.ws + WS_PROJ))[(size_t)t * NPROJ + n]), 0.5f);
}
DI void chk_conv(const Args& A, const Ctx& C, int l) {
    const int gw = C.bid * NWAVES + C.wave; if (gw >= 1024) return;
    const int t = (gw < 128) ? (gw * 129) % T : hsh(gw, 5) % T; const bf16* PROJ = (const bf16*)(A.ws + WS_PROJ);
    float cv[4];
#pragma unroll
    for (int q = 0; q < 4; ++q) { const int c = C.lane * 4 + q; float acc = A.in[9][l * 256 + c];
        for (int j = 0; j < 31; ++j) { const int ts = t - 30 + j; if ((ts >> 12) != (t >> 12) || ts < 0) continue;
            const float a = bf2f(PROJ[(size_t)ts * NPROJ + PCA + c]), b = bf2f(PROJ[(size_t)ts * NPROJ + PCB + c]);
            acc += a / (1.0f + expf(-b)) * A.in[8][(size_t)(l * 31 + j) * 256 + c]; }
        cv[q] = acc; }
    const float mean = wave_sum(cv[0] + cv[1] + cv[2] + cv[3]) / 256.0f; float q2 = 0.f;
#pragma unroll
    for (int q = 0; q < 4; ++q) { cv[q] -= mean; q2 += cv[q] * cv[q]; }
    const float rstd = 1.0f / sqrtf(wave_sum(q2) / 256.0f + LN_EPS);
#pragma unroll
    for (int q = 0; q < 4; ++q) { const int c = C.lane * 4 + q; const float y = cv[q] * rstd * A.in[10][l * 256 + c] + A.in[11][l * 256 + c]; const float r = y / (1.0f + expf(-y));
        err_put(A, 3, r, bf2f(((const bf16*)(A.ws + WS_HCAT))[(size_t)t * D + 768 + c]), 0.5f); }
}
DI void chk_gmlp(const Args& A, const Ctx& C, int l) {
    const int gw = C.bid * NWAVES + C.wave; if (gw >= 512) return;
    const int t = (gw < 64) ? (gw * 131 + 127) % T : hsh(gw, 6) % T; const bf16* PROJ = (const bf16*)(A.ws + WS_PROJ);
    const int tc = t & 127, t0 = t - tc, h = C.lane >> 4; float acc[4] = {0.f, 0.f, 0.f, 0.f};
    for (int s = 0; s <= tc; ++s) { float x[4];
#pragma unroll
        for (int q = 0; q < 4; ++q) { const float v = bf2f(PROJ[(size_t)(t0 + s) * NPROJ + PGV + C.lane * 4 + q]); x[q] = 0.5f * v * (1.0f + tanhf(0.7978845608028654f * (v + 0.044715f * v * v * v))); }
        const float mean = wave_sum(x[0] + x[1] + x[2] + x[3]) / 256.0f; float q2 = 0.f;
#pragma unroll
        for (int q = 0; q < 4; ++q) { x[q] -= mean; q2 += x[q] * x[q]; }
        const float rstd = 1.0f / sqrtf(wave_sum(q2) / 256.0f + LN_EPS); const float w = A.in[6][((size_t)(l * 4 + h) * CH + tc) * CH + s];
#pragma unroll
        for (int q = 0; q < 4; ++q) { const int c = C.lane * 4 + q; acc[q] += w * (x[q] * rstd * A.in[4][l * 256 + c] + A.in[5][l * 256 + c]); } }
#pragma unroll
    for (int q = 0; q < 4; ++q) { const int c = C.lane * 4 + q; const float v = bf2f(PROJ[(size_t)t * NPROJ + PGU + c]); const float u = 0.5f * v * (1.0f + tanhf(0.7978845608028654f * (v + 0.044715f * v * v * v)));
        const float r = u * (acc[q] + A.in[7][(size_t)(l * 4 + h) * CH + tc]);
        err_put(A, 4, r, bf2f(((const bf16*)(A.ws + WS_HCAT))[(size_t)t * D + 512 + c]), 0.5f); }
}
DI void chk_mlstm(const Args& A, const Ctx& C, int l) {
    const int gw = C.bid * NWAVES + C.wave; if (gw >= 1024) return;
    const int t = (gw < 64) ? (gw * 521 + (gw & 1) * 127) % T : hsh(gw, 7) % T, h = hsh(gw, 8) & 3; const bf16* PROJ = (const bf16*)(A.ws + WS_PROJ); const float* GATES = (const float*)(A.ws + SM_GATES);
    const int tb = t & ~(SEQ - 1); const int d0 = 2 * C.lane;
    const float q0 = bf2f(PROJ[(size_t)t * NPROJ + PQ + h * 128 + d0]), q1 = bf2f(PROJ[(size_t)t * NPROJ + PQ + h * 128 + d0 + 1]);
    float n0 = 0.f, n1 = 0.f, den = 0.f, F = 0.f;
    for (int s = t; s >= tb; --s) {
        const float k0 = bf2f(PROJ[(size_t)s * NPROJ + PK + h * 128 + d0]), k1 = bf2f(PROJ[(size_t)s * NPROJ + PK + h * 128 + d0 + 1]);
        const float qk = wave_sum(q0 * k0 + q1 * k1) * 0.08838834764831845f;
        const float w = expf(F + GATES[(size_t)s * 8 + h]) * qk;
        n0 += w * bf2f(PROJ[(size_t)s * NPROJ + PV + h * 128 + d0]); n1 += w * bf2f(PROJ[(size_t)s * NPROJ + PV + h * 128 + d0 + 1]); den += w;
        const float fp = GATES[(size_t)s * 8 + 4 + h]; F += fminf(fp, 0.f) - log1pf(expf(-fabsf(fp)));
        if (F < -60.f) break; }
    const float inv = 1.0f / fmaxf(fabsf(den), 1.0f); float x0 = n0 * inv, x1 = n1 * inv;
    const float mean = wave_sum(x0 + x1) / 128.0f; x0 -= mean; x1 -= mean; const float rstd = 1.0f / sqrtf(wave_sum(x0 * x0 + x1 * x1) / 128.0f + 1e-6f);
    const float o0 = bf2f(PROJ[(size_t)t * NPROJ + PO + h * 128 + d0]), o1 = bf2f(PROJ[(size_t)t * NPROJ + PO + h * 128 + d0 + 1]);
    const float r0 = x0 * rstd * A.in[3][(size_t)l * 512 + h * 128 + d0] / (1.0f + expf(-o0)), r1 = x1 * rstd * A.in[3][(size_t)l * 512 + h * 128 + d0 + 1] / (1.0f + expf(-o1));
    const bf16* HC = (const bf16*)(A.ws + WS_HCAT);
    err_put(A, 5, r0, bf2f(HC[(size_t)t * D + h * 128 + d0]), 0.5f); err_put(A, 5, r1, bf2f(HC[(size_t)t * D + h * 128 + d0 + 1]), 0.5f);
}
DI void chk_y(const Args& A, const Ctx& C, int l) {
    const int gt = C.bid * NTHREADS + C.tid; if (gt >= 8192) return;
    const int t = hsh(gt, 9) % T, n = hsh(gt, 10) % D; const bf16* HC = (const bf16*)(A.ws + WS_HCAT); float s = 0.f;
    for (int k = 0; k < D; ++k) s += bf2f(HC[(size_t)t * D + k]) * A.in[12][((size_t)l * D + k) * D + n];
    err_put(A, 6, s, bf2f(((const bf16*)(A.ws + WS_PROJ))[(size_t)t * D + n]), 0.2f);
}
DI void chk_ln1(const Args& A, const Ctx& C, int l, const bf16* X) {
    const int gw = C.bid * NWAVES + C.wave; if (gw >= 2048) return;
    const int t = hsh(gw, 11) % T; const bf16* Y = (const bf16*)(A.ws + WS_PROJ); const bf16* X1 = (const bf16*)(A.ws + WS_XNB);
    float v[16]; float s = 0.f;
#pragma unroll
    for (int i = 0; i < 16; ++i) { const int c = C.lane + 64 * i; v[i] = ALPHA * bf2f(X[(size_t)t * D + c]) + bf2f(Y[(size_t)t * D + c]); s += v[i]; }
    const float mean = wave_sum(s) / D; float q2 = 0.f;
#pragma unroll
    for (int i = 0; i < 16; ++i) { v[i] -= mean; q2 += v[i] * v[i]; }
    const float rstd = 1.0f / sqrtf(wave_sum(q2) / D + LN_EPS);
#pragma unroll
    for (int i = 0; i < 16; ++i) { const int c = C.lane + 64 * i; v[i] = v[i] * rstd * A.in[13][(size_t)l * D + c] + A.in[14][(size_t)l * D + c]; }
    err_put(A, 7, v[3], bf2f(X1[(size_t)t * D + C.lane + 192]), 1.0f);
    float sel[16], sg[16];
#pragma unroll
    for (int e = 0; e < 16; ++e) { float p = 0.f;
#pragma unroll
        for (int i = 0; i < 16; ++i) p += v[i] * A.in[15][(size_t)(C.lane + 64 * i) * 16 + e];
        p = wave_sum(p); sg[e] = 1.0f / (1.0f + expf(-p)); sel[e] = sg[e] + A.in[16][e]; }
    float bestg = -INFINITY; int bg = 0;
#pragma unroll
    for (int g = 0; g < 4; ++g) { float a = sel[4 * g], b = sel[4 * g + 1], c = sel[4 * g + 2], d = sel[4 * g + 3];
        float m1 = fmaxf(fmaxf(a, b), fmaxf(c, d)); float tot = a + b + c + d; float mn = fminf(fminf(a, b), fminf(c, d));
        float lo1 = fminf(a, b), hi1 = fmaxf(a, b), lo2 = fminf(c, d), hi2 = fmaxf(c, d); float second = fmaxf(fminf(hi1, hi2), fmaxf(lo1, lo2)); (void)tot; (void)mn;
        const float gs = m1 + second; if (gs > bestg) { bestg = gs; bg = g; } }
    int e0 = -1, e1 = -1; float m1 = -INFINITY, m2 = -INFINITY;
#pragma unroll
    for (int e = 0; e < 16; ++e) if ((e >> 2) == bg && sel[e] > m1) { m1 = sel[e]; e0 = e; }
#pragma unroll
    for (int e = 0; e < 16; ++e) if ((e >> 2) == bg && e != e0 && sel[e] > m2) { m2 = sel[e]; e1 = e; }
    const v4u got = ((const v4u*)(A.ws + SM_SEL))[t];
    if (C.lane == 0 && ((int)got.x != e0 || (int)got.y != e1)) atomicAdd((unsigned*)(A.ws + SM_ERR) + 8, 1u);
}
DI void chk_hid(const Args& A, const Ctx& C, int l) {
    const int gt = C.bid * NTHREADS + C.tid; if (gt >= 8192) return;
    const int t = hsh(gt, 12) % T, k = hsh(gt, 13) & 1, j = hsh(gt, 14) % DEXP; const v4u s = ((const v4u*)(A.ws + SM_SEL))[t]; const int e = k ? (int)s.y : (int)s.x; const int p = slot_of(A, l, t, k);
    const bf16* XN = (const bf16*)(A.ws + WS_XNB); float g = 0.f, u = 0.f;
    for (int c = 0; c < D; ++c) { const float x = bf2f(XN[(size_t)t * D + c]); g += x * A.in[17][((size_t)(l * NEXP + e) * D + c) * DEXP + j]; u += x * A.in[18][((size_t)(l * NEXP + e) * D + c) * DEXP + j]; }
    err_put(A, 9, g / (1.0f + expf(-g)) * u, bf2f(((const bf16*)(A.ws + WS_HID))[(size_t)p * DEXP + j]), 0.5f);
    if (p < 0 || p >= PADROWS) atomicAdd((unsigned*)(A.ws + SM_ERR) + 11, 1u);
}
DI void chk_yp(const Args& A, const Ctx& C, int l) {
    const int gt = C.bid * NTHREADS + C.tid; if (gt >= 8192) return;
    const int t = hsh(gt, 15) % T, k = hsh(gt, 16) & 1, n = hsh(gt, 17) % D; const v4u s = ((const v4u*)(A.ws + SM_SEL))[t]; const int e = k ? (int)s.y : (int)s.x; const int p = slot_of(A, l, t, k);
    const bf16* HID = (const bf16*)(A.ws + WS_HID); float y = 0.f;
    for (int j = 0; j < DEXP; ++j) y += bf2f(HID[(size_t)p * DEXP + j]) * A.in[19][((size_t)(l * NEXP + e) * DEXP + j) * D + n];
    err_put(A, 10, y, bf2f(((const bf16*)(A.ws + WS_PROJ))[(size_t)p * D + n]), 0.2f);
}
DI void chk_out(const Args& A, const Ctx& C, int l) {
    const int gw = C.bid * NWAVES + C.wave; if (gw >= 2048) return;
    const int t = hsh(gw, 18) % T; const bf16* X1 = (const bf16*)(A.ws + WS_XNB); const bf16* YP = (const bf16*)(A.ws + WS_PROJ);
    const v4u s = ((const v4u*)(A.ws + SM_SEL))[t]; const int p0 = slot_of(A, l, t, 0), p1 = slot_of(A, l, t, 1);
    const f32x2 gw2 = ((const f32x2*)(A.ws + SM_GW))[t]; const float g0 = gw2[0], g1 = gw2[1];
    float v[16]; float sm = 0.f;
#pragma unroll
    for (int i = 0; i < 16; ++i) { const int c = C.lane + 64 * i; v[i] = ALPHA * bf2f(X1[(size_t)t * D + c]) + g0 * bf2f(YP[(size_t)p0 * D + c]) + g1 * bf2f(YP[(size_t)p1 * D + c]); sm += v[i]; }
    { float sy = 0.f, sx = 0.f;
#pragma unroll
      for (int i = 0; i < 16; ++i) { const int c = C.lane + 64 * i; const float yy = g0 * bf2f(YP[(size_t)p0 * D + c]) + g1 * bf2f(YP[(size_t)p1 * D + c]); const float xx = ALPHA * bf2f(X1[(size_t)t * D + c]); sy += yy * yy; sx += xx * xx; }
      sy = wave_sum(sy); sx = wave_sum(sx); const float ratio = sqrtf(sy / sx);
      if (C.lane == 0) atomicMax((unsigned*)(A.ws + SM_ERR) + 20, __builtin_bit_cast(unsigned, ratio));
      float sxn = 0.f, shid = 0.f, syp = 0.f; const bf16* XNb = (const bf16*)(A.ws + WS_XN); const bf16* HIDb = (const bf16*)(A.ws + WS_HID);
#pragma unroll
      for (int i = 0; i < 16; ++i) { const int c = C.lane + 64 * i; const float a = bf2f(YP[(size_t)p0 * D + c]); syp += a * a; }
#pragma unroll
      for (int i = 0; i < 8; ++i) { const int c = C.lane + 64 * i; const float a = bf2f(HIDb[(size_t)p0 * DEXP + c]); shid += a * a; }
      syp = sqrtf(wave_sum(syp) / D); shid = sqrtf(wave_sum(shid) / DEXP);
      if (C.lane == 0) { atomicMax((unsigned*)(A.ws + SM_ERR) + 21, __builtin_bit_cast(unsigned, syp)); atomicMax((unsigned*)(A.ws + SM_ERR) + 22, __builtin_bit_cast(unsigned, shid)); atomicMax((unsigned*)(A.ws + SM_ERR) + 23, __builtin_bit_cast(unsigned, g0 + g1)); atomicMax((unsigned*)(A.ws + SM_ERR) + 24, s.z); atomicMax((unsigned*)(A.ws + SM_ERR) + 25, s.w); atomicMax((unsigned*)(A.ws + SM_ERR) + 26, s.x); } }
    const float mean = wave_sum(sm) / D; float q2 = 0.f;
#pragma unroll
    for (int i = 0; i < 16; ++i) { v[i] -= mean; q2 += v[i] * v[i]; }
    const float rstd = 1.0f / sqrtf(wave_sum(q2) / D + LN_EPS);
    const int c = C.lane + 64 * 5; const float r = v[5] * rstd * A.in[20][(size_t)l * D + c] + A.in[21][(size_t)l * D + c];
    err_put(A, 12, r, (l == NLAYER - 1) ? A.out[(size_t)t * D + c] : bf2f(((const bf16*)(A.ws + WS_XN))[(size_t)t * D + c]), 1.0f);
}
DI void probe_gates(const Args& A, const Ctx& C, int slot) {
    const int gt = C.bid * NTHREADS + C.tid; if (gt >= 4096) return;
    const int t = hsh(gt, 30) % T; const v4u s = ((const v4u*)(A.ws + SM_SEL))[t];
    const f32x2 gw2 = ((const f32x2*)(A.ws + SM_GW))[t];
    atomicMax((unsigned*)(A.ws + SM_ERR) + slot, __builtin_bit_cast(unsigned, gw2[0] + gw2[1]));
    { const float sm = gw2[0] + gw2[1]; if (!(fabsf(sm - 1.0f) < 1e-3f)) atomicAdd((unsigned*)(A.ws + SM_ERR) + slot + 8, 1u); }
}
DI void dbg_finish(const Args& A, const Ctx& C) {
    const unsigned* E = (const unsigned*)(A.ws + SM_ERR);
    const float tol[13] = {0, 1e-3f, 0.03f, 0.04f, 0.04f, 0.08f, 0.03f, 0.01f, 0, 0.04f, 0.04f, 0, 0.01f};
    int code = 0;
#pragma unroll
    for (int k = 12; k >= 1; --k) { bool bad;
        if (k == 8) bad = E[8] > 20u; else if (k == 11) bad = E[11] > 0u; else bad = __builtin_bit_cast(float, E[k]) > tol[k];
        if (bad) code = k; }
    const float cv = (float)(code + DBG_BIAS);
    for (size_t i = (size_t)C.bid * NTHREADS + C.tid; i < (size_t)T * D; i += (size_t)GRID * NTHREADS) A.out[i] = cv;
}
#endif
__global__ void __launch_bounds__(NTHREADS, 2) fwd_kernel(Args A0) {
    extern __shared__ __attribute__((aligned(16))) unsigned char lds_raw[];
    Ctx CK; CK.lds = (LAS unsigned char*)lds_raw; CK.tid = threadIdx.x; CK.lane = CK.tid & 63; CK.wave = __builtin_amdgcn_readfirstlane(CK.tid >> 6); CK.bid = blockIdx.x;
    for (int u = CK.tid; u < (LDS_BYTES - LDSCTL_OFF) / 4; u += NTHREADS) ((LAS unsigned*)(CK.lds + LDSCTL_OFF))[u] = 0u;
    __syncthreads();
    unsigned* ctl = (unsigned*)(A0.ws + WS_CTL);
    XcdBarrier bar = xcd_barrier_post(ctl + CW_BAR, (volatile LAS unsigned*)(CK.lds + MISC_OFF) + 8);
#define GRID_BAR() xcd_barrier<false>(bar)
#if DBG_TIME
#define TS(k) do { if (l == TIME_LAYER && CK.bid == 0 && CK.tid == 0) ((unsigned long long*)(A0.ws + WS_CTL + 12288))[k] = __builtin_amdgcn_s_memrealtime(); } while (0)
#else
#define TS(k) do { } while (0)
#endif
#define FRESH() Args A; { int z_ = 0; asm volatile("" : "+s"(z_)); _Pragma("unroll") for (int k_ = 0; k_ < 22; ++k_) A.in[k_] = A0.in[k_] + z_; A.out = A0.out + z_; A.ws = A0.ws + z_; } const Ctx C = fresh_ctx(CK)
    { FRESH(); phase_prologue_rows(A, C); }
    xcd_barrier<true>(bar);
#if DBG_CHECK
    if (DBG_LAYER == 0) { FRESH(); chk_gates(A, C, 0, A.in[0]); }
#endif
    for (int l = 0; l < NLAYER_RUN; ++l) {
        TS(0);
        { FRESH(); phase_convert(A, C, l); }
        GRID_BAR(); TS(1);
#if DUP_CONV
        { FRESH(); phase_convert(A, C, l); }
        GRID_BAR(); TS(1);
#endif

        {
            FRESH(); pg8::Gemm g{(const pg8::bf16_t*)(A.ws + WS_XN), (const pg8::bf16_t*)(A.ws + WS_WIN), T, NPROJ, D}; pg8::StaticOrder S; S.init(T, NPROJ, GRID, C.bid);
            pg8::EpiStoreBf16 E{(pg8::bf16_t*)(A.ws + WS_PROJ), NPROJ, (const float*)(A.ws + SM_BIAS), 0xffff};
            pg8::gemm_phase<pg8::EpiStoreBf16, pg8::StaticOrder, true, true>(C.lds, g, S, E);
        }
        GRID_BAR(); TS(2);
#if DUP_G1
        {
            FRESH(); pg8::Gemm g{(const pg8::bf16_t*)(A.ws + WS_XN), (const pg8::bf16_t*)(A.ws + WS_WIN), T, NPROJ, D}; pg8::StaticOrder S; S.init(T, NPROJ, GRID, C.bid);
            pg8::EpiStoreBf16 E{(pg8::bf16_t*)(A.ws + WS_PROJ), NPROJ, (const float*)(A.ws + SM_BIAS), 0xffff};
            pg8::gemm_phase<pg8::EpiStoreBf16, pg8::StaticOrder, true, true>(C.lds, g, S, E);
        }
        GRID_BAR(); TS(2);
#endif
#if DBG_CHECK
        if (l == DBG_LAYER) { FRESH(); chk_proj(A, C, l); }
#endif
        { FRESH(); for (int un = C.bid; un < NUNIT; un += GRID) mlstm_local_mfma(A, C, un); } TS(3);
        { FRESH(); for (int gu = C.bid; gu < 512; gu += GRID) gmlp_unit_mfma(A, C, l, gu); } TS(4);
        { FRESH(); for (int cu = C.bid; cu < T / 32; cu += GRID) conv_unit(A, C, l, cu); }
        GRID_BAR(); TS(5);
#if DUP_P2
        { FRESH(); for (int un = C.bid; un < NUNIT; un += GRID) mlstm_local_mfma(A, C, un); } TS(3);
        { FRESH(); for (int gu = C.bid; gu < 512; gu += GRID) gmlp_unit_mfma(A, C, l, gu); } TS(4);
        { FRESH(); for (int cu = C.bid; cu < T / 32; cu += GRID) conv_unit(A, C, l, cu); }
        GRID_BAR(); TS(5);
#endif

        { FRESH(); phase_scan(A, C); }
        GRID_BAR(); TS(6);
#if DUP_SCAN
        { FRESH(); phase_scan(A, C); }
        GRID_BAR(); TS(6);
#endif

        { FRESH(); for (int un = C.bid; un < NUNIT; un += GRID) mlstm_out_mfma(A, C, l, un); }
        GRID_BAR(); TS(7);
#if DUP_P4
        { FRESH(); for (int un = C.bid; un < NUNIT; un += GRID) mlstm_out_mfma(A, C, l, un); }
        GRID_BAR(); TS(7);
#endif

#if DBG_CHECK
        if (l == DBG_LAYER) { FRESH(); chk_conv(A, C, l); chk_gmlp(A, C, l); chk_mlstm(A, C, l); GRID_BAR(); }
#endif
        {
            FRESH(); pg8::Gemm g{(const pg8::bf16_t*)(A.ws + WS_HCAT), (const pg8::bf16_t*)(A.ws + WS_WOUT), T, D, D}; pg8::StaticOrder S; S.init(T, D, GRID, C.bid);
            pg8::EpiStoreBf16 E{(pg8::bf16_t*)(A.ws + WS_PROJ), D, nullptr, 0xffff};
            pg8::gemm_phase<pg8::EpiStoreBf16, pg8::StaticOrder, true, true>(C.lds, g, S, E);
        }
        GRID_BAR(); TS(8);
#if DUP_G5
        {
            FRESH(); pg8::Gemm g{(const pg8::bf16_t*)(A.ws + WS_HCAT), (const pg8::bf16_t*)(A.ws + WS_WOUT), T, D, D}; pg8::StaticOrder S; S.init(T, D, GRID, C.bid);
            pg8::EpiStoreBf16 E{(pg8::bf16_t*)(A.ws + WS_PROJ), D, nullptr, 0xffff};
            pg8::gemm_phase<pg8::EpiStoreBf16, pg8::StaticOrder, true, true>(C.lds, g, S, E);
        }
        GRID_BAR(); TS(8);
#endif
#if DBG_CHECK
        if (l == DBG_LAYER) { FRESH(); chk_y(A, C, l); GRID_BAR(); }
#endif
        for (int rep = (DUP_P6 ? 0 : 1); rep < 2; ++rep) { FRESH(); phase_ln1_router(A, C, l, rep == 0); GRID_BAR(); }
        TS(9);

#if DBG_CHECK
        if (l == DBG_LAYER) { FRESH(); chk_ln1(A, C, l, (const bf16*)(A.ws + WS_XN)); probe_gates(A, C, 27); GRID_BAR(); }
#endif


        {
            FRESH(); pg8::MoeOrder<true> S{(const unsigned*)(A.ws + WS_CTL) + CW_CNT + l * 256, (const int*)(A.ws + WS_LIST), GRID, C.bid, D * 2};
            pg8::Gemm g{(const pg8::bf16_t*)(A.ws + WS_XNB), (const pg8::bf16_t*)(A.ws + WS_WGU), PADROWS, NEXP * 1024, D};
            pg8::EpiSwiGLU E{(pg8::bf16_t*)(A.ws + WS_HID), DEXP};
            pg8::gemm_phase<pg8::EpiSwiGLU, pg8::MoeOrder<true>, true, true>(C.lds, g, S, E);
        }
        GRID_BAR(); TS(11);
#if DUP_G8
        {
            FRESH(); pg8::MoeOrder<true> S{(const unsigned*)(A.ws + WS_CTL) + CW_CNT + l * 256, (const int*)(A.ws + WS_LIST), GRID, C.bid, D * 2};
            pg8::Gemm g{(const pg8::bf16_t*)(A.ws + WS_XNB), (const pg8::bf16_t*)(A.ws + WS_WGU), PADROWS, NEXP * 1024, D};
            pg8::EpiSwiGLU E{(pg8::bf16_t*)(A.ws + WS_HID), DEXP};
            pg8::gemm_phase<pg8::EpiSwiGLU, pg8::MoeOrder<true>, true, true>(C.lds, g, S, E);
        }
        GRID_BAR(); TS(11);
#endif
#if DBG_CHECK
        if (l == DBG_LAYER) { FRESH(); chk_hid(A, C, l); probe_gates(A, C, 29); }
#endif
        {
            FRESH(); pg8::MoeOrder<false> S{(const unsigned*)(A.ws + WS_CTL) + CW_CNT + l * 256, (const int*)(A.ws + WS_LIST), GRID, C.bid, 0};
            pg8::Gemm g{(const pg8::bf16_t*)(A.ws + WS_HID), (const pg8::bf16_t*)(A.ws + WS_WD), PADROWS, NEXP * 1024, DEXP};
            pg8::EpiStoreBf16 E{(pg8::bf16_t*)(A.ws + WS_PROJ), D, nullptr, 3};
            pg8::gemm_phase<pg8::EpiStoreBf16, pg8::MoeOrder<false>, true, true>(C.lds, g, S, E);
        }
        GRID_BAR(); TS(12);
#if DUP_G9
        {
            FRESH(); pg8::MoeOrder<false> S{(const unsigned*)(A.ws + WS_CTL) + CW_CNT + l * 256, (const int*)(A.ws + WS_LIST), GRID, C.bid, 0};
            pg8::Gemm g{(const pg8::bf16_t*)(A.ws + WS_HID), (const pg8::bf16_t*)(A.ws + WS_WD), PADROWS, NEXP * 1024, DEXP};
            pg8::EpiStoreBf16 E{(pg8::bf16_t*)(A.ws + WS_PROJ), D, nullptr, 3};
            pg8::gemm_phase<pg8::EpiStoreBf16, pg8::MoeOrder<false>, true, true>(C.lds, g, S, E);
        }
        GRID_BAR(); TS(12);
#endif
#if DBG_CHECK
        if (l == DBG_LAYER) { FRESH(); chk_yp(A, C, l); probe_gates(A, C, 30); }
#endif
        { FRESH(); phase_combine(A, C, l); }
        GRID_BAR(); TS(13);
#if DUP_P10
        { FRESH(); phase_combine(A, C, l); }
        GRID_BAR(); TS(13);
#endif

#if DBG_CHECK
        if (l == DBG_LAYER) { FRESH(); chk_out(A, C, l);  GRID_BAR(); }
#endif
    }
#if DBG_CHECK
    { FRESH(); dbg_finish(A, C); }
#endif
#if DBG_TIME
    { FRESH(); const unsigned long long* tsb = (const unsigned long long*)(A.ws + WS_CTL + 12288);
      const float c1 = floorf(((float)(tsb[TIME_A] - tsb[TIME_A - 1]) + TIME_OFF * 100.0f) * (1.0f / 1600.0f));
      for (size_t i = (size_t)C.bid * NTHREADS + C.tid; i < (size_t)T * D; i += (size_t)GRID * NTHREADS) A.out[i] = c1; }
#endif
}

extern "C" void kernel_launch(void* const* d_in, const int* in_sizes, int n_in, void* d_out, int out_size, void* d_ws, size_t ws_size, hipStream_t stream) {
    static int ready = 0;
    if (ready == 0) {
        if (n_in != 22 || in_sizes[0] != T * D || out_size != T * D || ws_size < WS_END) { fprintf(stderr, "kernel_launch: unexpected shapes (n_in %d, in0 %d, out %d, ws %zu)\n", n_in, n_in > 0 ? in_sizes[0] : -1, out_size, ws_size); ready = -1; return; }
        if (hipFuncSetAttribute((const void*)fwd_kernel, hipFuncAttributeMaxDynamicSharedMemorySize, LDS_BYTES) != hipSuccess) { fprintf(stderr, "kernel_launch: hipFuncSetAttribute failed\n"); ready = -1; return; }
        (void)hipGetLastError();
        ready = 1;
    }
    if (ready < 0) return;
    if (hipMemsetAsync((char*)d_ws + WS_CTL, 0, CTL_ZERO_BYTES, stream) != hipSuccess) return;
    Args a{};
    for (int i = 0; i < 22; ++i) a.in[i] = (const float*)d_in[i];
    a.out = (float*)d_out; a.ws = (unsigned char*)d_ws;
    hipLaunchKernelGGL(fwd_kernel, dim3(GRID), dim3(NTHREADS), LDS_BYTES, stream, a);
}
```

```cpp
#include <hip/hip_runtime.h>
#include <cstdio>
#include <cstdint>
namespace pg8 {
#define PG8_LAS __attribute__((address_space(3)))
typedef unsigned short bf16_t;
typedef short bf16x8 __attribute__((ext_vector_type(8)));
typedef float f32x4 __attribute__((ext_vector_type(4)));
typedef unsigned u32x4 __attribute__((ext_vector_type(4)));
constexpr int BM = 256, BK = 64, HALF = 128, HTB = HALF * BK * 2  , STAGE_BYTES = 8 * HTB, NXCD = 8, WGM = 8;

__host__ __device__ __forceinline__ int lds_byte(int r, int c) { const int st = (r >> 4) * 2 + (c >> 5), rr = r & 15, cc = c & 31, ob = rr * 64 + cc * 2; return st * 1024 + (ob ^ (((ob >> 9) & 1) << 5)); }
__host__ __device__ __forceinline__ void stage_rc(int b, int& R, int& C) { const int st = b / 1024, sb = b % 1024, swz = sb ^ (((sb >> 9) & 1) << 5); R = (st >> 1) * 16 + swz / 64; C = (st & 1) * 32 + (swz % 64) / 2; }
__host__ __device__ __forceinline__ int perm32(int rho) { const int n = rho >> 4, i = rho & 15; return 8 * (i >> 2) + 4 * n + (i & 3); }

struct Unit { int pm, pn, e, r0, cnt; };
struct Gemm { const bf16_t* A; const bf16_t* Bt; int M, N, K; };

struct StaticOrder {
    static constexpr bool GATHER = false;
    int nM, nN, nwg, G, c;
    __device__ __forceinline__ unsigned a_off(const Unit&, int) const { return 0u; }
    __host__ __device__ void init(int M, int N, int G_, int c_) { nM = M / BM; nN = N / BM; nwg = nM * nN; G = G_; c = c_; }
    __host__ __device__ bool next(int i, Unit& u) const {
        const long L = (long)i * G + c; if (L >= nwg) return false;
        int wgid = (int)L; { const int q = nwg / NXCD, r = nwg % NXCD, xcd = wgid % NXCD, off = wgid / NXCD; wgid = (xcd < r ? xcd * (q + 1) : r * (q + 1) + (xcd - r) * q) + off; }
        const int nig = WGM * nN, gid = wgid / nig, fm = gid * WGM, gsz = (nM - fm) < WGM ? (nM - fm) : WGM;
        u.pm = fm + ((wgid % nig) % gsz); u.pn = (wgid % nig) / gsz; return true;
    }
    __device__ __forceinline__ void a_ready(const Unit&) const {}
    __device__ __forceinline__ void done(const Unit&) const {}
};
template <bool GATH> struct MoeOrder {
    static constexpr bool GATHER = GATH;
    const PG8_LAS int* desc; const int* list; int G, c, rowbytes;
    __device__ __forceinline__ bool next(int i, Unit& u) const {
        u.pm = 0; u.pn = 0; u.e = 0; u.r0 = 0; u.cnt = 0;
        if (i >= 4) return false;
        const int L = i * G + c; const int f = __builtin_amdgcn_readfirstlane(desc[5 * i]);
        if (!f) return false;
        u.pm = L >> 2; u.e = __builtin_amdgcn_readfirstlane(desc[5 * i + 1]); u.r0 = __builtin_amdgcn_readfirstlane(desc[5 * i + 2]); u.cnt = __builtin_amdgcn_readfirstlane(desc[5 * i + 3]); u.pn = __builtin_amdgcn_readfirstlane(desc[5 * i + 4]);
        return true;
    }
    __device__ __forceinline__ unsigned a_off(const Unit& u, int row) const { const int pos = u.r0 + row; const int tok = pos < u.cnt ? list[(size_t)u.e * 16384 + pos] : 0; return (unsigned)tok * (unsigned)rowbytes; }
    __device__ __forceinline__ void a_ready(const Unit&) const {}
    __device__ __forceinline__ void done(const Unit&) const {}
};
__device__ __forceinline__ void moe_units(PG8_LAS int* desc, const unsigned* cnt, int G, int c) {
    if (threadIdx.x < 4) { const int i = threadIdx.x, L = i * G + c, rt = L >> 2; int acc = 0, f = 0, ee = 0, r0 = 0, cn = 0;
        for (int e = 0; e < 16; ++e) { const int n = (int)__hip_atomic_load(cnt + 16 * e, __ATOMIC_RELAXED, __HIP_MEMORY_SCOPE_AGENT); const int nt = (n + 255) >> 8;
            if (!f && rt < acc + nt) { f = 1; ee = e; r0 = (rt - acc) * 256; cn = n; }
            acc += nt; }
        desc[5 * i] = f; desc[5 * i + 1] = ee; desc[5 * i + 2] = r0; desc[5 * i + 3] = cn; desc[5 * i + 4] = ee * 4 + (L & 3); }
    __syncthreads();
}

__device__ __forceinline__ unsigned cvt_pk_bf16(float lo, float hi) { unsigned r; asm volatile("v_cvt_pk_bf16_f32 %0, %1, %2" : "=v"(r) : "v"(lo), "v"(hi)); return r; }

struct EpiStoreBf16 {
    static constexpr bool PERM = true, AFTER_DRAIN = false;
    bf16_t* O; int ldc; const float* bias; int pn_mask;
    __device__ __forceinline__ void operator()(const f32x4 (&acc)[2][2][4][2], const Unit& u, int wr, int wc, int fr, int fq) const {
        const int row0 = u.pm * BM + wr * 64 + fr; const int col0 = (u.pn & pn_mask) * BM + wc * 32 + 8 * fq;
        f32x4 bv[2][2];
#pragma unroll
        for (int bj = 0; bj < 2; ++bj)
#pragma unroll
            for (int n = 0; n < 2; ++n) bv[bj][n] = bias ? *(const f32x4*)(bias + col0 + bj * HALF + 4 * n) : (f32x4){0.f, 0.f, 0.f, 0.f};
#pragma unroll
        for (int ai = 0; ai < 2; ++ai)
#pragma unroll
            for (int m = 0; m < 4; ++m) { bf16_t* rowp = O + (size_t)(row0 + ai * HALF + m * 16) * ldc + col0;
#pragma unroll
                for (int bj = 0; bj < 2; ++bj) { const f32x4 v0 = acc[ai][bj][m][0] + bv[bj][0], v1 = acc[ai][bj][m][1] + bv[bj][1];
                    u32x4 w; w.x = cvt_pk_bf16(v0[0], v0[1]); w.y = cvt_pk_bf16(v0[2], v0[3]); w.z = cvt_pk_bf16(v1[0], v1[1]); w.w = cvt_pk_bf16(v1[2], v1[3]);
                    *(u32x4*)(rowp + bj * HALF) = w; } }
    }
};
struct EpiSwiGLU {
    static constexpr bool PERM = true, AFTER_DRAIN = false;
    bf16_t* O; int ldc;
    __device__ __forceinline__ void operator()(const f32x4 (&acc)[2][2][4][2], const Unit& u, int wr, int wc, int fr, int fq) const {
        const int row0 = u.pm * BM + wr * 64 + fr; const int col0 = (u.pn & 3) * HALF + wc * 32 + 8 * fq;
#pragma unroll
        for (int ai = 0; ai < 2; ++ai)
#pragma unroll
            for (int m = 0; m < 4; ++m) { bf16_t* rowp = O + (size_t)(row0 + ai * HALF + m * 16) * ldc + col0;
                float h[8];
#pragma unroll
                for (int n = 0; n < 2; ++n)
#pragma unroll
                    for (int k = 0; k < 4; ++k) { const float g = acc[ai][0][m][n][k], up = acc[ai][1][m][n][k]; h[4 * n + k] = g * up / (1.0f + __expf(-g)); }
                u32x4 w; w.x = cvt_pk_bf16(h[0], h[1]); w.y = cvt_pk_bf16(h[2], h[3]); w.z = cvt_pk_bf16(h[4], h[5]); w.w = cvt_pk_bf16(h[6], h[7]);
                *(u32x4*)rowp = w; }
    }
};
template <class Epi, class Sched, bool ALIGN_EPI = false, bool SP2 = false>
__device__ __forceinline__ void gemm_phase(PG8_LAS unsigned char* lds, const Gemm g, const Sched& S, const Epi& E) {
    int tid_l = threadIdx.x; asm volatile("" : "+v"(tid_l)); const int tid = tid_l, wid = __builtin_amdgcn_readfirstlane(tid >> 6), lane = tid & 63, wr = wid >> 2, wc = wid & 3, fr = lane & 15, fq = lane >> 4;
    const int K = g.K, nt = K / BK;
    unsigned voffA[2], voffB[2];
#pragma unroll
    for (int i = 0; i < 2; ++i) { int R, C; stage_rc(tid * 16 + i * 8192, R, C); const int Rb = Epi::PERM ? ((R & ~31) + perm32(R & 31)) : R;
        voffA[i] = (unsigned)(R * K + C) * 2u; voffB[i] = (unsigned)(Rb * K + C) * 2u; }
    unsigned cv0[2] = {voffA[0], voffA[1]}, cv1[2] = {voffA[0], voffA[1]};
#define PG8_GOFF(u, d0, d1) do { _Pragma("unroll") for (int _i = 0; _i < 2; ++_i) { int R_, C_; stage_rc(tid * 16 + _i * 8192, R_, C_); d0[_i] = S.a_off(u, R_) + (unsigned)(C_ * 2); d1[_i] = S.a_off(u, HALF + R_) + (unsigned)(C_ * 2); } } while (0)
    const size_t kstep = (size_t)(BK * 2);
    const size_t hstep = (size_t)HALF * K * 2;
    const size_t tstep = 2 * hstep;
    const unsigned ldsw = (unsigned)wid * 1024u;
    const int aoff = lds_byte(wr * 64 + fr, fq * 8), boff = lds_byte(wc * 32 + fr, fq * 8);
#define PG8_SA(b, h) (((b) * 2 + (h)) * HTB)
#define PG8_SB(b, h) ((4 + (b) * 2 + (h)) * HTB)
#define PG8_STAGE(bufoff, gbase, voff) do { _Pragma("unroll") for (int _i = 0; _i < 2; ++_i) \
        __builtin_amdgcn_global_load_lds((const unsigned*)((const char*)(gbase) + (voff)[_i]), (PG8_LAS unsigned*)(lds + (bufoff) + ldsw + _i * 8192), 16, 0, 0); } while (0)
#define PG8_LDA(dst, b, h) do { _Pragma("unroll") for (int m = 0; m < 4; ++m) _Pragma("unroll") for (int k = 0; k < 2; ++k) dst[m][k] = *(const PG8_LAS bf16x8*)(lds + PG8_SA(b, h) + aoff + m * 2048 + k * 1024); } while (0)
#define PG8_LDB(dst, b, h) do { _Pragma("unroll") for (int n = 0; n < 2; ++n) _Pragma("unroll") for (int k = 0; k < 2; ++k) dst[n][k] = *(const PG8_LAS bf16x8*)(lds + PG8_SB(b, h) + boff + n * 2048 + k * 1024); } while (0)
#define PG8_MMA(ai, bj, At, Bt) do { __builtin_amdgcn_s_setprio(1); _Pragma("unroll") for (int m = 0; m < 4; ++m) _Pragma("unroll") for (int n = 0; n < 2; ++n) _Pragma("unroll") for (int k = 0; k < 2; ++k) \
        acc[ai][bj][m][n] = __builtin_amdgcn_mfma_f32_16x16x32_bf16(Bt[n][k], At[m][k], acc[ai][bj][m][n], 0, 0, 0); __builtin_amdgcn_s_setprio(0); } while (0)
#define PG8_WAIT_V(n) asm volatile("s_waitcnt vmcnt(" #n ")" ::: "memory")
#define PG8_WAIT_L(n) asm volatile("s_waitcnt lgkmcnt(" #n ")" ::: "memory")
#define PG8_BAR __builtin_amdgcn_s_barrier()
#define PG8_SCHED __builtin_amdgcn_sched_barrier(0)
    Unit cur, nxt; int ui = 0;
    if (!S.next(0, cur)) return;
    f32x4 acc[2][2][4][2];
#pragma unroll
    for (int a = 0; a < 2; ++a)
#pragma unroll
        for (int b = 0; b < 2; ++b)
#pragma unroll
            for (int m = 0; m < 4; ++m)
#pragma unroll
                for (int n = 0; n < 2; ++n) acc[a][b][m][n] = (f32x4){0.f, 0.f, 0.f, 0.f};
    bf16x8 At[4][2], B0[2][2], B1[2][2];
    const char* cA = Sched::GATHER ? (const char*)g.A : (const char*)g.A + (size_t)cur.pm * tstep; const char* cB = (const char*)g.Bt + (size_t)cur.pn * tstep;
    const size_t hstepA = Sched::GATHER ? 0 : hstep;
    if constexpr (Sched::GATHER) { static_assert(SP2, "gather is wired into the SP2 loop only"); PG8_GOFF(cur, cv0, cv1); }
    S.a_ready(cur);
    if constexpr (SP2) {
        PG8_STAGE(PG8_SB(0, 0), cB, voffB); PG8_STAGE(PG8_SB(0, 1), cB + hstep, voffB); PG8_STAGE(PG8_SA(0, 0), cA, cv0); PG8_STAGE(PG8_SA(0, 1), cA + hstepA, cv1);
        if (wr == 1) PG8_BAR;
        PG8_WAIT_V(2); PG8_BAR;
        PG8_STAGE(PG8_SB(1, 0), cB + kstep, voffB); PG8_STAGE(PG8_SA(1, 0), cA + kstep, cv0); PG8_STAGE(PG8_SB(1, 1), cB + hstep + kstep, voffB);
        PG8_WAIT_V(6); PG8_BAR;
    } else {
        PG8_STAGE(PG8_SB(0, 0), cB, voffB); PG8_STAGE(PG8_SA(0, 0), cA, voffA); PG8_STAGE(PG8_SB(0, 1), cB + hstep, voffB); PG8_STAGE(PG8_SA(0, 1), cA + hstep, voffA);
        if (wr == 1) PG8_BAR;
        PG8_WAIT_V(4); PG8_BAR;
        PG8_STAGE(PG8_SB(1, 0), cB + kstep, voffB); PG8_STAGE(PG8_SA(1, 0), cA + kstep, voffA); PG8_STAGE(PG8_SB(1, 1), cB + hstep + kstep, voffB);
        PG8_WAIT_V(6); PG8_BAR;
    }
    for (;;) {
        const bool has_next = S.next(ui + 1, nxt);
        const char* nA = Sched::GATHER ? (const char*)g.A : (has_next ? (const char*)g.A + (size_t)nxt.pm * tstep : cA); const char* nB = has_next ? (const char*)g.Bt + (size_t)nxt.pn * tstep : cB;
        for (int t = 0; t < nt; t += 2) {
            const bool last = (t == nt - 2);
            const char* a1 = cA + (size_t)(t + 1) * kstep;
            const char* a2 = last ? nA : cA + (size_t)(t + 2) * kstep; const char* b2 = last ? nB : cB + (size_t)(t + 2) * kstep;
            const char* a3 = a2 + kstep; const char* b3 = b2 + kstep;
            if (last && has_next) S.a_ready(nxt);
            if constexpr (SP2) {
            PG8_LDB(B0, 0, 0); PG8_LDB(B1, 0, 1); PG8_SCHED; PG8_LDA(At, 0, 0); PG8_STAGE(PG8_SA(1, 1), a1 + hstepA, cv1);
            if constexpr (Sched::GATHER) { if (last && has_next) { PG8_GOFF(nxt, cv0, cv1); } }
            PG8_WAIT_V(8); PG8_WAIT_L(0); PG8_BAR; PG8_MMA(0, 0, At, B0); PG8_MMA(0, 1, At, B1); PG8_BAR; PG8_SCHED;
            PG8_LDA(At, 0, 1); PG8_STAGE(PG8_SB(0, 0), b2, voffB); PG8_STAGE(PG8_SB(0, 1), b2 + hstep, voffB); PG8_STAGE(PG8_SA(0, 0), a2, cv0);
            PG8_WAIT_V(8); PG8_WAIT_L(0); PG8_BAR; PG8_MMA(1, 0, At, B0); PG8_MMA(1, 1, At, B1); PG8_BAR; PG8_SCHED;
            PG8_LDB(B0, 1, 0); PG8_LDB(B1, 1, 1); PG8_SCHED; PG8_LDA(At, 1, 0); PG8_STAGE(PG8_SA(0, 1), a2 + hstepA, cv1);
            PG8_WAIT_V(8); PG8_WAIT_L(0); PG8_BAR; PG8_MMA(0, 0, At, B0); PG8_MMA(0, 1, At, B1); PG8_BAR; PG8_SCHED;
            PG8_LDA(At, 1, 1); PG8_STAGE(PG8_SB(1, 0), b3, voffB); PG8_STAGE(PG8_SB(1, 1), b3 + hstep, voffB); PG8_STAGE(PG8_SA(1, 0), a3, cv0);
            PG8_WAIT_V(8); PG8_WAIT_L(0); PG8_BAR; PG8_MMA(1, 0, At, B0); PG8_MMA(1, 1, At, B1); PG8_BAR; PG8_SCHED;
            } else {
            PG8_LDB(B0, 0, 0); PG8_SCHED; PG8_LDA(At, 0, 0); PG8_STAGE(PG8_SA(1, 1), a1 + hstep, voffA);
            PG8_WAIT_L(8); PG8_BAR; PG8_WAIT_L(0); PG8_MMA(0, 0, At, B0); PG8_BAR; PG8_SCHED;
            PG8_LDB(B1, 0, 1); PG8_STAGE(PG8_SB(0, 0), b2, voffB);
            PG8_BAR; PG8_WAIT_L(0); PG8_MMA(0, 1, At, B1); PG8_BAR;
            PG8_LDA(At, 0, 1); PG8_STAGE(PG8_SA(0, 0), a2, voffA);
            PG8_BAR; PG8_WAIT_L(0); PG8_MMA(1, 0, At, B0); PG8_BAR; PG8_SCHED;
            PG8_STAGE(PG8_SB(0, 1), b2 + hstep, voffB);
            PG8_WAIT_V(6); PG8_BAR; PG8_MMA(1, 1, At, B1); PG8_BAR;
            PG8_LDB(B0, 1, 0); PG8_SCHED; PG8_LDA(At, 1, 0); PG8_STAGE(PG8_SA(0, 1), a2 + hstep, voffA);
            PG8_WAIT_L(8); PG8_BAR; PG8_WAIT_L(0); PG8_MMA(0, 0, At, B0); PG8_BAR; PG8_SCHED;
            PG8_LDB(B1, 1, 1); PG8_STAGE(PG8_SB(1, 0), b3, voffB);
            PG8_BAR; PG8_WAIT_L(0); PG8_MMA(0, 1, At, B1); PG8_BAR;
            PG8_LDA(At, 1, 1); PG8_STAGE(PG8_SA(1, 0), a3, voffA);
            PG8_BAR; PG8_WAIT_L(0); PG8_MMA(1, 0, At, B0); PG8_BAR; PG8_SCHED;
            PG8_STAGE(PG8_SB(1, 1), b3 + hstep, voffB);
            PG8_WAIT_V(6); PG8_BAR; PG8_MMA(1, 1, At, B1); PG8_BAR;
            }
        }
        if constexpr (ALIGN_EPI) { if (wr == 0) PG8_BAR; }
        if constexpr (!Epi::AFTER_DRAIN) { E(acc, cur, wr, wc, fr, fq); S.done(cur); }
        if (!has_next) break;
#pragma unroll
        for (int a = 0; a < 2; ++a)
#pragma unroll
            for (int b = 0; b < 2; ++b)
#pragma unroll
                for (int m = 0; m < 4; ++m)
#pragma unroll
                    for (int n = 0; n < 2; ++n) acc[a][b][m][n] = (f32x4){0.f, 0.f, 0.f, 0.f};
        cur = nxt; cA = nA; cB = nB; ++ui;
        if constexpr (ALIGN_EPI) { if (wr == 1) PG8_BAR; }
    }
    PG8_WAIT_V(0);
    if constexpr (!ALIGN_EPI) { if (wr == 0) PG8_BAR; }
    PG8_BAR;
    if constexpr (Epi::AFTER_DRAIN) { E.fused(acc, cur, wr, wc, fr, fq, lds, wid, lane); S.done(cur); }
#undef PG8_SA
#undef PG8_SB
#undef PG8_STAGE
#undef PG8_LDA
#undef PG8_LDB
#undef PG8_MMA
#undef PG8_WAIT_V
#undef PG8_WAIT_L
#undef PG8_BAR
#undef PG8_SCHED
#undef PG8_GOFF
}
}
#ifndef DBG_CHECK
#define DBG_CHECK 0
#endif
#define DBG_LAYER 0
#ifndef DBG_TIME
#define DBG_TIME 0
#endif
#define TIME_LAYER 1
#define DUP_CONV 0
#define DUP_SCAN 0
#define DUP_P10 0
#define DUP_P6 0
#define DUP_P2 0
#define DUP_LOCAL 0
#define DUP_GMLP 0
#define DUP_CONVU 0
#define DUP_P4 0
#define DUP_G1 0
#define DUP_G5 0
#define DUP_G8 0
#define DUP_G9 0
#define TIME_A 9
#define TIME_B 2
#define TIME_OFF 0
#define DBG_BIAS 0
constexpr int NWAVES = 8, NTHREADS = 512, GRID = 256;
constexpr int NLAYER_RUN = DBG_CHECK ? (DBG_LAYER + 1) : 4;
constexpr int T = 16384, D = 1024, SEQ = 4096, NLAYER = 4;
constexpr int PIN = 3080, NPROJ = 3072;
constexpr int CH = 128, NCH = 32, NUNIT = 512;
constexpr int NEXP = 16, DEXP = 512;
constexpr int PADROWS = 36864;
constexpr float ALPHA = 1.6817928305074290f;
constexpr float LN_EPS = 1e-5f;
constexpr int PQ = 0, PK = 512, PV = 1024, PO = 1536, PGU = 2048, PGV = 2304, PCA = 2560, PCB = 2816;
constexpr size_t MiB = 1u << 20;
constexpr size_t WS_CTL = 0, CTL_ZERO_BYTES = 1 * MiB;
constexpr size_t WS_WIN = 2 * MiB, WS_WOUT = 8 * MiB, WS_WGU = 10 * MiB, WS_WD = 42 * MiB;
constexpr size_t WS_SMALL = 58 * MiB;
constexpr size_t SM_BIAS = WS_SMALL;
constexpr size_t SM_GATES = WS_SMALL + 64 * 1024;
constexpr size_t SM_SEL = SM_GATES + 512 * 1024;
constexpr size_t SM_HIST = SM_SEL + 256 * 1024;
constexpr size_t SM_META = SM_HIST + 16 * 1024;
constexpr size_t SM_TOKSLOT = SM_META + 4 * 1024;
constexpr size_t SM_G = SM_TOKSLOT + 128 * 1024;
constexpr size_t SM_MLOC = SM_G + 2048;
constexpr size_t SM_MPREV = SM_MLOC + 2048;
constexpr size_t SM_NLOC = SM_MPREV + 2048;
constexpr size_t SM_NPREV = SM_NLOC + 256 * 1024;
constexpr size_t SM_END = SM_NPREV + 256 * 1024;
constexpr size_t SM_WM = SM_END + 128 * 1024;
constexpr size_t SM_GW = SM_END;
static_assert(SM_WM + 128 * 1024 <= 62 * MiB, "small region");
constexpr size_t WS_XN = 62 * MiB, WS_HCAT = 94 * MiB, WS_XNB = 126 * MiB, WS_CLOCT = 190 * MiB, WS_CPREVT = 222 * MiB, WS_HID = 238 * MiB;
constexpr size_t WS_PROJ = 274 * MiB;
constexpr size_t WS_WGU2 = 370 * MiB, WS_WD2 = 402 * MiB;
constexpr size_t WS_END = 418 * MiB;
static_assert(WS_HID + (size_t)PADROWS * DEXP * 2 <= WS_PROJ && WS_PROJ + (size_t)PADROWS * D * 2 <= WS_END && WS_PROJ + (size_t)T * NPROJ * 2 <= WS_END, "ws map");
constexpr int CW_TMO = 0, CW_BAR = 4096, CW_CNT = 8192;
constexpr size_t WS_LIST = 158 * MiB;
constexpr int RING_BYTES = 131072, LDSCTL_OFF = 139264, MISC_OFF = LDSCTL_OFF + 320, PTR_OFF = LDSCTL_OFF + 512, VEC_OFF = LDSCTL_OFF + 1024, LDS_BYTES = 151552;

#define LAS __attribute__((address_space(3)))
typedef unsigned short bf16;
typedef unsigned v4u __attribute__((ext_vector_type(4)));
typedef unsigned v2u __attribute__((ext_vector_type(2)));
typedef float f32x4 __attribute__((ext_vector_type(4)));
typedef float f32x2 __attribute__((ext_vector_type(2)));
#define DI __device__ __forceinline__
typedef __bf16 bf16x2_t __attribute__((ext_vector_type(2)));
DI unsigned pk2(float lo, float hi) { const f32x2 v = {lo, hi}; return __builtin_bit_cast(unsigned, __builtin_convertvector(v, bf16x2_t)); }
DI unsigned f2bf(float f) { return pk2(f, 0.f) & 0xffffu; }
DI float bflo(unsigned w) { return __builtin_bit_cast(float, w << 16); }
DI float bfhi(unsigned w) { return __builtin_bit_cast(float, w & 0xffff0000u); }
DI float bf2f(bf16 h) { return __builtin_bit_cast(float, (unsigned)h << 16); }
DI float wave_sum_ref(float v) {
#pragma unroll
    for (int o = 1; o < 64; o <<= 1) v += __shfl_xor(v, o);
    return v;
}
template <int CTRL> DI float dpp_f(float v) { return __builtin_bit_cast(float, __builtin_amdgcn_update_dpp(0, __builtin_bit_cast(int, v), CTRL, 0xf, 0xf, false)); }
DI float row_sum16(float v) {
    v += dpp_f<0xB1>(v);
    v += dpp_f<0x4E>(v);
    v += dpp_f<0x141>(v);
    v += dpp_f<0x140>(v);
    return v;
}
DI float rl_f(float v, int l) { return __builtin_bit_cast(float, __builtin_amdgcn_readlane(__builtin_bit_cast(int, v), l)); }
DI float wave_sum(float v) { v = row_sum16(v); return (rl_f(v, 0) + rl_f(v, 16)) + (rl_f(v, 32) + rl_f(v, 48)); }
template <int N> DI int red_idx(int lane) { int idx = 0, n = N, o = 32; while (n > 1) { n >>= 1; if (lane & o) idx += n; o >>= 1; } return idx; }
typedef unsigned u32x2_t __attribute__((ext_vector_type(2)));
template <int N, int O> struct RedStep { template <int NN> static DI void run(float (&v)[NN], int lane) {
#pragma unroll
        for (int k = 0; k < N / 2; ++k) {
            if constexpr (O == 32) { float a = v[k], b = v[k + N / 2]; asm volatile("s_nop 1\n\tv_permlane32_swap_b32 %0, %1\n\ts_nop 1" : "+v"(a), "+v"(b)); v[k] = a + b; }
            else if constexpr (O == 16) { float a = v[k], b = v[k + N / 2]; asm volatile("s_nop 1\n\tv_permlane16_swap_b32 %0, %1\n\ts_nop 1" : "+v"(a), "+v"(b)); v[k] = a + b; }
            else { const bool up = (lane & O) != 0; const float keep = up ? v[k + N / 2] : v[k], send = up ? v[k] : v[k + N / 2];
                v[k] = keep + (O == 8 ? dpp_f<0x128>(send) : (O == 4 ? dpp_f<0x141>(send) : (O == 2 ? dpp_f<0x4E>(send) : dpp_f<0xB1>(send)))); } }
        RedStep<N / 2, O / 2>::run(v, lane); } };
template <int O> struct RedStep<1, O> { template <int NN> static DI void run(float (&v)[NN], int) {
        if constexpr (O == 32) { v[0] = wave_sum(v[0]); }
        else if constexpr (O == 16) { v[0] = row_sum16(v[0]); float a = v[0], b = v[0]; asm volatile("s_nop 1\n\tv_permlane16_swap_b32 %0, %1\n\ts_nop 1" : "+v"(a), "+v"(b)); v[0] = a + b; }
        else if constexpr (O == 8) { v[0] = row_sum16(v[0]); }
        else if constexpr (O == 4) { v[0] += dpp_f<0xB1>(v[0]); v[0] += dpp_f<0x4E>(v[0]); v[0] += dpp_f<0x141>(v[0]); }
        else if constexpr (O == 2) { v[0] += dpp_f<0xB1>(v[0]); v[0] += dpp_f<0x4E>(v[0]); }
        else if constexpr (O == 1) { v[0] += dpp_f<0xB1>(v[0]); } } };
template <> struct RedStep<1, 0> { template <int NN> static DI void run(float (&)[NN], int) {} };
template <int N> DI void red_multi(float (&v)[N], int lane) { RedStep<N, 32>::run(v, lane); }
DI float sigmoidf_(float x) { return __builtin_amdgcn_rcpf(1.0f + __builtin_amdgcn_exp2f(-1.4426950408889634f * x)); }
DI float gelu_tanh(float x) { const float t = x * x; const float p = x * __builtin_fmaf(t, -0.10294324f, -2.3022082f); return x * __builtin_amdgcn_rcpf(1.0f + __builtin_amdgcn_exp2f(p)); }
DI float logsigmoidf_(float x) { return fminf(x, 0.0f) - log1pf(__expf(-fabsf(x))); }

#define XB_TMO      128
#define XB_XCNT(j)  (256  + 64 * (j))
#define XB_XSUB(j)  (1280 + 64 * (j))
#define XB_XGEN(j)  (2304 + 64 * (j))
#define XB_TOP      3328
#define XB_TOPGEN   3392
#define XCD_BAR_WORDS 3456
#define XB_SPIN_CAP (1u << 18)
__device__ __forceinline__ unsigned xb_ld(unsigned* p)              { return __hip_atomic_load(p, __ATOMIC_RELAXED, __HIP_MEMORY_SCOPE_AGENT); }
__device__ __forceinline__ unsigned xb_add(unsigned* p, unsigned v) { return __hip_atomic_fetch_add(p, v, __ATOMIC_RELAXED, __HIP_MEMORY_SCOPE_AGENT); }
__device__ __forceinline__ unsigned xb_xcc_id() { return (unsigned)__builtin_amdgcn_s_getreg((3 << 11) | 20) & 0xFu; }
#define XB_SPIN(cond, bar) do { unsigned _sp = 0; while (cond) { __builtin_amdgcn_s_sleep(1); \
    if ((++_sp & 255u) == 0u) { if (xb_ld(&(bar)[XB_TMO])) break; if (_sp > XB_SPIN_CAP) { atomicAdd(&(bar)[XB_TMO], 1u); break; } } } } while (0)
struct XcdBarrier { unsigned* bar; unsigned x; volatile LAS unsigned* st; };
__device__ __forceinline__ XcdBarrier xcd_barrier_post(unsigned* bar, volatile LAS unsigned* st) {
    XcdBarrier b; b.bar = bar; b.x = xb_xcc_id(); b.st = st;
    if (threadIdx.x == 0) (void)xb_add(&bar[XB_XCNT(b.x)], 1u);
    return b;
}
__device__ __forceinline__ void xcd_barrier_complete(unsigned* bar, unsigned x, unsigned& nloc, unsigned& nx) {
    const unsigned G = gridDim.x * gridDim.y * gridDim.z;
    unsigned sum, cnt, mine, sp = 0u;
    for (;;) {
        sum = 0u; cnt = 0u; mine = 0u;
#pragma unroll
        for (unsigned j = 0; j < 16; ++j) { const unsigned c = xb_ld(&bar[XB_XCNT(j)]); sum += c; cnt += (c > 0u) ? 1u : 0u; mine = (j == x) ? c : mine; }
        if (sum == G) break;
        __builtin_amdgcn_s_sleep(1);
        if ((++sp & 255u) == 0u) { if (xb_ld(&bar[XB_TMO])) break; if (sp > XB_SPIN_CAP) { atomicAdd(&bar[XB_TMO], 1u); break; } }
    }
    nloc = mine > 0u ? mine : 1u; nx = cnt > 0u ? cnt : 1u;
}
template <bool FIRST> __device__ __forceinline__ void xcd_barrier(const XcdBarrier& b) {
    asm volatile("s_waitcnt vmcnt(0)" ::: "memory");
    __syncthreads();
    if (threadIdx.x == 0) {
        unsigned* bar = b.bar; unsigned bx = b.x; { int z_ = 0; asm volatile("" : "+s"(z_)); bar += z_; bx += (unsigned)z_; }
        __builtin_amdgcn_s_waitcnt(0);
        unsigned nloc = b.st[0], nx = b.st[1];
        if (FIRST) { if (nloc == 0u) { xcd_barrier_complete(bar, bx, nloc, nx); b.st[0] = nloc; b.st[1] = nx; } }
        const unsigned old = xb_add(&bar[XB_XSUB(bx)], 1u);
        const unsigned gen = old / nloc;
        if (old + 1u == (gen + 1u) * nloc) {
            __builtin_amdgcn_fence(__ATOMIC_RELEASE, "agent");
            asm volatile("s_waitcnt vmcnt(0)" ::: "memory");
            const unsigned og = xb_add(&bar[XB_TOP], 1u);
            const unsigned tg = og / nx;
            if (og + 1u == (tg + 1u) * nx) xb_add(&bar[XB_TOPGEN], 1u);
            else XB_SPIN(xb_ld(&bar[XB_TOPGEN]) == tg, bar);
            __builtin_amdgcn_fence(__ATOMIC_ACQUIRE, "agent");
            xb_add(&bar[XB_XGEN(bx)], 1u);
            asm volatile("s_waitcnt vmcnt(0)" ::: "memory");
        } else {
            XB_SPIN(xb_ld(&bar[XB_XGEN(bx)]) == gen, bar);
            __builtin_amdgcn_fence(__ATOMIC_ACQUIRE, "agent");
            asm volatile("s_waitcnt vmcnt(0)" ::: "memory");
        }
    }
    __syncthreads();
}

struct Args { const float* in[22]; float* out; unsigned char* ws; };
struct Ctx { LAS unsigned char* lds; int tid, lane, wave, bid; };
__device__ __forceinline__ Ctx fresh_ctx(const Ctx& C0) { Ctx C = C0; asm volatile("" : "+v"(C.tid)); asm volatile("" : "+s"(C.bid)); asm volatile("" : "+s"(C.lds)); C.lane = C.tid & 63; C.wave = __builtin_amdgcn_readfirstlane(C.tid >> 6); return C; }

DI void transpose_item(const float* src, int ld, int k0, int n0, bf16* dst, int K, int drow0, LAS float* scr, int lane) {
    float tv[32];
#pragma unroll
    for (int i = 0; i < 32; ++i) tv[i] = src[(size_t)(k0 + 2 * i + (lane >> 5)) * ld + n0 + (lane & 31)];
#pragma unroll
    for (int i = 0; i < 32; ++i) scr[(2 * i + (lane >> 5)) * 33 + (lane & 31)] = tv[i];
    asm volatile("s_waitcnt lgkmcnt(0)" ::: "memory");
    const int c = lane & 7;
#pragma unroll
    for (int j = 0; j < 4; ++j) { const int n = (lane >> 3) + 8 * j; const LAS float* s = scr + (8 * c) * 33 + n;
        v4u o; o.x = pk2(s[0 * 33], s[1 * 33]); o.y = pk2(s[2 * 33], s[3 * 33]); o.z = pk2(s[4 * 33], s[5 * 33]); o.w = pk2(s[6 * 33], s[7 * 33]);
        *(v4u*)(dst + (size_t)(drow0 + n) * K + k0 + 8 * c) = o; }
    asm volatile("s_waitcnt lgkmcnt(0)" ::: "memory");
}
constexpr int CV_IN = 16 * 96, CV_OUT = 16 * 32, CV_GU = 16 * 512, CV_D = 16 * 256, CV_ITEMS = CV_IN + CV_OUT + CV_GU + CV_D, CV_SPLIT = 9216;
DI size_t wgu_off(int l) { return (l & 1) ? WS_WGU2 : WS_WGU; }
DI size_t wd_off(int l) { return (l & 1) ? WS_WD2 : WS_WD; }
DI void convert_items(const Args& A, const Ctx& C, int l, int lo, int hi, int wrank, int nw) {
    LAS float* scr = (LAS float*)(C.lds + C.wave * 16384);
    bf16* WIN = (bf16*)(A.ws + WS_WIN); bf16* WOUT = (bf16*)(A.ws + WS_WOUT); bf16* WGU = (bf16*)(A.ws + wgu_off(l)); bf16* WD = (bf16*)(A.ws + wd_off(l));
    for (int it = lo + wrank; it < hi; it += nw) {
        int r = it;
        if (r < CV_IN) { const int kb = r / 96, nb = r % 96, n0 = 32 * nb; transpose_item(A.in[1] + (size_t)l * D * PIN, PIN, 64 * kb, n0 + (n0 >= 2048 ? 8 : 0), WIN, D, n0, scr, C.lane); continue; } r -= CV_IN;
        if (r < CV_OUT) { const int kb = r / 32, nb = r % 32; transpose_item(A.in[12] + (size_t)l * D * D, D, 64 * kb, 32 * nb, WOUT, D, 32 * nb, scr, C.lane); continue; } r -= CV_OUT;
        if (r < CV_GU) { const int e = r / 512, r1 = r % 512, half = r1 / 256, r2 = r1 % 256, kb = r2 / 16, nb = r2 % 16, j0 = 32 * nb;
            transpose_item((half ? A.in[18] : A.in[17]) + (size_t)(l * NEXP + e) * D * DEXP, DEXP, 64 * kb, j0, WGU, D, e * 1024 + (j0 / 128) * 256 + half * 128 + (j0 % 128), scr, C.lane); continue; } r -= CV_GU;
        { const int e = r / 256, r1 = r % 256, kb = r1 / 32, nb = r1 % 32;
            transpose_item(A.in[19] + (size_t)(l * NEXP + e) * DEXP * D, D, 64 * kb, 32 * nb, WD, DEXP, e * 1024 + 32 * nb, scr, C.lane); }
    }
}
DI void convert_small(const Args& A, const Ctx& C, int l) {
    { bf16* WM = (bf16*)(A.ws + SM_WM); const float* wsrc = A.in[6] + (size_t)l * 4 * CH * CH;
        for (int i = C.bid * NTHREADS + C.tid; i < 4 * CH * CH; i += GRID * NTHREADS) { const int s = i & 127, t = (i >> 7) & 127; WM[i] = (bf16)f2bf(s <= t ? wsrc[i] : 0.f); } }
    float* BIAS = (float*)(A.ws + SM_BIAS);
    for (int n = C.bid * NTHREADS + C.tid; n < NPROJ; n += GRID * NTHREADS) BIAS[n] = A.in[2][(size_t)l * PIN + n + (n >= 2048 ? 8 : 0)];
}
DI void phase_convert(const Args& A, const Ctx& C0, int l) { const Ctx C = fresh_ctx(C0);
    convert_items(A, C, l, 0, CV_ITEMS, C.bid * NWAVES + C.wave, GRID * NWAVES);
    convert_small(A, C, l);
}
DI void convert_in_tail(const Args& A, const Ctx& C0, int l, int lo, int hi, const unsigned* cnt) { const Ctx C = fresh_ctx(C0);
    int tiles = 0;
#pragma unroll
    for (int e = 0; e < 16; ++e) tiles += ((int)__builtin_amdgcn_readfirstlane(__hip_atomic_load(cnt + 16 * e, __ATOMIC_RELAXED, __HIP_MEMORY_SCOPE_AGENT)) + 255) >> 8;
    const int nunits = tiles * 4, maxu = (nunits + GRID - 1) / GRID, nfull = nunits - (maxu - 1) * GRID;
    int rank = C.bid - nfull, nidle = GRID - nfull;
    if (nidle == 0) { rank = C.bid; nidle = GRID; }
    if (rank < 0) return;
    convert_items(A, C, l, lo, hi, rank * NWAVES + C.wave, nidle * NWAVES);
}
DI void stage_gate_weights(const Args& A, const Ctx& C, int lg) {
    LAS float* gwl = (LAS float*)C.lds;
    const float* w = A.in[1] + (size_t)lg * D * PIN + 2048;
    f32x4 gq[2][2];
#pragma unroll
    for (int k = 0; k < 2; ++k) { const int col = C.tid + k * NTHREADS; gq[k][0] = *(const f32x4*)(w + (size_t)col * PIN); gq[k][1] = *(const f32x4*)(w + (size_t)col * PIN + 4); }
#pragma unroll
    for (int k = 0; k < 2; ++k) { const int col = C.tid + k * NTHREADS;
#pragma unroll
        for (int g = 0; g < 4; ++g) { gwl[g * D + col] = gq[k][0][g]; gwl[(4 + g) * D + col] = gq[k][1][g]; } }
}
DI void row_emit(const Args& A, const Ctx& C, int t, const f32x4 (&v)[4], float* xout, bf16* XN, int lg) {
    if (xout) {
#pragma unroll
        for (int j = 0; j < 4; ++j) *(f32x4*)(xout + (size_t)t * D + 256 * j + 4 * C.lane) = v[j];
    }
    if (XN) {
#pragma unroll
        for (int j = 0; j < 4; ++j) { v2u w; w.x = pk2(v[j][0], v[j][1]); w.y = pk2(v[j][2], v[j][3]); *(v2u*)(XN + (size_t)t * D + 256 * j + 4 * C.lane) = w; }
    }
    if (lg >= 0) {
        const LAS float* gwl = (const LAS float*)C.lds;
        float* GATES = (float*)(A.ws + SM_GATES);
        float gs[8];
#pragma unroll
        for (int g = 0; g < 8; ++g) { float s = 0.f;
#pragma unroll
            for (int j = 0; j < 4; ++j) { const f32x4 w = *(const LAS f32x4*)(gwl + g * D + 256 * j + 4 * C.lane); s += v[j][0] * w[0] + v[j][1] * w[1] + v[j][2] * w[2] + v[j][3] * w[3]; }
            gs[g] = s; }
        red_multi<8>(gs, C.lane);
        if ((C.lane & 7) == 0) { const int g = red_idx<8>(C.lane); GATES[(size_t)t * 8 + g] = gs[0] + A.in[2][(size_t)lg * PIN + 2048 + g]; }
    }
}
DI void phase_prologue_rows(const Args& A, const Ctx& C0) { const Ctx C = fresh_ctx(C0);
    stage_gate_weights(A, C, 0);
    __syncthreads();
    for (int t = C.bid * NWAVES + C.wave; t < T; t += GRID * NWAVES) {
        f32x4 v[4];
#pragma unroll
        for (int j = 0; j < 4; ++j) v[j] = *(const f32x4*)(A.in[0] + (size_t)t * D + 256 * j + 4 * C.lane);
        row_emit(A, C, t, v, nullptr, (bf16*)(A.ws + WS_XN), 0);
    }
    __syncthreads();
}
DI void row_layernorm(f32x4 (&v)[4], const float* w, const float* b, int lane) {
    float s = 0.f;
#pragma unroll
    for (int j = 0; j < 4; ++j) s += (v[j][0] + v[j][1]) + (v[j][2] + v[j][3]);
    const float mean = wave_sum(s) * (1.0f / D); float q = 0.f;
#pragma unroll
    for (int j = 0; j < 4; ++j) { v[j] = v[j] - mean; q += (v[j][0] * v[j][0] + v[j][1] * v[j][1]) + (v[j][2] * v[j][2] + v[j][3] * v[j][3]); }
    const float rstd = __builtin_amdgcn_rsqf(wave_sum(q) * (1.0f / D) + LN_EPS);
#pragma unroll
    for (int j = 0; j < 4; ++j) { const f32x4 ww = *(const f32x4*)(w + 256 * j + 4 * lane), bb = *(const f32x4*)(b + 256 * j + 4 * lane); v[j] = v[j] * rstd * ww + bb; }
}
DI void phase_ln1_router(const Args& A, const Ctx& C0, int l, bool dry = false) { const Ctx C = fresh_ctx(C0);
    LAS float* rwl = (LAS float*)C.lds;
    LAS int* hist = (LAS int*)(C.lds + VEC_OFF); LAS int* lbase = hist + 16, *le = hist + 32, *lrank = hist + 160;
    { f32x4 rq[8];
#pragma unroll
      for (int k = 0; k < 8; ++k) rq[k] = *(const f32x4*)(A.in[15] + (size_t)(C.tid + k * NTHREADS) * 4);
#pragma unroll
      for (int k = 0; k < 8; ++k) { const int i4 = C.tid + k * NTHREADS, col = i4 >> 2, e4 = (i4 & 3) * 4;
#pragma unroll
          for (int q = 0; q < 4; ++q) rwl[(e4 + q) * D + col] = rq[k][q]; } }
    if (C.tid < 16) hist[C.tid] = 0;
    __syncthreads();
    const bf16* X = (const bf16*)(A.ws + WS_XN);
    const bf16* Y = (const bf16*)(A.ws + WS_PROJ);
    bf16* XNB = (bf16*)(A.ws + WS_XNB);
    v4u* SEL = (v4u*)(A.ws + SM_SEL);
    float rb[16];
#pragma unroll
    for (int e = 0; e < 16; ++e) rb[e] = A.in[16][e];
    v2u xr[2][4], yr[2][4];
#pragma unroll
    for (int j = 0; j < 4; ++j) { const size_t o = (size_t)(C.bid * 64 + C.wave * 8) * D + 256 * j + 4 * C.lane; xr[0][j] = *(const v2u*)(X + o); yr[0][j] = *(const v2u*)(Y + o); }
#pragma unroll
    for (int i = 0; i < 8; ++i) {
        const int t = C.bid * 64 + C.wave * 8 + i;
        if (i < 7) {
#pragma unroll
            for (int j = 0; j < 4; ++j) { const size_t o = (size_t)(t + 1) * D + 256 * j + 4 * C.lane; xr[(i + 1) & 1][j] = *(const v2u*)(X + o); yr[(i + 1) & 1][j] = *(const v2u*)(Y + o); } }
        f32x4 v[4];
#pragma unroll
        for (int j = 0; j < 4; ++j) { const v2u x = xr[i & 1][j]; const v2u y = yr[i & 1][j];
            v[j][0] = ALPHA * bflo(x.x) + bflo(y.x); v[j][1] = ALPHA * bfhi(x.x) + bfhi(y.x); v[j][2] = ALPHA * bflo(x.y) + bflo(y.y); v[j][3] = ALPHA * bfhi(x.y) + bfhi(y.y); }
        row_layernorm(v, A.in[13] + (size_t)l * D, A.in[14] + (size_t)l * D, C.lane);
        row_emit(A, C, t, v, nullptr, XNB, -1);
        float lg16[16];
#pragma unroll
        for (int e = 0; e < 16; ++e) { float s = 0.f;
#pragma unroll
            for (int j = 0; j < 4; ++j) { const f32x4 w = *(const LAS f32x4*)(rwl + e * D + 256 * j + 4 * C.lane); s += v[j][0] * w[0] + v[j][1] * w[1] + v[j][2] * w[2] + v[j][3] * w[3]; }
            lg16[e] = s; }
        red_multi<16>(lg16, C.lane);
        float best = -INFINITY, bs0 = 0.f, bs1 = 0.f; int be0 = 0, be1 = 1;
#pragma unroll
        for (int g = 0; g < 4; ++g) {
            float sel[4], sg[4];
#pragma unroll
            for (int k = 0; k < 4; ++k) { const int e = 4 * g + k;
                const int src = 32 * ((e >> 3) & 1) + 16 * ((e >> 2) & 1) + 8 * ((e >> 1) & 1) + 4 * (e & 1);
                const float s = __builtin_bit_cast(float, __builtin_amdgcn_readlane(__builtin_bit_cast(int, lg16[0]), src));
                sg[k] = sigmoidf_(s); sel[k] = sg[k] + rb[e]; }
            float m1 = sel[0], s1 = sg[0]; int i1 = 0;
#pragma unroll
            for (int k = 1; k < 4; ++k) if (sel[k] > m1) { m1 = sel[k]; s1 = sg[k]; i1 = k; }
            float m2 = -INFINITY, s2 = 0.f; int i2 = 0;
#pragma unroll
            for (int k = 0; k < 4; ++k) if (k != i1 && sel[k] > m2) { m2 = sel[k]; s2 = sg[k]; i2 = k; }
            const float gsc = m1 + m2;
            if (gsc > best) { best = gsc; be0 = 4 * g + i1; be1 = 4 * g + i2; bs0 = s1; bs1 = s2; }
        }
        if (C.lane == 0) {
            const float inv = __builtin_amdgcn_rcpf(bs0 + bs1);
            v4u o; o.x = (unsigned)be0; o.y = (unsigned)be1; o.z = __builtin_bit_cast(unsigned, bs0 * inv); o.w = __builtin_bit_cast(unsigned, bs1 * inv);
            SEL[t] = o;
            ((f32x2*)(A.ws + SM_GW))[t] = (f32x2){bs0 * inv, bs1 * inv};
            const int q = (C.wave * 8 + i) * 2;
            le[q] = be0; lrank[q] = __hip_atomic_fetch_add(hist + be0, 1, __ATOMIC_RELAXED, __HIP_MEMORY_SCOPE_WORKGROUP);
            le[q + 1] = be1; lrank[q + 1] = __hip_atomic_fetch_add(hist + be1, 1, __ATOMIC_RELAXED, __HIP_MEMORY_SCOPE_WORKGROUP);
        }
    }
    __syncthreads();
    if (dry) return;
    if (C.tid < 16) lbase[C.tid] = (int)__hip_atomic_fetch_add((unsigned*)(A.ws + WS_CTL) + CW_CNT + (l * 16 + C.tid) * 16, (unsigned)hist[C.tid], __ATOMIC_RELAXED, __HIP_MEMORY_SCOPE_AGENT);
    __syncthreads();
    if (C.tid < 128) { const int e = le[C.tid], pos = lbase[e] + lrank[C.tid], t = C.bid * 64 + (C.tid >> 1);
        ((int*)(A.ws + WS_LIST))[(size_t)e * 16384 + pos] = t; ((int*)(A.ws + SM_TOKSLOT))[2 * t + (C.tid & 1)] = pos; }
    __syncthreads();
}
DI void phase_combine(const Args& A, const Ctx& C0, int l) { const Ctx C = fresh_ctx(C0);
    const bool last = (l == NLAYER - 1);
    if (!last) { stage_gate_weights(A, C, l + 1); convert_small(A, C, l + 1); }
    LAS int* tpl = (LAS int*)(C.lds + VEC_OFF);
    if (C.tid == 0) { int run = 0; for (int e = 0; e < 16; ++e) { tpl[e] = run; const int n = (int)__hip_atomic_load((const unsigned*)(A.ws + WS_CTL) + CW_CNT + (l * 16 + e) * 16, __ATOMIC_RELAXED, __HIP_MEMORY_SCOPE_AGENT); run += ((n + 255) >> 8) * 256; } }
    __syncthreads();
    const bf16* X1 = (const bf16*)(A.ws + WS_XNB); const bf16* YP = (const bf16*)(A.ws + WS_PROJ);
    const v4u* SEL = (const v4u*)(A.ws + SM_SEL); const int* TOKSLOT = (const int*)(A.ws + SM_TOKSLOT);
    const int tb = C.bid * 64 + C.wave * 8;
    int pp0[8], pp1[8]; float gg0[8], gg1[8];
#pragma unroll
    for (int i = 0; i < 8; ++i) { const int t = tb + i; const v4u s = SEL[t]; const f32x2 gw2 = ((const f32x2*)(A.ws + SM_GW))[t]; pp0[i] = tpl[s.x & 15u] + TOKSLOT[2 * t]; pp1[i] = tpl[s.y & 15u] + TOKSLOT[2 * t + 1]; gg0[i] = gw2[0]; gg1[i] = gw2[1]; }
    v2u xr[2][4], ar[2][4], br[2][4];
#pragma unroll
    for (int j = 0; j < 4; ++j) { xr[0][j] = *(const v2u*)(X1 + (size_t)tb * D + 256 * j + 4 * C.lane); ar[0][j] = *(const v2u*)(YP + (size_t)pp0[0] * D + 256 * j + 4 * C.lane); br[0][j] = *(const v2u*)(YP + (size_t)pp1[0] * D + 256 * j + 4 * C.lane); }
#pragma unroll
    for (int i = 0; i < 8; ++i) { const int t = tb + i;
        if (i < 7) {
#pragma unroll
            for (int j = 0; j < 4; ++j) { xr[(i + 1) & 1][j] = *(const v2u*)(X1 + (size_t)(t + 1) * D + 256 * j + 4 * C.lane); ar[(i + 1) & 1][j] = *(const v2u*)(YP + (size_t)pp0[(i + 1) & 7] * D + 256 * j + 4 * C.lane); br[(i + 1) & 1][j] = *(const v2u*)(YP + (size_t)pp1[(i + 1) & 7] * D + 256 * j + 4 * C.lane); } }
        const float g0 = gg0[i], g1 = gg1[i];
        f32x4 v[4];
#pragma unroll
        for (int j = 0; j < 4; ++j) { const v2u x = xr[i & 1][j], a = ar[i & 1][j], b = br[i & 1][j];
            v[j][0] = ALPHA * bflo(x.x) + g0 * bflo(a.x) + g1 * bflo(b.x); v[j][1] = ALPHA * bfhi(x.x) + g0 * bfhi(a.x) + g1 * bfhi(b.x);
            v[j][2] = ALPHA * bflo(x.y) + g0 * bflo(a.y) + g1 * bflo(b.y); v[j][3] = ALPHA * bfhi(x.y) + g0 * bfhi(a.y) + g1 * bfhi(b.y); }
        row_layernorm(v, A.in[20] + (size_t)l * D, A.in[21] + (size_t)l * D, C.lane);
        row_emit(A, C, t, v, last ? A.out : nullptr, last ? nullptr : (bf16*)(A.ws + WS_XN), last ? -1 : l + 1);
    }
    __syncthreads();
}
DI void unpack8(const v4u w, float (&f)[8]) { f[0] = bflo(w.x); f[1] = bfhi(w.x); f[2] = bflo(w.y); f[3] = bfhi(w.y); f[4] = bflo(w.z); f[5] = bfhi(w.z); f[6] = bflo(w.w); f[7] = bfhi(w.w); }
DI void conv_unit(const Args& A, const Ctx& C0, int l, int unit) { const Ctx C = fresh_ctx(C0);
    const bf16* PROJ = (const bf16*)(A.ws + WS_PROJ); bf16* HCAT = (bf16*)(A.ws + WS_HCAT);
    LAS float* cin = (LAS float*)C.lds;
    LAS float* cou = (LAS float*)(C.lds + 65536);
    const int t0 = unit * 32, tseq = t0 & (SEQ - 1);
    float w[31];
#pragma unroll
    for (int j = 0; j < 31; ++j) w[j] = A.in[8][(size_t)(l * 31 + j) * 256 + (C.tid & 255)];
    const float bias = A.in[9][l * 256 + (C.tid & 255)];
    const f32x4 nw = *(const f32x4*)(A.in[10] + l * 256 + 4 * C.lane), nb = *(const f32x4*)(A.in[11] + l * 256 + 4 * C.lane);
    v4u cqa[4], cqb[4];
#pragma unroll
    for (int kq = 0; kq < 4; ++kq) { const int it = C.tid + kq * NTHREADS, r = it >> 5, c8 = (it & 31) * 8; const bool ok = (it < 62 * 32) && (tseq - 30 + r >= 0); const size_t rowo = ok ? (size_t)(t0 - 30 + r) * NPROJ : 0;
        cqa[kq] = ok ? *(const v4u*)(PROJ + rowo + PCA + c8) : (v4u){0u, 0u, 0u, 0u}; cqb[kq] = ok ? *(const v4u*)(PROJ + rowo + PCB + c8) : (v4u){0u, 0u, 0u, 0u}; }
#pragma unroll
    for (int kq = 0; kq < 4; ++kq) { const int it = C.tid + kq * NTHREADS; if (it >= 62 * 32) continue; const int r = it >> 5, c8 = (it & 31) * 8; float o[8];
        if (tseq - 30 + r >= 0) { float a[8], b[8]; unpack8(cqa[kq], a); unpack8(cqb[kq], b);
#pragma unroll
            for (int i = 0; i < 8; ++i) o[i] = a[i] * sigmoidf_(b[i]); }
        else {
#pragma unroll
            for (int i = 0; i < 8; ++i) o[i] = 0.f; }
        *(LAS f32x4*)(cin + r * 256 + c8) = (f32x4){o[0], o[1], o[2], o[3]}; *(LAS f32x4*)(cin + r * 256 + c8 + 4) = (f32x4){o[4], o[5], o[6], o[7]}; }
    __syncthreads();
    { const int c = C.tid & 255, half = C.tid >> 8;

        float xin[46];
#pragma unroll
        for (int r = 0; r < 46; ++r) xin[r] = cin[(half * 16 + r) * 256 + c];
#pragma unroll
        for (int i = 0; i < 16; ++i) { float acc = bias;
#pragma unroll
            for (int j = 0; j < 31; ++j) acc += xin[i + j] * w[j];
            cou[(half * 16 + i) * 256 + c] = acc; } }
    __syncthreads();
    {
#pragma unroll
        for (int q = 0; q < 4; ++q) { const int r = 4 * C.wave + q; f32x4 x = *(const LAS f32x4*)(cou + r * 256 + 4 * C.lane);
            const float mean = wave_sum((x[0] + x[1]) + (x[2] + x[3])) * (1.0f / 256.0f); x = x - mean;
            const float var = wave_sum((x[0] * x[0] + x[1] * x[1]) + (x[2] * x[2] + x[3] * x[3])) * (1.0f / 256.0f);
            const float rstd = __builtin_amdgcn_rsqf(var + LN_EPS); x = x * rstd * nw + nb;
            float o[4];
#pragma unroll
            for (int k = 0; k < 4; ++k) o[k] = x[k] * sigmoidf_(x[k]);
            v2u pk; pk.x = pk2(o[0], o[1]); pk.y = pk2(o[2], o[3]);
            *(v2u*)(HCAT + (size_t)(t0 + r) * D + 768 + 4 * C.lane) = pk; } }
    __syncthreads();
}
DI void gmlp_unit_simple(const Args& A, const Ctx& C0, int l, int ck) { const Ctx C = fresh_ctx(C0);
    const bf16* PROJ = (const bf16*)(A.ws + WS_PROJ); bf16* HCAT = (bf16*)(A.ws + WS_HCAT);
    LAS float* zs = (LAS float*)C.lds;
    const int t0 = ck * CH;
    { const f32x4 nw = *(const f32x4*)(A.in[4] + l * 256 + 4 * C.lane), nb = *(const f32x4*)(A.in[5] + l * 256 + 4 * C.lane);
        for (int i = 0; i < 16; ++i) { const int r = C.wave * 16 + i; const v2u g = *(const v2u*)(PROJ + (size_t)(t0 + r) * NPROJ + PGV + 4 * C.lane);
            f32x4 x = {gelu_tanh(bflo(g.x)), gelu_tanh(bfhi(g.x)), gelu_tanh(bflo(g.y)), gelu_tanh(bfhi(g.y))};
            const float mean = wave_sum((x[0] + x[1]) + (x[2] + x[3])) * (1.0f / 256.0f); x = x - mean;
            const float var = wave_sum((x[0] * x[0] + x[1] * x[1]) + (x[2] * x[2] + x[3] * x[3])) * (1.0f / 256.0f);
            const float rstd = __builtin_amdgcn_rsqf(var + LN_EPS); x = x * rstd * nw + nb;
            *(LAS f32x4*)(zs + r * 256 + 4 * C.lane) = x; } }
    __syncthreads();
    { const int tb = C.tid >> 4, cb = C.tid & 15, c0 = 16 * cb, h = cb >> 2, tr0 = 4 * tb;
        const float* ws = A.in[6] + (size_t)(l * 4 + h) * CH * CH;
        float acc[4][16];
#pragma unroll
        for (int i = 0; i < 4; ++i)
#pragma unroll
            for (int j = 0; j < 16; ++j) acc[i][j] = 0.f;
        for (int s = 0; s <= tr0 + 3; ++s) {
            float zv[16];
#pragma unroll
            for (int q = 0; q < 4; ++q) { const f32x4 z4 = *(const LAS f32x4*)(zs + s * 256 + c0 + 4 * q); zv[4 * q] = z4[0]; zv[4 * q + 1] = z4[1]; zv[4 * q + 2] = z4[2]; zv[4 * q + 3] = z4[3]; }
#pragma unroll
            for (int i = 0; i < 4; ++i) { const float wg = (s <= tr0 + i) ? ws[(size_t)(tr0 + i) * CH + s] : 0.f;
#pragma unroll
                for (int j = 0; j < 16; ++j) acc[i][j] += wg * zv[j]; }
        }
#pragma unroll
        for (int i = 0; i < 4; ++i) { const int tr = tr0 + i; const float bsv = A.in[7][(size_t)(l * 4 + h) * CH + tr]; const size_t rowo = (size_t)(t0 + tr) * NPROJ + PGU + c0;
            float u[16]; { float tmp[8]; unpack8(*(const v4u*)(PROJ + rowo), tmp);
#pragma unroll
                for (int j = 0; j < 8; ++j) u[j] = tmp[j];
                unpack8(*(const v4u*)(PROJ + rowo + 8), tmp);
#pragma unroll
                for (int j = 0; j < 8; ++j) u[8 + j] = tmp[j]; }
            float o[16];
#pragma unroll
            for (int j = 0; j < 16; ++j) o[j] = gelu_tanh(u[j]) * (acc[i][j] + bsv);
            v4u w0, w1; w0.x = pk2(o[0], o[1]); w0.y = pk2(o[2], o[3]); w0.z = pk2(o[4], o[5]); w0.w = pk2(o[6], o[7]); w1.x = pk2(o[8], o[9]); w1.y = pk2(o[10], o[11]); w1.z = pk2(o[12], o[13]); w1.w = pk2(o[14], o[15]);
            *(v4u*)(HCAT + (size_t)(t0 + tr) * D + 512 + c0) = w0; *(v4u*)(HCAT + (size_t)(t0 + tr) * D + 512 + c0 + 8) = w1; }
    }
    __syncthreads();
}
DI void mlstm_local_simple(const Args& A, const Ctx& C0, int un) { const Ctx C = fresh_ctx(C0);
    const bf16* PROJ = (const bf16*)(A.ws + WS_PROJ); const float* GATES = (const float*)(A.ws + SM_GATES);
    const int bh = un >> 5, c = un & 31, b = bh >> 2, h = bh & 3, t0 = b * SEQ + c * CH;
    LAS float* kw = (LAS float*)C.lds;
    LAS float* vs = (LAS float*)(C.lds + 65536);
    LAS float* vec = (LAS float*)(C.lds + VEC_OFF);
    if (C.tid < CH) { const float fp = GATES[(size_t)(t0 + C.tid) * 8 + 4 + h], ip = GATES[(size_t)(t0 + C.tid) * 8 + h]; vec[C.tid] = logsigmoidf_(fp); vec[128 + C.tid] = ip; }
    __syncthreads();
    if (C.tid == 0) { float run = 0.f; for (int i = 0; i < CH; ++i) { run += vec[i]; vec[i] = run; } const float g = run; float ml = -INFINITY;
        for (int i = 0; i < CH; ++i) { const float a = g - vec[i] + vec[128 + i]; vec[256 + i] = a; ml = fmaxf(ml, a); }
        for (int i = 0; i < CH; ++i) vec[256 + i] = __expf(vec[256 + i] - ml);
        ((float*)(A.ws + SM_G))[un] = g; ((float*)(A.ws + SM_MLOC))[un] = ml; }
    __syncthreads();
    for (int it = C.tid; it < CH * 16; it += NTHREADS) { const int r = it >> 4, c8 = (it & 15) * 8; const size_t rowo = (size_t)(t0 + r) * NPROJ + h * 128 + c8; float k8[8], v8[8];
        unpack8(*(const v4u*)(PROJ + rowo + PK), k8); unpack8(*(const v4u*)(PROJ + rowo + PV), v8); const float sc = vec[256 + r] * 0.08838834764831845f;
#pragma unroll
        for (int i = 0; i < 8; ++i) { kw[r * 128 + c8 + i] = k8[i] * sc; vs[r * 128 + c8 + i] = v8[i]; } }
    __syncthreads();
    { const int db = C.tid >> 4, eb = C.tid & 15, d0 = 4 * db, e0 = 8 * eb; float acc[4][8];
#pragma unroll
        for (int i = 0; i < 4; ++i)
#pragma unroll
            for (int j = 0; j < 8; ++j) acc[i][j] = 0.f;
        for (int r = 0; r < CH; ++r) { const f32x4 kd = *(const LAS f32x4*)(kw + r * 128 + d0); const f32x4 va = *(const LAS f32x4*)(vs + r * 128 + e0), vb = *(const LAS f32x4*)(vs + r * 128 + e0 + 4);
#pragma unroll
            for (int i = 0; i < 4; ++i) { acc[i][0] += kd[i] * va[0]; acc[i][1] += kd[i] * va[1]; acc[i][2] += kd[i] * va[2]; acc[i][3] += kd[i] * va[3]; acc[i][4] += kd[i] * vb[0]; acc[i][5] += kd[i] * vb[1]; acc[i][6] += kd[i] * vb[2]; acc[i][7] += kd[i] * vb[3]; } }
        float* CL = (float*)(A.ws + WS_CLOCT) + (size_t)un * CH * CH;
#pragma unroll
        for (int j = 0; j < 8; ++j) *(f32x4*)(CL + (size_t)(e0 + j) * CH + d0) = (f32x4){acc[0][j], acc[1][j], acc[2][j], acc[3][j]}; }
    if (C.tid < CH) { float s = 0.f; for (int r = 0; r < CH; ++r) s += kw[r * 128 + C.tid]; ((float*)(A.ws + SM_NLOC))[(size_t)un * CH + C.tid] = s; }
    __syncthreads();
}
DI void phase_scan(const Args& A, const Ctx& C0) { const Ctx C = fresh_ctx(C0);
    const int gt = C.bid * NTHREADS + C.tid, bh = gt >> 13, pr = gt & 8191;
    const float* G = (const float*)(A.ws + SM_G); const float* ML = (const float*)(A.ws + SM_MLOC); float* MP = (float*)(A.ws + SM_MPREV);
    const float* CL = (const float*)(A.ws + WS_CLOCT); unsigned* CP = (unsigned*)(A.ws + WS_CPREVT);
    const float* NL = (const float*)(A.ws + SM_NLOC); float* NP = (float*)(A.ws + SM_NPREV);
    float c0 = 0.f, c1 = 0.f, n0 = 0.f, n1 = 0.f, m = 0.f;
    for (int cb = 0; cb < NCH; cb += 8) {
        f32x2 cl[8], nl[8]; float g[8], ml[8];
#pragma unroll
        for (int i = 0; i < 8; ++i) { const int un = bh * NCH + cb + i; cl[i] = *(const f32x2*)(CL + (size_t)un * CH * CH + 2 * pr); g[i] = G[un]; ml[i] = ML[un]; nl[i] = (pr < 64) ? *(const f32x2*)(NL + (size_t)un * CH + 2 * pr) : (f32x2){0.f, 0.f}; }
#pragma unroll
        for (int i = 0; i < 8; ++i) { const int un = bh * NCH + cb + i;
            CP[(size_t)un * (CH * CH / 2) + pr] = pk2(c0, c1);
            if (pr == 0) MP[un] = m;
            if (pr < 64) *(f32x2*)(NP + (size_t)un * CH + 2 * pr) = (f32x2){n0, n1};
            const float mn = fmaxf(g[i] + m, ml[i]), dec = __expf(g[i] + m - mn), sc = __expf(ml[i] - mn);
            c0 = dec * c0 + sc * cl[i][0]; c1 = dec * c1 + sc * cl[i][1]; n0 = dec * n0 + sc * nl[i][0]; n1 = dec * n1 + sc * nl[i][1]; m = mn; }
    }
}
DI void mlstm_out_simple(const Args& A, const Ctx& C0, int l, int un) { const Ctx C = fresh_ctx(C0);
    const bf16* PROJ = (const bf16*)(A.ws + WS_PROJ); const float* GATES = (const float*)(A.ws + SM_GATES); bf16* HCAT = (bf16*)(A.ws + WS_HCAT);
    const int bh = un >> 5, c = un & 31, b = bh >> 2, h = bh & 3, t0 = b * SEQ + c * CH;
    LAS bf16* qs = (LAS bf16*)C.lds;
    LAS bf16* ks = (LAS bf16*)(C.lds + 32768);
    LAS float* ps = (LAS float*)(C.lds + 65536);
    LAS float* vec = (LAS float*)(C.lds + VEC_OFF);
    LAS float* bvec = vec, *uvec = vec + 128, *Mvec = vec + 256, *wint = vec + 384, *flo = vec + 512, *den = vec + 640, *npv = vec + 768, *ipv = vec + 896, *lfv = vec + 1024, *qnv = vec + 1152;
    if (C.tid < CH) { const float fp = GATES[(size_t)(t0 + C.tid) * 8 + 4 + h], ip = GATES[(size_t)(t0 + C.tid) * 8 + h]; lfv[C.tid] = logsigmoidf_(fp); ipv[C.tid] = ip; npv[C.tid] = ((const float*)(A.ws + SM_NPREV))[(size_t)un * CH + C.tid]; }
    __syncthreads();
    if (C.tid == 0) { const float mprev = ((const float*)(A.ws + SM_MPREV))[un]; float run = 0.f, pm = -INFINITY;
        for (int i = 0; i < CH; ++i) { run += lfv[i]; bvec[i] = run; const float u = ipv[i] - run; uvec[i] = u; pm = fmaxf(pm, u); const float M = fmaxf(mprev, pm); Mvec[i] = M; wint[i] = __expf(mprev - M); flo[i] = __expf(-(run + M)); } }
    for (int it = C.tid; it < CH * 16; it += NTHREADS) { const int r = it >> 4, c8 = (it & 15) * 8; const size_t rowo = (size_t)(t0 + r) * NPROJ + h * 128 + c8;
        *(LAS v4u*)(qs + r * 128 + c8) = *(const v4u*)(PROJ + rowo + PQ); *(LAS v4u*)(ks + r * 128 + c8) = *(const v4u*)(PROJ + rowo + PK); }
    __syncthreads();
    const int lb = C.tid >> 4, xb = C.tid & 15, l0 = 4 * lb, x0 = 8 * xb;
    {
        float acc[4][8];
#pragma unroll
        for (int i = 0; i < 4; ++i)
#pragma unroll
            for (int j = 0; j < 8; ++j) acc[i][j] = 0.f;
        if (x0 <= l0 + 3) {
            for (int d8 = 0; d8 < 16; ++d8) { float qf[4][8], kf[8];
#pragma unroll
                for (int i = 0; i < 4; ++i) unpack8(*(const LAS v4u*)(qs + (l0 + i) * 128 + d8 * 8), qf[i]);
#pragma unroll
                for (int j = 0; j < 8; ++j) { unpack8(*(const LAS v4u*)(ks + (x0 + j) * 128 + d8 * 8), kf);
#pragma unroll
                    for (int i = 0; i < 4; ++i) { float s = 0.f;
#pragma unroll
                        for (int dd = 0; dd < 8; ++dd) s += qf[i][dd] * kf[dd];
                        acc[i][j] += s; } } } }
#pragma unroll
        for (int i = 0; i < 4; ++i)
#pragma unroll
            for (int j = 0; j < 8; ++j) { const int li = l0 + i, sj = x0 + j; ps[li * 128 + sj] = (sj <= li) ? acc[i][j] * 0.08838834764831845f * __expf(uvec[sj] - Mvec[li]) : 0.f; }
    }
    __syncthreads();
    if (C.tid < CH) { const int li = C.tid; float s = 0.f; for (int k = 0; k < CH; ++k) s += ps[li * 128 + ((k + li) & 127)]; den[li] = s; }
    else if (C.tid < 2 * CH) { const int li = C.tid - CH; float s = 0.f; for (int k = 0; k < CH; ++k) { const int d = (k + li) & 127; s += bf2f(qs[li * 128 + d]) * npv[d]; } qnv[li] = s; }
    for (int it = C.tid; it < CH * 16; it += NTHREADS) { const int r = it >> 4, c8 = (it & 15) * 8; }
    __syncthreads();
    for (int it = C.tid; it < CH * 16; it += NTHREADS) { const int r = it >> 4, c8 = (it & 15) * 8; const size_t rowo = (size_t)(t0 + r) * NPROJ + h * 128 + c8; *(LAS v4u*)(ks + r * 128 + c8) = *(const v4u*)(PROJ + rowo + PV); }
    __syncthreads();
    float hv[4][8];
    {   const int e0 = x0; float acc[4][8], acc2[4][8];
#pragma unroll
        for (int i = 0; i < 4; ++i)
#pragma unroll
            for (int j = 0; j < 8; ++j) { acc[i][j] = 0.f; acc2[i][j] = 0.f; }
        for (int s = 0; s <= l0 + 3; ++s) { float vv[8]; unpack8(*(const LAS v4u*)(ks + s * 128 + e0), vv);
#pragma unroll
            for (int i = 0; i < 4; ++i) { const float p = ps[(l0 + i) * 128 + s];
#pragma unroll
                for (int j = 0; j < 8; ++j) acc[i][j] += p * vv[j]; } }
        const bf16* CPT = (const bf16*)(A.ws + WS_CPREVT) + (size_t)un * CH * CH;
        for (int d8 = 0; d8 < 16; ++d8) { float qf[4][8], cf[8];
#pragma unroll
            for (int i = 0; i < 4; ++i) unpack8(*(const LAS v4u*)(qs + (l0 + i) * 128 + d8 * 8), qf[i]);
#pragma unroll
            for (int j = 0; j < 8; ++j) { unpack8(*(const v4u*)(CPT + (size_t)(e0 + j) * CH + d8 * 8), cf);
#pragma unroll
                for (int i = 0; i < 4; ++i) { float s = 0.f;
#pragma unroll
                    for (int dd = 0; dd < 8; ++dd) s += qf[i][dd] * cf[dd];
                    acc2[i][j] += s; } } }
#pragma unroll
        for (int i = 0; i < 4; ++i) { const int li = l0 + i; const float wi = wint[li]; const float dn = den[li] + wi * qnv[li]; const float inv = 1.0f / fmaxf(fabsf(dn), flo[li]);
#pragma unroll
            for (int j = 0; j < 8; ++j) hv[i][j] = (acc[i][j] + wi * acc2[i][j]) * inv; }
    }
    __syncthreads();
#pragma unroll
    for (int i = 0; i < 4; ++i)
#pragma unroll
        for (int j = 0; j < 8; ++j) ps[(l0 + i) * 128 + x0 + j] = hv[i][j];
    __syncthreads();
    { const f32x2 nw = *(const f32x2*)(A.in[3] + (size_t)l * 512 + h * 128 + 2 * C.lane);
        for (int i = 0; i < 16; ++i) { const int li = C.wave * 16 + i; f32x2 x = *(const LAS f32x2*)(ps + li * 128 + 2 * C.lane);
            const float mean = wave_sum(x[0] + x[1]) * (1.0f / 128.0f); x = x - mean; const float var = wave_sum(x[0] * x[0] + x[1] * x[1]) * (1.0f / 128.0f);
            const float rstd = 1.0f / sqrtf(var + 1e-6f); const unsigned ow = *(const unsigned*)(PROJ + (size_t)(t0 + li) * NPROJ + PO + h * 128 + 2 * C.lane);
            const float o0 = sigmoidf_(bflo(ow)) * (x[0] * rstd * nw[0]), o1 = sigmoidf_(bfhi(ow)) * (x[1] * rstd * nw[1]);
            *(unsigned*)(HCAT + (size_t)(t0 + li) * D + h * 128 + 2 * C.lane) = pk2(o0, o1); } }
    __syncthreads();
}
typedef short bf16x8 __attribute__((ext_vector_type(8)));
DI f32x4 mfma16(bf16x8 a, bf16x8 b, f32x4 c) { return __builtin_amdgcn_mfma_f32_16x16x32_bf16(a, b, c, 0, 0, 0); }
constexpr int LDT = 136;
constexpr int TILE_B = 128 * LDT * 2;
DI float wave_scan_add(float v, int lane) {
#pragma unroll
    for (int o = 1; o < 64; o <<= 1) { const float t = __shfl_up(v, o); if (lane >= o) v += t; }
    return v;
}
DI float wave_scan_max(float v, int lane) {
#pragma unroll
    for (int o = 1; o < 64; o <<= 1) { const float t = __shfl_up(v, o); if (lane >= o) v = fmaxf(v, t); }
    return v;
}
DI float wave_max(float v) {
#pragma unroll
    for (int o = 1; o < 64; o <<= 1) v = fmaxf(v, __shfl_xor(v, o));
    return v;
}
DI float red16(float v) { return row_sum16(v); }

DI void mlstm_local_mfma(const Args& A, const Ctx& C0, int un) { const Ctx C = fresh_ctx(C0);
    const bf16* PROJ = (const bf16*)(A.ws + WS_PROJ); const float* GATES = (const float*)(A.ws + SM_GATES);
    const int bh = un >> 5, c = un & 31, b = bh >> 2, h = bh & 3, t0 = b * SEQ + c * CH;
    LAS bf16* VT = (LAS bf16*)C.lds;
    LAS bf16* KWT = (LAS bf16*)(C.lds + TILE_B);
    LAS float* wv = (LAS float*)(C.lds + VEC_OFF);
    v4u kq4[4], vq4[4];
#pragma unroll
    for (int kq = 0; kq < 4; ++kq) { const int it = C.tid + kq * NTHREADS; const int r = it & 127, c8 = (it >> 7) * 8; const size_t rowo = (size_t)(t0 + r) * NPROJ + h * 128 + c8; kq4[kq] = *(const v4u*)(PROJ + rowo + PK); vq4[kq] = *(const v4u*)(PROJ + rowo + PV); }
    if (C.wave == 0) {
        const int l0 = 2 * C.lane; const f32x4 ga = *(const f32x4*)(GATES + (size_t)(t0 + l0) * 8), gb = *(const f32x4*)(GATES + (size_t)(t0 + l0) * 8 + 4), gc = *(const f32x4*)(GATES + (size_t)(t0 + l0 + 1) * 8), gd = *(const f32x4*)(GATES + (size_t)(t0 + l0 + 1) * 8 + 4);
        const float ip0 = h == 0 ? ga[0] : (h == 1 ? ga[1] : (h == 2 ? ga[2] : ga[3])), fp0 = h == 0 ? gb[0] : (h == 1 ? gb[1] : (h == 2 ? gb[2] : gb[3]));
        const float ip1 = h == 0 ? gc[0] : (h == 1 ? gc[1] : (h == 2 ? gc[2] : gc[3])), fp1 = h == 0 ? gd[0] : (h == 1 ? gd[1] : (h == 2 ? gd[2] : gd[3]));
        const float lf0 = logsigmoidf_(fp0), lf1 = logsigmoidf_(fp1);
        const float incl = wave_scan_add(lf0 + lf1, C.lane), b1 = incl, b0 = incl - lf1;
        const float g = __shfl(incl, 63);
        const float a0 = g - b0 + ip0, a1 = g - b1 + ip1, ml = wave_max(fmaxf(a0, a1));
        wv[l0] = __expf(a0 - ml); wv[l0 + 1] = __expf(a1 - ml);
        if (C.lane == 0) { ((float*)(A.ws + SM_G))[un] = g; ((float*)(A.ws + SM_MLOC))[un] = ml; }
    }
    __syncthreads();
#pragma unroll
    for (int kq = 0; kq < 4; ++kq) { const int it = C.tid + kq * NTHREADS; const int r = it & 127, c8 = (it >> 7) * 8; float k8[8];
        unpack8(kq4[kq], k8); const v4u vv = vq4[kq]; const float sc = wv[r] * 0.08838834764831845f;
        const unsigned vw[4] = {vv.x, vv.y, vv.z, vv.w};
#pragma unroll
        for (int i = 0; i < 8; ++i) { KWT[(c8 + i) * LDT + r] = (bf16)f2bf(k8[i] * sc); VT[(c8 + i) * LDT + r] = (bf16)((i & 1) ? (vw[i >> 1] >> 16) : (vw[i >> 1] & 0xffffu)); } }
    __syncthreads();
    { const int fr = C.lane & 15, fg = C.lane >> 4, w = C.wave;
        bf16x8 a[4];
#pragma unroll
        for (int ks = 0; ks < 4; ++ks) a[ks] = *(const LAS bf16x8*)(VT + (16 * w + fr) * LDT + 32 * ks + 8 * fg);
        float* CL = (float*)(A.ws + WS_CLOCT) + (size_t)un * CH * CH;
#pragma unroll
        for (int dt = 0; dt < 8; ++dt) { f32x4 acc = {0.f, 0.f, 0.f, 0.f};
#pragma unroll
            for (int ks = 0; ks < 4; ++ks) { const bf16x8 bb = *(const LAS bf16x8*)(KWT + (16 * dt + fr) * LDT + 32 * ks + 8 * fg); acc = mfma16(a[ks], bb, acc); }
#pragma unroll
            for (int rg = 0; rg < 4; ++rg) CL[(size_t)(16 * w + 4 * fg + rg) * CH + 16 * dt + fr] = acc[rg]; } }
    if (C.tid < CH) { float s = 0.f;
#pragma unroll
        for (int q = 0; q < 16; ++q) { float f[8]; unpack8(*(const LAS v4u*)(KWT + C.tid * LDT + 8 * q), f); s += ((f[0] + f[1]) + (f[2] + f[3])) + ((f[4] + f[5]) + (f[6] + f[7])); }
        ((float*)(A.ws + SM_NLOC))[(size_t)un * CH + C.tid] = s; }
    __syncthreads();
}
DI void mlstm_out_mfma(const Args& A, const Ctx& C0, int l, int un) { const Ctx C = fresh_ctx(C0);
    const bf16* PROJ = (const bf16*)(A.ws + WS_PROJ); const float* GATES = (const float*)(A.ws + SM_GATES); bf16* HCAT = (bf16*)(A.ws + WS_HCAT);
    const int bh = un >> 5, c = un & 31, b = bh >> 2, h = bh & 3, t0 = b * SEQ + c * CH;
    LAS bf16* QS = (LAS bf16*)C.lds;
    LAS bf16* KS = (LAS bf16*)(C.lds + TILE_B);
    LAS bf16* PS = (LAS bf16*)(C.lds + 2 * TILE_B);
    LAS bf16* CT = (LAS bf16*)(C.lds + 3 * TILE_B);
    LAS float* vec = (LAS float*)(C.lds + VEC_OFF);
    LAS float* uvec = vec, *Mvec = vec + 128, *wint = vec + 256, *flo = vec + 384; LAS bf16* npb = (LAS bf16*)(vec + 512);
    if (C.wave == 0) {
        const int l0 = 2 * C.lane; const f32x4 ga = *(const f32x4*)(GATES + (size_t)(t0 + l0) * 8), gb = *(const f32x4*)(GATES + (size_t)(t0 + l0) * 8 + 4), gc = *(const f32x4*)(GATES + (size_t)(t0 + l0 + 1) * 8), gd = *(const f32x4*)(GATES + (size_t)(t0 + l0 + 1) * 8 + 4);
        const float ip0 = h == 0 ? ga[0] : (h == 1 ? ga[1] : (h == 2 ? ga[2] : ga[3])), fp0 = h == 0 ? gb[0] : (h == 1 ? gb[1] : (h == 2 ? gb[2] : gb[3]));
        const float ip1 = h == 0 ? gc[0] : (h == 1 ? gc[1] : (h == 2 ? gc[2] : gc[3])), fp1 = h == 0 ? gd[0] : (h == 1 ? gd[1] : (h == 2 ? gd[2] : gd[3]));
        const float lf0 = logsigmoidf_(fp0), lf1 = logsigmoidf_(fp1);
        const float incl = wave_scan_add(lf0 + lf1, C.lane), b1 = incl, b0 = incl - lf1;
        const float u0 = ip0 - b0, u1 = ip1 - b1;
        const float pm_incl = wave_scan_max(fmaxf(u0, u1), C.lane); const float pm_prev = __shfl_up(pm_incl, 1);
        const float pm0 = C.lane == 0 ? u0 : fmaxf(pm_prev, u0), pm1 = pm_incl;
        const float mprev = ((const float*)(A.ws + SM_MPREV))[un];
        const float M0 = fmaxf(mprev, pm0), M1 = fmaxf(mprev, pm1);
        uvec[l0] = u0; uvec[l0 + 1] = u1; Mvec[l0] = M0; Mvec[l0 + 1] = M1; wint[l0] = __expf(mprev - M0); wint[l0 + 1] = __expf(mprev - M1); flo[l0] = __expf(-(b0 + M0)); flo[l0 + 1] = __expf(-(b1 + M1));
        const f32x2 np2 = *(const f32x2*)((const float*)(A.ws + SM_NPREV) + (size_t)un * CH + l0); *(LAS unsigned*)(npb + l0) = pk2(np2[0], np2[1]);
    }
    { const bf16* CPT = (const bf16*)(A.ws + WS_CPREVT) + (size_t)un * CH * CH;
        v4u sq[4], sk[4], sc[4];
#pragma unroll
        for (int kq = 0; kq < 4; ++kq) { const int it = C.tid + kq * NTHREADS, r = it >> 4, c8 = (it & 15) * 8; const size_t rowo = (size_t)(t0 + r) * NPROJ + h * 128 + c8;
            sq[kq] = *(const v4u*)(PROJ + rowo + PQ); sk[kq] = *(const v4u*)(PROJ + rowo + PK); sc[kq] = *(const v4u*)(CPT + (size_t)r * CH + c8); }
#pragma unroll
        for (int kq = 0; kq < 4; ++kq) { const int it = C.tid + kq * NTHREADS, r = it >> 4, c8 = (it & 15) * 8;
            *(LAS v4u*)(QS + r * LDT + c8) = sq[kq]; *(LAS v4u*)(KS + r * LDT + c8) = sk[kq]; *(LAS v4u*)(CT + r * LDT + c8) = sc[kq]; } }
    v4u vpre[4];
#pragma unroll
    for (int kq = 0; kq < 4; ++kq) { const int it = C.tid + kq * NTHREADS; const int r = it & 127, c8 = (it >> 7) * 8; vpre[kq] = *(const v4u*)(PROJ + (size_t)(t0 + r) * NPROJ + h * 128 + c8 + PV); }
    v4u opre[4];
#pragma unroll
    for (int q = 0; q < 4; ++q) opre[q] = *(const v4u*)(PROJ + (size_t)(t0 + (C.tid >> 2)) * NPROJ + PO + h * 128 + (C.tid & 3) * 32 + 8 * q);
    __syncthreads();
    const int fr = C.lane & 15, fg = C.lane >> 4, w = C.wave;
    bf16x8 aq[4];
#pragma unroll
    for (int ks = 0; ks < 4; ++ks) aq[ks] = *(const LAS bf16x8*)(QS + (16 * w + fr) * LDT + 32 * ks + 8 * fg);
    float Ml[4], wl[4], inv[4];
#pragma unroll
    for (int rg = 0; rg < 4; ++rg) { Ml[rg] = Mvec[16 * w + 4 * fg + rg]; wl[rg] = wint[16 * w + 4 * fg + rg]; }
    {   float rs[4] = {0.f, 0.f, 0.f, 0.f};
#pragma unroll
        for (int st = 0; st < 8; ++st) {
            if (st <= w) { f32x4 acc = {0.f, 0.f, 0.f, 0.f};
#pragma unroll
                for (int ks = 0; ks < 4; ++ks) { const bf16x8 bb = *(const LAS bf16x8*)(KS + (16 * st + fr) * LDT + 32 * ks + 8 * fg); acc = mfma16(aq[ks], bb, acc); }
                const int s = 16 * st + fr; const float us = uvec[s];
#pragma unroll
                for (int rg = 0; rg < 4; ++rg) { const int li = 16 * w + 4 * fg + rg; const float p = (s <= li) ? acc[rg] * 0.08838834764831845f * __expf(us - Ml[rg]) : 0.f; rs[rg] += p; PS[li * LDT + s] = (bf16)f2bf(p); } }
            else if (st == w + 1 && (w & 1) == 0) {
#pragma unroll
                for (int rg = 0; rg < 4; ++rg) PS[(16 * w + 4 * fg + rg) * LDT + 16 * st + fr] = (bf16)0; }
        }
        f32x4 an = {0.f, 0.f, 0.f, 0.f};
#pragma unroll
        for (int ks = 0; ks < 4; ++ks) { bf16x8 bn = *(const LAS bf16x8*)(npb + 32 * ks + 8 * fg); if (fr != 0) bn = (bf16x8){0, 0, 0, 0, 0, 0, 0, 0}; an = mfma16(aq[ks], bn, an); }
#pragma unroll
        for (int rg = 0; rg < 4; ++rg) { const float qn = __shfl(an[rg], 16 * fg); const float dn = red16(rs[rg]) + wl[rg] * qn; inv[rg] = __builtin_amdgcn_rcpf(fmaxf(fabsf(dn), flo[16 * w + 4 * fg + rg])); }
    }
    __syncthreads();
#pragma unroll
    for (int kq = 0; kq < 4; ++kq) { const int it = C.tid + kq * NTHREADS; const int r = it & 127, c8 = (it >> 7) * 8; const unsigned vw[4] = {vpre[kq].x, vpre[kq].y, vpre[kq].z, vpre[kq].w};
#pragma unroll
        for (int i = 0; i < 8; ++i) KS[(c8 + i) * LDT + r] = (bf16)((i & 1) ? (vw[i >> 1] >> 16) : (vw[i >> 1] & 0xffffu)); }
    __syncthreads();
    {   const int nk2 = (w >> 1) + 1;
        bf16x8 ap[4];
#pragma unroll
        for (int k2 = 0; k2 < 4; ++k2) ap[k2] = (k2 < nk2) ? *(const LAS bf16x8*)(PS + (16 * w + fr) * LDT + 32 * k2 + 8 * fg) : (bf16x8){0, 0, 0, 0, 0, 0, 0, 0};
        float hv[8][4]; float sm[4] = {0.f, 0.f, 0.f, 0.f};
#pragma unroll
        for (int et = 0; et < 8; ++et) { f32x4 a1 = {0.f, 0.f, 0.f, 0.f}, a2 = {0.f, 0.f, 0.f, 0.f};
#pragma unroll
            for (int k2 = 0; k2 < 4; ++k2) if (k2 < nk2) { const bf16x8 bb = *(const LAS bf16x8*)(KS + (16 * et + fr) * LDT + 32 * k2 + 8 * fg); a1 = mfma16(ap[k2], bb, a1); }
#pragma unroll
            for (int ks = 0; ks < 4; ++ks) { const bf16x8 bb = *(const LAS bf16x8*)(CT + (16 * et + fr) * LDT + 32 * ks + 8 * fg); a2 = mfma16(aq[ks], bb, a2); }
#pragma unroll
            for (int rg = 0; rg < 4; ++rg) { hv[et][rg] = (a1[rg] + wl[rg] * a2[rg]) * inv[rg]; sm[rg] += hv[et][rg]; } }
        float mean[4], rstd[4];
#pragma unroll
        for (int rg = 0; rg < 4; ++rg) { mean[rg] = red16(sm[rg]) * (1.0f / 128.0f); float q = 0.f;
#pragma unroll
            for (int et = 0; et < 8; ++et) { const float dlt = hv[et][rg] - mean[rg]; q += dlt * dlt; }
            rstd[rg] = __builtin_amdgcn_rsqf(red16(q) * (1.0f / 128.0f) + 1e-6f); }
#pragma unroll
        for (int et = 0; et < 8; ++et) { const int e = 16 * et + fr; const float nw = A.in[3][(size_t)l * 512 + h * 128 + e];
#pragma unroll
            for (int rg = 0; rg < 4; ++rg) { const int li = 16 * w + 4 * fg + rg; PS[li * LDT + e] = (bf16)f2bf((hv[et][rg] - mean[rg]) * rstd[rg] * nw); } }
    }
    __syncthreads();
    { const int r = C.tid >> 2, cg = (C.tid & 3) * 32;
#pragma unroll
        for (int q = 0; q < 4; ++q) { float hn[8], ov[8]; unpack8(*(const LAS v4u*)(PS + r * LDT + cg + 8 * q), hn); unpack8(opre[q], ov);
            v4u o4; o4.x = pk2(sigmoidf_(ov[0]) * hn[0], sigmoidf_(ov[1]) * hn[1]); o4.y = pk2(sigmoidf_(ov[2]) * hn[2], sigmoidf_(ov[3]) * hn[3]); o4.z = pk2(sigmoidf_(ov[4]) * hn[4], sigmoidf_(ov[5]) * hn[5]); o4.w = pk2(sigmoidf_(ov[6]) * hn[6], sigmoidf_(ov[7]) * hn[7]);
            *(v4u*)(HCAT + (size_t)(t0 + r) * D + h * 128 + cg + 8 * q) = o4; } }
    __syncthreads();
}
DI void gmlp_unit_mfma(const Args& A, const Ctx& C0, int l, int unit) { const Ctx C = fresh_ctx(C0);
    const bf16* PROJ = (const bf16*)(A.ws + WS_PROJ); bf16* HCAT = (bf16*)(A.ws + WS_HCAT); const bf16* WM = (const bf16*)(A.ws + SM_WM);
    const int ck = unit >> 2, hh = unit & 3, t0 = ck * CH;
    LAS bf16* ZT = (LAS bf16*)C.lds;
    LAS float* OUTS = (LAS float*)(C.lds + 32768);
    bf16x8 awm[4];
    { const int fr = C.lane & 15, fg = C.lane >> 4, w = C.wave, nk = (w >> 1) + 1;
#pragma unroll
        for (int ks = 0; ks < 4; ++ks) awm[ks] = (ks < nk) ? *(const bf16x8*)(WM + ((size_t)(hh * CH + 16 * w + fr) * CH + 32 * ks + 8 * fg)) : (bf16x8){0, 0, 0, 0, 0, 0, 0, 0}; }
    const v4u gu0 = *(const v4u*)(PROJ + (size_t)(t0 + (C.tid >> 2)) * NPROJ + PGU + 64 * hh + (C.tid & 3) * 16), gu1 = *(const v4u*)(PROJ + (size_t)(t0 + (C.tid >> 2)) * NPROJ + PGU + 64 * hh + (C.tid & 3) * 16 + 8);
    const float bsv0 = A.in[7][(size_t)(l * 4 + hh) * CH + (C.tid >> 2)];
    { const f32x4 nw = *(const f32x4*)(A.in[4] + l * 256 + 4 * C.lane), nb = *(const f32x4*)(A.in[5] + l * 256 + 4 * C.lane);
        v2u gvr[16];
#pragma unroll
        for (int i = 0; i < 16; ++i) gvr[i] = *(const v2u*)(PROJ + (size_t)(t0 + C.wave * 16 + i) * NPROJ + PGV + 4 * C.lane);
#pragma unroll
        for (int i = 0; i < 16; ++i) { const int r = C.wave * 16 + i; const v2u g = gvr[i];
            f32x4 x = {gelu_tanh(bflo(g.x)), gelu_tanh(bfhi(g.x)), gelu_tanh(bflo(g.y)), gelu_tanh(bfhi(g.y))};
            const float mean = wave_sum((x[0] + x[1]) + (x[2] + x[3])) * (1.0f / 256.0f); x = x - mean;
            const float var = wave_sum((x[0] * x[0] + x[1] * x[1]) + (x[2] * x[2] + x[3] * x[3])) * (1.0f / 256.0f);
            const float rstd = __builtin_amdgcn_rsqf(var + LN_EPS); x = x * rstd * nw + nb;
            if ((C.lane >> 4) == hh) { const int d0 = 4 * (C.lane & 15);
#pragma unroll
                for (int q = 0; q < 4; ++q) ZT[(d0 + q) * LDT + r] = (bf16)f2bf(x[q]); } } }
    __syncthreads();
    { const int fr = C.lane & 15, fg = C.lane >> 4, w = C.wave, nk = (w >> 1) + 1;

#pragma unroll
        for (int dt = 0; dt < 4; ++dt) { f32x4 acc = {0.f, 0.f, 0.f, 0.f};
#pragma unroll
            for (int ks = 0; ks < 4; ++ks) if (ks < nk) { const bf16x8 bb = *(const LAS bf16x8*)(ZT + (16 * dt + fr) * LDT + 32 * ks + 8 * fg); acc = mfma16(awm[ks], bb, acc); }
#pragma unroll
            for (int rg = 0; rg < 4; ++rg) OUTS[(16 * w + 4 * fg + rg) * 68 + 16 * dt + fr] = acc[rg]; } }
    __syncthreads();
    { const int r = C.tid >> 2, cg = (C.tid & 3) * 16; const float bsv = bsv0;
        float u[16]; { float tmp[8]; unpack8(gu0, tmp);
#pragma unroll
            for (int j = 0; j < 8; ++j) u[j] = tmp[j];
            unpack8(gu1, tmp);
#pragma unroll
            for (int j = 0; j < 8; ++j) u[8 + j] = tmp[j]; }
        float o[16];
#pragma unroll
        for (int q = 0; q < 4; ++q) { const f32x4 a4 = *(const LAS f32x4*)(OUTS + r * 68 + cg + 4 * q);
#pragma unroll
            for (int j = 0; j < 4; ++j) o[4 * q + j] = gelu_tanh(u[4 * q + j]) * (a4[j] + bsv); }
        v4u w0, w1; w0.x = pk2(o[0], o[1]); w0.y = pk2(o[2], o[3]); w0.z = pk2(o[4], o[5]); w0.w = pk2(o[6], o[7]); w1.x = pk2(o[8], o[9]); w1.y = pk2(o[10], o[11]); w1.z = pk2(o[12], o[13]); w1.w = pk2(o[14], o[15]);
        *(v4u*)(HCAT + (size_t)(t0 + r) * D + 512 + 64 * hh + cg) = w0; *(v4u*)(HCAT + (size_t)(t0 + r) * D + 512 + 64 * hh + cg + 8) = w1; }
    __syncthreads();
}
#if DBG_CHECK
constexpr size_t SM_ERR = WS_CTL + 8192;
DI int slot_of(const Args& A, int l, int t, int k) { const v4u s = ((const v4u*)(A.ws + SM_SEL))[t]; const int e = k ? (int)s.y : (int)s.x; int run = 0;
    for (int q = 0; q < e; ++q) run += (((int)((const unsigned*)(A.ws + WS_CTL))[CW_CNT + (l * 16 + q) * 16] + 255) >> 8) * 256;
    return run + ((const int*)(A.ws + SM_TOKSLOT))[2 * t + k]; }
DI unsigned hsh(unsigned s, unsigned k) { unsigned h = s * 2654435761u + k * 40503u + 12345u; h ^= h >> 15; h *= 2246822519u; h ^= h >> 13; return h; }
DI void err_put(const Args& A, int chk, float ref, float got, float floor_) {
    float e = fabsf(ref - got) / (fabsf(ref) + floor_); if (!(e == e)) e = 1e9f;
    atomicMax((unsigned*)(A.ws + SM_ERR) + chk, __builtin_bit_cast(unsigned, e));
}
DI void chk_gates(const Args& A, const Ctx& C, int l, const float* X) {
    const int gt = C.bid * NTHREADS + C.tid; if (gt >= 2048) return;
    const int t = hsh(gt, 1) % T, g = hsh(gt, 2) % 8; float s = 0.f;
    for (int k = 0; k < D; ++k) s += X[(size_t)t * D + k] * A.in[1][((size_t)l * D + k) * PIN + 2048 + g];
    s += A.in[2][(size_t)l * PIN + 2048 + g];
    err_put(A, 1, s, ((const float*)(A.ws + SM_GATES))[(size_t)t * 8 + g], 0.1f);
}
DI void chk_proj(const Args& A, const Ctx& C, int l) {
    const int gt = C.bid * NTHREADS + C.tid; if (gt >= 8192) return;
    const int t = (gt < 64) ? (gt * 4099) % T : hsh(gt, 3) % T, n = hsh(gt, 4) % NPROJ, ns = n + (n >= 2048 ? 8 : 0);
    const bf16* XN = (const bf16*)(A.ws + WS_XN); float s = 0.f;
    for (int k = 0; k < D; ++k) s += bf2f(XN[(size_t)t * D + k]) * A.in[1][((size_t)l * D + k) * PIN + ns];
    s += A.in[2][(size_t)l * PIN + ns];
    err_put(A, 2, s, bf2f(((const bf16*)(A.ws + WS_PROJ))[(size_t)t * NPROJ + n]), 0.5f);
}
DI void chk_conv(const Args& A, const Ctx& C, int l) {
    const int gw = C.bid * NWAVES + C.wave; if (gw >= 1024) return;
    const int t = (gw < 128) ? (gw * 129) % T : hsh(gw, 5) % T; const bf16* PROJ = (const bf16*)(A.ws + WS_PROJ);
    float cv[4];
#pragma unroll
    for (int q = 0; q < 4; ++q) { const int c = C.lane * 4 + q; float acc = A.in[9][l * 256 + c];
        for (int j = 0; j < 31; ++j) { const int ts = t - 30 + j; if ((ts >> 12) != (t >> 12) || ts < 0) continue;
            const float a = bf2f(PROJ[(size_t)ts * NPROJ + PCA + c]), b = bf2f(PROJ[(size_t)ts * NPROJ + PCB + c]);
            acc += a / (1.0f + expf(-b)) * A.in[8][(size_t)(l * 31 + j) * 256 + c]; }
        cv[q] = acc; }
    const float mean = wave_sum_ref(cv[0] + cv[1] + cv[2] + cv[3]) / 256.0f; float q2 = 0.f;
#pragma unroll
    for (int q = 0; q < 4; ++q) { cv[q] -= mean; q2 += cv[q] * cv[q]; }
    const float rstd = 1.0f / sqrtf(wave_sum_ref(q2) / 256.0f + LN_EPS);
#pragma unroll
    for (int q = 0; q < 4; ++q) { const int c = C.lane * 4 + q; const float y = cv[q] * rstd * A.in[10][l * 256 + c] + A.in[11][l * 256 + c]; const float r = y / (1.0f + expf(-y));
        err_put(A, 3, r, bf2f(((const bf16*)(A.ws + WS_HCAT))[(size_t)t * D + 768 + c]), 0.5f); }
}
DI void chk_gmlp(const Args& A, const Ctx& C, int l) {
    const int gw = C.bid * NWAVES + C.wave; if (gw >= 512) return;
    const int t = (gw < 64) ? (gw * 131 + 127) % T : hsh(gw, 6) % T; const bf16* PROJ = (const bf16*)(A.ws + WS_PROJ);
    const int tc = t & 127, t0 = t - tc, h = C.lane >> 4; float acc[4] = {0.f, 0.f, 0.f, 0.f};
    for (int s = 0; s <= tc; ++s) { float x[4];
#pragma unroll
        for (int q = 0; q < 4; ++q) { const float v = bf2f(PROJ[(size_t)(t0 + s) * NPROJ + PGV + C.lane * 4 + q]); x[q] = 0.5f * v * (1.0f + tanhf(0.7978845608028654f * (v + 0.044715f * v * v * v))); }
        const float mean = wave_sum_ref(x[0] + x[1] + x[2] + x[3]) / 256.0f; float q2 = 0.f;
#pragma unroll
        for (int q = 0; q < 4; ++q) { x[q] -= mean; q2 += x[q] * x[q]; }
        const float rstd = 1.0f / sqrtf(wave_sum_ref(q2) / 256.0f + LN_EPS); const float w = A.in[6][((size_t)(l * 4 + h) * CH + tc) * CH + s];
#pragma unroll
        for (int q = 0; q < 4; ++q) { const int c = C.lane * 4 + q; acc[q] += w * (x[q] * rstd * A.in[4][l * 256 + c] + A.in[5][l * 256 + c]); } }
#pragma unroll
    for (int q = 0; q < 4; ++q) { const int c = C.lane * 4 + q; const float v = bf2f(PROJ[(size_t)t * NPROJ + PGU + c]); const float u = 0.5f * v * (1.0f + tanhf(0.7978845608028654f * (v + 0.044715f * v * v * v)));
        const float r = u * (acc[q] + A.in[7][(size_t)(l * 4 + h) * CH + tc]);
        err_put(A, 4, r, bf2f(((const bf16*)(A.ws + WS_HCAT))[(size_t)t * D + 512 + c]), 0.5f); }
}
DI void chk_mlstm(const Args& A, const Ctx& C, int l) {
    const int gw = C.bid * NWAVES + C.wave; if (gw >= 1024) return;
    const int t = (gw < 64) ? (gw * 521 + (gw & 1) * 127) % T : hsh(gw, 7) % T, h = hsh(gw, 8) & 3; const bf16* PROJ = (const bf16*)(A.ws + WS_PROJ); const float* GATES = (const float*)(A.ws + SM_GATES);
    const int tb = t & ~(SEQ - 1); const int d0 = 2 * C.lane;
    const float q0 = bf2f(PROJ[(size_t)t * NPROJ + PQ + h * 128 + d0]), q1 = bf2f(PROJ[(size_t)t * NPROJ + PQ + h * 128 + d0 + 1]);
    float n0 = 0.f, n1 = 0.f, den = 0.f, F = 0.f;
    for (int s = t; s >= tb; --s) {
        const float k0 = bf2f(PROJ[(size_t)s * NPROJ + PK + h * 128 + d0]), k1 = bf2f(PROJ[(size_t)s * NPROJ + PK + h * 128 + d0 + 1]);
        const float qk = wave_sum_ref(q0 * k0 + q1 * k1) * 0.08838834764831845f;
        const float w = expf(F + GATES[(size_t)s * 8 + h]) * qk;
        n0 += w * bf2f(PROJ[(size_t)s * NPROJ + PV + h * 128 + d0]); n1 += w * bf2f(PROJ[(size_t)s * NPROJ + PV + h * 128 + d0 + 1]); den += w;
        const float fp = GATES[(size_t)s * 8 + 4 + h]; F += fminf(fp, 0.f) - log1pf(expf(-fabsf(fp)));
        if (F < -60.f) break; }
    const float inv = 1.0f / fmaxf(fabsf(den), 1.0f); float x0 = n0 * inv, x1 = n1 * inv;
    const float mean = wave_sum_ref(x0 + x1) / 128.0f; x0 -= mean; x1 -= mean; const float rstd = 1.0f / sqrtf(wave_sum_ref(x0 * x0 + x1 * x1) / 128.0f + 1e-6f);
    const float o0 = bf2f(PROJ[(size_t)t * NPROJ + PO + h * 128 + d0]), o1 = bf2f(PROJ[(size_t)t * NPROJ + PO + h * 128 + d0 + 1]);
    const float r0 = x0 * rstd * A.in[3][(size_t)l * 512 + h * 128 + d0] / (1.0f + expf(-o0)), r1 = x1 * rstd * A.in[3][(size_t)l * 512 + h * 128 + d0 + 1] / (1.0f + expf(-o1));
    const bf16* HC = (const bf16*)(A.ws + WS_HCAT);
    err_put(A, 5, r0, bf2f(HC[(size_t)t * D + h * 128 + d0]), 0.5f); err_put(A, 5, r1, bf2f(HC[(size_t)t * D + h * 128 + d0 + 1]), 0.5f);
}
DI void chk_y(const Args& A, const Ctx& C, int l) {
    const int gt = C.bid * NTHREADS + C.tid; if (gt >= 8192) return;
    const int t = hsh(gt, 9) % T, n = hsh(gt, 10) % D; const bf16* HC = (const bf16*)(A.ws + WS_HCAT); float s = 0.f;
    for (int k = 0; k < D; ++k) s += bf2f(HC[(size_t)t * D + k]) * A.in[12][((size_t)l * D + k) * D + n];
    err_put(A, 6, s, bf2f(((const bf16*)(A.ws + WS_PROJ))[(size_t)t * D + n]), 0.2f);
}
DI void chk_ln1(const Args& A, const Ctx& C, int l, const bf16* X) {
    const int gw = C.bid * NWAVES + C.wave; if (gw >= 2048) return;
    const int t = hsh(gw, 11) % T; const bf16* Y = (const bf16*)(A.ws + WS_PROJ); const bf16* X1 = (const bf16*)(A.ws + WS_XNB);
    float v[16]; float s = 0.f;
#pragma unroll
    for (int i = 0; i < 16; ++i) { const int c = C.lane + 64 * i; v[i] = ALPHA * bf2f(X[(size_t)t * D + c]) + bf2f(Y[(size_t)t * D + c]); s += v[i]; }
    const float mean = wave_sum_ref(s) / D; float q2 = 0.f;
#pragma unroll
    for (int i = 0; i < 16; ++i) { v[i] -= mean; q2 += v[i] * v[i]; }
    const float rstd = 1.0f / sqrtf(wave_sum_ref(q2) / D + LN_EPS);
#pragma unroll
    for (int i = 0; i < 16; ++i) { const int c = C.lane + 64 * i; v[i] = v[i] * rstd * A.in[13][(size_t)l * D + c] + A.in[14][(size_t)l * D + c]; }
    err_put(A, 7, v[3], bf2f(X1[(size_t)t * D + C.lane + 192]), 1.0f);
    float sel[16], sg[16];
#pragma unroll
    for (int e = 0; e < 16; ++e) { float p = 0.f;
#pragma unroll
        for (int i = 0; i < 16; ++i) p += v[i] * A.in[15][(size_t)(C.lane + 64 * i) * 16 + e];
        p = wave_sum_ref(p); sg[e] = 1.0f / (1.0f + expf(-p)); sel[e] = sg[e] + A.in[16][e]; }
    float bestg = -INFINITY; int bg = 0;
#pragma unroll
    for (int g = 0; g < 4; ++g) { float a = sel[4 * g], b = sel[4 * g + 1], c = sel[4 * g + 2], d = sel[4 * g + 3];
        float m1 = fmaxf(fmaxf(a, b), fmaxf(c, d)); float tot = a + b + c + d; float mn = fminf(fminf(a, b), fminf(c, d));
        float lo1 = fminf(a, b), hi1 = fmaxf(a, b), lo2 = fminf(c, d), hi2 = fmaxf(c, d); float second = fmaxf(fminf(hi1, hi2), fmaxf(lo1, lo2)); (void)tot; (void)mn;
        const float gs = m1 + second; if (gs > bestg) { bestg = gs; bg = g; } }
    int e0 = -1, e1 = -1; float m1 = -INFINITY, m2 = -INFINITY;
#pragma unroll
    for (int e = 0; e < 16; ++e) if ((e >> 2) == bg && sel[e] > m1) { m1 = sel[e]; e0 = e; }
#pragma unroll
    for (int e = 0; e < 16; ++e) if ((e >> 2) == bg && e != e0 && sel[e] > m2) { m2 = sel[e]; e1 = e; }
    const v4u got = ((const v4u*)(A.ws + SM_SEL))[t];
    if (C.lane == 0 && ((int)got.x != e0 || (int)got.y != e1)) atomicAdd((unsigned*)(A.ws + SM_ERR) + 8, 1u);
}
DI void chk_hid(const Args& A, const Ctx& C, int l) {
    const int gt = C.bid * NTHREADS + C.tid; if (gt >= 8192) return;
    const int t = hsh(gt, 12) % T, k = hsh(gt, 13) & 1, j = hsh(gt, 14) % DEXP; const v4u s = ((const v4u*)(A.ws + SM_SEL))[t]; const int e = k ? (int)s.y : (int)s.x; const int p = slot_of(A, l, t, k);
    const bf16* XN = (const bf16*)(A.ws + WS_XNB); float g = 0.f, u = 0.f;
    for (int c = 0; c < D; ++c) { const float x = bf2f(XN[(size_t)t * D + c]); g += x * A.in[17][((size_t)(l * NEXP + e) * D + c) * DEXP + j]; u += x * A.in[18][((size_t)(l * NEXP + e) * D + c) * DEXP + j]; }
    err_put(A, 9, g / (1.0f + expf(-g)) * u, bf2f(((const bf16*)(A.ws + WS_HID))[(size_t)p * DEXP + j]), 0.5f);
    if (p < 0 || p >= PADROWS) atomicAdd((unsigned*)(A.ws + SM_ERR) + 11, 1u);
}
DI void chk_yp(const Args& A, const Ctx& C, int l) {
    const int gt = C.bid * NTHREADS + C.tid; if (gt >= 8192) return;
    const int t = hsh(gt, 15) % T, k = hsh(gt, 16) & 1, n = hsh(gt, 17) % D; const v4u s = ((const v4u*)(A.ws + SM_SEL))[t]; const int e = k ? (int)s.y : (int)s.x; const int p = slot_of(A, l, t, k);
    const bf16* HID = (const bf16*)(A.ws + WS_HID); float y = 0.f;
    for (int j = 0; j < DEXP; ++j) y += bf2f(HID[(size_t)p * DEXP + j]) * A.in[19][((size_t)(l * NEXP + e) * DEXP + j) * D + n];
    err_put(A, 10, y, bf2f(((const bf16*)(A.ws + WS_PROJ))[(size_t)p * D + n]), 0.2f);
}
DI void chk_out(const Args& A, const Ctx& C, int l) {
    const int gw = C.bid * NWAVES + C.wave; if (gw >= 2048) return;
    const int t = hsh(gw, 18) % T; const bf16* X1 = (const bf16*)(A.ws + WS_XNB); const bf16* YP = (const bf16*)(A.ws + WS_PROJ);
    const v4u s = ((const v4u*)(A.ws + SM_SEL))[t]; const int p0 = slot_of(A, l, t, 0), p1 = slot_of(A, l, t, 1);
    const f32x2 gw2 = ((const f32x2*)(A.ws + SM_GW))[t]; const float g0 = gw2[0], g1 = gw2[1];
    float v[16]; float sm = 0.f;
#pragma unroll
    for (int i = 0; i < 16; ++i) { const int c = C.lane + 64 * i; v[i] = ALPHA * bf2f(X1[(size_t)t * D + c]) + g0 * bf2f(YP[(size_t)p0 * D + c]) + g1 * bf2f(YP[(size_t)p1 * D + c]); sm += v[i]; }
    { float sy = 0.f, sx = 0.f;
#pragma unroll
      for (int i = 0; i < 16; ++i) { const int c = C.lane + 64 * i; const float yy = g0 * bf2f(YP[(size_t)p0 * D + c]) + g1 * bf2f(YP[(size_t)p1 * D + c]); const float xx = ALPHA * bf2f(X1[(size_t)t * D + c]); sy += yy * yy; sx += xx * xx; }
      sy = wave_sum_ref(sy); sx = wave_sum_ref(sx); const float ratio = sqrtf(sy / sx);
      if (C.lane == 0) atomicMax((unsigned*)(A.ws + SM_ERR) + 20, __builtin_bit_cast(unsigned, ratio));
      float sxn = 0.f, shid = 0.f, syp = 0.f; const bf16* XNb = (const bf16*)(A.ws + WS_XN); const bf16* HIDb = (const bf16*)(A.ws + WS_HID);
#pragma unroll
      for (int i = 0; i < 16; ++i) { const int c = C.lane + 64 * i; const float a = bf2f(YP[(size_t)p0 * D + c]); syp += a * a; }
#pragma unroll
      for (int i = 0; i < 8; ++i) { const int c = C.lane + 64 * i; const float a = bf2f(HIDb[(size_t)p0 * DEXP + c]); shid += a * a; }
      syp = sqrtf(wave_sum_ref(syp) / D); shid = sqrtf(wave_sum_ref(shid) / DEXP);
      if (C.lane == 0) { atomicMax((unsigned*)(A.ws + SM_ERR) + 21, __builtin_bit_cast(unsigned, syp)); atomicMax((unsigned*)(A.ws + SM_ERR) + 22, __builtin_bit_cast(unsigned, shid)); atomicMax((unsigned*)(A.ws + SM_ERR) + 23, __builtin_bit_cast(unsigned, g0 + g1)); atomicMax((unsigned*)(A.ws + SM_ERR) + 24, s.z); atomicMax((unsigned*)(A.ws + SM_ERR) + 25, s.w); atomicMax((unsigned*)(A.ws + SM_ERR) + 26, s.x); } }
    const float mean = wave_sum_ref(sm) / D; float q2 = 0.f;
#pragma unroll
    for (int i = 0; i < 16; ++i) { v[i] -= mean; q2 += v[i] * v[i]; }
    const float rstd = 1.0f / sqrtf(wave_sum_ref(q2) / D + LN_EPS);
    const int c = C.lane + 64 * 5; const float r = v[5] * rstd * A.in[20][(size_t)l * D + c] + A.in[21][(size_t)l * D + c];
    err_put(A, 12, r, (l == NLAYER - 1) ? A.out[(size_t)t * D + c] : bf2f(((const bf16*)(A.ws + WS_XN))[(size_t)t * D + c]), 1.0f);
}
DI void probe_gates(const Args& A, const Ctx& C, int slot) {
    const int gt = C.bid * NTHREADS + C.tid; if (gt >= 4096) return;
    const int t = hsh(gt, 30) % T; const v4u s = ((const v4u*)(A.ws + SM_SEL))[t];
    const f32x2 gw2 = ((const f32x2*)(A.ws + SM_GW))[t];
    atomicMax((unsigned*)(A.ws + SM_ERR) + slot, __builtin_bit_cast(unsigned, gw2[0] + gw2[1]));
    { const float sm = gw2[0] + gw2[1]; if (!(fabsf(sm - 1.0f) < 1e-3f)) atomicAdd((unsigned*)(A.ws + SM_ERR) + slot + 8, 1u); }
}
DI void dbg_finish(const Args& A, const Ctx& C) {
    const unsigned* E = (const unsigned*)(A.ws + SM_ERR);
    const float tol[13] = {0, 1e-3f, 0.03f, 0.04f, 0.04f, 0.08f, 0.03f, 0.01f, 0, 0.04f, 0.04f, 0, 0.01f};
    int code = 0;
#pragma unroll
    for (int k = 12; k >= 1; --k) { bool bad;
        if (k == 8) bad = E[8] > 20u; else if (k == 11) bad = E[11] > 0u; else bad = __builtin_bit_cast(float, E[k]) > tol[k];
        if (bad) code = k; }
    const float cv = (float)(code + DBG_BIAS);
    for (size_t i = (size_t)C.bid * NTHREADS + C.tid; i < (size_t)T * D; i += (size_t)GRID * NTHREADS) A.out[i] = cv;
}
#endif
__global__ void __launch_bounds__(NTHREADS, 2) fwd_kernel(Args A0) {
    extern __shared__ __attribute__((aligned(16))) unsigned char lds_raw[];
    Ctx CK; CK.lds = (LAS unsigned char*)lds_raw; CK.tid = threadIdx.x; CK.lane = CK.tid & 63; CK.wave = __builtin_amdgcn_readfirstlane(CK.tid >> 6); CK.bid = blockIdx.x;
    for (int u = CK.tid; u < (LDS_BYTES - LDSCTL_OFF) / 4; u += NTHREADS) ((LAS unsigned*)(CK.lds + LDSCTL_OFF))[u] = 0u;
    __syncthreads();
    unsigned* ctl = (unsigned*)(A0.ws + WS_CTL);
    XcdBarrier bar = xcd_barrier_post(ctl + CW_BAR, (volatile LAS unsigned*)(CK.lds + MISC_OFF) + 8);
#define GRID_BAR() xcd_barrier<false>(bar)
#if DBG_TIME
#define TS(k) do { if (l == TIME_LAYER && CK.bid == 0 && CK.tid == 0) ((unsigned long long*)(A0.ws + WS_CTL + 12288))[k] = __builtin_amdgcn_s_memrealtime(); } while (0)
#else
#define TS(k) do { } while (0)
#endif
#define FRESH() Args A; { int z_ = 0; asm volatile("" : "+s"(z_)); _Pragma("unroll") for (int k_ = 0; k_ < 22; ++k_) A.in[k_] = A0.in[k_] + z_; A.out = A0.out + z_; A.ws = A0.ws + z_; } const Ctx C = fresh_ctx(CK)
    { FRESH(); phase_prologue_rows(A, C); }
    xcd_barrier<true>(bar);
#if DBG_CHECK
    if (DBG_LAYER == 0) { FRESH(); chk_gates(A, C, 0, A.in[0]); }
#endif
    for (int l = 0; l < NLAYER_RUN; ++l) {
        TS(0);
        if (l == 0) { { FRESH(); phase_convert(A, C, 0); } GRID_BAR(); }
        TS(1);

        {
            FRESH(); pg8::Gemm g{(const pg8::bf16_t*)(A.ws + WS_XN), (const pg8::bf16_t*)(A.ws + WS_WIN), T, NPROJ, D}; pg8::StaticOrder S; S.init(T, NPROJ, GRID, C.bid);
            pg8::EpiStoreBf16 E{(pg8::bf16_t*)(A.ws + WS_PROJ), NPROJ, (const float*)(A.ws + SM_BIAS), 0xffff};
            pg8::gemm_phase<pg8::EpiStoreBf16, pg8::StaticOrder, true, true>(C.lds, g, S, E);
        }
        GRID_BAR(); TS(2);
#if DUP_G1
        {
            FRESH(); pg8::Gemm g{(const pg8::bf16_t*)(A.ws + WS_XN), (const pg8::bf16_t*)(A.ws + WS_WIN), T, NPROJ, D}; pg8::StaticOrder S; S.init(T, NPROJ, GRID, C.bid);
            pg8::EpiStoreBf16 E{(pg8::bf16_t*)(A.ws + WS_PROJ), NPROJ, (const float*)(A.ws + SM_BIAS), 0xffff};
            pg8::gemm_phase<pg8::EpiStoreBf16, pg8::StaticOrder, true, true>(C.lds, g, S, E);
        }
        GRID_BAR(); TS(2);
#endif
#if DBG_CHECK
        if (l == DBG_LAYER) { FRESH(); chk_proj(A, C, l); }
#endif
        { FRESH(); for (int un = C.bid; un < NUNIT; un += GRID) mlstm_local_mfma(A, C, un); } TS(3);
#if DUP_LOCAL
        { FRESH(); for (int un = C.bid; un < NUNIT; un += GRID) mlstm_local_mfma(A, C, un); } TS(3);
#endif
        { FRESH(); for (int gu = C.bid; gu < 512; gu += GRID) gmlp_unit_mfma(A, C, l, gu); } TS(4);
#if DUP_GMLP
        { FRESH(); for (int gu = C.bid; gu < 512; gu += GRID) gmlp_unit_mfma(A, C, l, gu); } TS(4);
#endif
        { FRESH(); for (int cu = C.bid; cu < T / 32; cu += GRID) conv_unit(A, C, l, cu); }
#if DUP_CONVU
        { FRESH(); for (int cu = C.bid; cu < T / 32; cu += GRID) conv_unit(A, C, l, cu); }
#endif
        GRID_BAR(); TS(5);
#if DUP_P2
        { FRESH(); for (int un = C.bid; un < NUNIT; un += GRID) mlstm_local_mfma(A, C, un); } TS(3);
        { FRESH(); for (int gu = C.bid; gu < 512; gu += GRID) gmlp_unit_mfma(A, C, l, gu); } TS(4);
        { FRESH(); for (int cu = C.bid; cu < T / 32; cu += GRID) conv_unit(A, C, l, cu); }
        GRID_BAR(); TS(5);
#endif

        { FRESH(); phase_scan(A, C); }
        GRID_BAR(); TS(6);
#if DUP_SCAN
        { FRESH(); phase_scan(A, C); }
        GRID_BAR(); TS(6);
#endif

        { FRESH(); for (int un = C.bid; un < NUNIT; un += GRID) mlstm_out_mfma(A, C, l, un); }
        GRID_BAR(); TS(7);
#if DUP_P4
        { FRESH(); for (int un = C.bid; un < NUNIT; un += GRID) mlstm_out_mfma(A, C, l, un); }
        GRID_BAR(); TS(7);
#endif

#if DBG_CHECK
        if (l == DBG_LAYER) { FRESH(); chk_conv(A, C, l); chk_gmlp(A, C, l); chk_mlstm(A, C, l); GRID_BAR(); }
#endif
        {
            FRESH(); pg8::Gemm g{(const pg8::bf16_t*)(A.ws + WS_HCAT), (const pg8::bf16_t*)(A.ws + WS_WOUT), T, D, D}; pg8::StaticOrder S; S.init(T, D, GRID, C.bid);
            pg8::EpiStoreBf16 E{(pg8::bf16_t*)(A.ws + WS_PROJ), D, nullptr, 0xffff};
            pg8::gemm_phase<pg8::EpiStoreBf16, pg8::StaticOrder, true, true>(C.lds, g, S, E);
        }
        GRID_BAR(); TS(8);
#if DUP_G5
        {
            FRESH(); pg8::Gemm g{(const pg8::bf16_t*)(A.ws + WS_HCAT), (const pg8::bf16_t*)(A.ws + WS_WOUT), T, D, D}; pg8::StaticOrder S; S.init(T, D, GRID, C.bid);
            pg8::EpiStoreBf16 E{(pg8::bf16_t*)(A.ws + WS_PROJ), D, nullptr, 0xffff};
            pg8::gemm_phase<pg8::EpiStoreBf16, pg8::StaticOrder, true, true>(C.lds, g, S, E);
        }
        GRID_BAR(); TS(8);
#endif
#if DBG_CHECK
        if (l == DBG_LAYER) { FRESH(); chk_y(A, C, l); GRID_BAR(); }
#endif
        for (int rep = (DUP_P6 ? 0 : 1); rep < 2; ++rep) { FRESH(); phase_ln1_router(A, C, l, rep == 0); GRID_BAR(); }
        TS(9);

#if DBG_CHECK
        if (l == DBG_LAYER) { FRESH(); chk_ln1(A, C, l, (const bf16*)(A.ws + WS_XN)); probe_gates(A, C, 27); GRID_BAR(); }
#endif


        {
            FRESH(); PG8_LAS int* desc = (PG8_LAS int*)(C.lds + VEC_OFF); pg8::moe_units(desc, (const unsigned*)(A.ws + WS_CTL) + CW_CNT + l * 256, GRID, C.bid);
            pg8::MoeOrder<true> S{desc, (const int*)(A.ws + WS_LIST), GRID, C.bid, D * 2};
            pg8::Gemm g{(const pg8::bf16_t*)(A.ws + WS_XNB), (const pg8::bf16_t*)(A.ws + wgu_off(l)), PADROWS, NEXP * 1024, D};
            pg8::EpiSwiGLU E{(pg8::bf16_t*)(A.ws + WS_HID), DEXP};
            pg8::gemm_phase<pg8::EpiSwiGLU, pg8::MoeOrder<true>, true, true>(C.lds, g, S, E);
            if (l + 1 < NLAYER) convert_in_tail(A, C, l + 1, 0, CV_SPLIT, (const unsigned*)(A.ws + WS_CTL) + CW_CNT + l * 256);
        }
        GRID_BAR(); TS(11);
#if DUP_G8
        {
            FRESH(); PG8_LAS int* desc = (PG8_LAS int*)(C.lds + VEC_OFF); pg8::moe_units(desc, (const unsigned*)(A.ws + WS_CTL) + CW_CNT + l * 256, GRID, C.bid);
            pg8::MoeOrder<true> S{desc, (const int*)(A.ws + WS_LIST), GRID, C.bid, D * 2};
            pg8::Gemm g{(const pg8::bf16_t*)(A.ws + WS_XNB), (const pg8::bf16_t*)(A.ws + wgu_off(l)), PADROWS, NEXP * 1024, D};
            pg8::EpiSwiGLU E{(pg8::bf16_t*)(A.ws + WS_HID), DEXP};
            pg8::gemm_phase<pg8::EpiSwiGLU, pg8::MoeOrder<true>, true, true>(C.lds, g, S, E);
        }
        GRID_BAR(); TS(11);
#endif
#if DBG_CHECK
        if (l == DBG_LAYER) { FRESH(); chk_hid(A, C, l); probe_gates(A, C, 29); }
#endif
        {
            FRESH(); PG8_LAS int* desc = (PG8_LAS int*)(C.lds + VEC_OFF); pg8::moe_units(desc, (const unsigned*)(A.ws + WS_CTL) + CW_CNT + l * 256, GRID, C.bid);
            pg8::MoeOrder<false> S{desc, (const int*)(A.ws + WS_LIST), GRID, C.bid, 0};
            pg8::Gemm g{(const pg8::bf16_t*)(A.ws + WS_HID), (const pg8::bf16_t*)(A.ws + wd_off(l)), PADROWS, NEXP * 1024, DEXP};
            pg8::EpiStoreBf16 E{(pg8::bf16_t*)(A.ws + WS_PROJ), D, nullptr, 3};
            pg8::gemm_phase<pg8::EpiStoreBf16, pg8::MoeOrder<false>, true, true>(C.lds, g, S, E);
            if (l + 1 < NLAYER) convert_in_tail(A, C, l + 1, CV_SPLIT, CV_ITEMS, (const unsigned*)(A.ws + WS_CTL) + CW_CNT + l * 256);
        }
        GRID_BAR(); TS(12);
#if DUP_G9
        {
            FRESH(); PG8_LAS int* desc = (PG8_LAS int*)(C.lds + VEC_OFF); pg8::moe_units(desc, (const unsigned*)(A.ws + WS_CTL) + CW_CNT + l * 256, GRID, C.bid);
            pg8::MoeOrder<false> S{desc, (const int*)(A.ws + WS_LIST), GRID, C.bid, 0};
            pg8::Gemm g{(const pg8::bf16_t*)(A.ws + WS_HID), (const pg8::bf16_t*)(A.ws + wd_off(l)), PADROWS, NEXP * 1024, DEXP};
            pg8::EpiStoreBf16 E{(pg8::bf16_t*)(A.ws + WS_PROJ), D, nullptr, 3};
            pg8::gemm_phase<pg8::EpiStoreBf16, pg8::MoeOrder<false>, true, true>(C.lds, g, S, E);
        }
        GRID_BAR(); TS(12);
#endif
#if DBG_CHECK
        if (l == DBG_LAYER) { FRESH(); chk_yp(A, C, l); probe_gates(A, C, 30); }
#endif
        { FRESH(); phase_combine(A, C, l); }
        GRID_BAR(); TS(13);
#if DUP_P10
        { FRESH(); phase_combine(A, C, l); }
        GRID_BAR(); TS(13);
#endif

#if DBG_CHECK
        if (l == DBG_LAYER) { FRESH(); chk_out(A, C, l);  GRID_BAR(); }
#endif
    }
#if DBG_CHECK
    { FRESH(); dbg_finish(A, C); }
#endif
#if DBG_TIME
    { FRESH(); const unsigned long long* tsb = (const unsigned long long*)(A.ws + WS_CTL + 12288);
      const float c1 = floorf(((float)(tsb[TIME_A] - tsb[TIME_A - 1]) + TIME_OFF * 100.0f) * (1.0f / 1600.0f));
      for (size_t i = (size_t)C.bid * NTHREADS + C.tid; i < (size_t)T * D; i += (size_t)GRID * NTHREADS) A.out[i] = c1; }
#endif
}

extern "C" void kernel_launch(void* const* d_in, const int* in_sizes, int n_in, void* d_out, int out_size, void* d_ws, size_t ws_size, hipStream_t stream) {
    static int ready = 0;
    if (ready == 0) {
        if (n_in != 22 || in_sizes[0] != T * D || out_size != T * D || ws_size < WS_END) { fprintf(stderr, "kernel_launch: unexpected shapes (n_in %d, in0 %d, out %d, ws %zu)\n", n_in, n_in > 0 ? in_sizes[0] : -1, out_size, ws_size); ready = -1; return; }
        if (hipFuncSetAttribute((const void*)fwd_kernel, hipFuncAttributeMaxDynamicSharedMemorySize, LDS_BYTES) != hipSuccess) { fprintf(stderr, "kernel_launch: hipFuncSetAttribute failed\n"); ready = -1; return; }
        (void)hipGetLastError();
        ready = 1;
    }
    if (ready < 0) return;
    if (hipMemsetAsync((char*)d_ws + WS_CTL, 0, CTL_ZERO_BYTES, stream) != hipSuccess) return;
    Args a{};
    for (int i = 0; i < 22; ++i) a.in[i] = (const float*)d_in[i];
    a.out = (float*)d_out; a.ws = (unsigned char*)d_ws;
    hipLaunchKernelGGL(fwd_kernel, dim3(GRID), dim3(NTHREADS), LDS_BYTES, stream, a);
}
```

```cpp
#include <hip/hip_runtime.h>
#include <cstdio>
#include <cstdint>
namespace pg8 {
#define PG8_LAS __attribute__((address_space(3)))
typedef unsigned short bf16_t;
typedef short bf16x8 __attribute__((ext_vector_type(8)));
typedef float f32x4 __attribute__((ext_vector_type(4)));
typedef unsigned u32x4 __attribute__((ext_vector_type(4)));
constexpr int BM = 256, BK = 64, HALF = 128, HTB = HALF * BK * 2  , STAGE_BYTES = 8 * HTB, NXCD = 8, WGM = 8;

__host__ __device__ __forceinline__ int lds_byte(int r, int c) { const int st = (r >> 4) * 2 + (c >> 5), rr = r & 15, cc = c & 31, ob = rr * 64 + cc * 2; return st * 1024 + (ob ^ (((ob >> 9) & 1) << 5)); }
__host__ __device__ __forceinline__ void stage_rc(int b, int& R, int& C) { const int st = b / 1024, sb = b % 1024, swz = sb ^ (((sb >> 9) & 1) << 5); R = (st >> 1) * 16 + swz / 64; C = (st & 1) * 32 + (swz % 64) / 2; }
__host__ __device__ __forceinline__ int perm32(int rho) { const int n = rho >> 4, i = rho & 15; return 8 * (i >> 2) + 4 * n + (i & 3); }

struct Unit { int pm, pn, e, r0, cnt; };
struct Gemm { const bf16_t* A; const bf16_t* Bt; int M, N, K; };

struct StaticOrder {
    static constexpr bool GATHER = false;
    int nM, nN, nwg, G, c;
    __device__ __forceinline__ unsigned a_off(const Unit&, int) const { return 0u; }
    __host__ __device__ void init(int M, int N, int G_, int c_) { nM = M / BM; nN = N / BM; nwg = nM * nN; G = G_; c = c_; }
    __host__ __device__ bool next(int i, Unit& u) const {
        const long L = (long)i * G + c; if (L >= nwg) return false;
        int wgid = (int)L; { const int q = nwg / NXCD, r = nwg % NXCD, xcd = wgid % NXCD, off = wgid / NXCD; wgid = (xcd < r ? xcd * (q + 1) : r * (q + 1) + (xcd - r) * q) + off; }
        const int nig = WGM * nN, gid = wgid / nig, fm = gid * WGM, gsz = (nM - fm) < WGM ? (nM - fm) : WGM;
        u.pm = fm + ((wgid % nig) % gsz); u.pn = (wgid % nig) / gsz; return true;
    }
    __device__ __forceinline__ void a_ready(const Unit&) const {}
    __device__ __forceinline__ void done(const Unit&) const {}
};
template <bool GATH> struct MoeOrder {
    static constexpr bool GATHER = GATH;
    const PG8_LAS int* desc; const int* list; int G, c, rowbytes;
    __device__ __forceinline__ bool next(int i, Unit& u) const {
        u.pm = 0; u.pn = 0; u.e = 0; u.r0 = 0; u.cnt = 0;
        if (i >= 4) return false;
        const int L = i * G + c; const int f = __builtin_amdgcn_readfirstlane(desc[5 * i]);
        if (!f) return false;
        u.pm = L >> 2; u.e = __builtin_amdgcn_readfirstlane(desc[5 * i + 1]); u.r0 = __builtin_amdgcn_readfirstlane(desc[5 * i + 2]); u.cnt = __builtin_amdgcn_readfirstlane(desc[5 * i + 3]); u.pn = __builtin_amdgcn_readfirstlane(desc[5 * i + 4]);
        return true;
    }
    __device__ __forceinline__ unsigned a_off(const Unit& u, int row) const { const int pos = u.r0 + row; const int tok = pos < u.cnt ? list[(size_t)u.e * 16384 + pos] : 0; return (unsigned)tok * (unsigned)rowbytes; }
    __device__ __forceinline__ void a_ready(const Unit&) const {}
    __device__ __forceinline__ void done(const Unit&) const {}
};
__device__ __forceinline__ void moe_units(PG8_LAS int* desc, const unsigned* cnt, int G, int c) {
    if (threadIdx.x < 4) { const int i = threadIdx.x, L = i * G + c, rt = L >> 2; int acc = 0, f = 0, ee = 0, r0 = 0, cn = 0;
        for (int e = 0; e < 16; ++e) { const int n = (int)__hip_atomic_load(cnt + 16 * e, __ATOMIC_RELAXED, __HIP_MEMORY_SCOPE_AGENT); const int nt = (n + 255) >> 8;
            if (!f && rt < acc + nt) { f = 1; ee = e; r0 = (rt - acc) * 256; cn = n; }
            acc += nt; }
        desc[5 * i] = f; desc[5 * i + 1] = ee; desc[5 * i + 2] = r0; desc[5 * i + 3] = cn; desc[5 * i + 4] = ee * 4 + (L & 3); }
    __syncthreads();
}

__device__ __forceinline__ unsigned cvt_pk_bf16(float lo, float hi) { unsigned r; asm volatile("v_cvt_pk_bf16_f32 %0, %1, %2" : "=v"(r) : "v"(lo), "v"(hi)); return r; }

struct EpiStoreBf16 {
    static constexpr bool PERM = true, AFTER_DRAIN = false;
    bf16_t* O; int ldc; const float* bias; int pn_mask;
    __device__ __forceinline__ void operator()(const f32x4 (&acc)[2][2][4][2], const Unit& u, int wr, int wc, int fr, int fq) const {
        const int row0 = u.pm * BM + wr * 64 + fr; const int col0 = (u.pn & pn_mask) * BM + wc * 32 + 8 * fq;
        f32x4 bv[2][2];
#pragma unroll
        for (int bj = 0; bj < 2; ++bj)
#pragma unroll
            for (int n = 0; n < 2; ++n) bv[bj][n] = bias ? *(const f32x4*)(bias + col0 + bj * HALF + 4 * n) : (f32x4){0.f, 0.f, 0.f, 0.f};
#pragma unroll
        for (int ai = 0; ai < 2; ++ai)
#pragma unroll
            for (int m = 0; m < 4; ++m) { bf16_t* rowp = O + (size_t)(row0 + ai * HALF + m * 16) * ldc + col0;
#pragma unroll
                for (int bj = 0; bj < 2; ++bj) { const f32x4 v0 = acc[ai][bj][m][0] + bv[bj][0], v1 = acc[ai][bj][m][1] + bv[bj][1];
                    u32x4 w; w.x = cvt_pk_bf16(v0[0], v0[1]); w.y = cvt_pk_bf16(v0[2], v0[3]); w.z = cvt_pk_bf16(v1[0], v1[1]); w.w = cvt_pk_bf16(v1[2], v1[3]);
                    *(u32x4*)(rowp + bj * HALF) = w; } }
    }
};
struct EpiSwiGLU {
    static constexpr bool PERM = true, AFTER_DRAIN = false;
    bf16_t* O; int ldc;
    __device__ __forceinline__ void operator()(const f32x4 (&acc)[2][2][4][2], const Unit& u, int wr, int wc, int fr, int fq) const {
        const int row0 = u.pm * BM + wr * 64 + fr; const int col0 = (u.pn & 3) * HALF + wc * 32 + 8 * fq;
#pragma unroll
        for (int ai = 0; ai < 2; ++ai)
#pragma unroll
            for (int m = 0; m < 4; ++m) { bf16_t* rowp = O + (size_t)(row0 + ai * HALF + m * 16) * ldc + col0;
                float h[8];
#pragma unroll
                for (int n = 0; n < 2; ++n)
#pragma unroll
                    for (int k = 0; k < 4; ++k) { const float g = acc[ai][0][m][n][k], up = acc[ai][1][m][n][k]; h[4 * n + k] = g * up / (1.0f + __expf(-g)); }
                u32x4 w; w.x = cvt_pk_bf16(h[0], h[1]); w.y = cvt_pk_bf16(h[2], h[3]); w.z = cvt_pk_bf16(h[4], h[5]); w.w = cvt_pk_bf16(h[6], h[7]);
                *(u32x4*)rowp = w; }
    }
};
template <class Epi, class Sched, bool ALIGN_EPI = false, bool SP2 = false>
__device__ __forceinline__ void gemm_phase(PG8_LAS unsigned char* lds, const Gemm g, const Sched& S, const Epi& E) {
    int tid_l = threadIdx.x; asm volatile("" : "+v"(tid_l)); const int tid = tid_l, wid = __builtin_amdgcn_readfirstlane(tid >> 6), lane = tid & 63, wr = wid >> 2, wc = wid & 3, fr = lane & 15, fq = lane >> 4;
    const int K = g.K, nt = K / BK;
    unsigned voffA[2], voffB[2];
#pragma unroll
    for (int i = 0; i < 2; ++i) { int R, C; stage_rc(tid * 16 + i * 8192, R, C); const int Rb = Epi::PERM ? ((R & ~31) + perm32(R & 31)) : R;
        voffA[i] = (unsigned)(R * K + C) * 2u; voffB[i] = (unsigned)(Rb * K + C) * 2u; }
    unsigned cv0[2] = {voffA[0], voffA[1]}, cv1[2] = {voffA[0], voffA[1]};
#define PG8_GOFF(u, d0, d1) do { _Pragma("unroll") for (int _i = 0; _i < 2; ++_i) { int R_, C_; stage_rc(tid * 16 + _i * 8192, R_, C_); d0[_i] = S.a_off(u, R_) + (unsigned)(C_ * 2); d1[_i] = S.a_off(u, HALF + R_) + (unsigned)(C_ * 2); } } while (0)
    const size_t kstep = (size_t)(BK * 2);
    const size_t hstep = (size_t)HALF * K * 2;
    const size_t tstep = 2 * hstep;
    const unsigned ldsw = (unsigned)wid * 1024u;
    const int aoff = lds_byte(wr * 64 + fr, fq * 8), boff = lds_byte(wc * 32 + fr, fq * 8);
#define PG8_SA(b, h) (((b) * 2 + (h)) * HTB)
#define PG8_SB(b, h) ((4 + (b) * 2 + (h)) * HTB)
#define PG8_STAGE(bufoff, gbase, voff) do { _Pragma("unroll") for (int _i = 0; _i < 2; ++_i) \
        __builtin_amdgcn_global_load_lds((const unsigned*)((const char*)(gbase) + (voff)[_i]), (PG8_LAS unsigned*)(lds + (bufoff) + ldsw + _i * 8192), 16, 0, 0); } while (0)
#define PG8_LDA(dst, b, h) do { _Pragma("unroll") for (int m = 0; m < 4; ++m) _Pragma("unroll") for (int k = 0; k < 2; ++k) dst[m][k] = *(const PG8_LAS bf16x8*)(lds + PG8_SA(b, h) + aoff + m * 2048 + k * 1024); } while (0)
#define PG8_LDB(dst, b, h) do { _Pragma("unroll") for (int n = 0; n < 2; ++n) _Pragma("unroll") for (int k = 0; k < 2; ++k) dst[n][k] = *(const PG8_LAS bf16x8*)(lds + PG8_SB(b, h) + boff + n * 2048 + k * 1024); } while (0)
#define PG8_MMA(ai, bj, At, Bt) do { __builtin_amdgcn_s_setprio(1); _Pragma("unroll") for (int m = 0; m < 4; ++m) _Pragma("unroll") for (int n = 0; n < 2; ++n) _Pragma("unroll") for (int k = 0; k < 2; ++k) \
        acc[ai][bj][m][n] = __builtin_amdgcn_mfma_f32_16x16x32_bf16(Bt[n][k], At[m][k], acc[ai][bj][m][n], 0, 0, 0); __builtin_amdgcn_s_setprio(0); } while (0)
#define PG8_WAIT_V(n) asm volatile("s_waitcnt vmcnt(" #n ")" ::: "memory")
#define PG8_WAIT_L(n) asm volatile("s_waitcnt lgkmcnt(" #n ")" ::: "memory")
#define PG8_BAR __builtin_amdgcn_s_barrier()
#define PG8_SCHED __builtin_amdgcn_sched_barrier(0)
    Unit cur, nxt; int ui = 0;
    if (!S.next(0, cur)) return;
    f32x4 acc[2][2][4][2];
#pragma unroll
    for (int a = 0; a < 2; ++a)
#pragma unroll
        for (int b = 0; b < 2; ++b)
#pragma unroll
            for (int m = 0; m < 4; ++m)
#pragma unroll
                for (int n = 0; n < 2; ++n) acc[a][b][m][n] = (f32x4){0.f, 0.f, 0.f, 0.f};
    bf16x8 At[4][2], B0[2][2], B1[2][2];
    const char* cA = Sched::GATHER ? (const char*)g.A : (const char*)g.A + (size_t)cur.pm * tstep; const char* cB = (const char*)g.Bt + (size_t)cur.pn * tstep;
    const size_t hstepA = Sched::GATHER ? 0 : hstep;
    if constexpr (Sched::GATHER) { static_assert(SP2, "gather is wired into the SP2 loop only"); PG8_GOFF(cur, cv0, cv1); }
    S.a_ready(cur);
    if constexpr (SP2) {
        PG8_STAGE(PG8_SB(0, 0), cB, voffB); PG8_STAGE(PG8_SB(0, 1), cB + hstep, voffB); PG8_STAGE(PG8_SA(0, 0), cA, cv0); PG8_STAGE(PG8_SA(0, 1), cA + hstepA, cv1);
        if (wr == 1) PG8_BAR;
        PG8_WAIT_V(2); PG8_BAR;
        PG8_STAGE(PG8_SB(1, 0), cB + kstep, voffB); PG8_STAGE(PG8_SA(1, 0), cA + kstep, cv0); PG8_STAGE(PG8_SB(1, 1), cB + hstep + kstep, voffB);
        PG8_WAIT_V(6); PG8_BAR;
    } else {
        PG8_STAGE(PG8_SB(0, 0), cB, voffB); PG8_STAGE(PG8_SA(0, 0), cA, voffA); PG8_STAGE(PG8_SB(0, 1), cB + hstep, voffB); PG8_STAGE(PG8_SA(0, 1), cA + hstep, voffA);
        if (wr == 1) PG8_BAR;
        PG8_WAIT_V(4); PG8_BAR;
        PG8_STAGE(PG8_SB(1, 0), cB + kstep, voffB); PG8_STAGE(PG8_SA(1, 0), cA + kstep, voffA); PG8_STAGE(PG8_SB(1, 1), cB + hstep + kstep, voffB);
        PG8_WAIT_V(6); PG8_BAR;
    }
    for (;;) {
        const bool has_next = S.next(ui + 1, nxt);
        const char* nA = Sched::GATHER ? (const char*)g.A : (has_next ? (const char*)g.A + (size_t)nxt.pm * tstep : cA); const char* nB = has_next ? (const char*)g.Bt + (size_t)nxt.pn * tstep : cB;
        for (int t = 0; t < nt; t += 2) {
            const bool last = (t == nt - 2);
            const char* a1 = cA + (size_t)(t + 1) * kstep;
            const char* a2 = last ? nA : cA + (size_t)(t + 2) * kstep; const char* b2 = last ? nB : cB + (size_t)(t + 2) * kstep;
            const char* a3 = a2 + kstep; const char* b3 = b2 + kstep;
            if (last && has_next) S.a_ready(nxt);
            if constexpr (SP2) {
            PG8_LDB(B0, 0, 0); PG8_LDB(B1, 0, 1); PG8_SCHED; PG8_LDA(At, 0, 0); PG8_STAGE(PG8_SA(1, 1), a1 + hstepA, cv1);
            if constexpr (Sched::GATHER) { if (last && has_next) { PG8_GOFF(nxt, cv0, cv1); } }
            PG8_WAIT_V(8); PG8_WAIT_L(0); PG8_BAR; PG8_MMA(0, 0, At, B0); PG8_MMA(0, 1, At, B1); PG8_BAR; PG8_SCHED;
            PG8_LDA(At, 0, 1); PG8_STAGE(PG8_SB(0, 0), b2, voffB); PG8_STAGE(PG8_SB(0, 1), b2 + hstep, voffB); PG8_STAGE(PG8_SA(0, 0), a2, cv0);
            PG8_WAIT_V(8); PG8_WAIT_L(0); PG8_BAR; PG8_MMA(1, 0, At, B0); PG8_MMA(1, 1, At, B1); PG8_BAR; PG8_SCHED;
            PG8_LDB(B0, 1, 0); PG8_LDB(B1, 1, 1); PG8_SCHED; PG8_LDA(At, 1, 0); PG8_STAGE(PG8_SA(0, 1), a2 + hstepA, cv1);
            PG8_WAIT_V(8); PG8_WAIT_L(0); PG8_BAR; PG8_MMA(0, 0, At, B0); PG8_MMA(0, 1, At, B1); PG8_BAR; PG8_SCHED;
            PG8_LDA(At, 1, 1); PG8_STAGE(PG8_SB(1, 0), b3, voffB); PG8_STAGE(PG8_SB(1, 1), b3 + hstep, voffB); PG8_STAGE(PG8_SA(1, 0), a3, cv0);
            PG8_WAIT_V(8); PG8_WAIT_L(0); PG8_BAR; PG8_MMA(1, 0, At, B0); PG8_MMA(1, 1, At, B1); PG8_BAR; PG8_SCHED;
            } else {
            PG8_LDB(B0, 0, 0); PG8_SCHED; PG8_LDA(At, 0, 0); PG8_STAGE(PG8_SA(1, 1), a1 + hstep, voffA);
            PG8_WAIT_L(8); PG8_BAR; PG8_WAIT_L(0); PG8_MMA(0, 0, At, B0); PG8_BAR; PG8_SCHED;
            PG8_LDB(B1, 0, 1); PG8_STAGE(PG8_SB(0, 0), b2, voffB);
            PG8_BAR; PG8_WAIT_L(0); PG8_MMA(0, 1, At, B1); PG8_BAR;
            PG8_LDA(At, 0, 1); PG8_STAGE(PG8_SA(0, 0), a2, voffA);
            PG8_BAR; PG8_WAIT_L(0); PG8_MMA(1, 0, At, B0); PG8_BAR; PG8_SCHED;
            PG8_STAGE(PG8_SB(0, 1), b2 + hstep, voffB);
            PG8_WAIT_V(6); PG8_BAR; PG8_MMA(1, 1, At, B1); PG8_BAR;
            PG8_LDB(B0, 1, 0); PG8_SCHED; PG8_LDA(At, 1, 0); PG8_STAGE(PG8_SA(0, 1), a2 + hstep, voffA);
            PG8_WAIT_L(8); PG8_BAR; PG8_WAIT_L(0); PG8_MMA(0, 0, At, B0); PG8_BAR; PG8_SCHED;
            PG8_LDB(B1, 1, 1); PG8_STAGE(PG8_SB(1, 0), b3, voffB);
            PG8_BAR; PG8_WAIT_L(0); PG8_MMA(0, 1, At, B1); PG8_BAR;
            PG8_LDA(At, 1, 1); PG8_STAGE(PG8_SA(1, 0), a3, voffA);
            PG8_BAR; PG8_WAIT_L(0); PG8_MMA(1, 0, At, B0); PG8_BAR; PG8_SCHED;
            PG8_STAGE(PG8_SB(1, 1), b3 + hstep, voffB);
            PG8_WAIT_V(6); PG8_BAR; PG8_MMA(1, 1, At, B1); PG8_BAR;
            }
        }
        if constexpr (ALIGN_EPI) { if (wr == 0) PG8_BAR; }
        if constexpr (!Epi::AFTER_DRAIN) { E(acc, cur, wr, wc, fr, fq); S.done(cur); }
        if (!has_next) break;
#pragma unroll
        for (int a = 0; a < 2; ++a)
#pragma unroll
            for (int b = 0; b < 2; ++b)
#pragma unroll
                for (int m = 0; m < 4; ++m)
#pragma unroll
                    for (int n = 0; n < 2; ++n) acc[a][b][m][n] = (f32x4){0.f, 0.f, 0.f, 0.f};
        cur = nxt; cA = nA; cB = nB; ++ui;
        if constexpr (ALIGN_EPI) { if (wr == 1) PG8_BAR; }
    }
    PG8_WAIT_V(0);
    if constexpr (!ALIGN_EPI) { if (wr == 0) PG8_BAR; }
    PG8_BAR;
    if constexpr (Epi::AFTER_DRAIN) { E.fused(acc, cur, wr, wc, fr, fq, lds, wid, lane); S.done(cur); }
#undef PG8_SA
#undef PG8_SB
#undef PG8_STAGE
#undef PG8_LDA
#undef PG8_LDB
#undef PG8_MMA
#undef PG8_WAIT_V
#undef PG8_WAIT_L
#undef PG8_BAR
#undef PG8_SCHED
#undef PG8_GOFF
}
}
#ifndef DBG_CHECK
#define DBG_CHECK 0
#endif
#define DBG_LAYER 0
#ifndef DBG_TIME
#define DBG_TIME 0
#endif
#define TIME_LAYER 1
#define DUP_CONV 0
#define DUP_SCAN 0
#define DUP_P10 0
#define DUP_P6 0
#define DUP_P2 0
#define DUP_LOCAL 0
#define DUP_GMLP 0
#define DUP_CONVU 0
#define DUP_P4 0
#define DUP_G1 0
#define DUP_G5 0
#define DUP_G8 0
#define DUP_G9 0
#define TIME_A 9
#define TIME_B 2
#define TIME_OFF 0
#define DBG_BIAS 0
constexpr int NWAVES = 8, NTHREADS = 512, GRID = 256;
constexpr int NLAYER_RUN = DBG_CHECK ? (DBG_LAYER + 1) : 4;
constexpr int T = 16384, D = 1024, SEQ = 4096, NLAYER = 4;
constexpr int PIN = 3080, NPROJ = 3072;
constexpr int CH = 128, NCH = 32, NUNIT = 512;
constexpr int NEXP = 16, DEXP = 512;
constexpr int PADROWS = 36864;
constexpr float ALPHA = 1.6817928305074290f;
constexpr float LN_EPS = 1e-5f;
constexpr int PQ = 0, PK = 512, PV = 1024, PO = 1536, PGU = 2048, PGV = 2304, PCA = 2560, PCB = 2816;
constexpr size_t MiB = 1u << 20;
constexpr size_t WS_CTL = 0, CTL_ZERO_BYTES = 1 * MiB;
constexpr size_t WS_WIN = 2 * MiB, WS_WOUT = 8 * MiB, WS_WGU = 10 * MiB, WS_WD = 42 * MiB;
constexpr size_t WS_SMALL = 58 * MiB;
constexpr size_t SM_BIAS = WS_SMALL;
constexpr size_t SM_GATES = WS_SMALL + 64 * 1024;
constexpr size_t SM_SEL = SM_GATES + 512 * 1024;
constexpr size_t SM_HIST = SM_SEL + 256 * 1024;
constexpr size_t SM_META = SM_HIST + 16 * 1024;
constexpr size_t SM_TOKSLOT = SM_META + 4 * 1024;
constexpr size_t SM_G = SM_TOKSLOT + 128 * 1024;
constexpr size_t SM_MLOC = SM_G + 2048;
constexpr size_t SM_MPREV = SM_MLOC + 2048;
constexpr size_t SM_NLOC = SM_MPREV + 2048;
constexpr size_t SM_NPREV = SM_NLOC + 256 * 1024;
constexpr size_t SM_END = SM_NPREV + 256 * 1024;
constexpr size_t SM_WM = SM_END + 128 * 1024;
constexpr size_t SM_GW = SM_END;
static_assert(SM_WM + 128 * 1024 <= 62 * MiB, "small region");
constexpr size_t WS_XN = 62 * MiB, WS_HCAT = 94 * MiB, WS_XNB = 126 * MiB, WS_CLOCT = 190 * MiB, WS_CPREVT = 222 * MiB, WS_HID = 238 * MiB;
constexpr size_t WS_PROJ = 274 * MiB;
constexpr size_t WS_WGU2 = 370 * MiB, WS_WD2 = 402 * MiB;
constexpr size_t WS_END = 418 * MiB;
static_assert(WS_HID + (size_t)PADROWS * DEXP * 2 <= WS_PROJ && WS_PROJ + (size_t)PADROWS * D * 2 <= WS_END && WS_PROJ + (size_t)T * NPROJ * 2 <= WS_END, "ws map");
constexpr int CW_TMO = 0, CW_BAR = 4096, CW_CNT = 8192;
constexpr size_t WS_LIST = 158 * MiB;
constexpr int RING_BYTES = 131072, LDSCTL_OFF = 139264, MISC_OFF = LDSCTL_OFF + 320, PTR_OFF = LDSCTL_OFF + 512, VEC_OFF = LDSCTL_OFF + 1024, LDS_BYTES = 151552;

#define LAS __attribute__((address_space(3)))
typedef unsigned short bf16;
typedef unsigned v4u __attribute__((ext_vector_type(4)));
typedef unsigned v2u __attribute__((ext_vector_type(2)));
typedef float f32x4 __attribute__((ext_vector_type(4)));
typedef float f32x2 __attribute__((ext_vector_type(2)));
#define DI __device__ __forceinline__
typedef __bf16 bf16x2_t __attribute__((ext_vector_type(2)));
DI unsigned pk2(float lo, float hi) { const f32x2 v = {lo, hi}; return __builtin_bit_cast(unsigned, __builtin_convertvector(v, bf16x2_t)); }
DI unsigned f2bf(float f) { return pk2(f, 0.f) & 0xffffu; }
DI float bflo(unsigned w) { return __builtin_bit_cast(float, w << 16); }
DI float bfhi(unsigned w) { return __builtin_bit_cast(float, w & 0xffff0000u); }
DI float bf2f(bf16 h) { return __builtin_bit_cast(float, (unsigned)h << 16); }
DI float wave_sum_ref(float v) {
#pragma unroll
    for (int o = 1; o < 64; o <<= 1) v += __shfl_xor(v, o);
    return v;
}
template <int CTRL> DI float dpp_f(float v) { return __builtin_bit_cast(float, __builtin_amdgcn_update_dpp(0, __builtin_bit_cast(int, v), CTRL, 0xf, 0xf, false)); }
DI float row_sum16(float v) {
    v += dpp_f<0xB1>(v);
    v += dpp_f<0x4E>(v);
    v += dpp_f<0x141>(v);
    v += dpp_f<0x140>(v);
    return v;
}
DI float rl_f(float v, int l) { return __builtin_bit_cast(float, __builtin_amdgcn_readlane(__builtin_bit_cast(int, v), l)); }
DI float wave_sum(float v) { v = row_sum16(v); return (rl_f(v, 0) + rl_f(v, 16)) + (rl_f(v, 32) + rl_f(v, 48)); }
template <int N> DI int red_idx(int lane) { int idx = 0, n = N, o = 32; while (n > 1) { n >>= 1; if (lane & o) idx += n; o >>= 1; } return idx; }
typedef unsigned u32x2_t __attribute__((ext_vector_type(2)));
template <int N, int O> struct RedStep { template <int NN> static DI void run(float (&v)[NN], int lane) {
#pragma unroll
        for (int k = 0; k < N / 2; ++k) {
            if constexpr (O == 32) { float a = v[k], b = v[k + N / 2]; asm volatile("s_nop 1\n\tv_permlane32_swap_b32 %0, %1\n\ts_nop 1" : "+v"(a), "+v"(b)); v[k] = a + b; }
            else if constexpr (O == 16) { float a = v[k], b = v[k + N / 2]; asm volatile("s_nop 1\n\tv_permlane16_swap_b32 %0, %1\n\ts_nop 1" : "+v"(a), "+v"(b)); v[k] = a + b; }
            else { const bool up = (lane & O) != 0; const float keep = up ? v[k + N / 2] : v[k], send = up ? v[k] : v[k + N / 2];
                v[k] = keep + (O == 8 ? dpp_f<0x128>(send) : (O == 4 ? dpp_f<0x141>(send) : (O == 2 ? dpp_f<0x4E>(send) : dpp_f<0xB1>(send)))); } }
        RedStep<N / 2, O / 2>::run(v, lane); } };
template <int O> struct RedStep<1, O> { template <int NN> static DI void run(float (&v)[NN], int) {
        if constexpr (O == 32) { v[0] = wave_sum(v[0]); }
        else if constexpr (O == 16) { v[0] = row_sum16(v[0]); float a = v[0], b = v[0]; asm volatile("s_nop 1\n\tv_permlane16_swap_b32 %0, %1\n\ts_nop 1" : "+v"(a), "+v"(b)); v[0] = a + b; }
        else if constexpr (O == 8) { v[0] = row_sum16(v[0]); }
        else if constexpr (O == 4) { v[0] += dpp_f<0xB1>(v[0]); v[0] += dpp_f<0x4E>(v[0]); v[0] += dpp_f<0x141>(v[0]); }
        else if constexpr (O == 2) { v[0] += dpp_f<0xB1>(v[0]); v[0] += dpp_f<0x4E>(v[0]); }
        else if constexpr (O == 1) { v[0] += dpp_f<0xB1>(v[0]); } } };
template <> struct RedStep<1, 0> { template <int NN> static DI void run(float (&)[NN], int) {} };
template <int N> DI void red_multi(float (&v)[N], int lane) { RedStep<N, 32>::run(v, lane); }
DI float sigmoidf_(float x) { return __builtin_amdgcn_rcpf(1.0f + __builtin_amdgcn_exp2f(-1.4426950408889634f * x)); }
DI float gelu_tanh(float x) { const float t = x * x; const float p = x * __builtin_fmaf(t, -0.10294324f, -2.3022082f); return x * __builtin_amdgcn_rcpf(1.0f + __builtin_amdgcn_exp2f(p)); }
DI float logsigmoidf_(float x) { return fminf(x, 0.0f) - log1pf(__expf(-fabsf(x))); }

#define XB_TMO      128
#define XB_XCNT(j)  (256  + 64 * (j))
#define XB_XSUB(j)  (1280 + 64 * (j))
#define XB_XGEN(j)  (2304 + 64 * (j))
#define XB_TOP      3328
#define XB_TOPGEN   3392
#define XCD_BAR_WORDS 3456
#define XB_SPIN_CAP (1u << 18)
__device__ __forceinline__ unsigned xb_ld(unsigned* p)              { return __hip_atomic_load(p, __ATOMIC_RELAXED, __HIP_MEMORY_SCOPE_AGENT); }
__device__ __forceinline__ unsigned xb_add(unsigned* p, unsigned v) { return __hip_atomic_fetch_add(p, v, __ATOMIC_RELAXED, __HIP_MEMORY_SCOPE_AGENT); }
__device__ __forceinline__ unsigned xb_xcc_id() { return (unsigned)__builtin_amdgcn_s_getreg((3 << 11) | 20) & 0xFu; }
#define XB_SPIN(cond, bar) do { unsigned _sp = 0; while (cond) { __builtin_amdgcn_s_sleep(1); \
    if ((++_sp & 255u) == 0u) { if (xb_ld(&(bar)[XB_TMO])) break; if (_sp > XB_SPIN_CAP) { atomicAdd(&(bar)[XB_TMO], 1u); break; } } } } while (0)
struct XcdBarrier { unsigned* bar; unsigned x; volatile LAS unsigned* st; };
__device__ __forceinline__ XcdBarrier xcd_barrier_post(unsigned* bar, volatile LAS unsigned* st) {
    XcdBarrier b; b.bar = bar; b.x = xb_xcc_id(); b.st = st;
    if (threadIdx.x == 0) (void)xb_add(&bar[XB_XCNT(b.x)], 1u);
    return b;
}
__device__ __forceinline__ void xcd_barrier_complete(unsigned* bar, unsigned x, unsigned& nloc, unsigned& nx) {
    const unsigned G = gridDim.x * gridDim.y * gridDim.z;
    unsigned sum, cnt, mine, sp = 0u;
    for (;;) {
        sum = 0u; cnt = 0u; mine = 0u;
#pragma unroll
        for (unsigned j = 0; j < 16; ++j) { const unsigned c = xb_ld(&bar[XB_XCNT(j)]); sum += c; cnt += (c > 0u) ? 1u : 0u; mine = (j == x) ? c : mine; }
        if (sum == G) break;
        __builtin_amdgcn_s_sleep(1);
        if ((++sp & 255u) == 0u) { if (xb_ld(&bar[XB_TMO])) break; if (sp > XB_SPIN_CAP) { atomicAdd(&bar[XB_TMO], 1u); break; } }
    }
    nloc = mine > 0u ? mine : 1u; nx = cnt > 0u ? cnt : 1u;
}
template <bool FIRST> __device__ __forceinline__ void xcd_barrier(const XcdBarrier& b) {
    asm volatile("s_waitcnt vmcnt(0)" ::: "memory");
    __syncthreads();
    if (threadIdx.x == 0) {
        unsigned* bar = b.bar; unsigned bx = b.x; { int z_ = 0; asm volatile("" : "+s"(z_)); bar += z_; bx += (unsigned)z_; }
        __builtin_amdgcn_s_waitcnt(0);
        unsigned nloc = b.st[0], nx = b.st[1];
        if (FIRST) { if (nloc == 0u) { xcd_barrier_complete(bar, bx, nloc, nx); b.st[0] = nloc; b.st[1] = nx; } }
        const unsigned old = xb_add(&bar[XB_XSUB(bx)], 1u);
        const unsigned gen = old / nloc;
        if (old + 1u == (gen + 1u) * nloc) {
            __builtin_amdgcn_fence(__ATOMIC_RELEASE, "agent");
            asm volatile("s_waitcnt vmcnt(0)" ::: "memory");
            const unsigned og = xb_add(&bar[XB_TOP], 1u);
            const unsigned tg = og / nx;
            if (og + 1u == (tg + 1u) * nx) xb_add(&bar[XB_TOPGEN], 1u);
            else XB_SPIN(xb_ld(&bar[XB_TOPGEN]) == tg, bar);
            __builtin_amdgcn_fence(__ATOMIC_ACQUIRE, "agent");
            xb_add(&bar[XB_XGEN(bx)], 1u);
            asm volatile("s_waitcnt vmcnt(0)" ::: "memory");
        } else {
            XB_SPIN(xb_ld(&bar[XB_XGEN(bx)]) == gen, bar);
            __builtin_amdgcn_fence(__ATOMIC_ACQUIRE, "agent");
            asm volatile("s_waitcnt vmcnt(0)" ::: "memory");
        }
    }
    __syncthreads();
}

struct Args { const float* in[22]; float* out; unsigned char* ws; };
struct Ctx { LAS unsigned char* lds; int tid, lane, wave, bid; };
__device__ __forceinline__ Ctx fresh_ctx(const Ctx& C0) { Ctx C = C0; asm volatile("" : "+v"(C.tid)); asm volatile("" : "+s"(C.bid)); asm volatile("" : "+s"(C.lds)); C.lane = C.tid & 63; C.wave = __builtin_amdgcn_readfirstlane(C.tid >> 6); return C; }

DI void transpose_item(const float* src, int ld, int k0, int n0, bf16* dst, int K, int drow0, LAS float* scr, int lane) {
    float tv[32];
#pragma unroll
    for (int i = 0; i < 32; ++i) tv[i] = src[(size_t)(k0 + 2 * i + (lane >> 5)) * ld + n0 + (lane & 31)];
#pragma unroll
    for (int i = 0; i < 32; ++i) scr[(2 * i + (lane >> 5)) * 33 + (lane & 31)] = tv[i];
    asm volatile("s_waitcnt lgkmcnt(0)" ::: "memory");
    const int c = lane & 7;
#pragma unroll
    for (int j = 0; j < 4; ++j) { const int n = (lane >> 3) + 8 * j; const LAS float* s = scr + (8 * c) * 33 + n;
        v4u o; o.x = pk2(s[0 * 33], s[1 * 33]); o.y = pk2(s[2 * 33], s[3 * 33]); o.z = pk2(s[4 * 33], s[5 * 33]); o.w = pk2(s[6 * 33], s[7 * 33]);
        *(v4u*)(dst + (size_t)(drow0 + n) * K + k0 + 8 * c) = o; }
    asm volatile("s_waitcnt lgkmcnt(0)" ::: "memory");
}
constexpr int CV_IN = 16 * 96, CV_OUT = 16 * 32, CV_GU = 16 * 512, CV_D = 16 * 256, CV_ITEMS = CV_IN + CV_OUT + CV_GU + CV_D, CV_SPLIT = 9216;
DI size_t wgu_off(int l) { return (l & 1) ? WS_WGU2 : WS_WGU; }
DI size_t wd_off(int l) { return (l & 1) ? WS_WD2 : WS_WD; }
DI void convert_items(const Args& A, const Ctx& C, int l, int lo, int hi, int wrank, int nw) {
    LAS float* scr = (LAS float*)(C.lds + C.wave * 16384);
    bf16* WIN = (bf16*)(A.ws + WS_WIN); bf16* WOUT = (bf16*)(A.ws + WS_WOUT); bf16* WGU = (bf16*)(A.ws + wgu_off(l)); bf16* WD = (bf16*)(A.ws + wd_off(l));
    for (int it = lo + wrank; it < hi; it += nw) {
        int r = it;
        if (r < CV_IN) { const int kb = r / 96, nb = r % 96, n0 = 32 * nb; transpose_item(A.in[1] + (size_t)l * D * PIN, PIN, 64 * kb, n0 + (n0 >= 2048 ? 8 : 0), WIN, D, n0, scr, C.lane); continue; } r -= CV_IN;
        if (r < CV_OUT) { const int kb = r / 32, nb = r % 32; transpose_item(A.in[12] + (size_t)l * D * D, D, 64 * kb, 32 * nb, WOUT, D, 32 * nb, scr, C.lane); continue; } r -= CV_OUT;
        if (r < CV_GU) { const int e = r / 512, r1 = r % 512, half = r1 / 256, r2 = r1 % 256, kb = r2 / 16, nb = r2 % 16, j0 = 32 * nb;
            transpose_item((half ? A.in[18] : A.in[17]) + (size_t)(l * NEXP + e) * D * DEXP, DEXP, 64 * kb, j0, WGU, D, e * 1024 + (j0 / 128) * 256 + half * 128 + (j0 % 128), scr, C.lane); continue; } r -= CV_GU;
        { const int e = r / 256, r1 = r % 256, kb = r1 / 32, nb = r1 % 32;
            transpose_item(A.in[19] + (size_t)(l * NEXP + e) * DEXP * D, D, 64 * kb, 32 * nb, WD, DEXP, e * 1024 + 32 * nb, scr, C.lane); }
    }
}
DI void convert_small(const Args& A, const Ctx& C, int l) {
    { bf16* WM = (bf16*)(A.ws + SM_WM); const float* wsrc = A.in[6] + (size_t)l * 4 * CH * CH;
        for (int i = C.bid * NTHREADS + C.tid; i < 4 * CH * CH; i += GRID * NTHREADS) { const int s = i & 127, t = (i >> 7) & 127; WM[i] = (bf16)f2bf(s <= t ? wsrc[i] : 0.f); } }
    float* BIAS = (float*)(A.ws + SM_BIAS);
    for (int n = C.bid * NTHREADS + C.tid; n < NPROJ; n += GRID * NTHREADS) BIAS[n] = A.in[2][(size_t)l * PIN + n + (n >= 2048 ? 8 : 0)];
}
DI void phase_convert(const Args& A, const Ctx& C0, int l) { const Ctx C = fresh_ctx(C0);
    convert_items(A, C, l, 0, CV_ITEMS, C.bid * NWAVES + C.wave, GRID * NWAVES);
    convert_small(A, C, l);
}
DI void convert_in_tail(const Args& A, const Ctx& C0, int l, int lo, int hi, const unsigned* cnt) { const Ctx C = fresh_ctx(C0);
    int tiles = 0;
#pragma unroll
    for (int e = 0; e < 16; ++e) tiles += ((int)__builtin_amdgcn_readfirstlane(__hip_atomic_load(cnt + 16 * e, __ATOMIC_RELAXED, __HIP_MEMORY_SCOPE_AGENT)) + 255) >> 8;
    const int nunits = tiles * 4, maxu = (nunits + GRID - 1) / GRID, nfull = nunits - (maxu - 1) * GRID;
    int rank = C.bid - nfull, nidle = GRID - nfull;
    if (nidle == 0) { rank = C.bid; nidle = GRID; }
    if (rank < 0) return;
    convert_items(A, C, l, lo, hi, rank * NWAVES + C.wave, nidle * NWAVES);
}
DI void stage_gate_weights(const Args& A, const Ctx& C, int lg) {
    LAS float* gwl = (LAS float*)C.lds;
    const float* w = A.in[1] + (size_t)lg * D * PIN + 2048;
    f32x4 gq[2][2];
#pragma unroll
    for (int k = 0; k < 2; ++k) { const int col = C.tid + k * NTHREADS; gq[k][0] = *(const f32x4*)(w + (size_t)col * PIN); gq[k][1] = *(const f32x4*)(w + (size_t)col * PIN + 4); }
#pragma unroll
    for (int k = 0; k < 2; ++k) { const int col = C.tid + k * NTHREADS;
        *(LAS f32x2*)(gwl + (0 * D + col) * 2) = (f32x2){gq[k][0][0], gq[k][0][1]}; *(LAS f32x2*)(gwl + (1 * D + col) * 2) = (f32x2){gq[k][0][2], gq[k][0][3]};
        *(LAS f32x2*)(gwl + (2 * D + col) * 2) = (f32x2){gq[k][1][0], gq[k][1][1]}; *(LAS f32x2*)(gwl + (3 * D + col) * 2) = (f32x2){gq[k][1][2], gq[k][1][3]}; }
}
DI void row_emit(const Args& A, const Ctx& C, int t, const f32x4 (&v)[4], float* xout, bf16* XN, int lg) {
    if (xout) {
#pragma unroll
        for (int j = 0; j < 4; ++j) *(f32x4*)(xout + (size_t)t * D + 256 * j + 4 * C.lane) = v[j];
    }
    if (XN) {
#pragma unroll
        for (int j = 0; j < 4; ++j) { v2u w; w.x = pk2(v[j][0], v[j][1]); w.y = pk2(v[j][2], v[j][3]); *(v2u*)(XN + (size_t)t * D + 256 * j + 4 * C.lane) = w; }
    }
    if (lg >= 0) {
        const LAS float* gwl = (const LAS float*)C.lds;
        float* GATES = (float*)(A.ws + SM_GATES);
        float gs[8];
#pragma unroll
        for (int gp = 0; gp < 4; ++gp) { f32x2 s2 = {0.f, 0.f};
#pragma unroll
            for (int j = 0; j < 4; ++j) { const f32x4 wa = *(const LAS f32x4*)(gwl + (gp * D + 256 * j + 4 * C.lane) * 2), wb = *(const LAS f32x4*)(gwl + (gp * D + 256 * j + 4 * C.lane) * 2 + 4);
                s2 += (f32x2){v[j][0], v[j][0]} * (f32x2){wa[0], wa[1]}; s2 += (f32x2){v[j][1], v[j][1]} * (f32x2){wa[2], wa[3]}; s2 += (f32x2){v[j][2], v[j][2]} * (f32x2){wb[0], wb[1]}; s2 += (f32x2){v[j][3], v[j][3]} * (f32x2){wb[2], wb[3]}; }
            gs[2 * gp] = s2[0]; gs[2 * gp + 1] = s2[1]; }
        red_multi<8>(gs, C.lane);
        if ((C.lane & 7) == 0) { const int g = red_idx<8>(C.lane); GATES[(size_t)t * 8 + g] = gs[0] + A.in[2][(size_t)lg * PIN + 2048 + g]; }
    }
}
DI void phase_prologue_rows(const Args& A, const Ctx& C0) { const Ctx C = fresh_ctx(C0);
    stage_gate_weights(A, C, 0);
    __syncthreads();
    for (int t = C.bid * NWAVES + C.wave; t < T; t += GRID * NWAVES) {
        f32x4 v[4];
#pragma unroll
        for (int j = 0; j < 4; ++j) v[j] = *(const f32x4*)(A.in[0] + (size_t)t * D + 256 * j + 4 * C.lane);
        row_emit(A, C, t, v, nullptr, (bf16*)(A.ws + WS_XN), 0);
    }
    __syncthreads();
}
DI void row_layernorm(f32x4 (&v)[4], const f32x4 (&ww)[4], const f32x4 (&bb)[4]) {
    float s = 0.f;
#pragma unroll
    for (int j = 0; j < 4; ++j) s += (v[j][0] + v[j][1]) + (v[j][2] + v[j][3]);
    const float mean = wave_sum(s) * (1.0f / D); float q = 0.f;
#pragma unroll
    for (int j = 0; j < 4; ++j) { v[j] = v[j] - mean; q += (v[j][0] * v[j][0] + v[j][1] * v[j][1]) + (v[j][2] * v[j][2] + v[j][3] * v[j][3]); }
    const float rstd = __builtin_amdgcn_rsqf(wave_sum(q) * (1.0f / D) + LN_EPS);
#pragma unroll
    for (int j = 0; j < 4; ++j) v[j] = v[j] * rstd * ww[j] + bb[j];
}
DI void load_ln(f32x4 (&ww)[4], f32x4 (&bb)[4], const float* w, const float* b, int lane) {
#pragma unroll
    for (int j = 0; j < 4; ++j) { ww[j] = *(const f32x4*)(w + 256 * j + 4 * lane); bb[j] = *(const f32x4*)(b + 256 * j + 4 * lane); }
}
DI void phase_ln1_router(const Args& A, const Ctx& C0, int l, bool dry = false) { const Ctx C = fresh_ctx(C0);
    LAS float* rwl = (LAS float*)C.lds;
    LAS int* hist = (LAS int*)(C.lds + VEC_OFF); LAS int* lbase = hist + 16, *le = hist + 32, *lrank = hist + 160;
    { f32x4 rq[8];
#pragma unroll
      for (int k = 0; k < 8; ++k) rq[k] = *(const f32x4*)(A.in[15] + (size_t)(C.tid + k * NTHREADS) * 4);
#pragma unroll
      for (int k = 0; k < 8; ++k) { const int i4 = C.tid + k * NTHREADS, col = i4 >> 2, e4 = (i4 & 3) * 4;
          *(LAS f32x2*)(rwl + ((e4 >> 1) * D + col) * 2) = (f32x2){rq[k][0], rq[k][1]}; *(LAS f32x2*)(rwl + (((e4 >> 1) + 1) * D + col) * 2) = (f32x2){rq[k][2], rq[k][3]}; } }
    if (C.tid < 16) hist[C.tid] = 0;
    __syncthreads();
    const bf16* X = (const bf16*)(A.ws + WS_XN);
    const bf16* Y = (const bf16*)(A.ws + WS_PROJ);
    bf16* XNB = (bf16*)(A.ws + WS_XNB);
    v4u* SEL = (v4u*)(A.ws + SM_SEL);
    float rb[16];
#pragma unroll
    for (int e = 0; e < 16; ++e) rb[e] = A.in[16][e];
    f32x4 lnw[4], lnb[4]; load_ln(lnw, lnb, A.in[13] + (size_t)l * D, A.in[14] + (size_t)l * D, C.lane);
    v2u xr[2][4], yr[2][4];
#pragma unroll
    for (int j = 0; j < 4; ++j) { const size_t o = (size_t)(C.bid * 64 + C.wave * 8) * D + 256 * j + 4 * C.lane; xr[0][j] = *(const v2u*)(X + o); yr[0][j] = *(const v2u*)(Y + o); }
#pragma unroll
    for (int i = 0; i < 8; ++i) {
        const int t = C.bid * 64 + C.wave * 8 + i;
        if (i < 7) {
#pragma unroll
            for (int j = 0; j < 4; ++j) { const size_t o = (size_t)(t + 1) * D + 256 * j + 4 * C.lane; xr[(i + 1) & 1][j] = *(const v2u*)(X + o); yr[(i + 1) & 1][j] = *(const v2u*)(Y + o); } }
        f32x4 v[4];
#pragma unroll
        for (int j = 0; j < 4; ++j) { const v2u x = xr[i & 1][j]; const v2u y = yr[i & 1][j];
            v[j][0] = ALPHA * bflo(x.x) + bflo(y.x); v[j][1] = ALPHA * bfhi(x.x) + bfhi(y.x); v[j][2] = ALPHA * bflo(x.y) + bflo(y.y); v[j][3] = ALPHA * bfhi(x.y) + bfhi(y.y); }
        row_layernorm(v, lnw, lnb);
        row_emit(A, C, t, v, nullptr, XNB, -1);
        float lg16[16];
#pragma unroll
        for (int ep = 0; ep < 8; ++ep) { f32x2 s2 = {0.f, 0.f};
#pragma unroll
            for (int j = 0; j < 4; ++j) { const f32x4 wa = *(const LAS f32x4*)(rwl + (ep * D + 256 * j + 4 * C.lane) * 2), wb = *(const LAS f32x4*)(rwl + (ep * D + 256 * j + 4 * C.lane) * 2 + 4);
                s2 += (f32x2){v[j][0], v[j][0]} * (f32x2){wa[0], wa[1]}; s2 += (f32x2){v[j][1], v[j][1]} * (f32x2){wa[2], wa[3]}; s2 += (f32x2){v[j][2], v[j][2]} * (f32x2){wb[0], wb[1]}; s2 += (f32x2){v[j][3], v[j][3]} * (f32x2){wb[2], wb[3]}; }
            lg16[2 * ep] = s2[0]; lg16[2 * ep + 1] = s2[1]; }
        red_multi<16>(lg16, C.lane);
        float best = -INFINITY, bs0 = 0.f, bs1 = 0.f; int be0 = 0, be1 = 1;
#pragma unroll
        for (int g = 0; g < 4; ++g) {
            float sel[4], sg[4];
#pragma unroll
            for (int k = 0; k < 4; ++k) { const int e = 4 * g + k;
                const int src = 32 * ((e >> 3) & 1) + 16 * ((e >> 2) & 1) + 8 * ((e >> 1) & 1) + 4 * (e & 1);
                const float s = __builtin_bit_cast(float, __builtin_amdgcn_readlane(__builtin_bit_cast(int, lg16[0]), src));
                sg[k] = sigmoidf_(s); sel[k] = sg[k] + rb[e]; }
            float m1 = sel[0], s1 = sg[0]; int i1 = 0;
#pragma unroll
            for (int k = 1; k < 4; ++k) if (sel[k] > m1) { m1 = sel[k]; s1 = sg[k]; i1 = k; }
            float m2 = -INFINITY, s2 = 0.f; int i2 = 0;
#pragma unroll
            for (int k = 0; k < 4; ++k) if (k != i1 && sel[k] > m2) { m2 = sel[k]; s2 = sg[k]; i2 = k; }
            const float gsc = m1 + m2;
            if (gsc > best) { best = gsc; be0 = 4 * g + i1; be1 = 4 * g + i2; bs0 = s1; bs1 = s2; }
        }
        if (C.lane == 0) {
            const float inv = __builtin_amdgcn_rcpf(bs0 + bs1);
            v4u o; o.x = (unsigned)be0; o.y = (unsigned)be1; o.z = __builtin_bit_cast(unsigned, bs0 * inv); o.w = __builtin_bit_cast(unsigned, bs1 * inv);
            SEL[t] = o;
            ((f32x2*)(A.ws + SM_GW))[t] = (f32x2){bs0 * inv, bs1 * inv};
            const int q = (C.wave * 8 + i) * 2;
            le[q] = be0; lrank[q] = __hip_atomic_fetch_add(hist + be0, 1, __ATOMIC_RELAXED, __HIP_MEMORY_SCOPE_WORKGROUP);
            le[q + 1] = be1; lrank[q + 1] = __hip_atomic_fetch_add(hist + be1, 1, __ATOMIC_RELAXED, __HIP_MEMORY_SCOPE_WORKGROUP);
        }
    }
    __syncthreads();
    if (dry) return;
    if (C.tid < 16) lbase[C.tid] = (int)__hip_atomic_fetch_add((unsigned*)(A.ws + WS_CTL) + CW_CNT + (l * 16 + C.tid) * 16, (unsigned)hist[C.tid], __ATOMIC_RELAXED, __HIP_MEMORY_SCOPE_AGENT);
    __syncthreads();
    if (C.tid < 128) { const int e = le[C.tid], pos = lbase[e] + lrank[C.tid], t = C.bid * 64 + (C.tid >> 1);
        ((int*)(A.ws + WS_LIST))[(size_t)e * 16384 + pos] = t; ((int*)(A.ws + SM_TOKSLOT))[2 * t + (C.tid & 1)] = pos; }
    __syncthreads();
}
DI void phase_combine(const Args& A, const Ctx& C0, int l) { const Ctx C = fresh_ctx(C0);
    const bool last = (l == NLAYER - 1);
    if (!last) { stage_gate_weights(A, C, l + 1); convert_small(A, C, l + 1); }
    LAS int* tpl = (LAS int*)(C.lds + VEC_OFF);
    if (C.tid == 0) { int run = 0; for (int e = 0; e < 16; ++e) { tpl[e] = run; const int n = (int)__hip_atomic_load((const unsigned*)(A.ws + WS_CTL) + CW_CNT + (l * 16 + e) * 16, __ATOMIC_RELAXED, __HIP_MEMORY_SCOPE_AGENT); run += ((n + 255) >> 8) * 256; } }
    __syncthreads();
    const bf16* X1 = (const bf16*)(A.ws + WS_XNB); const bf16* YP = (const bf16*)(A.ws + WS_PROJ);
    const v4u* SEL = (const v4u*)(A.ws + SM_SEL); const int* TOKSLOT = (const int*)(A.ws + SM_TOKSLOT);
    f32x4 lnw[4], lnb[4]; load_ln(lnw, lnb, A.in[20] + (size_t)l * D, A.in[21] + (size_t)l * D, C.lane);
    const int tb = C.bid * 64 + C.wave * 8;
    int pp0[8], pp1[8]; float gg0[8], gg1[8];
#pragma unroll
    for (int i = 0; i < 8; ++i) { const int t = tb + i; const v4u s = SEL[t]; const f32x2 gw2 = ((const f32x2*)(A.ws + SM_GW))[t]; pp0[i] = tpl[s.x & 15u] + TOKSLOT[2 * t]; pp1[i] = tpl[s.y & 15u] + TOKSLOT[2 * t + 1]; gg0[i] = gw2[0]; gg1[i] = gw2[1]; }
    v2u xr[2][4], ar[2][4], br[2][4];
#pragma unroll
    for (int j = 0; j < 4; ++j) { xr[0][j] = *(const v2u*)(X1 + (size_t)tb * D + 256 * j + 4 * C.lane); ar[0][j] = *(const v2u*)(YP + (size_t)pp0[0] * D + 256 * j + 4 * C.lane); br[0][j] = *(const v2u*)(YP + (size_t)pp1[0] * D + 256 * j + 4 * C.lane); }
#pragma unroll
    for (int i = 0; i < 8; ++i) { const int t = tb + i;
        if (i < 7) {
#pragma unroll
            for (int j = 0; j < 4; ++j) { xr[(i + 1) & 1][j] = *(const v2u*)(X1 + (size_t)(t + 1) * D + 256 * j + 4 * C.lane); ar[(i + 1) & 1][j] = *(const v2u*)(YP + (size_t)pp0[(i + 1) & 7] * D + 256 * j + 4 * C.lane); br[(i + 1) & 1][j] = *(const v2u*)(YP + (size_t)pp1[(i + 1) & 7] * D + 256 * j + 4 * C.lane); } }
        const float g0 = gg0[i], g1 = gg1[i];
        f32x4 v[4];
#pragma unroll
        for (int j = 0; j < 4; ++j) { const v2u x = xr[i & 1][j], a = ar[i & 1][j], b = br[i & 1][j];
            v[j][0] = ALPHA * bflo(x.x) + g0 * bflo(a.x) + g1 * bflo(b.x); v[j][1] = ALPHA * bfhi(x.x) + g0 * bfhi(a.x) + g1 * bfhi(b.x);
            v[j][2] = ALPHA * bflo(x.y) + g0 * bflo(a.y) + g1 * bflo(b.y); v[j][3] = ALPHA * bfhi(x.y) + g0 * bfhi(a.y) + g1 * bfhi(b.y); }
        row_layernorm(v, lnw, lnb);
        row_emit(A, C, t, v, last ? A.out : nullptr, last ? nullptr : (bf16*)(A.ws + WS_XN), last ? -1 : l + 1);
    }
    __syncthreads();
}
DI void unpack8(const v4u w, float (&f)[8]) { f[0] = bflo(w.x); f[1] = bfhi(w.x); f[2] = bflo(w.y); f[3] = bfhi(w.y); f[4] = bflo(w.z); f[5] = bfhi(w.z); f[6] = bflo(w.w); f[7] = bfhi(w.w); }
DI void conv_unit(const Args& A, const Ctx& C0, int l, int unit) { const Ctx C = fresh_ctx(C0);
    const bf16* PROJ = (const bf16*)(A.ws + WS_PROJ); bf16* HCAT = (bf16*)(A.ws + WS_HCAT);
    LAS float* cin = (LAS float*)C.lds;
    LAS float* cou = (LAS float*)(C.lds + 65536);
    const int t0 = unit * 32, tseq = t0 & (SEQ - 1);
    float w[31];
#pragma unroll
    for (int j = 0; j < 31; ++j) w[j] = A.in[8][(size_t)(l * 31 + j) * 256 + (C.tid & 255)];
    const float bias = A.in[9][l * 256 + (C.tid & 255)];
    const f32x4 nw = *(const f32x4*)(A.in[10] + l * 256 + 4 * C.lane), nb = *(const f32x4*)(A.in[11] + l * 256 + 4 * C.lane);
    v4u cqa[4], cqb[4];
#pragma unroll
    for (int kq = 0; kq < 4; ++kq) { const int it = C.tid + kq * NTHREADS, r = it >> 5, c8 = (it & 31) * 8; const bool ok = (it < 62 * 32) && (tseq - 30 + r >= 0); const size_t rowo = ok ? (size_t)(t0 - 30 + r) * NPROJ : 0;
        cqa[kq] = ok ? *(const v4u*)(PROJ + rowo + PCA + c8) : (v4u){0u, 0u, 0u, 0u}; cqb[kq] = ok ? *(const v4u*)(PROJ + rowo + PCB + c8) : (v4u){0u, 0u, 0u, 0u}; }
#pragma unroll
    for (int kq = 0; kq < 4; ++kq) { const int it = C.tid + kq * NTHREADS; if (it >= 62 * 32) continue; const int r = it >> 5, c8 = (it & 31) * 8; float o[8];
        if (tseq - 30 + r >= 0) { float a[8], b[8]; unpack8(cqa[kq], a); unpack8(cqb[kq], b);
#pragma unroll
            for (int i = 0; i < 8; ++i) o[i] = a[i] * sigmoidf_(b[i]); }
        else {
#pragma unroll
            for (int i = 0; i < 8; ++i) o[i] = 0.f; }
        *(LAS f32x4*)(cin + r * 256 + c8) = (f32x4){o[0], o[1], o[2], o[3]}; *(LAS f32x4*)(cin + r * 256 + c8 + 4) = (f32x4){o[4], o[5], o[6], o[7]}; }
    __syncthreads();
    { const int c = C.tid & 255, half = C.tid >> 8;

        float xin[46];
#pragma unroll
        for (int r = 0; r < 46; ++r) xin[r] = cin[(half * 16 + r) * 256 + c];
#pragma unroll
        for (int i = 0; i < 16; ++i) { float acc = bias;
#pragma unroll
            for (int j = 0; j < 31; ++j) acc += xin[i + j] * w[j];
            cou[(half * 16 + i) * 256 + c] = acc; } }
    __syncthreads();
    {
#pragma unroll
        for (int q = 0; q < 4; ++q) { const int r = 4 * C.wave + q; f32x4 x = *(const LAS f32x4*)(cou + r * 256 + 4 * C.lane);
            const float mean = wave_sum((x[0] + x[1]) + (x[2] + x[3])) * (1.0f / 256.0f); x = x - mean;
            const float var = wave_sum((x[0] * x[0] + x[1] * x[1]) + (x[2] * x[2] + x[3] * x[3])) * (1.0f / 256.0f);
            const float rstd = __builtin_amdgcn_rsqf(var + LN_EPS); x = x * rstd * nw + nb;
            float o[4];
#pragma unroll
            for (int k = 0; k < 4; ++k) o[k] = x[k] * sigmoidf_(x[k]);
            v2u pk; pk.x = pk2(o[0], o[1]); pk.y = pk2(o[2], o[3]);
            *(v2u*)(HCAT + (size_t)(t0 + r) * D + 768 + 4 * C.lane) = pk; } }
    __syncthreads();
}
DI void gmlp_unit_simple(const Args& A, const Ctx& C0, int l, int ck) { const Ctx C = fresh_ctx(C0);
    const bf16* PROJ = (const bf16*)(A.ws + WS_PROJ); bf16* HCAT = (bf16*)(A.ws + WS_HCAT);
    LAS float* zs = (LAS float*)C.lds;
    const int t0 = ck * CH;
    { const f32x4 nw = *(const f32x4*)(A.in[4] + l * 256 + 4 * C.lane), nb = *(const f32x4*)(A.in[5] + l * 256 + 4 * C.lane);
        for (int i = 0; i < 16; ++i) { const int r = C.wave * 16 + i; const v2u g = *(const v2u*)(PROJ + (size_t)(t0 + r) * NPROJ + PGV + 4 * C.lane);
            f32x4 x = {gelu_tanh(bflo(g.x)), gelu_tanh(bfhi(g.x)), gelu_tanh(bflo(g.y)), gelu_tanh(bfhi(g.y))};
            const float mean = wave_sum((x[0] + x[1]) + (x[2] + x[3])) * (1.0f / 256.0f); x = x - mean;
            const float var = wave_sum((x[0] * x[0] + x[1] * x[1]) + (x[2] * x[2] + x[3] * x[3])) * (1.0f / 256.0f);
            const float rstd = __builtin_amdgcn_rsqf(var + LN_EPS); x = x * rstd * nw + nb;
            *(LAS f32x4*)(zs + r * 256 + 4 * C.lane) = x; } }
    __syncthreads();
    { const int tb = C.tid >> 4, cb = C.tid & 15, c0 = 16 * cb, h = cb >> 2, tr0 = 4 * tb;
        const float* ws = A.in[6] + (size_t)(l * 4 + h) * CH * CH;
        float acc[4][16];
#pragma unroll
        for (int i = 0; i < 4; ++i)
#pragma unroll
            for (int j = 0; j < 16; ++j) acc[i][j] = 0.f;
        for (int s = 0; s <= tr0 + 3; ++s) {
            float zv[16];
#pragma unroll
            for (int q = 0; q < 4; ++q) { const f32x4 z4 = *(const LAS f32x4*)(zs + s * 256 + c0 + 4 * q); zv[4 * q] = z4[0]; zv[4 * q + 1] = z4[1]; zv[4 * q + 2] = z4[2]; zv[4 * q + 3] = z4[3]; }
#pragma unroll
            for (int i = 0; i < 4; ++i) { const float wg = (s <= tr0 + i) ? ws[(size_t)(tr0 + i) * CH + s] : 0.f;
#pragma unroll
                for (int j = 0; j < 16; ++j) acc[i][j] += wg * zv[j]; }
        }
#pragma unroll
        for (int i = 0; i < 4; ++i) { const int tr = tr0 + i; const float bsv = A.in[7][(size_t)(l * 4 + h) * CH + tr]; const size_t rowo = (size_t)(t0 + tr) * NPROJ + PGU + c0;
            float u[16]; { float tmp[8]; unpack8(*(const v4u*)(PROJ + rowo), tmp);
#pragma unroll
                for (int j = 0; j < 8; ++j) u[j] = tmp[j];
                unpack8(*(const v4u*)(PROJ + rowo + 8), tmp);
#pragma unroll
                for (int j = 0; j < 8; ++j) u[8 + j] = tmp[j]; }
            float o[16];
#pragma unroll
            for (int j = 0; j < 16; ++j) o[j] = gelu_tanh(u[j]) * (acc[i][j] + bsv);
            v4u w0, w1; w0.x = pk2(o[0], o[1]); w0.y = pk2(o[2], o[3]); w0.z = pk2(o[4], o[5]); w0.w = pk2(o[6], o[7]); w1.x = pk2(o[8], o[9]); w1.y = pk2(o[10], o[11]); w1.z = pk2(o[12], o[13]); w1.w = pk2(o[14], o[15]);
            *(v4u*)(HCAT + (size_t)(t0 + tr) * D + 512 + c0) = w0; *(v4u*)(HCAT + (size_t)(t0 + tr) * D + 512 + c0 + 8) = w1; }
    }
    __syncthreads();
}
DI void mlstm_local_simple(const Args& A, const Ctx& C0, int un) { const Ctx C = fresh_ctx(C0);
    const bf16* PROJ = (const bf16*)(A.ws + WS_PROJ); const float* GATES = (const float*)(A.ws + SM_GATES);
    const int bh = un >> 5, c = un & 31, b = bh >> 2, h = bh & 3, t0 = b * SEQ + c * CH;
    LAS float* kw = (LAS float*)C.lds;
    LAS float* vs = (LAS float*)(C.lds + 65536);
    LAS float* vec = (LAS float*)(C.lds + VEC_OFF);
    if (C.tid < CH) { const float fp = GATES[(size_t)(t0 + C.tid) * 8 + 4 + h], ip = GATES[(size_t)(t0 + C.tid) * 8 + h]; vec[C.tid] = logsigmoidf_(fp); vec[128 + C.tid] = ip; }
    __syncthreads();
    if (C.tid == 0) { float run = 0.f; for (int i = 0; i < CH; ++i) { run += vec[i]; vec[i] = run; } const float g = run; float ml = -INFINITY;
        for (int i = 0; i < CH; ++i) { const float a = g - vec[i] + vec[128 + i]; vec[256 + i] = a; ml = fmaxf(ml, a); }
        for (int i = 0; i < CH; ++i) vec[256 + i] = __expf(vec[256 + i] - ml);
        ((float*)(A.ws + SM_G))[un] = g; ((float*)(A.ws + SM_MLOC))[un] = ml; }
    __syncthreads();
    for (int it = C.tid; it < CH * 16; it += NTHREADS) { const int r = it >> 4, c8 = (it & 15) * 8; const size_t rowo = (size_t)(t0 + r) * NPROJ + h * 128 + c8; float k8[8], v8[8];
        unpack8(*(const v4u*)(PROJ + rowo + PK), k8); unpack8(*(const v4u*)(PROJ + rowo + PV), v8); const float sc = vec[256 + r] * 0.08838834764831845f;
#pragma unroll
        for (int i = 0; i < 8; ++i) { kw[r * 128 + c8 + i] = k8[i] * sc; vs[r * 128 + c8 + i] = v8[i]; } }
    __syncthreads();
    { const int db = C.tid >> 4, eb = C.tid & 15, d0 = 4 * db, e0 = 8 * eb; float acc[4][8];
#pragma unroll
        for (int i = 0; i < 4; ++i)
#pragma unroll
            for (int j = 0; j < 8; ++j) acc[i][j] = 0.f;
        for (int r = 0; r < CH; ++r) { const f32x4 kd = *(const LAS f32x4*)(kw + r * 128 + d0); const f32x4 va = *(const LAS f32x4*)(vs + r * 128 + e0), vb = *(const LAS f32x4*)(vs + r * 128 + e0 + 4);
#pragma unroll
            for (int i = 0; i < 4; ++i) { acc[i][0] += kd[i] * va[0]; acc[i][1] += kd[i] * va[1]; acc[i][2] += kd[i] * va[2]; acc[i][3] += kd[i] * va[3]; acc[i][4] += kd[i] * vb[0]; acc[i][5] += kd[i] * vb[1]; acc[i][6] += kd[i] * vb[2]; acc[i][7] += kd[i] * vb[3]; } }
        float* CL = (float*)(A.ws + WS_CLOCT) + (size_t)un * CH * CH;
#pragma unroll
        for (int j = 0; j < 8; ++j) *(f32x4*)(CL + (size_t)(e0 + j) * CH + d0) = (f32x4){acc[0][j], acc[1][j], acc[2][j], acc[3][j]}; }
    if (C.tid < CH) { float s = 0.f; for (int r = 0; r < CH; ++r) s += kw[r * 128 + C.tid]; ((float*)(A.ws + SM_NLOC))[(size_t)un * CH + C.tid] = s; }
    __syncthreads();
}
DI void phase_scan(const Args& A, const Ctx& C0) { const Ctx C = fresh_ctx(C0);
    const int gt = C.bid * NTHREADS + C.tid, bh = gt >> 13, pr = gt & 8191;
    const float* G = (const float*)(A.ws + SM_G); const float* ML = (const float*)(A.ws + SM_MLOC); float* MP = (float*)(A.ws + SM_MPREV);
    const float* CL = (const float*)(A.ws + WS_CLOCT); unsigned* CP = (unsigned*)(A.ws + WS_CPREVT);
    const float* NL = (const float*)(A.ws + SM_NLOC); float* NP = (float*)(A.ws + SM_NPREV);
    float c0 = 0.f, c1 = 0.f, n0 = 0.f, n1 = 0.f, m = 0.f;
    for (int cb = 0; cb < NCH; cb += 8) {
        f32x2 cl[8], nl[8]; float g[8], ml[8];
#pragma unroll
        for (int i = 0; i < 8; ++i) { const int un = bh * NCH + cb + i; cl[i] = *(const f32x2*)(CL + (size_t)un * CH * CH + 2 * pr); g[i] = G[un]; ml[i] = ML[un]; nl[i] = (pr < 64) ? *(const f32x2*)(NL + (size_t)un * CH + 2 * pr) : (f32x2){0.f, 0.f}; }
#pragma unroll
        for (int i = 0; i < 8; ++i) { const int un = bh * NCH + cb + i;
            CP[(size_t)un * (CH * CH / 2) + pr] = pk2(c0, c1);
            if (pr == 0) MP[un] = m;
            if (pr < 64) *(f32x2*)(NP + (size_t)un * CH + 2 * pr) = (f32x2){n0, n1};
            const float mn = fmaxf(g[i] + m, ml[i]), dec = __expf(g[i] + m - mn), sc = __expf(ml[i] - mn);
            c0 = dec * c0 + sc * cl[i][0]; c1 = dec * c1 + sc * cl[i][1]; n0 = dec * n0 + sc * nl[i][0]; n1 = dec * n1 + sc * nl[i][1]; m = mn; }
    }
}
DI void mlstm_out_simple(const Args& A, const Ctx& C0, int l, int un) { const Ctx C = fresh_ctx(C0);
    const bf16* PROJ = (const bf16*)(A.ws + WS_PROJ); const float* GATES = (const float*)(A.ws + SM_GATES); bf16* HCAT = (bf16*)(A.ws + WS_HCAT);
    const int bh = un >> 5, c = un & 31, b = bh >> 2, h = bh & 3, t0 = b * SEQ + c * CH;
    LAS bf16* qs = (LAS bf16*)C.lds;
    LAS bf16* ks = (LAS bf16*)(C.lds + 32768);
    LAS float* ps = (LAS float*)(C.lds + 65536);
    LAS float* vec = (LAS float*)(C.lds + VEC_OFF);
    LAS float* bvec = vec, *uvec = vec + 128, *Mvec = vec + 256, *wint = vec + 384, *flo = vec + 512, *den = vec + 640, *npv = vec + 768, *ipv = vec + 896, *lfv = vec + 1024, *qnv = vec + 1152;
    if (C.tid < CH) { const float fp = GATES[(size_t)(t0 + C.tid) * 8 + 4 + h], ip = GATES[(size_t)(t0 + C.tid) * 8 + h]; lfv[C.tid] = logsigmoidf_(fp); ipv[C.tid] = ip; npv[C.tid] = ((const float*)(A.ws + SM_NPREV))[(size_t)un * CH + C.tid]; }
    __syncthreads();
    if (C.tid == 0) { const float mprev = ((const float*)(A.ws + SM_MPREV))[un]; float run = 0.f, pm = -INFINITY;
        for (int i = 0; i < CH; ++i) { run += lfv[i]; bvec[i] = run; const float u = ipv[i] - run; uvec[i] = u; pm = fmaxf(pm, u); const float M = fmaxf(mprev, pm); Mvec[i] = M; wint[i] = __expf(mprev - M); flo[i] = __expf(-(run + M)); } }
    for (int it = C.tid; it < CH * 16; it += NTHREADS) { const int r = it >> 4, c8 = (it & 15) * 8; const size_t rowo = (size_t)(t0 + r) * NPROJ + h * 128 + c8;
        *(LAS v4u*)(qs + r * 128 + c8) = *(const v4u*)(PROJ + rowo + PQ); *(LAS v4u*)(ks + r * 128 + c8) = *(const v4u*)(PROJ + rowo + PK); }
    __syncthreads();
    const int lb = C.tid >> 4, xb = C.tid & 15, l0 = 4 * lb, x0 = 8 * xb;
    {
        float acc[4][8];
#pragma unroll
        for (int i = 0; i < 4; ++i)
#pragma unroll
            for (int j = 0; j < 8; ++j) acc[i][j] = 0.f;
        if (x0 <= l0 + 3) {
            for (int d8 = 0; d8 < 16; ++d8) { float qf[4][8], kf[8];
#pragma unroll
                for (int i = 0; i < 4; ++i) unpack8(*(const LAS v4u*)(qs + (l0 + i) * 128 + d8 * 8), qf[i]);
#pragma unroll
                for (int j = 0; j < 8; ++j) { unpack8(*(const LAS v4u*)(ks + (x0 + j) * 128 + d8 * 8), kf);
#pragma unroll
                    for (int i = 0; i < 4; ++i) { float s = 0.f;
#pragma unroll
                        for (int dd = 0; dd < 8; ++dd) s += qf[i][dd] * kf[dd];
                        acc[i][j] += s; } } } }
#pragma unroll
        for (int i = 0; i < 4; ++i)
#pragma unroll
            for (int j = 0; j < 8; ++j) { const int li = l0 + i, sj = x0 + j; ps[li * 128 + sj] = (sj <= li) ? acc[i][j] * 0.08838834764831845f * __expf(uvec[sj] - Mvec[li]) : 0.f; }
    }
    __syncthreads();
    if (C.tid < CH) { const int li = C.tid; float s = 0.f; for (int k = 0; k < CH; ++k) s += ps[li * 128 + ((k + li) & 127)]; den[li] = s; }
    else if (C.tid < 2 * CH) { const int li = C.tid - CH; float s = 0.f; for (int k = 0; k < CH; ++k) { const int d = (k + li) & 127; s += bf2f(qs[li * 128 + d]) * npv[d]; } qnv[li] = s; }
    for (int it = C.tid; it < CH * 16; it += NTHREADS) { const int r = it >> 4, c8 = (it & 15) * 8; }
    __syncthreads();
    for (int it = C.tid; it < CH * 16; it += NTHREADS) { const int r = it >> 4, c8 = (it & 15) * 8; const size_t rowo = (size_t)(t0 + r) * NPROJ + h * 128 + c8; *(LAS v4u*)(ks + r * 128 + c8) = *(const v4u*)(PROJ + rowo + PV); }
    __syncthreads();
    float hv[4][8];
    {   const int e0 = x0; float acc[4][8], acc2[4][8];
#pragma unroll
        for (int i = 0; i < 4; ++i)
#pragma unroll
            for (int j = 0; j < 8; ++j) { acc[i][j] = 0.f; acc2[i][j] = 0.f; }
        for (int s = 0; s <= l0 + 3; ++s) { float vv[8]; unpack8(*(const LAS v4u*)(ks + s * 128 + e0), vv);
#pragma unroll
            for (int i = 0; i < 4; ++i) { const float p = ps[(l0 + i) * 128 + s];
#pragma unroll
                for (int j = 0; j < 8; ++j) acc[i][j] += p * vv[j]; } }
        const bf16* CPT = (const bf16*)(A.ws + WS_CPREVT) + (size_t)un * CH * CH;
        for (int d8 = 0; d8 < 16; ++d8) { float qf[4][8], cf[8];
#pragma unroll
            for (int i = 0; i < 4; ++i) unpack8(*(const LAS v4u*)(qs + (l0 + i) * 128 + d8 * 8), qf[i]);
#pragma unroll
            for (int j = 0; j < 8; ++j) { unpack8(*(const v4u*)(CPT + (size_t)(e0 + j) * CH + d8 * 8), cf);
#pragma unroll
                for (int i = 0; i < 4; ++i) { float s = 0.f;
#pragma unroll
                    for (int dd = 0; dd < 8; ++dd) s += qf[i][dd] * cf[dd];
                    acc2[i][j] += s; } } }
#pragma unroll
        for (int i = 0; i < 4; ++i) { const int li = l0 + i; const float wi = wint[li]; const float dn = den[li] + wi * qnv[li]; const float inv = 1.0f / fmaxf(fabsf(dn), flo[li]);
#pragma unroll
            for (int j = 0; j < 8; ++j) hv[i][j] = (acc[i][j] + wi * acc2[i][j]) * inv; }
    }
    __syncthreads();
#pragma unroll
    for (int i = 0; i < 4; ++i)
#pragma unroll
        for (int j = 0; j < 8; ++j) ps[(l0 + i) * 128 + x0 + j] = hv[i][j];
    __syncthreads();
    { const f32x2 nw = *(const f32x2*)(A.in[3] + (size_t)l * 512 + h * 128 + 2 * C.lane);
        for (int i = 0; i < 16; ++i) { const int li = C.wave * 16 + i; f32x2 x = *(const LAS f32x2*)(ps + li * 128 + 2 * C.lane);
            const float mean = wave_sum(x[0] + x[1]) * (1.0f / 128.0f); x = x - mean; const float var = wave_sum(x[0] * x[0] + x[1] * x[1]) * (1.0f / 128.0f);
            const float rstd = 1.0f / sqrtf(var + 1e-6f); const unsigned ow = *(const unsigned*)(PROJ + (size_t)(t0 + li) * NPROJ + PO + h * 128 + 2 * C.lane);
            const float o0 = sigmoidf_(bflo(ow)) * (x[0] * rstd * nw[0]), o1 = sigmoidf_(bfhi(ow)) * (x[1] * rstd * nw[1]);
            *(unsigned*)(HCAT + (size_t)(t0 + li) * D + h * 128 + 2 * C.lane) = pk2(o0, o1); } }
    __syncthreads();
}
typedef short bf16x8 __attribute__((ext_vector_type(8)));
DI f32x4 mfma16(bf16x8 a, bf16x8 b, f32x4 c) { return __builtin_amdgcn_mfma_f32_16x16x32_bf16(a, b, c, 0, 0, 0); }
constexpr int LDT = 136;
constexpr int TILE_B = 128 * LDT * 2;
DI float wave_scan_add(float v, int lane) {
#pragma unroll
    for (int o = 1; o < 64; o <<= 1) { const float t = __shfl_up(v, o); if (lane >= o) v += t; }
    return v;
}
DI float wave_scan_max(float v, int lane) {
#pragma unroll
    for (int o = 1; o < 64; o <<= 1) { const float t = __shfl_up(v, o); if (lane >= o) v = fmaxf(v, t); }
    return v;
}
DI float wave_max(float v) {
#pragma unroll
    for (int o = 1; o < 64; o <<= 1) v = fmaxf(v, __shfl_xor(v, o));
    return v;
}
DI float red16(float v) { return row_sum16(v); }

DI void mlstm_local_mfma(const Args& A, const Ctx& C0, int un) { const Ctx C = fresh_ctx(C0);
    const bf16* PROJ = (const bf16*)(A.ws + WS_PROJ); const float* GATES = (const float*)(A.ws + SM_GATES);
    const int bh = un >> 5, c = un & 31, b = bh >> 2, h = bh & 3, t0 = b * SEQ + c * CH;
    LAS bf16* VT = (LAS bf16*)C.lds;
    LAS bf16* KWT = (LAS bf16*)(C.lds + TILE_B);
    LAS float* wv = (LAS float*)(C.lds + VEC_OFF);
    v4u kq4[4], vq4[4];
#pragma unroll
    for (int kq = 0; kq < 4; ++kq) { const int it = C.tid + kq * NTHREADS; const int r = it & 127, c8 = (it >> 7) * 8; const size_t rowo = (size_t)(t0 + r) * NPROJ + h * 128 + c8; kq4[kq] = *(const v4u*)(PROJ + rowo + PK); vq4[kq] = *(const v4u*)(PROJ + rowo + PV); }
    if (C.wave == 0) {
        const int l0 = 2 * C.lane; const f32x4 ga = *(const f32x4*)(GATES + (size_t)(t0 + l0) * 8), gb = *(const f32x4*)(GATES + (size_t)(t0 + l0) * 8 + 4), gc = *(const f32x4*)(GATES + (size_t)(t0 + l0 + 1) * 8), gd = *(const f32x4*)(GATES + (size_t)(t0 + l0 + 1) * 8 + 4);
        const float ip0 = h == 0 ? ga[0] : (h == 1 ? ga[1] : (h == 2 ? ga[2] : ga[3])), fp0 = h == 0 ? gb[0] : (h == 1 ? gb[1] : (h == 2 ? gb[2] : gb[3]));
        const float ip1 = h == 0 ? gc[0] : (h == 1 ? gc[1] : (h == 2 ? gc[2] : gc[3])), fp1 = h == 0 ? gd[0] : (h == 1 ? gd[1] : (h == 2 ? gd[2] : gd[3]));
        const float lf0 = logsigmoidf_(fp0), lf1 = logsigmoidf_(fp1);
        const float incl = wave_scan_add(lf0 + lf1, C.lane), b1 = incl, b0 = incl - lf1;
        const float g = __shfl(incl, 63);
        const float a0 = g - b0 + ip0, a1 = g - b1 + ip1, ml = wave_max(fmaxf(a0, a1));
        wv[l0] = __expf(a0 - ml); wv[l0 + 1] = __expf(a1 - ml);
        if (C.lane == 0) { ((float*)(A.ws + SM_G))[un] = g; ((float*)(A.ws + SM_MLOC))[un] = ml; }
    }
    __syncthreads();
#pragma unroll
    for (int kq = 0; kq < 4; ++kq) { const int it = C.tid + kq * NTHREADS; const int r = it & 127, c8 = (it >> 7) * 8; float k8[8];
        unpack8(kq4[kq], k8); const v4u vv = vq4[kq]; const float sc = wv[r] * 0.08838834764831845f;
        const unsigned vw[4] = {vv.x, vv.y, vv.z, vv.w};
#pragma unroll
        for (int i = 0; i < 8; ++i) { KWT[(c8 + i) * LDT + r] = (bf16)f2bf(k8[i] * sc); VT[(c8 + i) * LDT + r] = (bf16)((i & 1) ? (vw[i >> 1] >> 16) : (vw[i >> 1] & 0xffffu)); } }
    __syncthreads();
    { const int fr = C.lane & 15, fg = C.lane >> 4, w = C.wave;
        bf16x8 a[4];
#pragma unroll
        for (int ks = 0; ks < 4; ++ks) a[ks] = *(const LAS bf16x8*)(VT + (16 * w + fr) * LDT + 32 * ks + 8 * fg);
        float* CL = (float*)(A.ws + WS_CLOCT) + (size_t)un * CH * CH;
#pragma unroll
        for (int dt = 0; dt < 8; ++dt) { f32x4 acc = {0.f, 0.f, 0.f, 0.f};
#pragma unroll
            for (int ks = 0; ks < 4; ++ks) { const bf16x8 bb = *(const LAS bf16x8*)(KWT + (16 * dt + fr) * LDT + 32 * ks + 8 * fg); acc = mfma16(a[ks], bb, acc); }
#pragma unroll
            for (int rg = 0; rg < 4; ++rg) CL[(size_t)(16 * w + 4 * fg + rg) * CH + 16 * dt + fr] = acc[rg]; } }
    if (C.tid < CH) { float s = 0.f;
#pragma unroll
        for (int q = 0; q < 16; ++q) { float f[8]; unpack8(*(const LAS v4u*)(KWT + C.tid * LDT + 8 * q), f); s += ((f[0] + f[1]) + (f[2] + f[3])) + ((f[4] + f[5]) + (f[6] + f[7])); }
        ((float*)(A.ws + SM_NLOC))[(size_t)un * CH + C.tid] = s; }
    __syncthreads();
}
DI void mlstm_out_mfma(const Args& A, const Ctx& C0, int l, int un) { const Ctx C = fresh_ctx(C0);
    const bf16* PROJ = (const bf16*)(A.ws + WS_PROJ); const float* GATES = (const float*)(A.ws + SM_GATES); bf16* HCAT = (bf16*)(A.ws + WS_HCAT);
    const int bh = un >> 5, c = un & 31, b = bh >> 2, h = bh & 3, t0 = b * SEQ + c * CH;
    LAS bf16* QS = (LAS bf16*)C.lds;
    LAS bf16* KS = (LAS bf16*)(C.lds + TILE_B);
    LAS bf16* PS = (LAS bf16*)(C.lds + 2 * TILE_B);
    LAS bf16* CT = (LAS bf16*)(C.lds + 3 * TILE_B);
    LAS float* vec = (LAS float*)(C.lds + VEC_OFF);
    LAS float* uvec = vec, *Mvec = vec + 128, *wint = vec + 256, *flo = vec + 384; LAS bf16* npb = (LAS bf16*)(vec + 512);
    if (C.wave == 0) {
        const int l0 = 2 * C.lane; const f32x4 ga = *(const f32x4*)(GATES + (size_t)(t0 + l0) * 8), gb = *(const f32x4*)(GATES + (size_t)(t0 + l0) * 8 + 4), gc = *(const f32x4*)(GATES + (size_t)(t0 + l0 + 1) * 8), gd = *(const f32x4*)(GATES + (size_t)(t0 + l0 + 1) * 8 + 4);
        const float ip0 = h == 0 ? ga[0] : (h == 1 ? ga[1] : (h == 2 ? ga[2] : ga[3])), fp0 = h == 0 ? gb[0] : (h == 1 ? gb[1] : (h == 2 ? gb[2] : gb[3]));
        const float ip1 = h == 0 ? gc[0] : (h == 1 ? gc[1] : (h == 2 ? gc[2] : gc[3])), fp1 = h == 0 ? gd[0] : (h == 1 ? gd[1] : (h == 2 ? gd[2] : gd[3]));
        const float lf0 = logsigmoidf_(fp0), lf1 = logsigmoidf_(fp1);
        const float incl = wave_scan_add(lf0 + lf1, C.lane), b1 = incl, b0 = incl - lf1;
        const float u0 = ip0 - b0, u1 = ip1 - b1;
        const float pm_incl = wave_scan_max(fmaxf(u0, u1), C.lane); const float pm_prev = __shfl_up(pm_incl, 1);
        const float pm0 = C.lane == 0 ? u0 : fmaxf(pm_prev, u0), pm1 = pm_incl;
        const float mprev = ((const float*)(A.ws + SM_MPREV))[un];
        const float M0 = fmaxf(mprev, pm0), M1 = fmaxf(mprev, pm1);
        uvec[l0] = u0; uvec[l0 + 1] = u1; Mvec[l0] = M0; Mvec[l0 + 1] = M1; wint[l0] = __expf(mprev - M0); wint[l0 + 1] = __expf(mprev - M1); flo[l0] = __expf(-(b0 + M0)); flo[l0 + 1] = __expf(-(b1 + M1));
        const f32x2 np2 = *(const f32x2*)((const float*)(A.ws + SM_NPREV) + (size_t)un * CH + l0); *(LAS unsigned*)(npb + l0) = pk2(np2[0], np2[1]);
    }
    { const bf16* CPT = (const bf16*)(A.ws + WS_CPREVT) + (size_t)un * CH * CH;
        v4u sq[4], sk[4], sc[4];
#pragma unroll
        for (int kq = 0; kq < 4; ++kq) { const int it = C.tid + kq * NTHREADS, r = it >> 4, c8 = (it & 15) * 8; const size_t rowo = (size_t)(t0 + r) * NPROJ + h * 128 + c8;
            sq[kq] = *(const v4u*)(PROJ + rowo + PQ); sk[kq] = *(const v4u*)(PROJ + rowo + PK); sc[kq] = *(const v4u*)(CPT + (size_t)r * CH + c8); }
#pragma unroll
        for (int kq = 0; kq < 4; ++kq) { const int it = C.tid + kq * NTHREADS, r = it >> 4, c8 = (it & 15) * 8;
            *(LAS v4u*)(QS + r * LDT + c8) = sq[kq]; *(LAS v4u*)(KS + r * LDT + c8) = sk[kq]; *(LAS v4u*)(CT + r * LDT + c8) = sc[kq]; } }
    v4u vpre[4];
#pragma unroll
    for (int kq = 0; kq < 4; ++kq) { const int it = C.tid + kq * NTHREADS; const int r = it & 127, c8 = (it >> 7) * 8; vpre[kq] = *(const v4u*)(PROJ + (size_t)(t0 + r) * NPROJ + h * 128 + c8 + PV); }
    v4u opre[4];
#pragma unroll
    for (int q = 0; q < 4; ++q) opre[q] = *(const v4u*)(PROJ + (size_t)(t0 + (C.tid >> 2)) * NPROJ + PO + h * 128 + (C.tid & 3) * 32 + 8 * q);
    __syncthreads();
    const int fr = C.lane & 15, fg = C.lane >> 4, w = C.wave;
    bf16x8 aq[4];
#pragma unroll
    for (int ks = 0; ks < 4; ++ks) aq[ks] = *(const LAS bf16x8*)(QS + (16 * w + fr) * LDT + 32 * ks + 8 * fg);
    float Ml[4], wl[4], inv[4];
#pragma unroll
    for (int rg = 0; rg < 4; ++rg) { Ml[rg] = Mvec[16 * w + 4 * fg + rg]; wl[rg] = wint[16 * w + 4 * fg + rg]; }
    {   float rs[4] = {0.f, 0.f, 0.f, 0.f};
#pragma unroll
        for (int st = 0; st < 8; ++st) {
            if (st <= w) { f32x4 acc = {0.f, 0.f, 0.f, 0.f};
#pragma unroll
                for (int ks = 0; ks < 4; ++ks) { const bf16x8 bb = *(const LAS bf16x8*)(KS + (16 * st + fr) * LDT + 32 * ks + 8 * fg); acc = mfma16(aq[ks], bb, acc); }
                const int s = 16 * st + fr; const float us = uvec[s];
#pragma unroll
                for (int rg = 0; rg < 4; ++rg) { const int li = 16 * w + 4 * fg + rg; const float p = (s <= li) ? acc[rg] * 0.08838834764831845f * __expf(us - Ml[rg]) : 0.f; rs[rg] += p; PS[li * LDT + s] = (bf16)f2bf(p); } }
            else if (st == w + 1 && (w & 1) == 0) {
#pragma unroll
                for (int rg = 0; rg < 4; ++rg) PS[(16 * w + 4 * fg + rg) * LDT + 16 * st + fr] = (bf16)0; }
        }
        f32x4 an = {0.f, 0.f, 0.f, 0.f};
#pragma unroll
        for (int ks = 0; ks < 4; ++ks) { bf16x8 bn = *(const LAS bf16x8*)(npb + 32 * ks + 8 * fg); if (fr != 0) bn = (bf16x8){0, 0, 0, 0, 0, 0, 0, 0}; an = mfma16(aq[ks], bn, an); }
#pragma unroll
        for (int rg = 0; rg < 4; ++rg) { const float qn = __shfl(an[rg], 16 * fg); const float dn = red16(rs[rg]) + wl[rg] * qn; inv[rg] = __builtin_amdgcn_rcpf(fmaxf(fabsf(dn), flo[16 * w + 4 * fg + rg])); }
    }
    __syncthreads();
#pragma unroll
    for (int kq = 0; kq < 4; ++kq) { const int it = C.tid + kq * NTHREADS; const int r = it & 127, c8 = (it >> 7) * 8; const unsigned vw[4] = {vpre[kq].x, vpre[kq].y, vpre[kq].z, vpre[kq].w};
#pragma unroll
        for (int i = 0; i < 8; ++i) KS[(c8 + i) * LDT + r] = (bf16)((i & 1) ? (vw[i >> 1] >> 16) : (vw[i >> 1] & 0xffffu)); }
    __syncthreads();
    {   const int nk2 = (w >> 1) + 1;
        bf16x8 ap[4];
#pragma unroll
        for (int k2 = 0; k2 < 4; ++k2) ap[k2] = (k2 < nk2) ? *(const LAS bf16x8*)(PS + (16 * w + fr) * LDT + 32 * k2 + 8 * fg) : (bf16x8){0, 0, 0, 0, 0, 0, 0, 0};
        float hv[8][4]; float sm[4] = {0.f, 0.f, 0.f, 0.f};
#pragma unroll
        for (int et = 0; et < 8; ++et) { f32x4 a1 = {0.f, 0.f, 0.f, 0.f}, a2 = {0.f, 0.f, 0.f, 0.f};
#pragma unroll
            for (int k2 = 0; k2 < 4; ++k2) if (k2 < nk2) { const bf16x8 bb = *(const LAS bf16x8*)(KS + (16 * et + fr) * LDT + 32 * k2 + 8 * fg); a1 = mfma16(ap[k2], bb, a1); }
#pragma unroll
            for (int ks = 0; ks < 4; ++ks) { const bf16x8 bb = *(const LAS bf16x8*)(CT + (16 * et + fr) * LDT + 32 * ks + 8 * fg); a2 = mfma16(aq[ks], bb, a2); }
#pragma unroll
            for (int rg = 0; rg < 4; ++rg) { hv[et][rg] = (a1[rg] + wl[rg] * a2[rg]) * inv[rg]; sm[rg] += hv[et][rg]; } }
        float mean[4], rstd[4];
#pragma unroll
        for (int rg = 0; rg < 4; ++rg) { mean[rg] = red16(sm[rg]) * (1.0f / 128.0f); float q = 0.f;
#pragma unroll
            for (int et = 0; et < 8; ++et) { const float dlt = hv[et][rg] - mean[rg]; q += dlt * dlt; }
            rstd[rg] = __builtin_amdgcn_rsqf(red16(q) * (1.0f / 128.0f) + 1e-6f); }
#pragma unroll
        for (int et = 0; et < 8; ++et) { const int e = 16 * et + fr; const float nw = A.in[3][(size_t)l * 512 + h * 128 + e];
#pragma unroll
            for (int rg = 0; rg < 4; ++rg) { const int li = 16 * w + 4 * fg + rg; PS[li * LDT + e] = (bf16)f2bf((hv[et][rg] - mean[rg]) * rstd[rg] * nw); } }
    }
    __syncthreads();
    { const int r = C.tid >> 2, cg = (C.tid & 3) * 32;
#pragma unroll
        for (int q = 0; q < 4; ++q) { float hn[8], ov[8]; unpack8(*(const LAS v4u*)(PS + r * LDT + cg + 8 * q), hn); unpack8(opre[q], ov);
            v4u o4; o4.x = pk2(sigmoidf_(ov[0]) * hn[0], sigmoidf_(ov[1]) * hn[1]); o4.y = pk2(sigmoidf_(ov[2]) * hn[2], sigmoidf_(ov[3]) * hn[3]); o4.z = pk2(sigmoidf_(ov[4]) * hn[4], sigmoidf_(ov[5]) * hn[5]); o4.w = pk2(sigmoidf_(ov[6]) * hn[6], sigmoidf_(ov[7]) * hn[7]);
            *(v4u*)(HCAT + (size_t)(t0 + r) * D + h * 128 + cg + 8 * q) = o4; } }
    __syncthreads();
}
DI void gmlp_chunk_mfma(const Args& A, const Ctx& C0, int l, int ck) { const Ctx C = fresh_ctx(C0);
    const bf16* PROJ = (const bf16*)(A.ws + WS_PROJ); bf16* HCAT = (bf16*)(A.ws + WS_HCAT); const bf16* WM = (const bf16*)(A.ws + SM_WM);
    const int t0 = ck * CH;
    LAS bf16* ZT = (LAS bf16*)C.lds;
    LAS float* OUTS = (LAS float*)(C.lds + 69632);
    { const f32x4 nw = *(const f32x4*)(A.in[4] + l * 256 + 4 * C.lane), nb = *(const f32x4*)(A.in[5] + l * 256 + 4 * C.lane);
        v2u gvr[16];
#pragma unroll
        for (int i = 0; i < 16; ++i) gvr[i] = *(const v2u*)(PROJ + (size_t)(t0 + C.wave * 16 + i) * NPROJ + PGV + 4 * C.lane);
#pragma unroll
        for (int i = 0; i < 16; ++i) { const int r = C.wave * 16 + i; const v2u g = gvr[i];
            f32x4 x = {gelu_tanh(bflo(g.x)), gelu_tanh(bfhi(g.x)), gelu_tanh(bflo(g.y)), gelu_tanh(bfhi(g.y))};
            const float mean = wave_sum((x[0] + x[1]) + (x[2] + x[3])) * (1.0f / 256.0f); x = x - mean;
            const float var = wave_sum((x[0] * x[0] + x[1] * x[1]) + (x[2] * x[2] + x[3] * x[3])) * (1.0f / 256.0f);
            const float rstd = __builtin_amdgcn_rsqf(var + LN_EPS); x = x * rstd * nw + nb;
            const unsigned p01 = pk2(x[0], x[1]), p23 = pk2(x[2], x[3]);
            ZT[(4 * C.lane + 0) * LDT + r] = (bf16)(p01 & 0xffffu); ZT[(4 * C.lane + 1) * LDT + r] = (bf16)(p01 >> 16); ZT[(4 * C.lane + 2) * LDT + r] = (bf16)(p23 & 0xffffu); ZT[(4 * C.lane + 3) * LDT + r] = (bf16)(p23 >> 16); } }
    __syncthreads();
    const int fr = C.lane & 15, fg = C.lane >> 4, w = C.wave, nk = (w >> 1) + 1;
#pragma unroll
    for (int hp = 0; hp < 2; ++hp) {
#pragma unroll
        for (int h2 = 0; h2 < 2; ++h2) { const int hh = 2 * hp + h2;
            bf16x8 a[4];
#pragma unroll
            for (int ks = 0; ks < 4; ++ks) a[ks] = (ks < nk) ? *(const bf16x8*)(WM + ((size_t)(hh * CH + 16 * w + fr) * CH + 32 * ks + 8 * fg)) : (bf16x8){0, 0, 0, 0, 0, 0, 0, 0};
#pragma unroll
            for (int dt = 0; dt < 4; ++dt) { f32x4 acc = {0.f, 0.f, 0.f, 0.f};
#pragma unroll
                for (int ks = 0; ks < 4; ++ks) if (ks < nk) { const bf16x8 bb = *(const LAS bf16x8*)(ZT + (64 * hh + 16 * dt + fr) * LDT + 32 * ks + 8 * fg); acc = mfma16(a[ks], bb, acc); }
#pragma unroll
                for (int rg = 0; rg < 4; ++rg) OUTS[(16 * w + 4 * fg + rg) * 136 + 64 * h2 + 16 * dt + fr] = acc[rg]; } }
        __syncthreads();
        { const int r = C.tid >> 2, cg = (C.tid & 3) * 32, hh = 2 * hp + (cg >> 6); const float bsv = A.in[7][(size_t)(l * 4 + hh) * CH + r];
#pragma unroll
            for (int q = 0; q < 4; ++q) { float u[8]; unpack8(*(const v4u*)(PROJ + (size_t)(t0 + r) * NPROJ + PGU + 128 * hp + cg + 8 * q), u);
                const f32x4 a0 = *(const LAS f32x4*)(OUTS + r * 136 + cg + 8 * q), a1 = *(const LAS f32x4*)(OUTS + r * 136 + cg + 8 * q + 4);
                v4u o4; o4.x = pk2(gelu_tanh(u[0]) * (a0[0] + bsv), gelu_tanh(u[1]) * (a0[1] + bsv)); o4.y = pk2(gelu_tanh(u[2]) * (a0[2] + bsv), gelu_tanh(u[3]) * (a0[3] + bsv));
                o4.z = pk2(gelu_tanh(u[4]) * (a1[0] + bsv), gelu_tanh(u[5]) * (a1[1] + bsv)); o4.w = pk2(gelu_tanh(u[6]) * (a1[2] + bsv), gelu_tanh(u[7]) * (a1[3] + bsv));
                *(v4u*)(HCAT + (size_t)(t0 + r) * D + 512 + 128 * hp + cg + 8 * q) = o4; } }
        __syncthreads();
    }
}
DI void gmlp_unit_mfma(const Args& A, const Ctx& C0, int l, int unit) { const Ctx C = fresh_ctx(C0);
    const bf16* PROJ = (const bf16*)(A.ws + WS_PROJ); bf16* HCAT = (bf16*)(A.ws + WS_HCAT); const bf16* WM = (const bf16*)(A.ws + SM_WM);
    const int ck = unit >> 2, hh = unit & 3, t0 = ck * CH;
    LAS bf16* ZT = (LAS bf16*)C.lds;
    LAS float* OUTS = (LAS float*)(C.lds + 32768);
    bf16x8 awm[4];
    { const int fr = C.lane & 15, fg = C.lane >> 4, w = C.wave, nk = (w >> 1) + 1;
#pragma unroll
        for (int ks = 0; ks < 4; ++ks) awm[ks] = (ks < nk) ? *(const bf16x8*)(WM + ((size_t)(hh * CH + 16 * w + fr) * CH + 32 * ks + 8 * fg)) : (bf16x8){0, 0, 0, 0, 0, 0, 0, 0}; }
    const v4u gu0 = *(const v4u*)(PROJ + (size_t)(t0 + (C.tid >> 2)) * NPROJ + PGU + 64 * hh + (C.tid & 3) * 16), gu1 = *(const v4u*)(PROJ + (size_t)(t0 + (C.tid >> 2)) * NPROJ + PGU + 64 * hh + (C.tid & 3) * 16 + 8);
    const float bsv0 = A.in[7][(size_t)(l * 4 + hh) * CH + (C.tid >> 2)];
    { const f32x4 nw = *(const f32x4*)(A.in[4] + l * 256 + 4 * C.lane), nb = *(const f32x4*)(A.in[5] + l * 256 + 4 * C.lane);
        v2u gvr[16];
#pragma unroll
        for (int i = 0; i < 16; ++i) gvr[i] = *(const v2u*)(PROJ + (size_t)(t0 + C.wave * 16 + i) * NPROJ + PGV + 4 * C.lane);
#pragma unroll
        for (int i = 0; i < 16; ++i) { const int r = C.wave * 16 + i; const v2u g = gvr[i];
            f32x4 x = {gelu_tanh(bflo(g.x)), gelu_tanh(bfhi(g.x)), gelu_tanh(bflo(g.y)), gelu_tanh(bfhi(g.y))};
            const float mean = wave_sum((x[0] + x[1]) + (x[2] + x[3])) * (1.0f / 256.0f); x = x - mean;
            const float var = wave_sum((x[0] * x[0] + x[1] * x[1]) + (x[2] * x[2] + x[3] * x[3])) * (1.0f / 256.0f);
            const float rstd = __builtin_amdgcn_rsqf(var + LN_EPS); x = x * rstd * nw + nb;
            if ((C.lane >> 4) == hh) { const int d0 = 4 * (C.lane & 15);
#pragma unroll
                for (int q = 0; q < 4; ++q) ZT[(d0 + q) * LDT + r] = (bf16)f2bf(x[q]); } } }
    __syncthreads();
    { const int fr = C.lane & 15, fg = C.lane >> 4, w = C.wave, nk = (w >> 1) + 1;

#pragma unroll
        for (int dt = 0; dt < 4; ++dt) { f32x4 acc = {0.f, 0.f, 0.f, 0.f};
#pragma unroll
            for (int ks = 0; ks < 4; ++ks) if (ks < nk) { const bf16x8 bb = *(const LAS bf16x8*)(ZT + (16 * dt + fr) * LDT + 32 * ks + 8 * fg); acc = mfma16(awm[ks], bb, acc); }
#pragma unroll
            for (int rg = 0; rg < 4; ++rg) OUTS[(16 * w + 4 * fg + rg) * 68 + 16 * dt + fr] = acc[rg]; } }
    __syncthreads();
    { const int r = C.tid >> 2, cg = (C.tid & 3) * 16; const float bsv = bsv0;
        float u[16]; { float tmp[8]; unpack8(gu0, tmp);
#pragma unroll
            for (int j = 0; j < 8; ++j) u[j] = tmp[j];
            unpack8(gu1, tmp);
#pragma unroll
            for (int j = 0; j < 8; ++j) u[8 + j] = tmp[j]; }
        float o[16];
#pragma unroll
        for (int q = 0; q < 4; ++q) { const f32x4 a4 = *(const LAS f32x4*)(OUTS + r * 68 + cg + 4 * q);
#pragma unroll
            for (int j = 0; j < 4; ++j) o[4 * q + j] = gelu_tanh(u[4 * q + j]) * (a4[j] + bsv); }
        v4u w0, w1; w0.x = pk2(o[0], o[1]); w0.y = pk2(o[2], o[3]); w0.z = pk2(o[4], o[5]); w0.w = pk2(o[6], o[7]); w1.x = pk2(o[8], o[9]); w1.y = pk2(o[10], o[11]); w1.z = pk2(o[12], o[13]); w1.w = pk2(o[14], o[15]);
        *(v4u*)(HCAT + (size_t)(t0 + r) * D + 512 + 64 * hh + cg) = w0; *(v4u*)(HCAT + (size_t)(t0 + r) * D + 512 + 64 * hh + cg + 8) = w1; }
    __syncthreads();
}
#if DBG_CHECK
constexpr size_t SM_ERR = WS_CTL + 8192;
DI int slot_of(const Args& A, int l, int t, int k) { const v4u s = ((const v4u*)(A.ws + SM_SEL))[t]; const int e = k ? (int)s.y : (int)s.x; int run = 0;
    for (int q = 0; q < e; ++q) run += (((int)((const unsigned*)(A.ws + WS_CTL))[CW_CNT + (l * 16 + q) * 16] + 255) >> 8) * 256;
    return run + ((const int*)(A.ws + SM_TOKSLOT))[2 * t + k]; }
DI unsigned hsh(unsigned s, unsigned k) { unsigned h = s * 2654435761u + k * 40503u + 12345u; h ^= h >> 15; h *= 2246822519u; h ^= h >> 13; return h; }
DI void err_put(const Args& A, int chk, float ref, float got, float floor_) {
    float e = fabsf(ref - got) / (fabsf(ref) + floor_); if (!(e == e)) e = 1e9f;
    atomicMax((unsigned*)(A.ws + SM_ERR) + chk, __builtin_bit_cast(unsigned, e));
}
DI void chk_gates(const Args& A, const Ctx& C, int l, const float* X) {
    const int gt = C.bid * NTHREADS + C.tid; if (gt >= 2048) return;
    const int t = hsh(gt, 1) % T, g = hsh(gt, 2) % 8; float s = 0.f;
    for (int k = 0; k < D; ++k) s += X[(size_t)t * D + k] * A.in[1][((size_t)l * D + k) * PIN + 2048 + g];
    s += A.in[2][(size_t)l * PIN + 2048 + g];
    err_put(A, 1, s, ((const float*)(A.ws + SM_GATES))[(size_t)t * 8 + g], 0.1f);
}
DI void chk_proj(const Args& A, const Ctx& C, int l) {
    const int gt = C.bid * NTHREADS + C.tid; if (gt >= 8192) return;
    const int t = (gt < 64) ? (gt * 4099) % T : hsh(gt, 3) % T, n = hsh(gt, 4) % NPROJ, ns = n + (n >= 2048 ? 8 : 0);
    const bf16* XN = (const bf16*)(A.ws + WS_XN); float s = 0.f;
    for (int k = 0; k < D; ++k) s += bf2f(XN[(size_t)t * D + k]) * A.in[1][((size_t)l * D + k) * PIN + ns];
    s += A.in[2][(size_t)l * PIN + ns];
    err_put(A, 2, s, bf2f(((const bf16*)(A.ws + WS_PROJ))[(size_t)t * NPROJ + n]), 0.5f);
}
DI void chk_conv(const Args& A, const Ctx& C, int l) {
    const int gw = C.bid * NWAVES + C.wave; if (gw >= 1024) return;
    const int t = (gw < 128) ? (gw * 129) % T : hsh(gw, 5) % T; const bf16* PROJ = (const bf16*)(A.ws + WS_PROJ);
    float cv[4];
#pragma unroll
    for (int q = 0; q < 4; ++q) { const int c = C.lane * 4 + q; float acc = A.in[9][l * 256 + c];
        for (int j = 0; j < 31; ++j) { const int ts = t - 30 + j; if ((ts >> 12) != (t >> 12) || ts < 0) continue;
            const float a = bf2f(PROJ[(size_t)ts * NPROJ + PCA + c]), b = bf2f(PROJ[(size_t)ts * NPROJ + PCB + c]);
            acc += a / (1.0f + expf(-b)) * A.in[8][(size_t)(l * 31 + j) * 256 + c]; }
        cv[q] = acc; }
    const float mean = wave_sum_ref(cv[0] + cv[1] + cv[2] + cv[3]) / 256.0f; float q2 = 0.f;
#pragma unroll
    for (int q = 0; q < 4; ++q) { cv[q] -= mean; q2 += cv[q] * cv[q]; }
    const float rstd = 1.0f / sqrtf(wave_sum_ref(q2) / 256.0f + LN_EPS);
#pragma unroll
    for (int q = 0; q < 4; ++q) { const int c = C.lane * 4 + q; const float y = cv[q] * rstd * A.in[10][l * 256 + c] + A.in[11][l * 256 + c]; const float r = y / (1.0f + expf(-y));
        err_put(A, 3, r, bf2f(((const bf16*)(A.ws + WS_HCAT))[(size_t)t * D + 768 + c]), 0.5f); }
}
DI void chk_gmlp(const Args& A, const Ctx& C, int l) {
    const int gw = C.bid * NWAVES + C.wave; if (gw >= 512) return;
    const int t = (gw < 64) ? (gw * 131 + 127) % T : hsh(gw, 6) % T; const bf16* PROJ = (const bf16*)(A.ws + WS_PROJ);
    const int tc = t & 127, t0 = t - tc, h = C.lane >> 4; float acc[4] = {0.f, 0.f, 0.f, 0.f};
    for (int s = 0; s <= tc; ++s) { float x[4];
#pragma unroll
        for (int q = 0; q < 4; ++q) { const float v = bf2f(PROJ[(size_t)(t0 + s) * NPROJ + PGV + C.lane * 4 + q]); x[q] = 0.5f * v * (1.0f + tanhf(0.7978845608028654f * (v + 0.044715f * v * v * v))); }
        const float mean = wave_sum_ref(x[0] + x[1] + x[2] + x[3]) / 256.0f; float q2 = 0.f;
#pragma unroll
        for (int q = 0; q < 4; ++q) { x[q] -= mean; q2 += x[q] * x[q]; }
        const float rstd = 1.0f / sqrtf(wave_sum_ref(q2) / 256.0f + LN_EPS); const float w = A.in[6][((size_t)(l * 4 + h) * CH + tc) * CH + s];
#pragma unroll
        for (int q = 0; q < 4; ++q) { const int c = C.lane * 4 + q; acc[q] += w * (x[q] * rstd * A.in[4][l * 256 + c] + A.in[5][l * 256 + c]); } }
#pragma unroll
    for (int q = 0; q < 4; ++q) { const int c = C.lane * 4 + q; const float v = bf2f(PROJ[(size_t)t * NPROJ + PGU + c]); const float u = 0.5f * v * (1.0f + tanhf(0.7978845608028654f * (v + 0.044715f * v * v * v)));
        const float r = u * (acc[q] + A.in[7][(size_t)(l * 4 + h) * CH + tc]);
        err_put(A, 4, r, bf2f(((const bf16*)(A.ws + WS_HCAT))[(size_t)t * D + 512 + c]), 0.5f); }
}
DI void chk_mlstm(const Args& A, const Ctx& C, int l) {
    const int gw = C.bid * NWAVES + C.wave; if (gw >= 1024) return;
    const int t = (gw < 64) ? (gw * 521 + (gw & 1) * 127) % T : hsh(gw, 7) % T, h = hsh(gw, 8) & 3; const bf16* PROJ = (const bf16*)(A.ws + WS_PROJ); const float* GATES = (const float*)(A.ws + SM_GATES);
    const int tb = t & ~(SEQ - 1); const int d0 = 2 * C.lane;
    const float q0 = bf2f(PROJ[(size_t)t * NPROJ + PQ + h * 128 + d0]), q1 = bf2f(PROJ[(size_t)t * NPROJ + PQ + h * 128 + d0 + 1]);
    float n0 = 0.f, n1 = 0.f, den = 0.f, F = 0.f;
    for (int s = t; s >= tb; --s) {
        const float k0 = bf2f(PROJ[(size_t)s * NPROJ + PK + h * 128 + d0]), k1 = bf2f(PROJ[(size_t)s * NPROJ + PK + h * 128 + d0 + 1]);
        const float qk = wave_sum_ref(q0 * k0 + q1 * k1) * 0.08838834764831845f;
        const float w = expf(F + GATES[(size_t)s * 8 + h]) * qk;
        n0 += w * bf2f(PROJ[(size_t)s * NPROJ + PV + h * 128 + d0]); n1 += w * bf2f(PROJ[(size_t)s * NPROJ + PV + h * 128 + d0 + 1]); den += w;
        const float fp = GATES[(size_t)s * 8 + 4 + h]; F += fminf(fp, 0.f) - log1pf(expf(-fabsf(fp)));
        if (F < -60.f) break; }
    const float inv = 1.0f / fmaxf(fabsf(den), 1.0f); float x0 = n0 * inv, x1 = n1 * inv;
    const float mean = wave_sum_ref(x0 + x1) / 128.0f; x0 -= mean; x1 -= mean; const float rstd = 1.0f / sqrtf(wave_sum_ref(x0 * x0 + x1 * x1) / 128.0f + 1e-6f);
    const float o0 = bf2f(PROJ[(size_t)t * NPROJ + PO + h * 128 + d0]), o1 = bf2f(PROJ[(size_t)t * NPROJ + PO + h * 128 + d0 + 1]);
    const float r0 = x0 * rstd * A.in[3][(size_t)l * 512 + h * 128 + d0] / (1.0f + expf(-o0)), r1 = x1 * rstd * A.in[3][(size_t)l * 512 + h * 128 + d0 + 1] / (1.0f + expf(-o1));
    const bf16* HC = (const bf16*)(A.ws + WS_HCAT);
    err_put(A, 5, r0, bf2f(HC[(size_t)t * D + h * 128 + d0]), 0.5f); err_put(A, 5, r1, bf2f(HC[(size_t)t * D + h * 128 + d0 + 1]), 0.5f);
}
DI void chk_y(const Args& A, const Ctx& C, int l) {
    const int gt = C.bid * NTHREADS + C.tid; if (gt >= 8192) return;
    const int t = hsh(gt, 9) % T, n = hsh(gt, 10) % D; const bf16* HC = (const bf16*)(A.ws + WS_HCAT); float s = 0.f;
    for (int k = 0; k < D; ++k) s += bf2f(HC[(size_t)t * D + k]) * A.in[12][((size_t)l * D + k) * D + n];
    err_put(A, 6, s, bf2f(((const bf16*)(A.ws + WS_PROJ))[(size_t)t * D + n]), 0.2f);
}
DI void chk_ln1(const Args& A, const Ctx& C, int l, const bf16* X) {
    const int gw = C.bid * NWAVES + C.wave; if (gw >= 2048) return;
    const int t = hsh(gw, 11) % T; const bf16* Y = (const bf16*)(A.ws + WS_PROJ); const bf16* X1 = (const bf16*)(A.ws + WS_XNB);
    float v[16]; float s = 0.f;
#pragma unroll
    for (int i = 0; i < 16; ++i) { const int c = C.lane + 64 * i; v[i] = ALPHA * bf2f(X[(size_t)t * D + c]) + bf2f(Y[(size_t)t * D + c]); s += v[i]; }
    const float mean = wave_sum_ref(s) / D; float q2 = 0.f;
#pragma unroll
    for (int i = 0; i < 16; ++i) { v[i] -= mean; q2 += v[i] * v[i]; }
    const float rstd = 1.0f / sqrtf(wave_sum_ref(q2) / D + LN_EPS);
#pragma unroll
    for (int i = 0; i < 16; ++i) { const int c = C.lane + 64 * i; v[i] = v[i] * rstd * A.in[13][(size_t)l * D + c] + A.in[14][(size_t)l * D + c]; }
    err_put(A, 7, v[3], bf2f(X1[(size_t)t * D + C.lane + 192]), 1.0f);
    float sel[16], sg[16];
#pragma unroll
    for (int e = 0; e < 16; ++e) { float p = 0.f;
#pragma unroll
        for (int i = 0; i < 16; ++i) p += v[i] * A.in[15][(size_t)(C.lane + 64 * i) * 16 + e];
        p = wave_sum_ref(p); sg[e] = 1.0f / (1.0f + expf(-p)); sel[e] = sg[e] + A.in[16][e]; }
    float bestg = -INFINITY; int bg = 0;
#pragma unroll
    for (int g = 0; g < 4; ++g) { float a = sel[4 * g], b = sel[4 * g + 1], c = sel[4 * g + 2], d = sel[4 * g + 3];
        float m1 = fmaxf(fmaxf(a, b), fmaxf(c, d)); float tot = a + b + c + d; float mn = fminf(fminf(a, b), fminf(c, d));
        float lo1 = fminf(a, b), hi1 = fmaxf(a, b), lo2 = fminf(c, d), hi2 = fmaxf(c, d); float second = fmaxf(fminf(hi1, hi2), fmaxf(lo1, lo2)); (void)tot; (void)mn;
        const float gs = m1 + second; if (gs > bestg) { bestg = gs; bg = g; } }
    int e0 = -1, e1 = -1; float m1 = -INFINITY, m2 = -INFINITY;
#pragma unroll
    for (int e = 0; e < 16; ++e) if ((e >> 2) == bg && sel[e] > m1) { m1 = sel[e]; e0 = e; }
#pragma unroll
    for (int e = 0; e < 16; ++e) if ((e >> 2) == bg && e != e0 && sel[e] > m2) { m2 = sel[e]; e1 = e; }
    const v4u got = ((const v4u*)(A.ws + SM_SEL))[t];
    if (C.lane == 0 && ((int)got.x != e0 || (int)got.y != e1)) atomicAdd((unsigned*)(A.ws + SM_ERR) + 8, 1u);
}
DI void chk_hid(const Args& A, const Ctx& C, int l) {
    const int gt = C.bid * NTHREADS + C.tid; if (gt >= 8192) return;
    const int t = hsh(gt, 12) % T, k = hsh(gt, 13) & 1, j = hsh(gt, 14) % DEXP; const v4u s = ((const v4u*)(A.ws + SM_SEL))[t]; const int e = k ? (int)s.y : (int)s.x; const int p = slot_of(A, l, t, k);
    const bf16* XN = (const bf16*)(A.ws + WS_XNB); float g = 0.f, u = 0.f;
    for (int c = 0; c < D; ++c) { const float x = bf2f(XN[(size_t)t * D + c]); g += x * A.in[17][((size_t)(l * NEXP + e) * D + c) * DEXP + j]; u += x * A.in[18][((size_t)(l * NEXP + e) * D + c) * DEXP + j]; }
    err_put(A, 9, g / (1.0f + expf(-g)) * u, bf2f(((const bf16*)(A.ws + WS_HID))[(size_t)p * DEXP + j]), 0.5f);
    if (p < 0 || p >= PADROWS) atomicAdd((unsigned*)(A.ws + SM_ERR) + 11, 1u);
}
DI void chk_yp(const Args& A, const Ctx& C, int l) {
    const int gt = C.bid * NTHREADS + C.tid; if (gt >= 8192) return;
    const int t = hsh(gt, 15) % T, k = hsh(gt, 16) & 1, n = hsh(gt, 17) % D; const v4u s = ((const v4u*)(A.ws + SM_SEL))[t]; const int e = k ? (int)s.y : (int)s.x; const int p = slot_of(A, l, t, k);
    const bf16* HID = (const bf16*)(A.ws + WS_HID); float y = 0.f;
    for (int j = 0; j < DEXP; ++j) y += bf2f(HID[(size_t)p * DEXP + j]) * A.in[19][((size_t)(l * NEXP + e) * DEXP + j) * D + n];
    err_put(A, 10, y, bf2f(((const bf16*)(A.ws + WS_PROJ))[(size_t)p * D + n]), 0.2f);
}
DI void chk_out(const Args& A, const Ctx& C, int l) {
    const int gw = C.bid * NWAVES + C.wave; if (gw >= 2048) return;
    const int t = hsh(gw, 18) % T; const bf16* X1 = (const bf16*)(A.ws + WS_XNB); const bf16* YP = (const bf16*)(A.ws + WS_PROJ);
    const v4u s = ((const v4u*)(A.ws + SM_SEL))[t]; const int p0 = slot_of(A, l, t, 0), p1 = slot_of(A, l, t, 1);
    const f32x2 gw2 = ((const f32x2*)(A.ws + SM_GW))[t]; const float g0 = gw2[0], g1 = gw2[1];
    float v[16]; float sm = 0.f;
#pragma unroll
    for (int i = 0; i < 16; ++i) { const int c = C.lane + 64 * i; v[i] = ALPHA * bf2f(X1[(size_t)t * D + c]) + g0 * bf2f(YP[(size_t)p0 * D + c]) + g1 * bf2f(YP[(size_t)p1 * D + c]); sm += v[i]; }
    { float sy = 0.f, sx = 0.f;
#pragma unroll
      for (int i = 0; i < 16; ++i) { const int c = C.lane + 64 * i; const float yy = g0 * bf2f(YP[(size_t)p0 * D + c]) + g1 * bf2f(YP[(size_t)p1 * D + c]); const float xx = ALPHA * bf2f(X1[(size_t)t * D + c]); sy += yy * yy; sx += xx * xx; }
      sy = wave_sum_ref(sy); sx = wave_sum_ref(sx); const float ratio = sqrtf(sy / sx);
      if (C.lane == 0) atomicMax((unsigned*)(A.ws + SM_ERR) + 20, __builtin_bit_cast(unsigned, ratio));
      float sxn = 0.f, shid = 0.f, syp = 0.f; const bf16* XNb = (const bf16*)(A.ws + WS_XN); const bf16* HIDb = (const bf16*)(A.ws + WS_HID);
#pragma unroll
      for (int i = 0; i < 16; ++i) { const int c = C.lane + 64 * i; const float a = bf2f(YP[(size_t)p0 * D + c]); syp += a * a; }
#pragma unroll
      for (int i = 0; i < 8; ++i) { const int c = C.lane + 64 * i; const float a = bf2f(HIDb[(size_t)p0 * DEXP + c]); shid += a * a; }
      syp = sqrtf(wave_sum_ref(syp) / D); shid = sqrtf(wave_sum_ref(shid) / DEXP);
      if (C.lane == 0) { atomicMax((unsigned*)(A.ws + SM_ERR) + 21, __builtin_bit_cast(unsigned, syp)); atomicMax((unsigned*)(A.ws + SM_ERR) + 22, __builtin_bit_cast(unsigned, shid)); atomicMax((unsigned*)(A.ws + SM_ERR) + 23, __builtin_bit_cast(unsigned, g0 + g1)); atomicMax((unsigned*)(A.ws + SM_ERR) + 24, s.z); atomicMax((unsigned*)(A.ws + SM_ERR) + 25, s.w); atomicMax((unsigned*)(A.ws + SM_ERR) + 26, s.x); } }
    const float mean = wave_sum_ref(sm) / D; float q2 = 0.f;
#pragma unroll
    for (int i = 0; i < 16; ++i) { v[i] -= mean; q2 += v[i] * v[i]; }
    const float rstd = 1.0f / sqrtf(wave_sum_ref(q2) / D + LN_EPS);
    const int c = C.lane + 64 * 5; const float r = v[5] * rstd * A.in[20][(size_t)l * D + c] + A.in[21][(size_t)l * D + c];
    err_put(A, 12, r, (l == NLAYER - 1) ? A.out[(size_t)t * D + c] : bf2f(((const bf16*)(A.ws + WS_XN))[(size_t)t * D + c]), 1.0f);
}
DI void probe_gates(const Args& A, const Ctx& C, int slot) {
    const int gt = C.bid * NTHREADS + C.tid; if (gt >= 4096) return;
    const int t = hsh(gt, 30) % T; const v4u s = ((const v4u*)(A.ws + SM_SEL))[t];
    const f32x2 gw2 = ((const f32x2*)(A.ws + SM_GW))[t];
    atomicMax((unsigned*)(A.ws + SM_ERR) + slot, __builtin_bit_cast(unsigned, gw2[0] + gw2[1]));
    { const float sm = gw2[0] + gw2[1]; if (!(fabsf(sm - 1.0f) < 1e-3f)) atomicAdd((unsigned*)(A.ws + SM_ERR) + slot + 8, 1u); }
}
DI void dbg_finish(const Args& A, const Ctx& C) {
    const unsigned* E = (const unsigned*)(A.ws + SM_ERR);
    const float tol[13] = {0, 1e-3f, 0.03f, 0.04f, 0.04f, 0.08f, 0.03f, 0.01f, 0, 0.04f, 0.04f, 0, 0.01f};
    int code = 0;
#pragma unroll
    for (int k = 12; k >= 1; --k) { bool bad;
        if (k == 8) bad = E[8] > 20u; else if (k == 11) bad = E[11] > 0u; else bad = __builtin_bit_cast(float, E[k]) > tol[k];
        if (bad) code = k; }
    const float cv = (float)(code + DBG_BIAS);
    for (size_t i = (size_t)C.bid * NTHREADS + C.tid; i < (size_t)T * D; i += (size_t)GRID * NTHREADS) A.out[i] = cv;
}
#endif
__global__ void __launch_bounds__(NTHREADS, 2) fwd_kernel(Args A0) {
    extern __shared__ __attribute__((aligned(16))) unsigned char lds_raw[];
    Ctx CK; CK.lds = (LAS unsigned char*)lds_raw; CK.tid = threadIdx.x; CK.lane = CK.tid & 63; CK.wave = __builtin_amdgcn_readfirstlane(CK.tid >> 6); CK.bid = blockIdx.x;
    for (int u = CK.tid; u < (LDS_BYTES - LDSCTL_OFF) / 4; u += NTHREADS) ((LAS unsigned*)(CK.lds + LDSCTL_OFF))[u] = 0u;
    __syncthreads();
    unsigned* ctl = (unsigned*)(A0.ws + WS_CTL);
    XcdBarrier bar = xcd_barrier_post(ctl + CW_BAR, (volatile LAS unsigned*)(CK.lds + MISC_OFF) + 8);
#define GRID_BAR() xcd_barrier<false>(bar)
#if DBG_TIME
#define TS(k) do { if (l == TIME_LAYER && CK.bid == 0 && CK.tid == 0) ((unsigned long long*)(A0.ws + WS_CTL + 12288))[k] = __builtin_amdgcn_s_memrealtime(); } while (0)
#else
#define TS(k) do { } while (0)
#endif
#define FRESH() Args A; { int z_ = 0; asm volatile("" : "+s"(z_)); _Pragma("unroll") for (int k_ = 0; k_ < 22; ++k_) A.in[k_] = A0.in[k_] + z_; A.out = A0.out + z_; A.ws = A0.ws + z_; } const Ctx C = fresh_ctx(CK)
    { FRESH(); phase_prologue_rows(A, C); }
    xcd_barrier<true>(bar);
#if DBG_CHECK
    if (DBG_LAYER == 0) { FRESH(); chk_gates(A, C, 0, A.in[0]); }
#endif
    for (int l = 0; l < NLAYER_RUN; ++l) {
        TS(0);
        if (l == 0) { { FRESH(); phase_convert(A, C, 0); } GRID_BAR(); }
        TS(1);

        {
            FRESH(); pg8::Gemm g{(const pg8::bf16_t*)(A.ws + WS_XN), (const pg8::bf16_t*)(A.ws + WS_WIN), T, NPROJ, D}; pg8::StaticOrder S; S.init(T, NPROJ, GRID, C.bid);
            pg8::EpiStoreBf16 E{(pg8::bf16_t*)(A.ws + WS_PROJ), NPROJ, (const float*)(A.ws + SM_BIAS), 0xffff};
            pg8::gemm_phase<pg8::EpiStoreBf16, pg8::StaticOrder, true, true>(C.lds, g, S, E);
        }
        GRID_BAR(); TS(2);
#if DUP_G1
        {
            FRESH(); pg8::Gemm g{(const pg8::bf16_t*)(A.ws + WS_XN), (const pg8::bf16_t*)(A.ws + WS_WIN), T, NPROJ, D}; pg8::StaticOrder S; S.init(T, NPROJ, GRID, C.bid);
            pg8::EpiStoreBf16 E{(pg8::bf16_t*)(A.ws + WS_PROJ), NPROJ, (const float*)(A.ws + SM_BIAS), 0xffff};
            pg8::gemm_phase<pg8::EpiStoreBf16, pg8::StaticOrder, true, true>(C.lds, g, S, E);
        }
        GRID_BAR(); TS(2);
#endif
#if DBG_CHECK
        if (l == DBG_LAYER) { FRESH(); chk_proj(A, C, l); }
#endif
        { FRESH(); for (int un = C.bid; un < NUNIT; un += GRID) mlstm_local_mfma(A, C, un); } TS(3);
#if DUP_LOCAL
        { FRESH(); for (int un = C.bid; un < NUNIT; un += GRID) mlstm_local_mfma(A, C, un); } TS(3);
#endif
        { FRESH(); if (C.bid < 128) gmlp_chunk_mfma(A, C, l, C.bid); } TS(4);
#if DUP_GMLP
        { FRESH(); if (C.bid < 128) gmlp_chunk_mfma(A, C, l, C.bid); } TS(4);
#endif
        { FRESH(); if (C.bid < 128) conv_unit(A, C, l, C.bid); else { for (int q = 0; q < 3; ++q) conv_unit(A, C, l, 128 + (C.bid - 128) * 3 + q); } }
#if DUP_CONVU
        { FRESH(); if (C.bid < 128) conv_unit(A, C, l, C.bid); else { for (int q = 0; q < 3; ++q) conv_unit(A, C, l, 128 + (C.bid - 128) * 3 + q); } }
#endif
        GRID_BAR(); TS(5);
#if DUP_P2
        { FRESH(); for (int un = C.bid; un < NUNIT; un += GRID) mlstm_local_mfma(A, C, un); } TS(3);
        { FRESH(); if (C.bid < 128) gmlp_chunk_mfma(A, C, l, C.bid); } TS(4);
        { FRESH(); if (C.bid < 128) conv_unit(A, C, l, C.bid); else { for (int q = 0; q < 3; ++q) conv_unit(A, C, l, 128 + (C.bid - 128) * 3 + q); } }
        GRID_BAR(); TS(5);
#endif

        { FRESH(); phase_scan(A, C); }
        GRID_BAR(); TS(6);
#if DUP_SCAN
        { FRESH(); phase_scan(A, C); }
        GRID_BAR(); TS(6);
#endif

        { FRESH(); for (int un = C.bid; un < NUNIT; un += GRID) mlstm_out_mfma(A, C, l, un); }
        GRID_BAR(); TS(7);
#if DUP_P4
        { FRESH(); for (int un = C.bid; un < NUNIT; un += GRID) mlstm_out_mfma(A, C, l, un); }
        GRID_BAR(); TS(7);
#endif

#if DBG_CHECK
        if (l == DBG_LAYER) { FRESH(); chk_conv(A, C, l); chk_gmlp(A, C, l); chk_mlstm(A, C, l); GRID_BAR(); }
#endif
        {
            FRESH(); pg8::Gemm g{(const pg8::bf16_t*)(A.ws + WS_HCAT), (const pg8::bf16_t*)(A.ws + WS_WOUT), T, D, D}; pg8::StaticOrder S; S.init(T, D, GRID, C.bid);
            pg8::EpiStoreBf16 E{(pg8::bf16_t*)(A.ws + WS_PROJ), D, nullptr, 0xffff};
            pg8::gemm_phase<pg8::EpiStoreBf16, pg8::StaticOrder, true, true>(C.lds, g, S, E);
        }
        GRID_BAR(); TS(8);
#if DUP_G5
        {
            FRESH(); pg8::Gemm g{(const pg8::bf16_t*)(A.ws + WS_HCAT), (const pg8::bf16_t*)(A.ws + WS_WOUT), T, D, D}; pg8::StaticOrder S; S.init(T, D, GRID, C.bid);
            pg8::EpiStoreBf16 E{(pg8::bf16_t*)(A.ws + WS_PROJ), D, nullptr, 0xffff};
            pg8::gemm_phase<pg8::EpiStoreBf16, pg8::StaticOrder, true, true>(C.lds, g, S, E);
        }
        GRID_BAR(); TS(8);
#endif
#if DBG_CHECK
        if (l == DBG_LAYER) { FRESH(); chk_y(A, C, l); GRID_BAR(); }
#endif
        for (int rep = (DUP_P6 ? 0 : 1); rep < 2; ++rep) { FRESH(); phase_ln1_router(A, C, l, rep == 0); GRID_BAR(); }
        TS(9);

#if DBG_CHECK
        if (l == DBG_LAYER) { FRESH(); chk_ln1(A, C, l, (const bf16*)(A.ws + WS_XN)); probe_gates(A, C, 27); GRID_BAR(); }
#endif


        {
            FRESH(); PG8_LAS int* desc = (PG8_LAS int*)(C.lds + VEC_OFF); pg8::moe_units(desc, (const unsigned*)(A.ws + WS_CTL) + CW_CNT + l * 256, GRID, C.bid);
            pg8::MoeOrder<true> S{desc, (const int*)(A.ws + WS_LIST), GRID, C.bid, D * 2};
            pg8::Gemm g{(const pg8::bf16_t*)(A.ws + WS_XNB), (const pg8::bf16_t*)(A.ws + wgu_off(l)), PADROWS, NEXP * 1024, D};
            pg8::EpiSwiGLU E{(pg8::bf16_t*)(A.ws + WS_HID), DEXP};
            pg8::gemm_phase<pg8::EpiSwiGLU, pg8::MoeOrder<true>, true, true>(C.lds, g, S, E);
            if (l + 1 < NLAYER) convert_in_tail(A, C, l + 1, 0, CV_SPLIT, (const unsigned*)(A.ws + WS_CTL) + CW_CNT + l * 256);
        }
        GRID_BAR(); TS(11);
#if DUP_G8
        {
            FRESH(); PG8_LAS int* desc = (PG8_LAS int*)(C.lds + VEC_OFF); pg8::moe_units(desc, (const unsigned*)(A.ws + WS_CTL) + CW_CNT + l * 256, GRID, C.bid);
            pg8::MoeOrder<true> S{desc, (const int*)(A.ws + WS_LIST), GRID, C.bid, D * 2};
            pg8::Gemm g{(const pg8::bf16_t*)(A.ws + WS_XNB), (const pg8::bf16_t*)(A.ws + wgu_off(l)), PADROWS, NEXP * 1024, D};
            pg8::EpiSwiGLU E{(pg8::bf16_t*)(A.ws + WS_HID), DEXP};
            pg8::gemm_phase<pg8::EpiSwiGLU, pg8::MoeOrder<true>, true, true>(C.lds, g, S, E);
        }
        GRID_BAR(); TS(11);
#endif
#if DBG_CHECK
        if (l == DBG_LAYER) { FRESH(); chk_hid(A, C, l); probe_gates(A, C, 29); }
#endif
        {
            FRESH(); PG8_LAS int* desc = (PG8_LAS int*)(C.lds + VEC_OFF); pg8::moe_units(desc, (const unsigned*)(A.ws + WS_CTL) + CW_CNT + l * 256, GRID, C.bid);
            pg8::MoeOrder<false> S{desc, (const int*)(A.ws + WS_LIST), GRID, C.bid, 0};
            pg8::Gemm g{(const pg8::bf16_t*)(A.ws + WS_HID), (const pg8::bf16_t*)(A.ws + wd_off(l)), PADROWS, NEXP * 1024, DEXP};
            pg8::EpiStoreBf16 E{(pg8::bf16_t*)(A.ws + WS_PROJ), D, nullptr, 3};
            pg8::gemm_phase<pg8::EpiStoreBf16, pg8::MoeOrder<false>, true, true>(C.lds, g, S, E);
            if (l + 1 < NLAYER) convert_in_tail(A, C, l + 1, CV_SPLIT, CV_ITEMS, (const unsigned*)(A.ws + WS_CTL) + CW_CNT + l * 256);
        }
        GRID_BAR(); TS(12);
#if DUP_G9
        {
            FRESH(); PG8_LAS int* desc = (PG8_LAS int*)(C.lds + VEC_OFF); pg8::moe_units(desc, (const unsigned*)(A.ws + WS_CTL) + CW_CNT + l * 256, GRID, C.bid);
            pg8::MoeOrder<false> S{desc, (const int*)(A.ws + WS_LIST), GRID, C.bid, 0};
            pg8::Gemm g{(const pg8::bf16_t*)(A.ws + WS_HID), (const pg8::bf16_t*)(A.ws + wd_off(l)), PADROWS, NEXP * 1024, DEXP};
            pg8::EpiStoreBf16 E{(pg8::bf16_t*)(A.ws + WS_PROJ), D, nullptr, 3};
            pg8::gemm_phase<pg8::EpiStoreBf16, pg8::MoeOrder<false>, true, true>(C.lds, g, S, E);
        }
        GRID_BAR(); TS(12);
#endif
#if DBG_CHECK
        if (l == DBG_LAYER) { FRESH(); chk_yp(A, C, l); probe_gates(A, C, 30); }
#endif
        { FRESH(); phase_combine(A, C, l); }
        GRID_BAR(); TS(13);
#if DUP_P10
        { FRESH(); phase_combine(A, C, l); }
        GRID_BAR(); TS(13);
#endif

#if DBG_CHECK
        if (l == DBG_LAYER) { FRESH(); chk_out(A, C, l);  GRID_BAR(); }
#endif
    }
#if DBG_CHECK
    { FRESH(); dbg_finish(A, C); }
#endif
#if DBG_TIME
    { FRESH(); const unsigned long long* tsb = (const unsigned long long*)(A.ws + WS_CTL + 12288);
      const float c1 = floorf(((float)(tsb[TIME_A] - tsb[TIME_A - 1]) + TIME_OFF * 100.0f) * (1.0f / 1600.0f));
      for (size_t i = (size_t)C.bid * NTHREADS + C.tid; i < (size_t)T * D; i += (size_t)GRID * NTHREADS) A.out[i] = c1; }
#endif
}

extern "C" void kernel_launch(void* const* d_in, const int* in_sizes, int n_in, void* d_out, int out_size, void* d_ws, size_t ws_size, hipStream_t stream) {
    static int ready = 0;
    if (ready == 0) {
        if (n_in != 22 || in_sizes[0] != T * D || out_size != T * D || ws_size < WS_END) { fprintf(stderr, "kernel_launch: unexpected shapes (n_in %d, in0 %d, out %d, ws %zu)\n", n_in, n_in > 0 ? in_sizes[0] : -1, out_size, ws_size); ready = -1; return; }
        if (hipFuncSetAttribute((const void*)fwd_kernel, hipFuncAttributeMaxDynamicSharedMemorySize, LDS_BYTES) != hipSuccess) { fprintf(stderr, "kernel_launch: hipFuncSetAttribute failed\n"); ready = -1; return; }
        (void)hipGetLastError();
        ready = 1;
    }
    if (ready < 0) return;
    if (hipMemsetAsync((char*)d_ws + WS_CTL, 0, CTL_ZERO_BYTES, stream) != hipSuccess) return;
    Args a{};
    for (int i = 0; i < 22; ++i) a.in[i] = (const float*)d_in[i];
    a.out = (float*)d_out; a.ws = (unsigned char*)d_ws;
    hipLaunchKernelGGL(fwd_kernel, dim3(GRID), dim3(NTHREADS), LDS_BYTES, stream, a);
}
```

```cpp
#include <hip/hip_runtime.h>
#include <cstdio>
#include <cstdint>
namespace pg8 {
#define PG8_LAS __attribute__((address_space(3)))
typedef unsigned short bf16_t;
typedef short bf16x8 __attribute__((ext_vector_type(8)));
typedef float f32x4 __attribute__((ext_vector_type(4)));
typedef unsigned u32x4 __attribute__((ext_vector_type(4)));
constexpr int BM = 256, BK = 64, HALF = 128, HTB = HALF * BK * 2  , STAGE_BYTES = 8 * HTB, NXCD = 8, WGM = 8;

__host__ __device__ __forceinline__ int lds_byte(int r, int c) { const int st = (r >> 4) * 2 + (c >> 5), rr = r & 15, cc = c & 31, ob = rr * 64 + cc * 2; return st * 1024 + (ob ^ (((ob >> 9) & 1) << 5)); }
__host__ __device__ __forceinline__ void stage_rc(int b, int& R, int& C) { const int st = b / 1024, sb = b % 1024, swz = sb ^ (((sb >> 9) & 1) << 5); R = (st >> 1) * 16 + swz / 64; C = (st & 1) * 32 + (swz % 64) / 2; }
__host__ __device__ __forceinline__ int perm32(int rho) { const int n = rho >> 4, i = rho & 15; return 8 * (i >> 2) + 4 * n + (i & 3); }

struct Unit { int pm, pn, e, r0, cnt; };
struct Gemm { const bf16_t* A; const bf16_t* Bt; int M, N, K; };

struct StaticOrder {
    static constexpr bool GATHER = false;
    int nM, nN, nwg, G, c;
    __device__ __forceinline__ unsigned a_off(const Unit&, int) const { return 0u; }
    __host__ __device__ void init(int M, int N, int G_, int c_) { nM = M / BM; nN = N / BM; nwg = nM * nN; G = G_; c = c_; }
    __host__ __device__ bool next(int i, Unit& u) const {
        const long L = (long)i * G + c; if (L >= nwg) return false;
        int wgid = (int)L; { const int q = nwg / NXCD, r = nwg % NXCD, xcd = wgid % NXCD, off = wgid / NXCD; wgid = (xcd < r ? xcd * (q + 1) : r * (q + 1) + (xcd - r) * q) + off; }
        const int nig = WGM * nN, gid = wgid / nig, fm = gid * WGM, gsz = (nM - fm) < WGM ? (nM - fm) : WGM;
        u.pm = fm + ((wgid % nig) % gsz); u.pn = (wgid % nig) / gsz; return true;
    }
    __device__ __forceinline__ void a_ready(const Unit&) const {}
    __device__ __forceinline__ void done(const Unit&) const {}
};
template <bool GATH> struct MoeOrder {
    static constexpr bool GATHER = GATH;
    const PG8_LAS int* desc; const int* list; int G, c, rowbytes;
    __device__ __forceinline__ bool next(int i, Unit& u) const {
        u.pm = 0; u.pn = 0; u.e = 0; u.r0 = 0; u.cnt = 0;
        if (i >= 4) return false;
        const int L = i * G + c; const int f = __builtin_amdgcn_readfirstlane(desc[5 * i]);
        if (!f) return false;
        u.pm = L >> 2; u.e = __builtin_amdgcn_readfirstlane(desc[5 * i + 1]); u.r0 = __builtin_amdgcn_readfirstlane(desc[5 * i + 2]); u.cnt = __builtin_amdgcn_readfirstlane(desc[5 * i + 3]); u.pn = __builtin_amdgcn_readfirstlane(desc[5 * i + 4]);
        return true;
    }
    __device__ __forceinline__ unsigned a_off(const Unit& u, int row) const { const int pos = u.r0 + row; const int tok = pos < u.cnt ? list[(size_t)u.e * 16384 + pos] : 0; return (unsigned)tok * (unsigned)rowbytes; }
    __device__ __forceinline__ void a_ready(const Unit&) const {}
    __device__ __forceinline__ void done(const Unit&) const {}
};
__device__ __forceinline__ void moe_units(PG8_LAS int* desc, const unsigned* cnt, int G, int c) {
    if (threadIdx.x < 4) { const int i = threadIdx.x, L = i * G + c, rt = L >> 2; int acc = 0, f = 0, ee = 0, r0 = 0, cn = 0;
        for (int e = 0; e < 16; ++e) { const int n = (int)__hip_atomic_load(cnt + 16 * e, __ATOMIC_RELAXED, __HIP_MEMORY_SCOPE_AGENT); const int nt = (n + 255) >> 8;
            if (!f && rt < acc + nt) { f = 1; ee = e; r0 = (rt - acc) * 256; cn = n; }
            acc += nt; }
        desc[5 * i] = f; desc[5 * i + 1] = ee; desc[5 * i + 2] = r0; desc[5 * i + 3] = cn; desc[5 * i + 4] = ee * 4 + (L & 3); }
    __syncthreads();
}

__device__ __forceinline__ unsigned cvt_pk_bf16(float lo, float hi) { unsigned r; asm volatile("v_cvt_pk_bf16_f32 %0, %1, %2" : "=v"(r) : "v"(lo), "v"(hi)); return r; }

struct EpiStoreBf16 {
    static constexpr bool PERM = true, AFTER_DRAIN = false;
    bf16_t* O; int ldc; const float* bias; int pn_mask;
    __device__ __forceinline__ void operator()(const f32x4 (&acc)[2][2][4][2], const Unit& u, int wr, int wc, int fr, int fq) const {
        const int row0 = u.pm * BM + wr * 64 + fr; const int col0 = (u.pn & pn_mask) * BM + wc * 32 + 8 * fq;
        f32x4 bv[2][2];
#pragma unroll
        for (int bj = 0; bj < 2; ++bj)
#pragma unroll
            for (int n = 0; n < 2; ++n) bv[bj][n] = bias ? *(const f32x4*)(bias + col0 + bj * HALF + 4 * n) : (f32x4){0.f, 0.f, 0.f, 0.f};
#pragma unroll
        for (int ai = 0; ai < 2; ++ai)
#pragma unroll
            for (int m = 0; m < 4; ++m) { bf16_t* rowp = O + (size_t)(row0 + ai * HALF + m * 16) * ldc + col0;
#pragma unroll
                for (int bj = 0; bj < 2; ++bj) { const f32x4 v0 = acc[ai][bj][m][0] + bv[bj][0], v1 = acc[ai][bj][m][1] + bv[bj][1];
                    u32x4 w; w.x = cvt_pk_bf16(v0[0], v0[1]); w.y = cvt_pk_bf16(v0[2], v0[3]); w.z = cvt_pk_bf16(v1[0], v1[1]); w.w = cvt_pk_bf16(v1[2], v1[3]);
                    *(u32x4*)(rowp + bj * HALF) = w; } }
    }
};
struct EpiSwiGLU {
    static constexpr bool PERM = true, AFTER_DRAIN = false;
    bf16_t* O; int ldc;
    __device__ __forceinline__ void operator()(const f32x4 (&acc)[2][2][4][2], const Unit& u, int wr, int wc, int fr, int fq) const {
        const int row0 = u.pm * BM + wr * 64 + fr; const int col0 = (u.pn & 3) * HALF + wc * 32 + 8 * fq;
#pragma unroll
        for (int ai = 0; ai < 2; ++ai)
#pragma unroll
            for (int m = 0; m < 4; ++m) { bf16_t* rowp = O + (size_t)(row0 + ai * HALF + m * 16) * ldc + col0;
                float h[8];
#pragma unroll
                for (int n = 0; n < 2; ++n)
#pragma unroll
                    for (int k = 0; k < 4; ++k) { const float g = acc[ai][0][m][n][k], up = acc[ai][1][m][n][k]; h[4 * n + k] = g * up / (1.0f + __expf(-g)); }
                u32x4 w; w.x = cvt_pk_bf16(h[0], h[1]); w.y = cvt_pk_bf16(h[2], h[3]); w.z = cvt_pk_bf16(h[4], h[5]); w.w = cvt_pk_bf16(h[6], h[7]);
                *(u32x4*)rowp = w; }
    }
};
template <class Epi, class Sched, bool ALIGN_EPI = false, bool SP2 = false>
__device__ __forceinline__ void gemm_phase(PG8_LAS unsigned char* lds, const Gemm g, const Sched& S, const Epi& E) {
    int tid_l = threadIdx.x; asm volatile("" : "+v"(tid_l)); const int tid = tid_l, wid = __builtin_amdgcn_readfirstlane(tid >> 6), lane = tid & 63, wr = wid >> 2, wc = wid & 3, fr = lane & 15, fq = lane >> 4;
    const int K = g.K, nt = K / BK;
    unsigned voffA[2], voffB[2];
#pragma unroll
    for (int i = 0; i < 2; ++i) { int R, C; stage_rc(tid * 16 + i * 8192, R, C); const int Rb = Epi::PERM ? ((R & ~31) + perm32(R & 31)) : R;
        voffA[i] = (unsigned)(R * K + C) * 2u; voffB[i] = (unsigned)(Rb * K + C) * 2u; }
    unsigned cv0[2] = {voffA[0], voffA[1]}, cv1[2] = {voffA[0], voffA[1]};
#define PG8_GOFF(u, d0, d1) do { _Pragma("unroll") for (int _i = 0; _i < 2; ++_i) { int R_, C_; stage_rc(tid * 16 + _i * 8192, R_, C_); d0[_i] = S.a_off(u, R_) + (unsigned)(C_ * 2); d1[_i] = S.a_off(u, HALF + R_) + (unsigned)(C_ * 2); } } while (0)
    const size_t kstep = (size_t)(BK * 2);
    const size_t hstep = (size_t)HALF * K * 2;
    const size_t tstep = 2 * hstep;
    const unsigned ldsw = (unsigned)wid * 1024u;
    const int aoff = lds_byte(wr * 64 + fr, fq * 8), boff = lds_byte(wc * 32 + fr, fq * 8);
#define PG8_SA(b, h) (((b) * 2 + (h)) * HTB)
#define PG8_SB(b, h) ((4 + (b) * 2 + (h)) * HTB)
#define PG8_STAGE(bufoff, gbase, voff) do { _Pragma("unroll") for (int _i = 0; _i < 2; ++_i) \
        __builtin_amdgcn_global_load_lds((const unsigned*)((const char*)(gbase) + (voff)[_i]), (PG8_LAS unsigned*)(lds + (bufoff) + ldsw + _i * 8192), 16, 0, 0); } while (0)
#define PG8_LDA(dst, b, h) do { _Pragma("unroll") for (int m = 0; m < 4; ++m) _Pragma("unroll") for (int k = 0; k < 2; ++k) dst[m][k] = *(const PG8_LAS bf16x8*)(lds + PG8_SA(b, h) + aoff + m * 2048 + k * 1024); } while (0)
#define PG8_LDB(dst, b, h) do { _Pragma("unroll") for (int n = 0; n < 2; ++n) _Pragma("unroll") for (int k = 0; k < 2; ++k) dst[n][k] = *(const PG8_LAS bf16x8*)(lds + PG8_SB(b, h) + boff + n * 2048 + k * 1024); } while (0)
#define PG8_MMA(ai, bj, At, Bt) do { __builtin_amdgcn_s_setprio(1); _Pragma("unroll") for (int m = 0; m < 4; ++m) _Pragma("unroll") for (int n = 0; n < 2; ++n) _Pragma("unroll") for (int k = 0; k < 2; ++k) \
        acc[ai][bj][m][n] = __builtin_amdgcn_mfma_f32_16x16x32_bf16(Bt[n][k], At[m][k], acc[ai][bj][m][n], 0, 0, 0); __builtin_amdgcn_s_setprio(0); } while (0)
#define PG8_WAIT_V(n) asm volatile("s_waitcnt vmcnt(" #n ")" ::: "memory")
#define PG8_WAIT_L(n) asm volatile("s_waitcnt lgkmcnt(" #n ")" ::: "memory")
#define PG8_BAR __builtin_amdgcn_s_barrier()
#define PG8_SCHED __builtin_amdgcn_sched_barrier(0)
    Unit cur, nxt; int ui = 0;
    if (!S.next(0, cur)) return;
    f32x4 acc[2][2][4][2];
#pragma unroll
    for (int a = 0; a < 2; ++a)
#pragma unroll
        for (int b = 0; b < 2; ++b)
#pragma unroll
            for (int m = 0; m < 4; ++m)
#pragma unroll
                for (int n = 0; n < 2; ++n) acc[a][b][m][n] = (f32x4){0.f, 0.f, 0.f, 0.f};
    bf16x8 At[4][2], B0[2][2], B1[2][2];
    const char* cA = Sched::GATHER ? (const char*)g.A : (const char*)g.A + (size_t)cur.pm * tstep; const char* cB = (const char*)g.Bt + (size_t)cur.pn * tstep;
    const size_t hstepA = Sched::GATHER ? 0 : hstep;
    if constexpr (Sched::GATHER) { static_assert(SP2, "gather is wired into the SP2 loop only"); PG8_GOFF(cur, cv0, cv1); }
    S.a_ready(cur);
    if constexpr (SP2) {
        PG8_STAGE(PG8_SB(0, 0), cB, voffB); PG8_STAGE(PG8_SB(0, 1), cB + hstep, voffB); PG8_STAGE(PG8_SA(0, 0), cA, cv0); PG8_STAGE(PG8_SA(0, 1), cA + hstepA, cv1);
        if (wr == 1) PG8_BAR;
        PG8_WAIT_V(2); PG8_BAR;
        PG8_STAGE(PG8_SB(1, 0), cB + kstep, voffB); PG8_STAGE(PG8_SA(1, 0), cA + kstep, cv0); PG8_STAGE(PG8_SB(1, 1), cB + hstep + kstep, voffB);
        PG8_WAIT_V(6); PG8_BAR;
    } else {
        PG8_STAGE(PG8_SB(0, 0), cB, voffB); PG8_STAGE(PG8_SA(0, 0), cA, voffA); PG8_STAGE(PG8_SB(0, 1), cB + hstep, voffB); PG8_STAGE(PG8_SA(0, 1), cA + hstep, voffA);
        if (wr == 1) PG8_BAR;
        PG8_WAIT_V(4); PG8_BAR;
        PG8_STAGE(PG8_SB(1, 0), cB + kstep, voffB); PG8_STAGE(PG8_SA(1, 0), cA + kstep, voffA); PG8_STAGE(PG8_SB(1, 1), cB + hstep + kstep, voffB);
        PG8_WAIT_V(6); PG8_BAR;
    }
    for (;;) {
        const bool has_next = S.next(ui + 1, nxt);
        const char* nA = Sched::GATHER ? (const char*)g.A : (has_next ? (const char*)g.A + (size_t)nxt.pm * tstep : cA); const char* nB = has_next ? (const char*)g.Bt + (size_t)nxt.pn * tstep : cB;
        for (int t = 0; t < nt; t += 2) {
            const bool last = (t == nt - 2);
            const char* a1 = cA + (size_t)(t + 1) * kstep;
            const char* a2 = last ? nA : cA + (size_t)(t + 2) * kstep; const char* b2 = last ? nB : cB + (size_t)(t + 2) * kstep;
            const char* a3 = a2 + kstep; const char* b3 = b2 + kstep;
            if (last && has_next) S.a_ready(nxt);
            if constexpr (SP2) {
            PG8_LDB(B0, 0, 0); PG8_LDB(B1, 0, 1); PG8_SCHED; PG8_LDA(At, 0, 0); PG8_STAGE(PG8_SA(1, 1), a1 + hstepA, cv1);
            if constexpr (Sched::GATHER) { if (last && has_next) { PG8_GOFF(nxt, cv0, cv1); } }
            PG8_WAIT_V(8); PG8_WAIT_L(0); PG8_BAR; PG8_MMA(0, 0, At, B0); PG8_MMA(0, 1, At, B1); PG8_BAR; PG8_SCHED;
            PG8_LDA(At, 0, 1); PG8_STAGE(PG8_SB(0, 0), b2, voffB); PG8_STAGE(PG8_SB(0, 1), b2 + hstep, voffB); PG8_STAGE(PG8_SA(0, 0), a2, cv0);
            PG8_WAIT_V(8); PG8_WAIT_L(0); PG8_BAR; PG8_MMA(1, 0, At, B0); PG8_MMA(1, 1, At, B1); PG8_BAR; PG8_SCHED;
            PG8_LDB(B0, 1, 0); PG8_LDB(B1, 1, 1); PG8_SCHED; PG8_LDA(At, 1, 0); PG8_STAGE(PG8_SA(0, 1), a2 + hstepA, cv1);
            PG8_WAIT_V(8); PG8_WAIT_L(0); PG8_BAR; PG8_MMA(0, 0, At, B0); PG8_MMA(0, 1, At, B1); PG8_BAR; PG8_SCHED;
            PG8_LDA(At, 1, 1); PG8_STAGE(PG8_SB(1, 0), b3, voffB); PG8_STAGE(PG8_SB(1, 1), b3 + hstep, voffB); PG8_STAGE(PG8_SA(1, 0), a3, cv0);
            PG8_WAIT_V(8); PG8_WAIT_L(0); PG8_BAR; PG8_MMA(1, 0, At, B0); PG8_MMA(1, 1, At, B1); PG8_BAR; PG8_SCHED;
            } else {
            PG8_LDB(B0, 0, 0); PG8_SCHED; PG8_LDA(At, 0, 0); PG8_STAGE(PG8_SA(1, 1), a1 + hstep, voffA);
            PG8_WAIT_L(8); PG8_BAR; PG8_WAIT_L(0); PG8_MMA(0, 0, At, B0); PG8_BAR; PG8_SCHED;
            PG8_LDB(B1, 0, 1); PG8_STAGE(PG8_SB(0, 0), b2, voffB);
            PG8_BAR; PG8_WAIT_L(0); PG8_MMA(0, 1, At, B1); PG8_BAR;
            PG8_LDA(At, 0, 1); PG8_STAGE(PG8_SA(0, 0), a2, voffA);
            PG8_BAR; PG8_WAIT_L(0); PG8_MMA(1, 0, At, B0); PG8_BAR; PG8_SCHED;
            PG8_STAGE(PG8_SB(0, 1), b2 + hstep, voffB);
            PG8_WAIT_V(6); PG8_BAR; PG8_MMA(1, 1, At, B1); PG8_BAR;
            PG8_LDB(B0, 1, 0); PG8_SCHED; PG8_LDA(At, 1, 0); PG8_STAGE(PG8_SA(0, 1), a2 + hstep, voffA);
            PG8_WAIT_L(8); PG8_BAR; PG8_WAIT_L(0); PG8_MMA(0, 0, At, B0); PG8_BAR; PG8_SCHED;
            PG8_LDB(B1, 1, 1); PG8_STAGE(PG8_SB(1, 0), b3, voffB);
            PG8_BAR; PG8_WAIT_L(0); PG8_MMA(0, 1, At, B1); PG8_BAR;
            PG8_LDA(At, 1, 1); PG8_STAGE(PG8_SA(1, 0), a3, voffA);
            PG8_BAR; PG8_WAIT_L(0); PG8_MMA(1, 0, At, B0); PG8_BAR; PG8_SCHED;
            PG8_STAGE(PG8_SB(1, 1), b3 + hstep, voffB);
            PG8_WAIT_V(6); PG8_BAR; PG8_MMA(1, 1, At, B1); PG8_BAR;
            }
        }
        if constexpr (ALIGN_EPI) { if (wr == 0) PG8_BAR; }
        if constexpr (!Epi::AFTER_DRAIN) { E(acc, cur, wr, wc, fr, fq); S.done(cur); }
        if (!has_next) break;
#pragma unroll
        for (int a = 0; a < 2; ++a)
#pragma unroll
            for (int b = 0; b < 2; ++b)
#pragma unroll
                for (int m = 0; m < 4; ++m)
#pragma unroll
                    for (int n = 0; n < 2; ++n) acc[a][b][m][n] = (f32x4){0.f, 0.f, 0.f, 0.f};
        cur = nxt; cA = nA; cB = nB; ++ui;
        if constexpr (ALIGN_EPI) { if (wr == 1) PG8_BAR; }
    }
    PG8_WAIT_V(0);
    if constexpr (!ALIGN_EPI) { if (wr == 0) PG8_BAR; }
    PG8_BAR;
    if constexpr (Epi::AFTER_DRAIN) { E.fused(acc, cur, wr, wc, fr, fq, lds, wid, lane); S.done(cur); }
#undef PG8_SA
#undef PG8_SB
#undef PG8_STAGE
#undef PG8_LDA
#undef PG8_LDB
#undef PG8_MMA
#undef PG8_WAIT_V
#undef PG8_WAIT_L
#undef PG8_BAR
#undef PG8_SCHED
#undef PG8_GOFF
}
}
#ifndef DBG_CHECK
#define DBG_CHECK 0
#endif
#define DBG_LAYER 0
#ifndef DBG_TIME
#define DBG_TIME 0
#endif
#define TIME_LAYER 1
#define DUP_CONV 0
#define DUP_SCAN 0
#define DUP_P10 0
#define DUP_P6 0
#define DUP_P2 0
#define DUP_LOCAL 0
#define DUP_GMLP 0
#define DUP_CONVU 0
#define DUP_P4 0
#define DUP_G1 0
#define DUP_G5 0
#define DUP_G8 0
#define DUP_G9 0
#define TIME_A 9
#define TIME_B 2
#define TIME_OFF 0
#define DBG_BIAS 0
constexpr int NWAVES = 8, NTHREADS = 512, GRID = 256;
constexpr int NLAYER_RUN = DBG_CHECK ? (DBG_LAYER + 1) : 4;
constexpr int T = 16384, D = 1024, SEQ = 4096, NLAYER = 4;
constexpr int PIN = 3080, NPROJ = 3072;
constexpr int CH = 128, NCH = 32, NUNIT = 512;
constexpr int NEXP = 16, DEXP = 512;
constexpr int PADROWS = 36864;
constexpr float ALPHA = 1.6817928305074290f;
constexpr float LN_EPS = 1e-5f;
constexpr int PQ = 0, PK = 512, PV = 1024, PO = 1536, PGU = 2048, PGV = 2304, PCA = 2560, PCB = 2816;
constexpr size_t MiB = 1u << 20;
constexpr size_t WS_CTL = 0, CTL_ZERO_BYTES = 1 * MiB;
constexpr size_t WS_WIN = 2 * MiB, WS_WOUT = 8 * MiB, WS_WGU = 10 * MiB, WS_WD = 42 * MiB;
constexpr size_t WS_SMALL = 58 * MiB;
constexpr size_t SM_BIAS = WS_SMALL;
constexpr size_t SM_GATES = WS_SMALL + 64 * 1024;
constexpr size_t SM_SEL = SM_GATES + 512 * 1024;
constexpr size_t SM_HIST = SM_SEL + 256 * 1024;
constexpr size_t SM_META = SM_HIST + 16 * 1024;
constexpr size_t SM_TOKSLOT = SM_META + 4 * 1024;
constexpr size_t SM_G = SM_TOKSLOT + 128 * 1024;
constexpr size_t SM_MLOC = SM_G + 2048;
constexpr size_t SM_MPREV = SM_MLOC + 2048;
constexpr size_t SM_NLOC = SM_MPREV + 2048;
constexpr size_t SM_NPREV = SM_NLOC + 256 * 1024;
constexpr size_t SM_END = SM_NPREV + 256 * 1024;
constexpr size_t SM_WM = SM_END + 128 * 1024;
constexpr size_t SM_GW = SM_END;
static_assert(SM_WM + 128 * 1024 <= 62 * MiB, "small region");
constexpr size_t WS_XN = 62 * MiB, WS_HCAT = 94 * MiB, WS_XNB = 126 * MiB, WS_CLOCT = 190 * MiB, WS_CPREVT = 222 * MiB, WS_HID = 238 * MiB;
constexpr size_t WS_PROJ = 274 * MiB;
constexpr size_t WS_WGU2 = 370 * MiB, WS_WD2 = 402 * MiB;
constexpr size_t WS_END = 418 * MiB;
static_assert(WS_HID + (size_t)PADROWS * DEXP * 2 <= WS_PROJ && WS_PROJ + (size_t)PADROWS * D * 2 <= WS_END && WS_PROJ + (size_t)T * NPROJ * 2 <= WS_END, "ws map");
constexpr int CW_TMO = 0, CW_BAR = 4096, CW_CNT = 8192;
constexpr size_t WS_LIST = 158 * MiB;
constexpr int RING_BYTES = 131072, LDSCTL_OFF = 139264, MISC_OFF = LDSCTL_OFF + 320, PTR_OFF = LDSCTL_OFF + 512, VEC_OFF = LDSCTL_OFF + 1024, LDS_BYTES = 151552;

#define LAS __attribute__((address_space(3)))
typedef unsigned short bf16;
typedef unsigned v4u __attribute__((ext_vector_type(4)));
typedef unsigned v2u __attribute__((ext_vector_type(2)));
typedef float f32x4 __attribute__((ext_vector_type(4)));
typedef float f32x2 __attribute__((ext_vector_type(2)));
#define DI __device__ __forceinline__
typedef __bf16 bf16x2_t __attribute__((ext_vector_type(2)));
DI unsigned pk2(float lo, float hi) { const f32x2 v = {lo, hi}; return __builtin_bit_cast(unsigned, __builtin_convertvector(v, bf16x2_t)); }
DI unsigned f2bf(float f) { return pk2(f, 0.f) & 0xffffu; }
DI float bflo(unsigned w) { return __builtin_bit_cast(float, w << 16); }
DI float bfhi(unsigned w) { return __builtin_bit_cast(float, w & 0xffff0000u); }
DI float bf2f(bf16 h) { return __builtin_bit_cast(float, (unsigned)h << 16); }
DI float wave_sum_ref(float v) {
#pragma unroll
    for (int o = 1; o < 64; o <<= 1) v += __shfl_xor(v, o);
    return v;
}
template <int CTRL> DI float dpp_f(float v) { return __builtin_bit_cast(float, __builtin_amdgcn_update_dpp(0, __builtin_bit_cast(int, v), CTRL, 0xf, 0xf, false)); }
DI float row_sum16(float v) {
    v += dpp_f<0xB1>(v);
    v += dpp_f<0x4E>(v);
    v += dpp_f<0x141>(v);
    v += dpp_f<0x140>(v);
    return v;
}
DI float rl_f(float v, int l) { return __builtin_bit_cast(float, __builtin_amdgcn_readlane(__builtin_bit_cast(int, v), l)); }
DI float wave_sum(float v) { v = row_sum16(v); return (rl_f(v, 0) + rl_f(v, 16)) + (rl_f(v, 32) + rl_f(v, 48)); }
template <int N> DI int red_idx(int lane) { int idx = 0, n = N, o = 32; while (n > 1) { n >>= 1; if (lane & o) idx += n; o >>= 1; } return idx; }
typedef unsigned u32x2_t __attribute__((ext_vector_type(2)));
template <int N, int O> struct RedStep { template <int NN> static DI void run(float (&v)[NN], int lane) {
#pragma unroll
        for (int k = 0; k < N / 2; ++k) {
            if constexpr (O == 32) { float a = v[k], b = v[k + N / 2]; asm volatile("s_nop 1\n\tv_permlane32_swap_b32 %0, %1\n\ts_nop 1" : "+v"(a), "+v"(b)); v[k] = a + b; }
            else if constexpr (O == 16) { float a = v[k], b = v[k + N / 2]; asm volatile("s_nop 1\n\tv_permlane16_swap_b32 %0, %1\n\ts_nop 1" : "+v"(a), "+v"(b)); v[k] = a + b; }
            else { const bool up = (lane & O) != 0; const float keep = up ? v[k + N / 2] : v[k], send = up ? v[k] : v[k + N / 2];
                v[k] = keep + (O == 8 ? dpp_f<0x128>(send) : (O == 4 ? dpp_f<0x141>(send) : (O == 2 ? dpp_f<0x4E>(send) : dpp_f<0xB1>(send)))); } }
        RedStep<N / 2, O / 2>::run(v, lane); } };
template <int O> struct RedStep<1, O> { template <int NN> static DI void run(float (&v)[NN], int) {
        if constexpr (O == 32) { v[0] = wave_sum(v[0]); }
        else if constexpr (O == 16) { v[0] = row_sum16(v[0]); float a = v[0], b = v[0]; asm volatile("s_nop 1\n\tv_permlane16_swap_b32 %0, %1\n\ts_nop 1" : "+v"(a), "+v"(b)); v[0] = a + b; }
        else if constexpr (O == 8) { v[0] = row_sum16(v[0]); }
        else if constexpr (O == 4) { v[0] += dpp_f<0xB1>(v[0]); v[0] += dpp_f<0x4E>(v[0]); v[0] += dpp_f<0x141>(v[0]); }
        else if constexpr (O == 2) { v[0] += dpp_f<0xB1>(v[0]); v[0] += dpp_f<0x4E>(v[0]); }
        else if constexpr (O == 1) { v[0] += dpp_f<0xB1>(v[0]); } } };
template <> struct RedStep<1, 0> { template <int NN> static DI void run(float (&)[NN], int) {} };
template <int N> DI void red_multi(float (&v)[N], int lane) { RedStep<N, 32>::run(v, lane); }
DI float sigmoidf_(float x) { return __builtin_amdgcn_rcpf(1.0f + __builtin_amdgcn_exp2f(-1.4426950408889634f * x)); }
DI float gelu_tanh(float x) { const float t = x * x; const float p = x * __builtin_fmaf(t, -0.10294324f, -2.3022082f); return x * __builtin_amdgcn_rcpf(1.0f + __builtin_amdgcn_exp2f(p)); }
DI float logsigmoidf_(float x) { return fminf(x, 0.0f) - log1pf(__expf(-fabsf(x))); }

#define XB_TMO      128
#define XB_XCNT(j)  (256  + 64 * (j))
#define XB_XSUB(j)  (1280 + 64 * (j))
#define XB_XGEN(j)  (2304 + 64 * (j))
#define XB_TOP      3328
#define XB_TOPGEN   3392
#define XCD_BAR_WORDS 3456
#define XB_SPIN_CAP (1u << 18)
__device__ __forceinline__ unsigned xb_ld(unsigned* p)              { return __hip_atomic_load(p, __ATOMIC_RELAXED, __HIP_MEMORY_SCOPE_AGENT); }
__device__ __forceinline__ unsigned xb_add(unsigned* p, unsigned v) { return __hip_atomic_fetch_add(p, v, __ATOMIC_RELAXED, __HIP_MEMORY_SCOPE_AGENT); }
__device__ __forceinline__ unsigned xb_xcc_id() { return (unsigned)__builtin_amdgcn_s_getreg((3 << 11) | 20) & 0xFu; }
#define XB_SPIN(cond, bar) do { unsigned _sp = 0; while (cond) { __builtin_amdgcn_s_sleep(1); \
    if ((++_sp & 255u) == 0u) { if (xb_ld(&(bar)[XB_TMO])) break; if (_sp > XB_SPIN_CAP) { atomicAdd(&(bar)[XB_TMO], 1u); break; } } } } while (0)
struct XcdBarrier { unsigned* bar; unsigned x; volatile LAS unsigned* st; };
__device__ __forceinline__ XcdBarrier xcd_barrier_post(unsigned* bar, volatile LAS unsigned* st) {
    XcdBarrier b; b.bar = bar; b.x = xb_xcc_id(); b.st = st;
    if (threadIdx.x == 0) (void)xb_add(&bar[XB_XCNT(b.x)], 1u);
    return b;
}
__device__ __forceinline__ void xcd_barrier_complete(unsigned* bar, unsigned x, unsigned& nloc, unsigned& nx) {
    const unsigned G = gridDim.x * gridDim.y * gridDim.z;
    unsigned sum, cnt, mine, sp = 0u;
    for (;;) {
        sum = 0u; cnt = 0u; mine = 0u;
#pragma unroll
        for (unsigned j = 0; j < 16; ++j) { const unsigned c = xb_ld(&bar[XB_XCNT(j)]); sum += c; cnt += (c > 0u) ? 1u : 0u; mine = (j == x) ? c : mine; }
        if (sum == G) break;
        __builtin_amdgcn_s_sleep(1);
        if ((++sp & 255u) == 0u) { if (xb_ld(&bar[XB_TMO])) break; if (sp > XB_SPIN_CAP) { atomicAdd(&bar[XB_TMO], 1u); break; } }
    }
    nloc = mine > 0u ? mine : 1u; nx = cnt > 0u ? cnt : 1u;
}
template <bool FIRST> __device__ __forceinline__ void xcd_barrier(const XcdBarrier& b) {
    asm volatile("s_waitcnt vmcnt(0)" ::: "memory");
    __syncthreads();
    if (threadIdx.x == 0) {
        unsigned* bar = b.bar; unsigned bx = b.x; { int z_ = 0; asm volatile("" : "+s"(z_)); bar += z_; bx += (unsigned)z_; }
        __builtin_amdgcn_s_waitcnt(0);
        unsigned nloc = b.st[0], nx = b.st[1];
        if (FIRST) { if (nloc == 0u) { xcd_barrier_complete(bar, bx, nloc, nx); b.st[0] = nloc; b.st[1] = nx; } }
        const unsigned old = xb_add(&bar[XB_XSUB(bx)], 1u);
        const unsigned gen = old / nloc;
        if (old + 1u == (gen + 1u) * nloc) {
            __builtin_amdgcn_fence(__ATOMIC_RELEASE, "agent");
            asm volatile("s_waitcnt vmcnt(0)" ::: "memory");
            const unsigned og = xb_add(&bar[XB_TOP], 1u);
            const unsigned tg = og / nx;
            if (og + 1u == (tg + 1u) * nx) xb_add(&bar[XB_TOPGEN], 1u);
            else XB_SPIN(xb_ld(&bar[XB_TOPGEN]) == tg, bar);
            __builtin_amdgcn_fence(__ATOMIC_ACQUIRE, "agent");
            xb_add(&bar[XB_XGEN(bx)], 1u);
            asm volatile("s_waitcnt vmcnt(0)" ::: "memory");
        } else {
            XB_SPIN(xb_ld(&bar[XB_XGEN(bx)]) == gen, bar);
            __builtin_amdgcn_fence(__ATOMIC_ACQUIRE, "agent");
            asm volatile("s_waitcnt vmcnt(0)" ::: "memory");
        }
    }
    __syncthreads();
}

struct Args { const float* in[22]; float* out; unsigned char* ws; };
struct Ctx { LAS unsigned char* lds; int tid, lane, wave, bid; };
__device__ __forceinline__ Ctx fresh_ctx(const Ctx& C0) { Ctx C = C0; asm volatile("" : "+v"(C.tid)); asm volatile("" : "+s"(C.bid)); asm volatile("" : "+s"(C.lds)); C.lane = C.tid & 63; C.wave = __builtin_amdgcn_readfirstlane(C.tid >> 6); return C; }

DI void transpose_item(const float* src, int ld, int k0, int n0, bf16* dst, int K, int drow0, LAS float* scr, int lane) {
    float tv[32];
#pragma unroll
    for (int i = 0; i < 32; ++i) tv[i] = src[(size_t)(k0 + 2 * i + (lane >> 5)) * ld + n0 + (lane & 31)];
#pragma unroll
    for (int i = 0; i < 32; ++i) scr[(2 * i + (lane >> 5)) * 33 + (lane & 31)] = tv[i];
    asm volatile("s_waitcnt lgkmcnt(0)" ::: "memory");
    const int c = lane & 7;
#pragma unroll
    for (int j = 0; j < 4; ++j) { const int n = (lane >> 3) + 8 * j; const LAS float* s = scr + (8 * c) * 33 + n;
        v4u o; o.x = pk2(s[0 * 33], s[1 * 33]); o.y = pk2(s[2 * 33], s[3 * 33]); o.z = pk2(s[4 * 33], s[5 * 33]); o.w = pk2(s[6 * 33], s[7 * 33]);
        *(v4u*)(dst + (size_t)(drow0 + n) * K + k0 + 8 * c) = o; }
    asm volatile("s_waitcnt lgkmcnt(0)" ::: "memory");
}
constexpr int CV_IN = 16 * 96, CV_OUT = 16 * 32, CV_GU = 16 * 512, CV_D = 16 * 256, CV_ITEMS = CV_IN + CV_OUT + CV_GU + CV_D, CV_SPLIT = 9216;
DI size_t wgu_off(int l) { return (l & 1) ? WS_WGU2 : WS_WGU; }
DI size_t wd_off(int l) { return (l & 1) ? WS_WD2 : WS_WD; }
DI void convert_items(const Args& A, const Ctx& C, int l, int lo, int hi, int wrank, int nw) {
    LAS float* scr = (LAS float*)(C.lds + C.wave * 16384);
    bf16* WIN = (bf16*)(A.ws + WS_WIN); bf16* WOUT = (bf16*)(A.ws + WS_WOUT); bf16* WGU = (bf16*)(A.ws + wgu_off(l)); bf16* WD = (bf16*)(A.ws + wd_off(l));
    for (int it = lo + wrank; it < hi; it += nw) {
        int r = it;
        if (r < CV_IN) { const int kb = r / 96, nb = r % 96, n0 = 32 * nb; transpose_item(A.in[1] + (size_t)l * D * PIN, PIN, 64 * kb, n0 + (n0 >= 2048 ? 8 : 0), WIN, D, n0, scr, C.lane); continue; } r -= CV_IN;
        if (r < CV_OUT) { const int kb = r / 32, nb = r % 32; transpose_item(A.in[12] + (size_t)l * D * D, D, 64 * kb, 32 * nb, WOUT, D, 32 * nb, scr, C.lane); continue; } r -= CV_OUT;
        if (r < CV_GU) { const int e = r / 512, r1 = r % 512, half = r1 / 256, r2 = r1 % 256, kb = r2 / 16, nb = r2 % 16, j0 = 32 * nb;
            transpose_item((half ? A.in[18] : A.in[17]) + (size_t)(l * NEXP + e) * D * DEXP, DEXP, 64 * kb, j0, WGU, D, e * 1024 + (j0 / 128) * 256 + half * 128 + (j0 % 128), scr, C.lane); continue; } r -= CV_GU;
        { const int e = r / 256, r1 = r % 256, kb = r1 / 32, nb = r1 % 32;
            transpose_item(A.in[19] + (size_t)(l * NEXP + e) * DEXP * D, D, 64 * kb, 32 * nb, WD, DEXP, e * 1024 + 32 * nb, scr, C.lane); }
    }
}
DI void convert_small(const Args& A, const Ctx& C, int l) {
    { bf16* WM = (bf16*)(A.ws + SM_WM); const float* wsrc = A.in[6] + (size_t)l * 4 * CH * CH;
        for (int i = C.bid * NTHREADS + C.tid; i < 4 * CH * CH; i += GRID * NTHREADS) { const int s = i & 127, t = (i >> 7) & 127; WM[i] = (bf16)f2bf(s <= t ? wsrc[i] : 0.f); } }
    float* BIAS = (float*)(A.ws + SM_BIAS);
    for (int n = C.bid * NTHREADS + C.tid; n < NPROJ; n += GRID * NTHREADS) BIAS[n] = A.in[2][(size_t)l * PIN + n + (n >= 2048 ? 8 : 0)];
}
DI void phase_convert(const Args& A, const Ctx& C0, int l) { const Ctx C = fresh_ctx(C0);
    convert_items(A, C, l, 0, CV_ITEMS, C.bid * NWAVES + C.wave, GRID * NWAVES);
    convert_small(A, C, l);
}
DI void convert_in_tail(const Args& A, const Ctx& C0, int l, int lo, int hi, const unsigned* cnt, int cperm) { const Ctx C = fresh_ctx(C0);
    int tiles = 0;
#pragma unroll
    for (int e = 0; e < 16; ++e) tiles += ((int)__builtin_amdgcn_readfirstlane(__hip_atomic_load(cnt + 16 * e, __ATOMIC_RELAXED, __HIP_MEMORY_SCOPE_AGENT)) + 255) >> 8;
    const int nunits = tiles * 4, maxu = (nunits + GRID - 1) / GRID, nfull = nunits - (maxu - 1) * GRID;
    int rank = cperm - nfull, nidle = GRID - nfull;
    if (nidle == 0) { rank = cperm; nidle = GRID; }
    if (rank < 0) return;
    convert_items(A, C, l, lo, hi, rank * NWAVES + C.wave, nidle * NWAVES);
}
DI void stage_gate_weights(const Args& A, const Ctx& C, int lg) {
    LAS float* gwl = (LAS float*)C.lds;
    const float* w = A.in[1] + (size_t)lg * D * PIN + 2048;
    f32x4 gq[2][2];
#pragma unroll
    for (int k = 0; k < 2; ++k) { const int col = C.tid + k * NTHREADS; gq[k][0] = *(const f32x4*)(w + (size_t)col * PIN); gq[k][1] = *(const f32x4*)(w + (size_t)col * PIN + 4); }
#pragma unroll
    for (int k = 0; k < 2; ++k) { const int col = C.tid + k * NTHREADS;
        *(LAS f32x2*)(gwl + (0 * D + col) * 2) = (f32x2){gq[k][0][0], gq[k][0][1]}; *(LAS f32x2*)(gwl + (1 * D + col) * 2) = (f32x2){gq[k][0][2], gq[k][0][3]};
        *(LAS f32x2*)(gwl + (2 * D + col) * 2) = (f32x2){gq[k][1][0], gq[k][1][1]}; *(LAS f32x2*)(gwl + (3 * D + col) * 2) = (f32x2){gq[k][1][2], gq[k][1][3]}; }
}
DI void row_emit(const Args& A, const Ctx& C, int t, const f32x4 (&v)[4], float* xout, bf16* XN, int lg) {
    if (xout) {
#pragma unroll
        for (int j = 0; j < 4; ++j) *(f32x4*)(xout + (size_t)t * D + 256 * j + 4 * C.lane) = v[j];
    }
    if (XN) {
#pragma unroll
        for (int j = 0; j < 4; ++j) { v2u w; w.x = pk2(v[j][0], v[j][1]); w.y = pk2(v[j][2], v[j][3]); *(v2u*)(XN + (size_t)t * D + 256 * j + 4 * C.lane) = w; }
    }
    if (lg >= 0) {
        const LAS float* gwl = (const LAS float*)C.lds;
        float* GATES = (float*)(A.ws + SM_GATES);
        float gs[8];
#pragma unroll
        for (int gp = 0; gp < 4; ++gp) { f32x2 s2 = {0.f, 0.f};
#pragma unroll
            for (int j = 0; j < 4; ++j) { const f32x4 wa = *(const LAS f32x4*)(gwl + (gp * D + 256 * j + 4 * C.lane) * 2), wb = *(const LAS f32x4*)(gwl + (gp * D + 256 * j + 4 * C.lane) * 2 + 4);
                s2 += (f32x2){v[j][0], v[j][0]} * (f32x2){wa[0], wa[1]}; s2 += (f32x2){v[j][1], v[j][1]} * (f32x2){wa[2], wa[3]}; s2 += (f32x2){v[j][2], v[j][2]} * (f32x2){wb[0], wb[1]}; s2 += (f32x2){v[j][3], v[j][3]} * (f32x2){wb[2], wb[3]}; }
            gs[2 * gp] = s2[0]; gs[2 * gp + 1] = s2[1]; }
        red_multi<8>(gs, C.lane);
        if ((C.lane & 7) == 0) { const int g = red_idx<8>(C.lane); GATES[(size_t)t * 8 + g] = gs[0] + A.in[2][(size_t)lg * PIN + 2048 + g]; }
    }
}
DI void phase_prologue_rows(const Args& A, const Ctx& C0) { const Ctx C = fresh_ctx(C0);
    stage_gate_weights(A, C, 0);
    __syncthreads();
    for (int t = C.bid * NWAVES + C.wave; t < T; t += GRID * NWAVES) {
        f32x4 v[4];
#pragma unroll
        for (int j = 0; j < 4; ++j) v[j] = *(const f32x4*)(A.in[0] + (size_t)t * D + 256 * j + 4 * C.lane);
        row_emit(A, C, t, v, nullptr, (bf16*)(A.ws + WS_XN), 0);
    }
    __syncthreads();
}
DI void row_layernorm(f32x4 (&v)[4], const f32x4 (&ww)[4], const f32x4 (&bb)[4]) {
    float s = 0.f;
#pragma unroll
    for (int j = 0; j < 4; ++j) s += (v[j][0] + v[j][1]) + (v[j][2] + v[j][3]);
    const float mean = wave_sum(s) * (1.0f / D); float q = 0.f;
#pragma unroll
    for (int j = 0; j < 4; ++j) { v[j] = v[j] - mean; q += (v[j][0] * v[j][0] + v[j][1] * v[j][1]) + (v[j][2] * v[j][2] + v[j][3] * v[j][3]); }
    const float rstd = __builtin_amdgcn_rsqf(wave_sum(q) * (1.0f / D) + LN_EPS);
#pragma unroll
    for (int j = 0; j < 4; ++j) v[j] = v[j] * rstd * ww[j] + bb[j];
}
DI void load_ln(f32x4 (&ww)[4], f32x4 (&bb)[4], const float* w, const float* b, int lane) {
#pragma unroll
    for (int j = 0; j < 4; ++j) { ww[j] = *(const f32x4*)(w + 256 * j + 4 * lane); bb[j] = *(const f32x4*)(b + 256 * j + 4 * lane); }
}
DI void phase_ln1_router(const Args& A, const Ctx& C0, int l, bool dry = false) { const Ctx C = fresh_ctx(C0);
    LAS float* rwl = (LAS float*)C.lds;
    LAS int* hist = (LAS int*)(C.lds + VEC_OFF); LAS int* lbase = hist + 16, *le = hist + 32, *lrank = hist + 160;
    { f32x4 rq[8];
#pragma unroll
      for (int k = 0; k < 8; ++k) rq[k] = *(const f32x4*)(A.in[15] + (size_t)(C.tid + k * NTHREADS) * 4);
#pragma unroll
      for (int k = 0; k < 8; ++k) { const int i4 = C.tid + k * NTHREADS, col = i4 >> 2, e4 = (i4 & 3) * 4;
          *(LAS f32x2*)(rwl + ((e4 >> 1) * D + col) * 2) = (f32x2){rq[k][0], rq[k][1]}; *(LAS f32x2*)(rwl + (((e4 >> 1) + 1) * D + col) * 2) = (f32x2){rq[k][2], rq[k][3]}; } }
    if (C.tid < 16) hist[C.tid] = 0;
    __syncthreads();
    const bf16* X = (const bf16*)(A.ws + WS_XN);
    const bf16* Y = (const bf16*)(A.ws + WS_PROJ);
    bf16* XNB = (bf16*)(A.ws + WS_XNB);
    v4u* SEL = (v4u*)(A.ws + SM_SEL);
    float rb[16];
#pragma unroll
    for (int e = 0; e < 16; ++e) rb[e] = A.in[16][e];
    f32x4 lnw[4], lnb[4]; load_ln(lnw, lnb, A.in[13] + (size_t)l * D, A.in[14] + (size_t)l * D, C.lane);
    float lgall[16];
#pragma unroll
    for (int e = 0; e < 16; ++e) lgall[e] = 0.f;
    v2u xr[2][4], yr[2][4];
#pragma unroll
    for (int j = 0; j < 4; ++j) { const size_t o = (size_t)(C.bid * 64 + C.wave * 8) * D + 256 * j + 4 * C.lane; xr[0][j] = *(const v2u*)(X + o); yr[0][j] = *(const v2u*)(Y + o); }
#pragma unroll
    for (int i = 0; i < 8; ++i) {
        const int t = C.bid * 64 + C.wave * 8 + i;
        if (i < 7) {
#pragma unroll
            for (int j = 0; j < 4; ++j) { const size_t o = (size_t)(t + 1) * D + 256 * j + 4 * C.lane; xr[(i + 1) & 1][j] = *(const v2u*)(X + o); yr[(i + 1) & 1][j] = *(const v2u*)(Y + o); } }
        f32x4 v[4];
#pragma unroll
        for (int j = 0; j < 4; ++j) { const v2u x = xr[i & 1][j]; const v2u y = yr[i & 1][j];
            v[j][0] = ALPHA * bflo(x.x) + bflo(y.x); v[j][1] = ALPHA * bfhi(x.x) + bfhi(y.x); v[j][2] = ALPHA * bflo(x.y) + bflo(y.y); v[j][3] = ALPHA * bfhi(x.y) + bfhi(y.y); }
        row_layernorm(v, lnw, lnb);
        row_emit(A, C, t, v, nullptr, XNB, -1);
        float lg16[16];
#pragma unroll
        for (int ep = 0; ep < 8; ++ep) { f32x2 s2 = {0.f, 0.f};
#pragma unroll
            for (int j = 0; j < 4; ++j) { const f32x4 wa = *(const LAS f32x4*)(rwl + (ep * D + 256 * j + 4 * C.lane) * 2), wb = *(const LAS f32x4*)(rwl + (ep * D + 256 * j + 4 * C.lane) * 2 + 4);
                s2 += (f32x2){v[j][0], v[j][0]} * (f32x2){wa[0], wa[1]}; s2 += (f32x2){v[j][1], v[j][1]} * (f32x2){wa[2], wa[3]}; s2 += (f32x2){v[j][2], v[j][2]} * (f32x2){wb[0], wb[1]}; s2 += (f32x2){v[j][3], v[j][3]} * (f32x2){wb[2], wb[3]}; }
            lg16[2 * ep] = s2[0]; lg16[2 * ep + 1] = s2[1]; }
        red_multi<16>(lg16, C.lane);
#pragma unroll
        for (int e = 0; e < 16; ++e) { const int src = 32 * ((e >> 3) & 1) + 16 * ((e >> 2) & 1) + 8 * ((e >> 1) & 1) + 4 * (e & 1);
            const float uv = __builtin_bit_cast(float, __builtin_amdgcn_readlane(__builtin_bit_cast(int, lg16[0]), src)); lgall[e] = (C.lane == i) ? uv : lgall[e]; }
    }
    {
        float best = -INFINITY, bs0 = 0.f, bs1 = 0.f; int be0 = 0, be1 = 1;
#pragma unroll
        for (int g = 0; g < 4; ++g) {
            float sel[4], sg[4];
#pragma unroll
            for (int k = 0; k < 4; ++k) { const int e = 4 * g + k; sg[k] = sigmoidf_(lgall[e]); sel[k] = sg[k] + rb[e]; }
            float m1 = sel[0], s1 = sg[0]; int i1 = 0;
#pragma unroll
            for (int k = 1; k < 4; ++k) if (sel[k] > m1) { m1 = sel[k]; s1 = sg[k]; i1 = k; }
            float m2 = -INFINITY, s2 = 0.f; int i2 = 0;
#pragma unroll
            for (int k = 0; k < 4; ++k) if (k != i1 && sel[k] > m2) { m2 = sel[k]; s2 = sg[k]; i2 = k; }
            const float gsc = m1 + m2;
            if (gsc > best) { best = gsc; be0 = 4 * g + i1; be1 = 4 * g + i2; bs0 = s1; bs1 = s2; }
        }
        if (C.lane < 8) {
            const int t = C.bid * 64 + C.wave * 8 + C.lane;
            const float inv = __builtin_amdgcn_rcpf(bs0 + bs1);
            v4u o; o.x = (unsigned)be0; o.y = (unsigned)be1; o.z = __builtin_bit_cast(unsigned, bs0 * inv); o.w = __builtin_bit_cast(unsigned, bs1 * inv);
            SEL[t] = o;
            ((f32x2*)(A.ws + SM_GW))[t] = (f32x2){bs0 * inv, bs1 * inv};
            const int q = (C.wave * 8 + C.lane) * 2;
            le[q] = be0; lrank[q] = __hip_atomic_fetch_add(hist + be0, 1, __ATOMIC_RELAXED, __HIP_MEMORY_SCOPE_WORKGROUP);
            le[q + 1] = be1; lrank[q + 1] = __hip_atomic_fetch_add(hist + be1, 1, __ATOMIC_RELAXED, __HIP_MEMORY_SCOPE_WORKGROUP);
        }
    }
    __syncthreads();
    if (dry) return;
    if (C.tid < 16) lbase[C.tid] = (int)__hip_atomic_fetch_add((unsigned*)(A.ws + WS_CTL) + CW_CNT + (l * 16 + C.tid) * 16, (unsigned)hist[C.tid], __ATOMIC_RELAXED, __HIP_MEMORY_SCOPE_AGENT);
    __syncthreads();
    if (C.tid < 128) { const int e = le[C.tid], pos = lbase[e] + lrank[C.tid], t = C.bid * 64 + (C.tid >> 1);
        ((int*)(A.ws + WS_LIST))[(size_t)e * 16384 + pos] = t; ((int*)(A.ws + SM_TOKSLOT))[2 * t + (C.tid & 1)] = pos; }
    __syncthreads();
}
DI void phase_combine(const Args& A, const Ctx& C0, int l) { const Ctx C = fresh_ctx(C0);
    const bool last = (l == NLAYER - 1);
    if (!last) { stage_gate_weights(A, C, l + 1); convert_small(A, C, l + 1); }
    LAS int* tpl = (LAS int*)(C.lds + VEC_OFF);
    if (C.tid == 0) { int run = 0; for (int e = 0; e < 16; ++e) { tpl[e] = run; const int n = (int)__hip_atomic_load((const unsigned*)(A.ws + WS_CTL) + CW_CNT + (l * 16 + e) * 16, __ATOMIC_RELAXED, __HIP_MEMORY_SCOPE_AGENT); run += ((n + 255) >> 8) * 256; } }
    __syncthreads();
    const bf16* X1 = (const bf16*)(A.ws + WS_XNB); const bf16* YP = (const bf16*)(A.ws + WS_PROJ);
    const v4u* SEL = (const v4u*)(A.ws + SM_SEL); const int* TOKSLOT = (const int*)(A.ws + SM_TOKSLOT);
    f32x4 lnw[4], lnb[4]; load_ln(lnw, lnb, A.in[20] + (size_t)l * D, A.in[21] + (size_t)l * D, C.lane);
    const int tb = C.bid * 64 + C.wave * 8;
    int pp0[8], pp1[8]; float gg0[8], gg1[8];
#pragma unroll
    for (int i = 0; i < 8; ++i) { const int t = tb + i; const v4u s = SEL[t]; const f32x2 gw2 = ((const f32x2*)(A.ws + SM_GW))[t]; pp0[i] = tpl[s.x & 15u] + TOKSLOT[2 * t]; pp1[i] = tpl[s.y & 15u] + TOKSLOT[2 * t + 1]; gg0[i] = gw2[0]; gg1[i] = gw2[1]; }
    v2u xr[2][4], ar[2][4], br[2][4];
#pragma unroll
    for (int j = 0; j < 4; ++j) { xr[0][j] = *(const v2u*)(X1 + (size_t)tb * D + 256 * j + 4 * C.lane); ar[0][j] = *(const v2u*)(YP + (size_t)pp0[0] * D + 256 * j + 4 * C.lane); br[0][j] = *(const v2u*)(YP + (size_t)pp1[0] * D + 256 * j + 4 * C.lane); }
#pragma unroll
    for (int i = 0; i < 8; ++i) { const int t = tb + i;
        if (i < 7) {
#pragma unroll
            for (int j = 0; j < 4; ++j) { xr[(i + 1) & 1][j] = *(const v2u*)(X1 + (size_t)(t + 1) * D + 256 * j + 4 * C.lane); ar[(i + 1) & 1][j] = *(const v2u*)(YP + (size_t)pp0[(i + 1) & 7] * D + 256 * j + 4 * C.lane); br[(i + 1) & 1][j] = *(const v2u*)(YP + (size_t)pp1[(i + 1) & 7] * D + 256 * j + 4 * C.lane); } }
        const float g0 = gg0[i], g1 = gg1[i];
        f32x4 v[4];
#pragma unroll
        for (int j = 0; j < 4; ++j) { const v2u x = xr[i & 1][j], a = ar[i & 1][j], b = br[i & 1][j];
            v[j][0] = ALPHA * bflo(x.x) + g0 * bflo(a.x) + g1 * bflo(b.x); v[j][1] = ALPHA * bfhi(x.x) + g0 * bfhi(a.x) + g1 * bfhi(b.x);
            v[j][2] = ALPHA * bflo(x.y) + g0 * bflo(a.y) + g1 * bflo(b.y); v[j][3] = ALPHA * bfhi(x.y) + g0 * bfhi(a.y) + g1 * bfhi(b.y); }
        row_layernorm(v, lnw, lnb);
        row_emit(A, C, t, v, last ? A.out : nullptr, last ? nullptr : (bf16*)(A.ws + WS_XN), last ? -1 : l + 1);
    }
    __syncthreads();
}
DI void unpack8(const v4u w, float (&f)[8]) { f[0] = bflo(w.x); f[1] = bfhi(w.x); f[2] = bflo(w.y); f[3] = bfhi(w.y); f[4] = bflo(w.z); f[5] = bfhi(w.z); f[6] = bflo(w.w); f[7] = bfhi(w.w); }
DI void conv_unit(const Args& A, const Ctx& C0, int l, int unit) { const Ctx C = fresh_ctx(C0);
    const bf16* PROJ = (const bf16*)(A.ws + WS_PROJ); bf16* HCAT = (bf16*)(A.ws + WS_HCAT);
    LAS float* cin = (LAS float*)C.lds;
    LAS float* cou = (LAS float*)(C.lds + 65536);
    const int t0 = unit * 32, tseq = t0 & (SEQ - 1);
    float w[31];
#pragma unroll
    for (int j = 0; j < 31; ++j) w[j] = A.in[8][(size_t)(l * 31 + j) * 256 + (C.tid & 255)];
    const float bias = A.in[9][l * 256 + (C.tid & 255)];
    const f32x4 nw = *(const f32x4*)(A.in[10] + l * 256 + 4 * C.lane), nb = *(const f32x4*)(A.in[11] + l * 256 + 4 * C.lane);
    v4u cqa[4], cqb[4];
#pragma unroll
    for (int kq = 0; kq < 4; ++kq) { const int it = C.tid + kq * NTHREADS, r = it >> 5, c8 = (it & 31) * 8; const bool ok = (it < 62 * 32) && (tseq - 30 + r >= 0); const size_t rowo = ok ? (size_t)(t0 - 30 + r) * NPROJ : 0;
        cqa[kq] = ok ? *(const v4u*)(PROJ + rowo + PCA + c8) : (v4u){0u, 0u, 0u, 0u}; cqb[kq] = ok ? *(const v4u*)(PROJ + rowo + PCB + c8) : (v4u){0u, 0u, 0u, 0u}; }
#pragma unroll
    for (int kq = 0; kq < 4; ++kq) { const int it = C.tid + kq * NTHREADS; if (it >= 62 * 32) continue; const int r = it >> 5, c8 = (it & 31) * 8; float o[8];
        if (tseq - 30 + r >= 0) { float a[8], b[8]; unpack8(cqa[kq], a); unpack8(cqb[kq], b);
#pragma unroll
            for (int i = 0; i < 8; ++i) o[i] = a[i] * sigmoidf_(b[i]); }
        else {
#pragma unroll
            for (int i = 0; i < 8; ++i) o[i] = 0.f; }
        *(LAS f32x4*)(cin + r * 256 + c8) = (f32x4){o[0], o[1], o[2], o[3]}; *(LAS f32x4*)(cin + r * 256 + c8 + 4) = (f32x4){o[4], o[5], o[6], o[7]}; }
    __syncthreads();
    { const int c = C.tid & 255, half = C.tid >> 8;

        float xin[46];
#pragma unroll
        for (int r = 0; r < 46; ++r) xin[r] = cin[(half * 16 + r) * 256 + c];
#pragma unroll
        for (int i = 0; i < 16; ++i) { float acc = bias;
#pragma unroll
            for (int j = 0; j < 31; ++j) acc += xin[i + j] * w[j];
            cou[(half * 16 + i) * 256 + c] = acc; } }
    __syncthreads();
    {
#pragma unroll
        for (int q = 0; q < 4; ++q) { const int r = 4 * C.wave + q; f32x4 x = *(const LAS f32x4*)(cou + r * 256 + 4 * C.lane);
            const float mean = wave_sum((x[0] + x[1]) + (x[2] + x[3])) * (1.0f / 256.0f); x = x - mean;
            const float var = wave_sum((x[0] * x[0] + x[1] * x[1]) + (x[2] * x[2] + x[3] * x[3])) * (1.0f / 256.0f);
            const float rstd = __builtin_amdgcn_rsqf(var + LN_EPS); x = x * rstd * nw + nb;
            float o[4];
#pragma unroll
            for (int k = 0; k < 4; ++k) o[k] = x[k] * sigmoidf_(x[k]);
            v2u pk; pk.x = pk2(o[0], o[1]); pk.y = pk2(o[2], o[3]);
            *(v2u*)(HCAT + (size_t)(t0 + r) * D + 768 + 4 * C.lane) = pk; } }
    __syncthreads();
}
DI void gmlp_unit_simple(const Args& A, const Ctx& C0, int l, int ck) { const Ctx C = fresh_ctx(C0);
    const bf16* PROJ = (const bf16*)(A.ws + WS_PROJ); bf16* HCAT = (bf16*)(A.ws + WS_HCAT);
    LAS float* zs = (LAS float*)C.lds;
    const int t0 = ck * CH;
    { const f32x4 nw = *(const f32x4*)(A.in[4] + l * 256 + 4 * C.lane), nb = *(const f32x4*)(A.in[5] + l * 256 + 4 * C.lane);
        for (int i = 0; i < 16; ++i) { const int r = C.wave * 16 + i; const v2u g = *(const v2u*)(PROJ + (size_t)(t0 + r) * NPROJ + PGV + 4 * C.lane);
            f32x4 x = {gelu_tanh(bflo(g.x)), gelu_tanh(bfhi(g.x)), gelu_tanh(bflo(g.y)), gelu_tanh(bfhi(g.y))};
            const float mean = wave_sum((x[0] + x[1]) + (x[2] + x[3])) * (1.0f / 256.0f); x = x - mean;
            const float var = wave_sum((x[0] * x[0] + x[1] * x[1]) + (x[2] * x[2] + x[3] * x[3])) * (1.0f / 256.0f);
            const float rstd = __builtin_amdgcn_rsqf(var + LN_EPS); x = x * rstd * nw + nb;
            *(LAS f32x4*)(zs + r * 256 + 4 * C.lane) = x; } }
    __syncthreads();
    { const int tb = C.tid >> 4, cb = C.tid & 15, c0 = 16 * cb, h = cb >> 2, tr0 = 4 * tb;
        const float* ws = A.in[6] + (size_t)(l * 4 + h) * CH * CH;
        float acc[4][16];
#pragma unroll
        for (int i = 0; i < 4; ++i)
#pragma unroll
            for (int j = 0; j < 16; ++j) acc[i][j] = 0.f;
        for (int s = 0; s <= tr0 + 3; ++s) {
            float zv[16];
#pragma unroll
            for (int q = 0; q < 4; ++q) { const f32x4 z4 = *(const LAS f32x4*)(zs + s * 256 + c0 + 4 * q); zv[4 * q] = z4[0]; zv[4 * q + 1] = z4[1]; zv[4 * q + 2] = z4[2]; zv[4 * q + 3] = z4[3]; }
#pragma unroll
            for (int i = 0; i < 4; ++i) { const float wg = (s <= tr0 + i) ? ws[(size_t)(tr0 + i) * CH + s] : 0.f;
#pragma unroll
                for (int j = 0; j < 16; ++j) acc[i][j] += wg * zv[j]; }
        }
#pragma unroll
        for (int i = 0; i < 4; ++i) { const int tr = tr0 + i; const float bsv = A.in[7][(size_t)(l * 4 + h) * CH + tr]; const size_t rowo = (size_t)(t0 + tr) * NPROJ + PGU + c0;
            float u[16]; { float tmp[8]; unpack8(*(const v4u*)(PROJ + rowo), tmp);
#pragma unroll
                for (int j = 0; j < 8; ++j) u[j] = tmp[j];
                unpack8(*(const v4u*)(PROJ + rowo + 8), tmp);
#pragma unroll
                for (int j = 0; j < 8; ++j) u[8 + j] = tmp[j]; }
            float o[16];
#pragma unroll
            for (int j = 0; j < 16; ++j) o[j] = gelu_tanh(u[j]) * (acc[i][j] + bsv);
            v4u w0, w1; w0.x = pk2(o[0], o[1]); w0.y = pk2(o[2], o[3]); w0.z = pk2(o[4], o[5]); w0.w = pk2(o[6], o[7]); w1.x = pk2(o[8], o[9]); w1.y = pk2(o[10], o[11]); w1.z = pk2(o[12], o[13]); w1.w = pk2(o[14], o[15]);
            *(v4u*)(HCAT + (size_t)(t0 + tr) * D + 512 + c0) = w0; *(v4u*)(HCAT + (size_t)(t0 + tr) * D + 512 + c0 + 8) = w1; }
    }
    __syncthreads();
}
DI void mlstm_local_simple(const Args& A, const Ctx& C0, int un) { const Ctx C = fresh_ctx(C0);
    const bf16* PROJ = (const bf16*)(A.ws + WS_PROJ); const float* GATES = (const float*)(A.ws + SM_GATES);
    const int bh = un >> 5, c = un & 31, b = bh >> 2, h = bh & 3, t0 = b * SEQ + c * CH;
    LAS float* kw = (LAS float*)C.lds;
    LAS float* vs = (LAS float*)(C.lds + 65536);
    LAS float* vec = (LAS float*)(C.lds + VEC_OFF);
    if (C.tid < CH) { const float fp = GATES[(size_t)(t0 + C.tid) * 8 + 4 + h], ip = GATES[(size_t)(t0 + C.tid) * 8 + h]; vec[C.tid] = logsigmoidf_(fp); vec[128 + C.tid] = ip; }
    __syncthreads();
    if (C.tid == 0) { float run = 0.f; for (int i = 0; i < CH; ++i) { run += vec[i]; vec[i] = run; } const float g = run; float ml = -INFINITY;
        for (int i = 0; i < CH; ++i) { const float a = g - vec[i] + vec[128 + i]; vec[256 + i] = a; ml = fmaxf(ml, a); }
        for (int i = 0; i < CH; ++i) vec[256 + i] = __expf(vec[256 + i] - ml);
        ((float*)(A.ws + SM_G))[un] = g; ((float*)(A.ws + SM_MLOC))[un] = ml; }
    __syncthreads();
    for (int it = C.tid; it < CH * 16; it += NTHREADS) { const int r = it >> 4, c8 = (it & 15) * 8; const size_t rowo = (size_t)(t0 + r) * NPROJ + h * 128 + c8; float k8[8], v8[8];
        unpack8(*(const v4u*)(PROJ + rowo + PK), k8); unpack8(*(const v4u*)(PROJ + rowo + PV), v8); const float sc = vec[256 + r] * 0.08838834764831845f;
#pragma unroll
        for (int i = 0; i < 8; ++i) { kw[r * 128 + c8 + i] = k8[i] * sc; vs[r * 128 + c8 + i] = v8[i]; } }
    __syncthreads();
    { const int db = C.tid >> 4, eb = C.tid & 15, d0 = 4 * db, e0 = 8 * eb; float acc[4][8];
#pragma unroll
        for (int i = 0; i < 4; ++i)
#pragma unroll
            for (int j = 0; j < 8; ++j) acc[i][j] = 0.f;
        for (int r = 0; r < CH; ++r) { const f32x4 kd = *(const LAS f32x4*)(kw + r * 128 + d0); const f32x4 va = *(const LAS f32x4*)(vs + r * 128 + e0), vb = *(const LAS f32x4*)(vs + r * 128 + e0 + 4);
#pragma unroll
            for (int i = 0; i < 4; ++i) { acc[i][0] += kd[i] * va[0]; acc[i][1] += kd[i] * va[1]; acc[i][2] += kd[i] * va[2]; acc[i][3] += kd[i] * va[3]; acc[i][4] += kd[i] * vb[0]; acc[i][5] += kd[i] * vb[1]; acc[i][6] += kd[i] * vb[2]; acc[i][7] += kd[i] * vb[3]; } }
        float* CL = (float*)(A.ws + WS_CLOCT) + (size_t)un * CH * CH;
#pragma unroll
        for (int j = 0; j < 8; ++j) *(f32x4*)(CL + (size_t)(e0 + j) * CH + d0) = (f32x4){acc[0][j], acc[1][j], acc[2][j], acc[3][j]}; }
    if (C.tid < CH) { float s = 0.f; for (int r = 0; r < CH; ++r) s += kw[r * 128 + C.tid]; ((float*)(A.ws + SM_NLOC))[(size_t)un * CH + C.tid] = s; }
    __syncthreads();
}
DI void phase_scan(const Args& A, const Ctx& C0) { const Ctx C = fresh_ctx(C0);
    const int gt = C.bid * NTHREADS + C.tid, bh = gt >> 13, pr = gt & 8191;
    const float* G = (const float*)(A.ws + SM_G); const float* ML = (const float*)(A.ws + SM_MLOC); float* MP = (float*)(A.ws + SM_MPREV);
    const float* CL = (const float*)(A.ws + WS_CLOCT); unsigned* CP = (unsigned*)(A.ws + WS_CPREVT);
    const float* NL = (const float*)(A.ws + SM_NLOC); float* NP = (float*)(A.ws + SM_NPREV);
    float c0 = 0.f, c1 = 0.f, n0 = 0.f, n1 = 0.f, m = 0.f;
    for (int cb = 0; cb < NCH; cb += 8) {
        f32x2 cl[8], nl[8]; float g[8], ml[8];
#pragma unroll
        for (int i = 0; i < 8; ++i) { const int un = bh * NCH + cb + i; cl[i] = *(const f32x2*)(CL + (size_t)un * CH * CH + 2 * pr); g[i] = G[un]; ml[i] = ML[un]; nl[i] = (pr < 64) ? *(const f32x2*)(NL + (size_t)un * CH + 2 * pr) : (f32x2){0.f, 0.f}; }
#pragma unroll
        for (int i = 0; i < 8; ++i) { const int un = bh * NCH + cb + i;
            CP[(size_t)un * (CH * CH / 2) + pr] = pk2(c0, c1);
            if (pr == 0) MP[un] = m;
            if (pr < 64) *(f32x2*)(NP + (size_t)un * CH + 2 * pr) = (f32x2){n0, n1};
            const float mn = fmaxf(g[i] + m, ml[i]), dec = __expf(g[i] + m - mn), sc = __expf(ml[i] - mn);
            c0 = dec * c0 + sc * cl[i][0]; c1 = dec * c1 + sc * cl[i][1]; n0 = dec * n0 + sc * nl[i][0]; n1 = dec * n1 + sc * nl[i][1]; m = mn; }
    }
}
DI void mlstm_out_simple(const Args& A, const Ctx& C0, int l, int un) { const Ctx C = fresh_ctx(C0);
    const bf16* PROJ = (const bf16*)(A.ws + WS_PROJ); const float* GATES = (const float*)(A.ws + SM_GATES); bf16* HCAT = (bf16*)(A.ws + WS_HCAT);
    const int bh = un >> 5, c = un & 31, b = bh >> 2, h = bh & 3, t0 = b * SEQ + c * CH;
    LAS bf16* qs = (LAS bf16*)C.lds;
    LAS bf16* ks = (LAS bf16*)(C.lds + 32768);
    LAS float* ps = (LAS float*)(C.lds + 65536);
    LAS float* vec = (LAS float*)(C.lds + VEC_OFF);
    LAS float* bvec = vec, *uvec = vec + 128, *Mvec = vec + 256, *wint = vec + 384, *flo = vec + 512, *den = vec + 640, *npv = vec + 768, *ipv = vec + 896, *lfv = vec + 1024, *qnv = vec + 1152;
    if (C.tid < CH) { const float fp = GATES[(size_t)(t0 + C.tid) * 8 + 4 + h], ip = GATES[(size_t)(t0 + C.tid) * 8 + h]; lfv[C.tid] = logsigmoidf_(fp); ipv[C.tid] = ip; npv[C.tid] = ((const float*)(A.ws + SM_NPREV))[(size_t)un * CH + C.tid]; }
    __syncthreads();
    if (C.tid == 0) { const float mprev = ((const float*)(A.ws + SM_MPREV))[un]; float run = 0.f, pm = -INFINITY;
        for (int i = 0; i < CH; ++i) { run += lfv[i]; bvec[i] = run; const float u = ipv[i] - run; uvec[i] = u; pm = fmaxf(pm, u); const float M = fmaxf(mprev, pm); Mvec[i] = M; wint[i] = __expf(mprev - M); flo[i] = __expf(-(run + M)); } }
    for (int it = C.tid; it < CH * 16; it += NTHREADS) { const int r = it >> 4, c8 = (it & 15) * 8; const size_t rowo = (size_t)(t0 + r) * NPROJ + h * 128 + c8;
        *(LAS v4u*)(qs + r * 128 + c8) = *(const v4u*)(PROJ + rowo + PQ); *(LAS v4u*)(ks + r * 128 + c8) = *(const v4u*)(PROJ + rowo + PK); }
    __syncthreads();
    const int lb = C.tid >> 4, xb = C.tid & 15, l0 = 4 * lb, x0 = 8 * xb;
    {
        float acc[4][8];
#pragma unroll
        for (int i = 0; i < 4; ++i)
#pragma unroll
            for (int j = 0; j < 8; ++j) acc[i][j] = 0.f;
        if (x0 <= l0 + 3) {
            for (int d8 = 0; d8 < 16; ++d8) { float qf[4][8], kf[8];
#pragma unroll
                for (int i = 0; i < 4; ++i) unpack8(*(const LAS v4u*)(qs + (l0 + i) * 128 + d8 * 8), qf[i]);
#pragma unroll
                for (int j = 0; j < 8; ++j) { unpack8(*(const LAS v4u*)(ks + (x0 + j) * 128 + d8 * 8), kf);
#pragma unroll
                    for (int i = 0; i < 4; ++i) { float s = 0.f;
#pragma unroll
                        for (int dd = 0; dd < 8; ++dd) s += qf[i][dd] * kf[dd];
                        acc[i][j] += s; } } } }
#pragma unroll
        for (int i = 0; i < 4; ++i)
#pragma unroll
            for (int j = 0; j < 8; ++j) { const int li = l0 + i, sj = x0 + j; ps[li * 128 + sj] = (sj <= li) ? acc[i][j] * 0.08838834764831845f * __expf(uvec[sj] - Mvec[li]) : 0.f; }
    }
    __syncthreads();
    if (C.tid < CH) { const int li = C.tid; float s = 0.f; for (int k = 0; k < CH; ++k) s += ps[li * 128 + ((k + li) & 127)]; den[li] = s; }
    else if (C.tid < 2 * CH) { const int li = C.tid - CH; float s = 0.f; for (int k = 0; k < CH; ++k) { const int d = (k + li) & 127; s += bf2f(qs[li * 128 + d]) * npv[d]; } qnv[li] = s; }
    for (int it = C.tid; it < CH * 16; it += NTHREADS) { const int r = it >> 4, c8 = (it & 15) * 8; }
    __syncthreads();
    for (int it = C.tid; it < CH * 16; it += NTHREADS) { const int r = it >> 4, c8 = (it & 15) * 8; const size_t rowo = (size_t)(t0 + r) * NPROJ + h * 128 + c8; *(LAS v4u*)(ks + r * 128 + c8) = *(const v4u*)(PROJ + rowo + PV); }
    __syncthreads();
    float hv[4][8];
    {   const int e0 = x0; float acc[4][8], acc2[4][8];
#pragma unroll
        for (int i = 0; i < 4; ++i)
#pragma unroll
            for (int j = 0; j < 8; ++j) { acc[i][j] = 0.f; acc2[i][j] = 0.f; }
        for (int s = 0; s <= l0 + 3; ++s) { float vv[8]; unpack8(*(const LAS v4u*)(ks + s * 128 + e0), vv);
#pragma unroll
            for (int i = 0; i < 4; ++i) { const float p = ps[(l0 + i) * 128 + s];
#pragma unroll
                for (int j = 0; j < 8; ++j) acc[i][j] += p * vv[j]; } }
        const bf16* CPT = (const bf16*)(A.ws + WS_CPREVT) + (size_t)un * CH * CH;
        for (int d8 = 0; d8 < 16; ++d8) { float qf[4][8], cf[8];
#pragma unroll
            for (int i = 0; i < 4; ++i) unpack8(*(const LAS v4u*)(qs + (l0 + i) * 128 + d8 * 8), qf[i]);
#pragma unroll
            for (int j = 0; j < 8; ++j) { unpack8(*(const v4u*)(CPT + (size_t)(e0 + j) * CH + d8 * 8), cf);
#pragma unroll
                for (int i = 0; i < 4; ++i) { float s = 0.f;
#pragma unroll
                    for (int dd = 0; dd < 8; ++dd) s += qf[i][dd] * cf[dd];
                    acc2[i][j] += s; } } }
#pragma unroll
        for (int i = 0; i < 4; ++i) { const int li = l0 + i; const float wi = wint[li]; const float dn = den[li] + wi * qnv[li]; const float inv = 1.0f / fmaxf(fabsf(dn), flo[li]);
#pragma unroll
            for (int j = 0; j < 8; ++j) hv[i][j] = (acc[i][j] + wi * acc2[i][j]) * inv; }
    }
    __syncthreads();
#pragma unroll
    for (int i = 0; i < 4; ++i)
#pragma unroll
        for (int j = 0; j < 8; ++j) ps[(l0 + i) * 128 + x0 + j] = hv[i][j];
    __syncthreads();
    { const f32x2 nw = *(const f32x2*)(A.in[3] + (size_t)l * 512 + h * 128 + 2 * C.lane);
        for (int i = 0; i < 16; ++i) { const int li = C.wave * 16 + i; f32x2 x = *(const LAS f32x2*)(ps + li * 128 + 2 * C.lane);
            const float mean = wave_sum(x[0] + x[1]) * (1.0f / 128.0f); x = x - mean; const float var = wave_sum(x[0] * x[0] + x[1] * x[1]) * (1.0f / 128.0f);
            const float rstd = 1.0f / sqrtf(var + 1e-6f); const unsigned ow = *(const unsigned*)(PROJ + (size_t)(t0 + li) * NPROJ + PO + h * 128 + 2 * C.lane);
            const float o0 = sigmoidf_(bflo(ow)) * (x[0] * rstd * nw[0]), o1 = sigmoidf_(bfhi(ow)) * (x[1] * rstd * nw[1]);
            *(unsigned*)(HCAT + (size_t)(t0 + li) * D + h * 128 + 2 * C.lane) = pk2(o0, o1); } }
    __syncthreads();
}
typedef short bf16x8 __attribute__((ext_vector_type(8)));
DI f32x4 mfma16(bf16x8 a, bf16x8 b, f32x4 c) { return __builtin_amdgcn_mfma_f32_16x16x32_bf16(a, b, c, 0, 0, 0); }
constexpr int LDT = 136;
constexpr int TILE_B = 128 * LDT * 2;
DI float wave_scan_add(float v, int lane) {
#pragma unroll
    for (int o = 1; o < 64; o <<= 1) { const float t = __shfl_up(v, o); if (lane >= o) v += t; }
    return v;
}
DI float wave_scan_max(float v, int lane) {
#pragma unroll
    for (int o = 1; o < 64; o <<= 1) { const float t = __shfl_up(v, o); if (lane >= o) v = fmaxf(v, t); }
    return v;
}
DI float wave_max(float v) {
#pragma unroll
    for (int o = 1; o < 64; o <<= 1) v = fmaxf(v, __shfl_xor(v, o));
    return v;
}
DI float red16(float v) { return row_sum16(v); }

DI void mlstm_local_mfma(const Args& A, const Ctx& C0, int un) { const Ctx C = fresh_ctx(C0);
    const bf16* PROJ = (const bf16*)(A.ws + WS_PROJ); const float* GATES = (const float*)(A.ws + SM_GATES);
    const int bh = un >> 5, c = un & 31, b = bh >> 2, h = bh & 3, t0 = b * SEQ + c * CH;
    LAS bf16* VT = (LAS bf16*)C.lds;
    LAS bf16* KWT = (LAS bf16*)(C.lds + TILE_B);
    LAS float* wv = (LAS float*)(C.lds + VEC_OFF);
    v4u kq4[4], vq4[4];
#pragma unroll
    for (int kq = 0; kq < 4; ++kq) { const int it = C.tid + kq * NTHREADS; const int r = it & 127, c8 = (it >> 7) * 8; const size_t rowo = (size_t)(t0 + r) * NPROJ + h * 128 + c8; kq4[kq] = *(const v4u*)(PROJ + rowo + PK); vq4[kq] = *(const v4u*)(PROJ + rowo + PV); }
    if (C.wave == 0) {
        const int l0 = 2 * C.lane; const f32x4 ga = *(const f32x4*)(GATES + (size_t)(t0 + l0) * 8), gb = *(const f32x4*)(GATES + (size_t)(t0 + l0) * 8 + 4), gc = *(const f32x4*)(GATES + (size_t)(t0 + l0 + 1) * 8), gd = *(const f32x4*)(GATES + (size_t)(t0 + l0 + 1) * 8 + 4);
        const float ip0 = h == 0 ? ga[0] : (h == 1 ? ga[1] : (h == 2 ? ga[2] : ga[3])), fp0 = h == 0 ? gb[0] : (h == 1 ? gb[1] : (h == 2 ? gb[2] : gb[3]));
        const float ip1 = h == 0 ? gc[0] : (h == 1 ? gc[1] : (h == 2 ? gc[2] : gc[3])), fp1 = h == 0 ? gd[0] : (h == 1 ? gd[1] : (h == 2 ? gd[2] : gd[3]));
        const float lf0 = logsigmoidf_(fp0), lf1 = logsigmoidf_(fp1);
        const float incl = wave_scan_add(lf0 + lf1, C.lane), b1 = incl, b0 = incl - lf1;
        const float g = __shfl(incl, 63);
        const float a0 = g - b0 + ip0, a1 = g - b1 + ip1, ml = wave_max(fmaxf(a0, a1));
        wv[l0] = __expf(a0 - ml); wv[l0 + 1] = __expf(a1 - ml);
        if (C.lane == 0) { ((float*)(A.ws + SM_G))[un] = g; ((float*)(A.ws + SM_MLOC))[un] = ml; }
    }
    __syncthreads();
#pragma unroll
    for (int kq = 0; kq < 4; ++kq) { const int it = C.tid + kq * NTHREADS; const int r = it & 127, c8 = (it >> 7) * 8; float k8[8];
        unpack8(kq4[kq], k8); const v4u vv = vq4[kq]; const float sc = wv[r] * 0.08838834764831845f;
        const unsigned vw[4] = {vv.x, vv.y, vv.z, vv.w};
#pragma unroll
        for (int i = 0; i < 8; ++i) { KWT[(c8 + i) * LDT + r] = (bf16)f2bf(k8[i] * sc); VT[(c8 + i) * LDT + r] = (bf16)((i & 1) ? (vw[i >> 1] >> 16) : (vw[i >> 1] & 0xffffu)); } }
    __syncthreads();
    { const int fr = C.lane & 15, fg = C.lane >> 4, w = C.wave;
        bf16x8 a[4];
#pragma unroll
        for (int ks = 0; ks < 4; ++ks) a[ks] = *(const LAS bf16x8*)(VT + (16 * w + fr) * LDT + 32 * ks + 8 * fg);
        float* CL = (float*)(A.ws + WS_CLOCT) + (size_t)un * CH * CH;
#pragma unroll
        for (int dt = 0; dt < 8; ++dt) { f32x4 acc = {0.f, 0.f, 0.f, 0.f};
#pragma unroll
            for (int ks = 0; ks < 4; ++ks) { const bf16x8 bb = *(const LAS bf16x8*)(KWT + (16 * dt + fr) * LDT + 32 * ks + 8 * fg); acc = mfma16(a[ks], bb, acc); }
#pragma unroll
            for (int rg = 0; rg < 4; ++rg) CL[(size_t)(16 * w + 4 * fg + rg) * CH + 16 * dt + fr] = acc[rg]; } }
    if (C.tid < CH) { float s = 0.f;
#pragma unroll
        for (int q = 0; q < 16; ++q) { float f[8]; unpack8(*(const LAS v4u*)(KWT + C.tid * LDT + 8 * q), f); s += ((f[0] + f[1]) + (f[2] + f[3])) + ((f[4] + f[5]) + (f[6] + f[7])); }
        ((float*)(A.ws + SM_NLOC))[(size_t)un * CH + C.tid] = s; }
    __syncthreads();
}
DI void mlstm_out_mfma(const Args& A, const Ctx& C0, int l, int un) { const Ctx C = fresh_ctx(C0);
    const bf16* PROJ = (const bf16*)(A.ws + WS_PROJ); const float* GATES = (const float*)(A.ws + SM_GATES); bf16* HCAT = (bf16*)(A.ws + WS_HCAT);
    const int bh = un >> 5, c = un & 31, b = bh >> 2, h = bh & 3, t0 = b * SEQ + c * CH;
    LAS bf16* QS = (LAS bf16*)C.lds;
    LAS bf16* KS = (LAS bf16*)(C.lds + TILE_B);
    LAS bf16* PS = (LAS bf16*)(C.lds + 2 * TILE_B);
    LAS bf16* CT = (LAS bf16*)(C.lds + 3 * TILE_B);
    LAS float* vec = (LAS float*)(C.lds + VEC_OFF);
    LAS float* uvec = vec, *Mvec = vec + 128, *wint = vec + 256, *flo = vec + 384; LAS bf16* npb = (LAS bf16*)(vec + 512);
    if (C.wave == 0) {
        const int l0 = 2 * C.lane; const f32x4 ga = *(const f32x4*)(GATES + (size_t)(t0 + l0) * 8), gb = *(const f32x4*)(GATES + (size_t)(t0 + l0) * 8 + 4), gc = *(const f32x4*)(GATES + (size_t)(t0 + l0 + 1) * 8), gd = *(const f32x4*)(GATES + (size_t)(t0 + l0 + 1) * 8 + 4);
        const float ip0 = h == 0 ? ga[0] : (h == 1 ? ga[1] : (h == 2 ? ga[2] : ga[3])), fp0 = h == 0 ? gb[0] : (h == 1 ? gb[1] : (h == 2 ? gb[2] : gb[3]));
        const float ip1 = h == 0 ? gc[0] : (h == 1 ? gc[1] : (h == 2 ? gc[2] : gc[3])), fp1 = h == 0 ? gd[0] : (h == 1 ? gd[1] : (h == 2 ? gd[2] : gd[3]));
        const float lf0 = logsigmoidf_(fp0), lf1 = logsigmoidf_(fp1);
        const float incl = wave_scan_add(lf0 + lf1, C.lane), b1 = incl, b0 = incl - lf1;
        const float u0 = ip0 - b0, u1 = ip1 - b1;
        const float pm_incl = wave_scan_max(fmaxf(u0, u1), C.lane); const float pm_prev = __shfl_up(pm_incl, 1);
        const float pm0 = C.lane == 0 ? u0 : fmaxf(pm_prev, u0), pm1 = pm_incl;
        const float mprev = ((const float*)(A.ws + SM_MPREV))[un];
        const float M0 = fmaxf(mprev, pm0), M1 = fmaxf(mprev, pm1);
        uvec[l0] = u0; uvec[l0 + 1] = u1; Mvec[l0] = M0; Mvec[l0 + 1] = M1; wint[l0] = __expf(mprev - M0); wint[l0 + 1] = __expf(mprev - M1); flo[l0] = __expf(-(b0 + M0)); flo[l0 + 1] = __expf(-(b1 + M1));
        const f32x2 np2 = *(const f32x2*)((const float*)(A.ws + SM_NPREV) + (size_t)un * CH + l0); *(LAS unsigned*)(npb + l0) = pk2(np2[0], np2[1]);
    }
    { const bf16* CPT = (const bf16*)(A.ws + WS_CPREVT) + (size_t)un * CH * CH;
        v4u sq[4], sk[4], sc[4];
#pragma unroll
        for (int kq = 0; kq < 4; ++kq) { const int it = C.tid + kq * NTHREADS, r = it >> 4, c8 = (it & 15) * 8; const size_t rowo = (size_t)(t0 + r) * NPROJ + h * 128 + c8;
            sq[kq] = *(const v4u*)(PROJ + rowo + PQ); sk[kq] = *(const v4u*)(PROJ + rowo + PK); sc[kq] = *(const v4u*)(CPT + (size_t)r * CH + c8); }
#pragma unroll
        for (int kq = 0; kq < 4; ++kq) { const int it = C.tid + kq * NTHREADS, r = it >> 4, c8 = (it & 15) * 8;
            *(LAS v4u*)(QS + r * LDT + c8) = sq[kq]; *(LAS v4u*)(KS + r * LDT + c8) = sk[kq]; *(LAS v4u*)(CT + r * LDT + c8) = sc[kq]; } }
    v4u vpre[4];
#pragma unroll
    for (int kq = 0; kq < 4; ++kq) { const int it = C.tid + kq * NTHREADS; const int r = it & 127, c8 = (it >> 7) * 8; vpre[kq] = *(const v4u*)(PROJ + (size_t)(t0 + r) * NPROJ + h * 128 + c8 + PV); }
    v4u opre[4];
#pragma unroll
    for (int q = 0; q < 4; ++q) opre[q] = *(const v4u*)(PROJ + (size_t)(t0 + (C.tid >> 2)) * NPROJ + PO + h * 128 + (C.tid & 3) * 32 + 8 * q);
    __syncthreads();
    const int fr = C.lane & 15, fg = C.lane >> 4, w = C.wave;
    bf16x8 aq[4];
#pragma unroll
    for (int ks = 0; ks < 4; ++ks) aq[ks] = *(const LAS bf16x8*)(QS + (16 * w + fr) * LDT + 32 * ks + 8 * fg);
    float Ml[4], wl[4], inv[4];
#pragma unroll
    for (int rg = 0; rg < 4; ++rg) { Ml[rg] = Mvec[16 * w + 4 * fg + rg]; wl[rg] = wint[16 * w + 4 * fg + rg]; }
    {   float rs[4] = {0.f, 0.f, 0.f, 0.f};
#pragma unroll
        for (int st = 0; st < 8; ++st) {
            if (st <= w) { f32x4 acc = {0.f, 0.f, 0.f, 0.f};
#pragma unroll
                for (int ks = 0; ks < 4; ++ks) { const bf16x8 bb = *(const LAS bf16x8*)(KS + (16 * st + fr) * LDT + 32 * ks + 8 * fg); acc = mfma16(aq[ks], bb, acc); }
                const int s = 16 * st + fr; const float us = uvec[s];
#pragma unroll
                for (int rg = 0; rg < 4; ++rg) { const int li = 16 * w + 4 * fg + rg; const float p = (s <= li) ? acc[rg] * 0.08838834764831845f * __expf(us - Ml[rg]) : 0.f; rs[rg] += p; PS[li * LDT + s] = (bf16)f2bf(p); } }
            else if (st == w + 1 && (w & 1) == 0) {
#pragma unroll
                for (int rg = 0; rg < 4; ++rg) PS[(16 * w + 4 * fg + rg) * LDT + 16 * st + fr] = (bf16)0; }
        }
        f32x4 an = {0.f, 0.f, 0.f, 0.f};
#pragma unroll
        for (int ks = 0; ks < 4; ++ks) { bf16x8 bn = *(const LAS bf16x8*)(npb + 32 * ks + 8 * fg); if (fr != 0) bn = (bf16x8){0, 0, 0, 0, 0, 0, 0, 0}; an = mfma16(aq[ks], bn, an); }
#pragma unroll
        for (int rg = 0; rg < 4; ++rg) { const float qn = __shfl(an[rg], 16 * fg); const float dn = red16(rs[rg]) + wl[rg] * qn; inv[rg] = __builtin_amdgcn_rcpf(fmaxf(fabsf(dn), flo[16 * w + 4 * fg + rg])); }
    }
    __syncthreads();
#pragma unroll
    for (int kq = 0; kq < 4; ++kq) { const int it = C.tid + kq * NTHREADS; const int r = it & 127, c8 = (it >> 7) * 8; const unsigned vw[4] = {vpre[kq].x, vpre[kq].y, vpre[kq].z, vpre[kq].w};
#pragma unroll
        for (int i = 0; i < 8; ++i) KS[(c8 + i) * LDT + r] = (bf16)((i & 1) ? (vw[i >> 1] >> 16) : (vw[i >> 1] & 0xffffu)); }
    __syncthreads();
    {   const int nk2 = (w >> 1) + 1;
        bf16x8 ap[4];
#pragma unroll
        for (int k2 = 0; k2 < 4; ++k2) ap[k2] = (k2 < nk2) ? *(const LAS bf16x8*)(PS + (16 * w + fr) * LDT + 32 * k2 + 8 * fg) : (bf16x8){0, 0, 0, 0, 0, 0, 0, 0};
        float hv[8][4]; float sm[4] = {0.f, 0.f, 0.f, 0.f};
#pragma unroll
        for (int et = 0; et < 8; ++et) { f32x4 a1 = {0.f, 0.f, 0.f, 0.f}, a2 = {0.f, 0.f, 0.f, 0.f};
#pragma unroll
            for (int k2 = 0; k2 < 4; ++k2) if (k2 < nk2) { const bf16x8 bb = *(const LAS bf16x8*)(KS + (16 * et + fr) * LDT + 32 * k2 + 8 * fg); a1 = mfma16(ap[k2], bb, a1); }
#pragma unroll
            for (int ks = 0; ks < 4; ++ks) { const bf16x8 bb = *(const LAS bf16x8*)(CT + (16 * et + fr) * LDT + 32 * ks + 8 * fg); a2 = mfma16(aq[ks], bb, a2); }
#pragma unroll
            for (int rg = 0; rg < 4; ++rg) { hv[et][rg] = (a1[rg] + wl[rg] * a2[rg]) * inv[rg]; sm[rg] += hv[et][rg]; } }
        float mean[4], rstd[4];
#pragma unroll
        for (int rg = 0; rg < 4; ++rg) { mean[rg] = red16(sm[rg]) * (1.0f / 128.0f); float q = 0.f;
#pragma unroll
            for (int et = 0; et < 8; ++et) { const float dlt = hv[et][rg] - mean[rg]; q += dlt * dlt; }
            rstd[rg] = __builtin_amdgcn_rsqf(red16(q) * (1.0f / 128.0f) + 1e-6f); }
#pragma unroll
        for (int et = 0; et < 8; ++et) { const int e = 16 * et + fr; const float nw = A.in[3][(size_t)l * 512 + h * 128 + e];
#pragma unroll
            for (int rg = 0; rg < 4; ++rg) { const int li = 16 * w + 4 * fg + rg; PS[li * LDT + e] = (bf16)f2bf((hv[et][rg] - mean[rg]) * rstd[rg] * nw); } }
    }
    __syncthreads();
    { const int r = C.tid >> 2, cg = (C.tid & 3) * 32;
#pragma unroll
        for (int q = 0; q < 4; ++q) { float hn[8], ov[8]; unpack8(*(const LAS v4u*)(PS + r * LDT + cg + 8 * q), hn); unpack8(opre[q], ov);
            v4u o4; o4.x = pk2(sigmoidf_(ov[0]) * hn[0], sigmoidf_(ov[1]) * hn[1]); o4.y = pk2(sigmoidf_(ov[2]) * hn[2], sigmoidf_(ov[3]) * hn[3]); o4.z = pk2(sigmoidf_(ov[4]) * hn[4], sigmoidf_(ov[5]) * hn[5]); o4.w = pk2(sigmoidf_(ov[6]) * hn[6], sigmoidf_(ov[7]) * hn[7]);
            *(v4u*)(HCAT + (size_t)(t0 + r) * D + h * 128 + cg + 8 * q) = o4; } }
    __syncthreads();
}
DI void gmlp_chunk_mfma(const Args& A, const Ctx& C0, int l, int ck) { const Ctx C = fresh_ctx(C0);
    const bf16* PROJ = (const bf16*)(A.ws + WS_PROJ); bf16* HCAT = (bf16*)(A.ws + WS_HCAT); const bf16* WM = (const bf16*)(A.ws + SM_WM);
    const int t0 = ck * CH;
    LAS bf16* ZT = (LAS bf16*)C.lds;
    LAS float* OUTS = (LAS float*)(C.lds + 69632);
    { const f32x4 nw = *(const f32x4*)(A.in[4] + l * 256 + 4 * C.lane), nb = *(const f32x4*)(A.in[5] + l * 256 + 4 * C.lane);
        v2u gvr[16];
#pragma unroll
        for (int i = 0; i < 16; ++i) gvr[i] = *(const v2u*)(PROJ + (size_t)(t0 + C.wave * 16 + i) * NPROJ + PGV + 4 * C.lane);
#pragma unroll
        for (int i = 0; i < 16; ++i) { const int r = C.wave * 16 + i; const v2u g = gvr[i];
            f32x4 x = {gelu_tanh(bflo(g.x)), gelu_tanh(bfhi(g.x)), gelu_tanh(bflo(g.y)), gelu_tanh(bfhi(g.y))};
            const float mean = wave_sum((x[0] + x[1]) + (x[2] + x[3])) * (1.0f / 256.0f); x = x - mean;
            const float var = wave_sum((x[0] * x[0] + x[1] * x[1]) + (x[2] * x[2] + x[3] * x[3])) * (1.0f / 256.0f);
            const float rstd = __builtin_amdgcn_rsqf(var + LN_EPS); x = x * rstd * nw + nb;
            const unsigned p01 = pk2(x[0], x[1]), p23 = pk2(x[2], x[3]);
            ZT[(4 * C.lane + 0) * LDT + r] = (bf16)(p01 & 0xffffu); ZT[(4 * C.lane + 1) * LDT + r] = (bf16)(p01 >> 16); ZT[(4 * C.lane + 2) * LDT + r] = (bf16)(p23 & 0xffffu); ZT[(4 * C.lane + 3) * LDT + r] = (bf16)(p23 >> 16); } }
    __syncthreads();
    const int fr = C.lane & 15, fg = C.lane >> 4, w = C.wave, nk = (w >> 1) + 1;
#pragma unroll
    for (int hp = 0; hp < 2; ++hp) {
#pragma unroll
        for (int h2 = 0; h2 < 2; ++h2) { const int hh = 2 * hp + h2;
            bf16x8 a[4];
#pragma unroll
            for (int ks = 0; ks < 4; ++ks) a[ks] = (ks < nk) ? *(const bf16x8*)(WM + ((size_t)(hh * CH + 16 * w + fr) * CH + 32 * ks + 8 * fg)) : (bf16x8){0, 0, 0, 0, 0, 0, 0, 0};
#pragma unroll
            for (int dt = 0; dt < 4; ++dt) { f32x4 acc = {0.f, 0.f, 0.f, 0.f};
#pragma unroll
                for (int ks = 0; ks < 4; ++ks) if (ks < nk) { const bf16x8 bb = *(const LAS bf16x8*)(ZT + (64 * hh + 16 * dt + fr) * LDT + 32 * ks + 8 * fg); acc = mfma16(a[ks], bb, acc); }
#pragma unroll
                for (int rg = 0; rg < 4; ++rg) OUTS[(16 * w + 4 * fg + rg) * 136 + 64 * h2 + 16 * dt + fr] = acc[rg]; } }
        __syncthreads();
        { const int r = C.tid >> 2, cg = (C.tid & 3) * 32, hh = 2 * hp + (cg >> 6); const float bsv = A.in[7][(size_t)(l * 4 + hh) * CH + r];
#pragma unroll
            for (int q = 0; q < 4; ++q) { float u[8]; unpack8(*(const v4u*)(PROJ + (size_t)(t0 + r) * NPROJ + PGU + 128 * hp + cg + 8 * q), u);
                const f32x4 a0 = *(const LAS f32x4*)(OUTS + r * 136 + cg + 8 * q), a1 = *(const LAS f32x4*)(OUTS + r * 136 + cg + 8 * q + 4);
                v4u o4; o4.x = pk2(gelu_tanh(u[0]) * (a0[0] + bsv), gelu_tanh(u[1]) * (a0[1] + bsv)); o4.y = pk2(gelu_tanh(u[2]) * (a0[2] + bsv), gelu_tanh(u[3]) * (a0[3] + bsv));
                o4.z = pk2(gelu_tanh(u[4]) * (a1[0] + bsv), gelu_tanh(u[5]) * (a1[1] + bsv)); o4.w = pk2(gelu_tanh(u[6]) * (a1[2] + bsv), gelu_tanh(u[7]) * (a1[3] + bsv));
                *(v4u*)(HCAT + (size_t)(t0 + r) * D + 512 + 128 * hp + cg + 8 * q) = o4; } }
        __syncthreads();
    }
}
DI void gmlp_unit_mfma(const Args& A, const Ctx& C0, int l, int unit) { const Ctx C = fresh_ctx(C0);
    const bf16* PROJ = (const bf16*)(A.ws + WS_PROJ); bf16* HCAT = (bf16*)(A.ws + WS_HCAT); const bf16* WM = (const bf16*)(A.ws + SM_WM);
    const int ck = unit >> 2, hh = unit & 3, t0 = ck * CH;
    LAS bf16* ZT = (LAS bf16*)C.lds;
    LAS float* OUTS = (LAS float*)(C.lds + 32768);
    bf16x8 awm[4];
    { const int fr = C.lane & 15, fg = C.lane >> 4, w = C.wave, nk = (w >> 1) + 1;
#pragma unroll
        for (int ks = 0; ks < 4; ++ks) awm[ks] = (ks < nk) ? *(const bf16x8*)(WM + ((size_t)(hh * CH + 16 * w + fr) * CH + 32 * ks + 8 * fg)) : (bf16x8){0, 0, 0, 0, 0, 0, 0, 0}; }
    const v4u gu0 = *(const v4u*)(PROJ + (size_t)(t0 + (C.tid >> 2)) * NPROJ + PGU + 64 * hh + (C.tid & 3) * 16), gu1 = *(const v4u*)(PROJ + (size_t)(t0 + (C.tid >> 2)) * NPROJ + PGU + 64 * hh + (C.tid & 3) * 16 + 8);
    const float bsv0 = A.in[7][(size_t)(l * 4 + hh) * CH + (C.tid >> 2)];
    { const f32x4 nw = *(const f32x4*)(A.in[4] + l * 256 + 4 * C.lane), nb = *(const f32x4*)(A.in[5] + l * 256 + 4 * C.lane);
        v2u gvr[16];
#pragma unroll
        for (int i = 0; i < 16; ++i) gvr[i] = *(const v2u*)(PROJ + (size_t)(t0 + C.wave * 16 + i) * NPROJ + PGV + 4 * C.lane);
#pragma unroll
        for (int i = 0; i < 16; ++i) { const int r = C.wave * 16 + i; const v2u g = gvr[i];
            f32x4 x = {gelu_tanh(bflo(g.x)), gelu_tanh(bfhi(g.x)), gelu_tanh(bflo(g.y)), gelu_tanh(bfhi(g.y))};
            const float mean = wave_sum((x[0] + x[1]) + (x[2] + x[3])) * (1.0f / 256.0f); x = x - mean;
            const float var = wave_sum((x[0] * x[0] + x[1] * x[1]) + (x[2] * x[2] + x[3] * x[3])) * (1.0f / 256.0f);
            const float rstd = __builtin_amdgcn_rsqf(var + LN_EPS); x = x * rstd * nw + nb;
            if ((C.lane >> 4) == hh) { const int d0 = 4 * (C.lane & 15);
#pragma unroll
                for (int q = 0; q < 4; ++q) ZT[(d0 + q) * LDT + r] = (bf16)f2bf(x[q]); } } }
    __syncthreads();
    { const int fr = C.lane & 15, fg = C.lane >> 4, w = C.wave, nk = (w >> 1) + 1;

#pragma unroll
        for (int dt = 0; dt < 4; ++dt) { f32x4 acc = {0.f, 0.f, 0.f, 0.f};
#pragma unroll
            for (int ks = 0; ks < 4; ++ks) if (ks < nk) { const bf16x8 bb = *(const LAS bf16x8*)(ZT + (16 * dt + fr) * LDT + 32 * ks + 8 * fg); acc = mfma16(awm[ks], bb, acc); }
#pragma unroll
            for (int rg = 0; rg < 4; ++rg) OUTS[(16 * w + 4 * fg + rg) * 68 + 16 * dt + fr] = acc[rg]; } }
    __syncthreads();
    { const int r = C.tid >> 2, cg = (C.tid & 3) * 16; const float bsv = bsv0;
        float u[16]; { float tmp[8]; unpack8(gu0, tmp);
#pragma unroll
            for (int j = 0; j < 8; ++j) u[j] = tmp[j];
            unpack8(gu1, tmp);
#pragma unroll
            for (int j = 0; j < 8; ++j) u[8 + j] = tmp[j]; }
        float o[16];
#pragma unroll
        for (int q = 0; q < 4; ++q) { const f32x4 a4 = *(const LAS f32x4*)(OUTS + r * 68 + cg + 4 * q);
#pragma unroll
            for (int j = 0; j < 4; ++j) o[4 * q + j] = gelu_tanh(u[4 * q + j]) * (a4[j] + bsv); }
        v4u w0, w1; w0.x = pk2(o[0], o[1]); w0.y = pk2(o[2], o[3]); w0.z = pk2(o[4], o[5]); w0.w = pk2(o[6], o[7]); w1.x = pk2(o[8], o[9]); w1.y = pk2(o[10], o[11]); w1.z = pk2(o[12], o[13]); w1.w = pk2(o[14], o[15]);
        *(v4u*)(HCAT + (size_t)(t0 + r) * D + 512 + 64 * hh + cg) = w0; *(v4u*)(HCAT + (size_t)(t0 + r) * D + 512 + 64 * hh + cg + 8) = w1; }
    __syncthreads();
}
#if DBG_CHECK
constexpr size_t SM_ERR = WS_CTL + 8192;
DI int slot_of(const Args& A, int l, int t, int k) { const v4u s = ((const v4u*)(A.ws + SM_SEL))[t]; const int e = k ? (int)s.y : (int)s.x; int run = 0;
    for (int q = 0; q < e; ++q) run += (((int)((const unsigned*)(A.ws + WS_CTL))[CW_CNT + (l * 16 + q) * 16] + 255) >> 8) * 256;
    return run + ((const int*)(A.ws + SM_TOKSLOT))[2 * t + k]; }
DI unsigned hsh(unsigned s, unsigned k) { unsigned h = s * 2654435761u + k * 40503u + 12345u; h ^= h >> 15; h *= 2246822519u; h ^= h >> 13; return h; }
DI void err_put(const Args& A, int chk, float ref, float got, float floor_) {
    float e = fabsf(ref - got) / (fabsf(ref) + floor_); if (!(e == e)) e = 1e9f;
    atomicMax((unsigned*)(A.ws + SM_ERR) + chk, __builtin_bit_cast(unsigned, e));
}
DI void chk_gates(const Args& A, const Ctx& C, int l, const float* X) {
    const int gt = C.bid * NTHREADS + C.tid; if (gt >= 2048) return;
    const int t = hsh(gt, 1) % T, g = hsh(gt, 2) % 8; float s = 0.f;
    for (int k = 0; k < D; ++k) s += X[(size_t)t * D + k] * A.in[1][((size_t)l * D + k) * PIN + 2048 + g];
    s += A.in[2][(size_t)l * PIN + 2048 + g];
    err_put(A, 1, s, ((const float*)(A.ws + SM_GATES))[(size_t)t * 8 + g], 0.1f);
}
DI void chk_proj(const Args& A, const Ctx& C, int l) {
    const int gt = C.bid * NTHREADS + C.tid; if (gt >= 8192) return;
    const int t = (gt < 64) ? (gt * 4099) % T : hsh(gt, 3) % T, n = hsh(gt, 4) % NPROJ, ns = n + (n >= 2048 ? 8 : 0);
    const bf16* XN = (const bf16*)(A.ws + WS_XN); float s = 0.f;
    for (int k = 0; k < D; ++k) s += bf2f(XN[(size_t)t * D + k]) * A.in[1][((size_t)l * D + k) * PIN + ns];
    s += A.in[2][(size_t)l * PIN + ns];
    err_put(A, 2, s, bf2f(((const bf16*)(A.ws + WS_PROJ))[(size_t)t * NPROJ + n]), 0.5f);
}
DI void chk_conv(const Args& A, const Ctx& C, int l) {
    const int gw = C.bid * NWAVES + C.wave; if (gw >= 1024) return;
    const int t = (gw < 128) ? (gw * 129) % T : hsh(gw, 5) % T; const bf16* PROJ = (const bf16*)(A.ws + WS_PROJ);
    float cv[4];
#pragma unroll
    for (int q = 0; q < 4; ++q) { const int c = C.lane * 4 + q; float acc = A.in[9][l * 256 + c];
        for (int j = 0; j < 31; ++j) { const int ts = t - 30 + j; if ((ts >> 12) != (t >> 12) || ts < 0) continue;
            const float a = bf2f(PROJ[(size_t)ts * NPROJ + PCA + c]), b = bf2f(PROJ[(size_t)ts * NPROJ + PCB + c]);
            acc += a / (1.0f + expf(-b)) * A.in[8][(size_t)(l * 31 + j) * 256 + c]; }
        cv[q] = acc; }
    const float mean = wave_sum_ref(cv[0] + cv[1] + cv[2] + cv[3]) / 256.0f; float q2 = 0.f;
#pragma unroll
    for (int q = 0; q < 4; ++q) { cv[q] -= mean; q2 += cv[q] * cv[q]; }
    const float rstd = 1.0f / sqrtf(wave_sum_ref(q2) / 256.0f + LN_EPS);
#pragma unroll
    for (int q = 0; q < 4; ++q) { const int c = C.lane * 4 + q; const float y = cv[q] * rstd * A.in[10][l * 256 + c] + A.in[11][l * 256 + c]; const float r = y / (1.0f + expf(-y));
        err_put(A, 3, r, bf2f(((const bf16*)(A.ws + WS_HCAT))[(size_t)t * D + 768 + c]), 0.5f); }
}
DI void chk_gmlp(const Args& A, const Ctx& C, int l) {
    const int gw = C.bid * NWAVES + C.wave; if (gw >= 512) return;
    const int t = (gw < 64) ? (gw * 131 + 127) % T : hsh(gw, 6) % T; const bf16* PROJ = (const bf16*)(A.ws + WS_PROJ);
    const int tc = t & 127, t0 = t - tc, h = C.lane >> 4; float acc[4] = {0.f, 0.f, 0.f, 0.f};
    for (int s = 0; s <= tc; ++s) { float x[4];
#pragma unroll
        for (int q = 0; q < 4; ++q) { const float v = bf2f(PROJ[(size_t)(t0 + s) * NPROJ + PGV + C.lane * 4 + q]); x[q] = 0.5f * v * (1.0f + tanhf(0.7978845608028654f * (v + 0.044715f * v * v * v))); }
        const float mean = wave_sum_ref(x[0] + x[1] + x[2] + x[3]) / 256.0f; float q2 = 0.f;
#pragma unroll
        for (int q = 0; q < 4; ++q) { x[q] -= mean; q2 += x[q] * x[q]; }
        const float rstd = 1.0f / sqrtf(wave_sum_ref(q2) / 256.0f + LN_EPS); const float w = A.in[6][((size_t)(l * 4 + h) * CH + tc) * CH + s];
#pragma unroll
        for (int q = 0; q < 4; ++q) { const int c = C.lane * 4 + q; acc[q] += w * (x[q] * rstd * A.in[4][l * 256 + c] + A.in[5][l * 256 + c]); } }
#pragma unroll
    for (int q = 0; q < 4; ++q) { const int c = C.lane * 4 + q; const float v = bf2f(PROJ[(size_t)t * NPROJ + PGU + c]); const float u = 0.5f * v * (1.0f + tanhf(0.7978845608028654f * (v + 0.044715f * v * v * v)));
        const float r = u * (acc[q] + A.in[7][(size_t)(l * 4 + h) * CH + tc]);
        err_put(A, 4, r, bf2f(((const bf16*)(A.ws + WS_HCAT))[(size_t)t * D + 512 + c]), 0.5f); }
}
DI void chk_mlstm(const Args& A, const Ctx& C, int l) {
    const int gw = C.bid * NWAVES + C.wave; if (gw >= 1024) return;
    const int t = (gw < 64) ? (gw * 521 + (gw & 1) * 127) % T : hsh(gw, 7) % T, h = hsh(gw, 8) & 3; const bf16* PROJ = (const bf16*)(A.ws + WS_PROJ); const float* GATES = (const float*)(A.ws + SM_GATES);
    const int tb = t & ~(SEQ - 1); const int d0 = 2 * C.lane;
    const float q0 = bf2f(PROJ[(size_t)t * NPROJ + PQ + h * 128 + d0]), q1 = bf2f(PROJ[(size_t)t * NPROJ + PQ + h * 128 + d0 + 1]);
    float n0 = 0.f, n1 = 0.f, den = 0.f, F = 0.f;
    for (int s = t; s >= tb; --s) {
        const float k0 = bf2f(PROJ[(size_t)s * NPROJ + PK + h * 128 + d0]), k1 = bf2f(PROJ[(size_t)s * NPROJ + PK + h * 128 + d0 + 1]);
        const float qk = wave_sum_ref(q0 * k0 + q1 * k1) * 0.08838834764831845f;
        const float w = expf(F + GATES[(size_t)s * 8 + h]) * qk;
        n0 += w * bf2f(PROJ[(size_t)s * NPROJ + PV + h * 128 + d0]); n1 += w * bf2f(PROJ[(size_t)s * NPROJ + PV + h * 128 + d0 + 1]); den += w;
        const float fp = GATES[(size_t)s * 8 + 4 + h]; F += fminf(fp, 0.f) - log1pf(expf(-fabsf(fp)));
        if (F < -60.f) break; }
    const float inv = 1.0f / fmaxf(fabsf(den), 1.0f); float x0 = n0 * inv, x1 = n1 * inv;
    const float mean = wave_sum_ref(x0 + x1) / 128.0f; x0 -= mean; x1 -= mean; const float rstd = 1.0f / sqrtf(wave_sum_ref(x0 * x0 + x1 * x1) / 128.0f + 1e-6f);
    const float o0 = bf2f(PROJ[(size_t)t * NPROJ + PO + h * 128 + d0]), o1 = bf2f(PROJ[(size_t)t * NPROJ + PO + h * 128 + d0 + 1]);
    const float r0 = x0 * rstd * A.in[3][(size_t)l * 512 + h * 128 + d0] / (1.0f + expf(-o0)), r1 = x1 * rstd * A.in[3][(size_t)l * 512 + h * 128 + d0 + 1] / (1.0f + expf(-o1));
    const bf16* HC = (const bf16*)(A.ws + WS_HCAT);
    err_put(A, 5, r0, bf2f(HC[(size_t)t * D + h * 128 + d0]), 0.5f); err_put(A, 5, r1, bf2f(HC[(size_t)t * D + h * 128 + d0 + 1]), 0.5f);
}
DI void chk_y(const Args& A, const Ctx& C, int l) {
    const int gt = C.bid * NTHREADS + C.tid; if (gt >= 8192) return;
    const int t = hsh(gt, 9) % T, n = hsh(gt, 10) % D; const bf16* HC = (const bf16*)(A.ws + WS_HCAT); float s = 0.f;
    for (int k = 0; k < D; ++k) s += bf2f(HC[(size_t)t * D + k]) * A.in[12][((size_t)l * D + k) * D + n];
    err_put(A, 6, s, bf2f(((const bf16*)(A.ws + WS_PROJ))[(size_t)t * D + n]), 0.2f);
}
DI void chk_ln1(const Args& A, const Ctx& C, int l, const bf16* X) {
    const int gw = C.bid * NWAVES + C.wave; if (gw >= 2048) return;
    const int t = hsh(gw, 11) % T; const bf16* Y = (const bf16*)(A.ws + WS_PROJ); const bf16* X1 = (const bf16*)(A.ws + WS_XNB);
    float v[16]; float s = 0.f;
#pragma unroll
    for (int i = 0; i < 16; ++i) { const int c = C.lane + 64 * i; v[i] = ALPHA * bf2f(X[(size_t)t * D + c]) + bf2f(Y[(size_t)t * D + c]); s += v[i]; }
    const float mean = wave_sum_ref(s) / D; float q2 = 0.f;
#pragma unroll
    for (int i = 0; i < 16; ++i) { v[i] -= mean; q2 += v[i] * v[i]; }
    const float rstd = 1.0f / sqrtf(wave_sum_ref(q2) / D + LN_EPS);
#pragma unroll
    for (int i = 0; i < 16; ++i) { const int c = C.lane + 64 * i; v[i] = v[i] * rstd * A.in[13][(size_t)l * D + c] + A.in[14][(size_t)l * D + c]; }
    err_put(A, 7, v[3], bf2f(X1[(size_t)t * D + C.lane + 192]), 1.0f);
    float sel[16], sg[16];
#pragma unroll
    for (int e = 0; e < 16; ++e) { float p = 0.f;
#pragma unroll
        for (int i = 0; i < 16; ++i) p += v[i] * A.in[15][(size_t)(C.lane + 64 * i) * 16 + e];
        p = wave_sum_ref(p); sg[e] = 1.0f / (1.0f + expf(-p)); sel[e] = sg[e] + A.in[16][e]; }
    float bestg = -INFINITY; int bg = 0;
#pragma unroll
    for (int g = 0; g < 4; ++g) { float a = sel[4 * g], b = sel[4 * g + 1], c = sel[4 * g + 2], d = sel[4 * g + 3];
        float m1 = fmaxf(fmaxf(a, b), fmaxf(c, d)); float tot = a + b + c + d; float mn = fminf(fminf(a, b), fminf(c, d));
        float lo1 = fminf(a, b), hi1 = fmaxf(a, b), lo2 = fminf(c, d), hi2 = fmaxf(c, d); float second = fmaxf(fminf(hi1, hi2), fmaxf(lo1, lo2)); (void)tot; (void)mn;
        const float gs = m1 + second; if (gs > bestg) { bestg = gs; bg = g; } }
    int e0 = -1, e1 = -1; float m1 = -INFINITY, m2 = -INFINITY;
#pragma unroll
    for (int e = 0; e < 16; ++e) if ((e >> 2) == bg && sel[e] > m1) { m1 = sel[e]; e0 = e; }
#pragma unroll
    for (int e = 0; e < 16; ++e) if ((e >> 2) == bg && e != e0 && sel[e] > m2) { m2 = sel[e]; e1 = e; }
    const v4u got = ((const v4u*)(A.ws + SM_SEL))[t];
    if (C.lane == 0 && ((int)got.x != e0 || (int)got.y != e1)) atomicAdd((unsigned*)(A.ws + SM_ERR) + 8, 1u);
}
DI void chk_hid(const Args& A, const Ctx& C, int l) {
    const int gt = C.bid * NTHREADS + C.tid; if (gt >= 8192) return;
    const int t = hsh(gt, 12) % T, k = hsh(gt, 13) & 1, j = hsh(gt, 14) % DEXP; const v4u s = ((const v4u*)(A.ws + SM_SEL))[t]; const int e = k ? (int)s.y : (int)s.x; const int p = slot_of(A, l, t, k);
    const bf16* XN = (const bf16*)(A.ws + WS_XNB); float g = 0.f, u = 0.f;
    for (int c = 0; c < D; ++c) { const float x = bf2f(XN[(size_t)t * D + c]); g += x * A.in[17][((size_t)(l * NEXP + e) * D + c) * DEXP + j]; u += x * A.in[18][((size_t)(l * NEXP + e) * D + c) * DEXP + j]; }
    err_put(A, 9, g / (1.0f + expf(-g)) * u, bf2f(((const bf16*)(A.ws + WS_HID))[(size_t)p * DEXP + j]), 0.5f);
    if (p < 0 || p >= PADROWS) atomicAdd((unsigned*)(A.ws + SM_ERR) + 11, 1u);
}
DI void chk_yp(const Args& A, const Ctx& C, int l) {
    const int gt = C.bid * NTHREADS + C.tid; if (gt >= 8192) return;
    const int t = hsh(gt, 15) % T, k = hsh(gt, 16) & 1, n = hsh(gt, 17) % D; const v4u s = ((const v4u*)(A.ws + SM_SEL))[t]; const int e = k ? (int)s.y : (int)s.x; const int p = slot_of(A, l, t, k);
    const bf16* HID = (const bf16*)(A.ws + WS_HID); float y = 0.f;
    for (int j = 0; j < DEXP; ++j) y += bf2f(HID[(size_t)p * DEXP + j]) * A.in[19][((size_t)(l * NEXP + e) * DEXP + j) * D + n];
    err_put(A, 10, y, bf2f(((const bf16*)(A.ws + WS_PROJ))[(size_t)p * D + n]), 0.2f);
}
DI void chk_out(const Args& A, const Ctx& C, int l) {
    const int gw = C.bid * NWAVES + C.wave; if (gw >= 2048) return;
    const int t = hsh(gw, 18) % T; const bf16* X1 = (const bf16*)(A.ws + WS_XNB); const bf16* YP = (const bf16*)(A.ws + WS_PROJ);
    const v4u s = ((const v4u*)(A.ws + SM_SEL))[t]; const int p0 = slot_of(A, l, t, 0), p1 = slot_of(A, l, t, 1);
    const f32x2 gw2 = ((const f32x2*)(A.ws + SM_GW))[t]; const float g0 = gw2[0], g1 = gw2[1];
    float v[16]; float sm = 0.f;
#pragma unroll
    for (int i = 0; i < 16; ++i) { const int c = C.lane + 64 * i; v[i] = ALPHA * bf2f(X1[(size_t)t * D + c]) + g0 * bf2f(YP[(size_t)p0 * D + c]) + g1 * bf2f(YP[(size_t)p1 * D + c]); sm += v[i]; }
    { float sy = 0.f, sx = 0.f;
#pragma unroll
      for (int i = 0; i < 16; ++i) { const int c = C.lane + 64 * i; const float yy = g0 * bf2f(YP[(size_t)p0 * D + c]) + g1 * bf2f(YP[(size_t)p1 * D + c]); const float xx = ALPHA * bf2f(X1[(size_t)t * D + c]); sy += yy * yy; sx += xx * xx; }
      sy = wave_sum_ref(sy); sx = wave_sum_ref(sx); const float ratio = sqrtf(sy / sx);
      if (C.lane == 0) atomicMax((unsigned*)(A.ws + SM_ERR) + 20, __builtin_bit_cast(unsigned, ratio));
      float sxn = 0.f, shid = 0.f, syp = 0.f; const bf16* XNb = (const bf16*)(A.ws + WS_XN); const bf16* HIDb = (const bf16*)(A.ws + WS_HID);
#pragma unroll
      for (int i = 0; i < 16; ++i) { const int c = C.lane + 64 * i; const float a = bf2f(YP[(size_t)p0 * D + c]); syp += a * a; }
#pragma unroll
      for (int i = 0; i < 8; ++i) { const int c = C.lane + 64 * i; const float a = bf2f(HIDb[(size_t)p0 * DEXP + c]); shid += a * a; }
      syp = sqrtf(wave_sum_ref(syp) / D); shid = sqrtf(wave_sum_ref(shid) / DEXP);
      if (C.lane == 0) { atomicMax((unsigned*)(A.ws + SM_ERR) + 21, __builtin_bit_cast(unsigned, syp)); atomicMax((unsigned*)(A.ws + SM_ERR) + 22, __builtin_bit_cast(unsigned, shid)); atomicMax((unsigned*)(A.ws + SM_ERR) + 23, __builtin_bit_cast(unsigned, g0 + g1)); atomicMax((unsigned*)(A.ws + SM_ERR) + 24, s.z); atomicMax((unsigned*)(A.ws + SM_ERR) + 25, s.w); atomicMax((unsigned*)(A.ws + SM_ERR) + 26, s.x); } }
    const float mean = wave_sum_ref(sm) / D; float q2 = 0.f;
#pragma unroll
    for (int i = 0; i < 16; ++i) { v[i] -= mean; q2 += v[i] * v[i]; }
    const float rstd = 1.0f / sqrtf(wave_sum_ref(q2) / D + LN_EPS);
    const int c = C.lane + 64 * 5; const float r = v[5] * rstd * A.in[20][(size_t)l * D + c] + A.in[21][(size_t)l * D + c];
    err_put(A, 12, r, (l == NLAYER - 1) ? A.out[(size_t)t * D + c] : bf2f(((const bf16*)(A.ws + WS_XN))[(size_t)t * D + c]), 1.0f);
}
DI void probe_gates(const Args& A, const Ctx& C, int slot) {
    const int gt = C.bid * NTHREADS + C.tid; if (gt >= 4096) return;
    const int t = hsh(gt, 30) % T; const v4u s = ((const v4u*)(A.ws + SM_SEL))[t];
    const f32x2 gw2 = ((const f32x2*)(A.ws + SM_GW))[t];
    atomicMax((unsigned*)(A.ws + SM_ERR) + slot, __builtin_bit_cast(unsigned, gw2[0] + gw2[1]));
    { const float sm = gw2[0] + gw2[1]; if (!(fabsf(sm - 1.0f) < 1e-3f)) atomicAdd((unsigned*)(A.ws + SM_ERR) + slot + 8, 1u); }
}
DI void dbg_finish(const Args& A, const Ctx& C) {
    const unsigned* E = (const unsigned*)(A.ws + SM_ERR);
    const float tol[13] = {0, 1e-3f, 0.03f, 0.04f, 0.04f, 0.08f, 0.03f, 0.01f, 0, 0.04f, 0.04f, 0, 0.01f};
    int code = 0;
#pragma unroll
    for (int k = 12; k >= 1; --k) { bool bad;
        if (k == 8) bad = E[8] > 20u; else if (k == 11) bad = E[11] > 0u; else bad = __builtin_bit_cast(float, E[k]) > tol[k];
        if (bad) code = k; }
    const float cv = (float)(code + DBG_BIAS);
    for (size_t i = (size_t)C.bid * NTHREADS + C.tid; i < (size_t)T * D; i += (size_t)GRID * NTHREADS) A.out[i] = cv;
}
#endif
__global__ void __launch_bounds__(NTHREADS, 2) fwd_kernel(Args A0) {
    extern __shared__ __attribute__((aligned(16))) unsigned char lds_raw[];
    Ctx CK; CK.lds = (LAS unsigned char*)lds_raw; CK.tid = threadIdx.x; CK.lane = CK.tid & 63; CK.wave = __builtin_amdgcn_readfirstlane(CK.tid >> 6); CK.bid = blockIdx.x;
    for (int u = CK.tid; u < (LDS_BYTES - LDSCTL_OFF) / 4; u += NTHREADS) ((LAS unsigned*)(CK.lds + LDSCTL_OFF))[u] = 0u;
    __syncthreads();
    unsigned* ctl = (unsigned*)(A0.ws + WS_CTL);
    XcdBarrier bar = xcd_barrier_post(ctl + CW_BAR, (volatile LAS unsigned*)(CK.lds + MISC_OFF) + 8);
#define GRID_BAR() xcd_barrier<false>(bar)
#if DBG_TIME
#define TS(k) do { if (l == TIME_LAYER && CK.bid == 0 && CK.tid == 0) ((unsigned long long*)(A0.ws + WS_CTL + 12288))[k] = __builtin_amdgcn_s_memrealtime(); } while (0)
#else
#define TS(k) do { } while (0)
#endif
#define FRESH() Args A; { int z_ = 0; asm volatile("" : "+s"(z_)); _Pragma("unroll") for (int k_ = 0; k_ < 22; ++k_) A.in[k_] = A0.in[k_] + z_; A.out = A0.out + z_; A.ws = A0.ws + z_; } const Ctx C = fresh_ctx(CK)
    { FRESH(); phase_prologue_rows(A, C); }
    xcd_barrier<true>(bar);
#if DBG_CHECK
    if (DBG_LAYER == 0) { FRESH(); chk_gates(A, C, 0, A.in[0]); }
#endif
    for (int l = 0; l < NLAYER_RUN; ++l) {
        TS(0);
        if (l == 0) { { FRESH(); phase_convert(A, C, 0); } GRID_BAR(); }
        TS(1);

        {
            FRESH(); pg8::Gemm g{(const pg8::bf16_t*)(A.ws + WS_XN), (const pg8::bf16_t*)(A.ws + WS_WIN), T, NPROJ, D}; pg8::StaticOrder S; S.init(T, NPROJ, GRID, C.bid);
            pg8::EpiStoreBf16 E{(pg8::bf16_t*)(A.ws + WS_PROJ), NPROJ, (const float*)(A.ws + SM_BIAS), 0xffff};
            pg8::gemm_phase<pg8::EpiStoreBf16, pg8::StaticOrder, true, true>(C.lds, g, S, E);
        }
        GRID_BAR(); TS(2);
#if DUP_G1
        {
            FRESH(); pg8::Gemm g{(const pg8::bf16_t*)(A.ws + WS_XN), (const pg8::bf16_t*)(A.ws + WS_WIN), T, NPROJ, D}; pg8::StaticOrder S; S.init(T, NPROJ, GRID, C.bid);
            pg8::EpiStoreBf16 E{(pg8::bf16_t*)(A.ws + WS_PROJ), NPROJ, (const float*)(A.ws + SM_BIAS), 0xffff};
            pg8::gemm_phase<pg8::EpiStoreBf16, pg8::StaticOrder, true, true>(C.lds, g, S, E);
        }
        GRID_BAR(); TS(2);
#endif
#if DBG_CHECK
        if (l == DBG_LAYER) { FRESH(); chk_proj(A, C, l); }
#endif
        { FRESH(); for (int un = C.bid; un < NUNIT; un += GRID) mlstm_local_mfma(A, C, un); } TS(3);
#if DUP_LOCAL
        { FRESH(); for (int un = C.bid; un < NUNIT; un += GRID) mlstm_local_mfma(A, C, un); } TS(3);
#endif
        { FRESH(); if (C.bid < 128) gmlp_chunk_mfma(A, C, l, C.bid); } TS(4);
#if DUP_GMLP
        { FRESH(); if (C.bid < 128) gmlp_chunk_mfma(A, C, l, C.bid); } TS(4);
#endif
        { FRESH(); if (C.bid < 128) conv_unit(A, C, l, C.bid); else { for (int q = 0; q < 3; ++q) conv_unit(A, C, l, 128 + (C.bid - 128) * 3 + q); } }
#if DUP_CONVU
        { FRESH(); if (C.bid < 128) conv_unit(A, C, l, C.bid); else { for (int q = 0; q < 3; ++q) conv_unit(A, C, l, 128 + (C.bid - 128) * 3 + q); } }
#endif
        GRID_BAR(); TS(5);
#if DUP_P2
        { FRESH(); for (int un = C.bid; un < NUNIT; un += GRID) mlstm_local_mfma(A, C, un); } TS(3);
        { FRESH(); if (C.bid < 128) gmlp_chunk_mfma(A, C, l, C.bid); } TS(4);
        { FRESH(); if (C.bid < 128) conv_unit(A, C, l, C.bid); else { for (int q = 0; q < 3; ++q) conv_unit(A, C, l, 128 + (C.bid - 128) * 3 + q); } }
        GRID_BAR(); TS(5);
#endif

        { FRESH(); phase_scan(A, C); }
        GRID_BAR(); TS(6);
#if DUP_SCAN
        { FRESH(); phase_scan(A, C); }
        GRID_BAR(); TS(6);
#endif

        { FRESH(); for (int un = C.bid; un < NUNIT; un += GRID) mlstm_out_mfma(A, C, l, un); }
        GRID_BAR(); TS(7);
#if DUP_P4
        { FRESH(); for (int un = C.bid; un < NUNIT; un += GRID) mlstm_out_mfma(A, C, l, un); }
        GRID_BAR(); TS(7);
#endif

#if DBG_CHECK
        if (l == DBG_LAYER) { FRESH(); chk_conv(A, C, l); chk_gmlp(A, C, l); chk_mlstm(A, C, l); GRID_BAR(); }
#endif
        {
            FRESH(); pg8::Gemm g{(const pg8::bf16_t*)(A.ws + WS_HCAT), (const pg8::bf16_t*)(A.ws + WS_WOUT), T, D, D}; pg8::StaticOrder S; S.init(T, D, GRID, C.bid);
            pg8::EpiStoreBf16 E{(pg8::bf16_t*)(A.ws + WS_PROJ), D, nullptr, 0xffff};
            pg8::gemm_phase<pg8::EpiStoreBf16, pg8::StaticOrder, true, true>(C.lds, g, S, E);
        }
        GRID_BAR(); TS(8);
#if DUP_G5
        {
            FRESH(); pg8::Gemm g{(const pg8::bf16_t*)(A.ws + WS_HCAT), (const pg8::bf16_t*)(A.ws + WS_WOUT), T, D, D}; pg8::StaticOrder S; S.init(T, D, GRID, C.bid);
            pg8::EpiStoreBf16 E{(pg8::bf16_t*)(A.ws + WS_PROJ), D, nullptr, 0xffff};
            pg8::gemm_phase<pg8::EpiStoreBf16, pg8::StaticOrder, true, true>(C.lds, g, S, E);
        }
        GRID_BAR(); TS(8);
#endif
#if DBG_CHECK
        if (l == DBG_LAYER) { FRESH(); chk_y(A, C, l); GRID_BAR(); }
#endif
        for (int rep = (DUP_P6 ? 0 : 1); rep < 2; ++rep) { FRESH(); phase_ln1_router(A, C, l, rep == 0); GRID_BAR(); }
        TS(9);

#if DBG_CHECK
        if (l == DBG_LAYER) { FRESH(); chk_ln1(A, C, l, (const bf16*)(A.ws + WS_XN)); probe_gates(A, C, 27); GRID_BAR(); }
#endif


        {
            FRESH(); PG8_LAS int* desc = (PG8_LAS int*)(C.lds + VEC_OFF); const int cperm = (C.bid & 7) * 32 + (C.bid >> 3);     pg8::moe_units(desc, (const unsigned*)(A.ws + WS_CTL) + CW_CNT + l * 256, GRID, cperm);
            pg8::MoeOrder<true> S{desc, (const int*)(A.ws + WS_LIST), GRID, cperm, D * 2};
            pg8::Gemm g{(const pg8::bf16_t*)(A.ws + WS_XNB), (const pg8::bf16_t*)(A.ws + wgu_off(l)), PADROWS, NEXP * 1024, D};
            pg8::EpiSwiGLU E{(pg8::bf16_t*)(A.ws + WS_HID), DEXP};
            pg8::gemm_phase<pg8::EpiSwiGLU, pg8::MoeOrder<true>, true, true>(C.lds, g, S, E);
            if (l + 1 < NLAYER) convert_in_tail(A, C, l + 1, 0, CV_SPLIT, (const unsigned*)(A.ws + WS_CTL) + CW_CNT + l * 256, cperm);
        }
        GRID_BAR(); TS(11);
#if DUP_G8
        {
            FRESH(); PG8_LAS int* desc = (PG8_LAS int*)(C.lds + VEC_OFF); const int cperm = (C.bid & 7) * 32 + (C.bid >> 3);     pg8::moe_units(desc, (const unsigned*)(A.ws + WS_CTL) + CW_CNT + l * 256, GRID, cperm);
            pg8::MoeOrder<true> S{desc, (const int*)(A.ws + WS_LIST), GRID, cperm, D * 2};
            pg8::Gemm g{(const pg8::bf16_t*)(A.ws + WS_XNB), (const pg8::bf16_t*)(A.ws + wgu_off(l)), PADROWS, NEXP * 1024, D};
            pg8::EpiSwiGLU E{(pg8::bf16_t*)(A.ws + WS_HID), DEXP};
            pg8::gemm_phase<pg8::EpiSwiGLU, pg8::MoeOrder<true>, true, true>(C.lds, g, S, E);
        }
        GRID_BAR(); TS(11);
#endif
#if DBG_CHECK
        if (l == DBG_LAYER) { FRESH(); chk_hid(A, C, l); probe_gates(A, C, 29); }
#endif
        {
            FRESH(); PG8_LAS int* desc = (PG8_LAS int*)(C.lds + VEC_OFF); const int cperm = (C.bid & 7) * 32 + (C.bid >> 3);     pg8::moe_units(desc, (const unsigned*)(A.ws + WS_CTL) + CW_CNT + l * 256, GRID, cperm);
            pg8::MoeOrder<false> S{desc, (const int*)(A.ws + WS_LIST), GRID, cperm, 0};
            pg8::Gemm g{(const pg8::bf16_t*)(A.ws + WS_HID), (const pg8::bf16_t*)(A.ws + wd_off(l)), PADROWS, NEXP * 1024, DEXP};
            pg8::EpiStoreBf16 E{(pg8::bf16_t*)(A.ws + WS_PROJ), D, nullptr, 3};
            pg8::gemm_phase<pg8::EpiStoreBf16, pg8::MoeOrder<false>, true, true>(C.lds, g, S, E);
            if (l + 1 < NLAYER) convert_in_tail(A, C, l + 1, CV_SPLIT, CV_ITEMS, (const unsigned*)(A.ws + WS_CTL) + CW_CNT + l * 256, cperm);
        }
        GRID_BAR(); TS(12);
#if DUP_G9
        {
            FRESH(); PG8_LAS int* desc = (PG8_LAS int*)(C.lds + VEC_OFF); const int cperm = (C.bid & 7) * 32 + (C.bid >> 3);     pg8::moe_units(desc, (const unsigned*)(A.ws + WS_CTL) + CW_CNT + l * 256, GRID, cperm);
            pg8::MoeOrder<false> S{desc, (const int*)(A.ws + WS_LIST), GRID, cperm, 0};
            pg8::Gemm g{(const pg8::bf16_t*)(A.ws + WS_HID), (const pg8::bf16_t*)(A.ws + wd_off(l)), PADROWS, NEXP * 1024, DEXP};
            pg8::EpiStoreBf16 E{(pg8::bf16_t*)(A.ws + WS_PROJ), D, nullptr, 3};
            pg8::gemm_phase<pg8::EpiStoreBf16, pg8::MoeOrder<false>, true, true>(C.lds, g, S, E);
        }
        GRID_BAR(); TS(12);
#endif
#if DBG_CHECK
        if (l == DBG_LAYER) { FRESH(); chk_yp(A, C, l); probe_gates(A, C, 30); }
#endif
        { FRESH(); phase_combine(A, C, l); }
        GRID_BAR(); TS(13);
#if DUP_P10
        { FRESH(); phase_combine(A, C, l); }
        GRID_BAR(); TS(13);
#endif

#if DBG_CHECK
        if (l == DBG_LAYER) { FRESH(); chk_out(A, C, l);  GRID_BAR(); }
#endif
    }
#if DBG_CHECK
    { FRESH(); dbg_finish(A, C); }
#endif
#if DBG_TIME
    { FRESH(); const unsigned long long* tsb = (const unsigned long long*)(A.ws + WS_CTL + 12288);
      const float c1 = floorf(((float)(tsb[TIME_A] - tsb[TIME_A - 1]) + TIME_OFF * 100.0f) * (1.0f / 1600.0f));
      for (size_t i = (size_t)C.bid * NTHREADS + C.tid; i < (size_t)T * D; i += (size_t)GRID * NTHREADS) A.out[i] = c1; }
#endif
}

extern "C" void kernel_launch(void* const* d_in, const int* in_sizes, int n_in, void* d_out, int out_size, void* d_ws, size_t ws_size, hipStream_t stream) {
    static int ready = 0;
    if (ready == 0) {
        if (n_in != 22 || in_sizes[0] != T * D || out_size != T * D || ws_size < WS_END) { fprintf(stderr, "kernel_launch: unexpected shapes (n_in %d, in0 %d, out %d, ws %zu)\n", n_in, n_in > 0 ? in_sizes[0] : -1, out_size, ws_size); ready = -1; return; }
        if (hipFuncSetAttribute((const void*)fwd_kernel, hipFuncAttributeMaxDynamicSharedMemorySize, LDS_BYTES) != hipSuccess) { fprintf(stderr, "kernel_launch: hipFuncSetAttribute failed\n"); ready = -1; return; }
        (void)hipGetLastError();
        ready = 1;
    }
    if (ready < 0) return;
    if (hipMemsetAsync((char*)d_ws + WS_CTL, 0, CTL_ZERO_BYTES, stream) != hipSuccess) return;
    Args a{};
    for (int i = 0; i < 22; ++i) a.in[i] = (const float*)d_in[i];
    a.out = (float*)d_out; a.ws = (unsigned char*)d_ws;
    hipLaunchKernelGGL(fwd_kernel, dim3(GRID), dim3(NTHREADS), LDS_BYTES, stream, a);
}
```
